# Optimizing an MI355X kernel written in HIP

```python
import math
import jax, jax.numpy as jnp
from jax import lax
import numpy as np

D_MODEL = 2048
BATCH = 4
SEQ = 4096
DEPTH = 1

HEAD_DIM = 128
N_NSA_HEADS = 8
N_NSA_KV = 2
NSA_GROUP = N_NSA_HEADS // N_NSA_KV
N_SB_HEADS = 8
CMP_BLOCK = 32
CMP_STRIDE = 16
CMP_HIDDEN = 256
SLC_BLOCK = 64
N_SELECT = 16
WINDOW = 512
Q_BLOCK = 128
SLC_Q_CHUNK = 64
D_FF = 5632
ROPE_THETA = 10000.0
EPS = 1e-6
NEG_INF = -1e30
FORCE_SCORE = 1e9

kernel_name = "hybrid_nsa_stickbreaking_macaron"


def rms_norm(x, g):
    xf = x.astype(jnp.float32)
    y = xf * lax.rsqrt(jnp.mean(xf * xf, axis=-1, keepdims=True) + EPS)
    return (y * g.astype(jnp.float32)).astype(x.dtype)


def apply_rope(x, cos, sin):
    x1, x2 = jnp.split(x, 2, axis=-1)
    return jnp.concatenate([x1 * cos - x2 * sin, x2 * cos + x1 * sin], axis=-1)


def swiglu(x, w_gate, w_up, w_down):
    return (jax.nn.silu(x @ w_gate) * (x @ w_up)) @ w_down


def compress_blocks(t, pos, w1, w2):
    b, s, g, d = t.shape
    n_cmp = (s - CMP_BLOCK) // CMP_STRIDE + 1
    idx = jnp.arange(n_cmp)[:, None] * CMP_STRIDE + jnp.arange(CMP_BLOCK)[None, :]
    blocks = t[:, idx] + pos[None, None, :, None, :]
    blocks = blocks.transpose(0, 1, 3, 2, 4).reshape(b, n_cmp, g, CMP_BLOCK * d)
    return jax.nn.gelu(blocks @ w1) @ w2


def nsa_attention(q, kc, vc, k_slc, v_slc, k_win, v_win, gates):
    b, s, h, d = q.shape
    g, r = N_NSA_KV, NSA_GROUP
    scale = d ** -0.5
    t = jnp.arange(s)
    qg = q.reshape(b, s, g, r, d).transpose(0, 2, 3, 1, 4)

    n_cmp = kc.shape[1]
    sc = jnp.einsum('bgrtd,bngd->bgrtn', qg, kc, preferred_element_type=jnp.float32) * scale
    blk_end = jnp.arange(n_cmp) * CMP_STRIDE + CMP_BLOCK - 1
    cvalid = blk_end[None, :] <= t[:, None]
    pc = jax.nn.softmax(jnp.where(cvalid, sc, NEG_INF), axis=-1)
    pc = jnp.where(cvalid, pc, 0.0)
    o_cmp = jnp.einsum('bgrtn,bngd->bgrtd', pc.astype(vc.dtype), vc)

    n_slc = s // SLC_BLOCK
    ratio = SLC_BLOCK // CMP_STRIDE
    span = CMP_BLOCK // CMP_STRIDE
    imp = pc.sum(axis=2)
    pad_front = span - 1
    pad_back = max(ratio * n_slc + span - 1 - (n_cmp + pad_front), 0)
    imp = jnp.pad(imp, ((0, 0), (0, 0), (0, 0), (pad_front, pad_back)))
    p_slc = imp[..., 0:ratio * n_slc:ratio]
    for off in range(1, ratio + span - 1):
        p_slc = p_slc + imp[..., off:off + ratio * n_slc:ratio]
    blk = jnp.arange(n_slc)
    cur = t // SLC_BLOCK
    forced = (blk[None, :] == 0) | (blk[None, :] == cur[:, None]) | (blk[None, :] == cur[:, None] - 1)
    causal_ok = blk[None, :] * SLC_BLOCK <= t[:, None]
    score = jnp.where(causal_ok, jnp.where(forced, FORCE_SCORE, p_slc), NEG_INF)
    n_top = min(N_SELECT, n_slc)
    _, sel = lax.top_k(score, n_top)

    kb = k_slc.reshape(b, n_slc, SLC_BLOCK, g, d).transpose(0, 3, 1, 2, 4)
    vb = v_slc.reshape(b, n_slc, SLC_BLOCK, g, d).transpose(0, 3, 1, 2, 4)
    nc = s // SLC_Q_CHUNK
    q_c = qg.reshape(b, g, r, nc, SLC_Q_CHUNK, d).transpose(3, 0, 1, 2, 4, 5)
    sel_c = sel.reshape(b, g, nc, SLC_Q_CHUNK, n_top).transpose(2, 0, 1, 3, 4)
    t_c = t.reshape(nc, SLC_Q_CHUNK)
    bi = jnp.arange(b)[:, None, None, None]
    gi = jnp.arange(g)[None, :, None, None]

    def slc_chunk(args):
        qb, ib, tb = args
        kg = kb[bi, gi, ib]
        vg = vb[bi, gi, ib]
        sc_ = jnp.einsum('bgrqd,bgqnld->bgrqnl', qb, kg, preferred_element_type=jnp.float32) * scale
        kpos = ib[..., None] * SLC_BLOCK + jnp.arange(SLC_BLOCK)
        mask = (kpos <= tb[None, None, :, None, None])[:, :, None]
        sc_ = jnp.where(mask, sc_, NEG_INF).reshape(b, g, r, SLC_Q_CHUNK, n_top * SLC_BLOCK)
        p = jax.nn.softmax(sc_, axis=-1).reshape(b, g, r, SLC_Q_CHUNK, n_top, SLC_BLOCK)
        return jnp.einsum('bgrqnl,bgqnld->bgrqd', p.astype(vg.dtype), vg)

    o_slc = lax.map(slc_chunk, (q_c, sel_c, t_c))
    o_slc = o_slc.transpose(1, 2, 3, 0, 4, 5).reshape(b, g, r, s, d)

    nq = s // Q_BLOCK
    span_w = WINDOW + Q_BLOCK
    widx = jnp.arange(nq)[:, None] * Q_BLOCK + jnp.arange(span_w)[None, :]
    kpad = jnp.pad(k_win, ((0, 0), (WINDOW, 0), (0, 0), (0, 0)))
    vpad = jnp.pad(v_win, ((0, 0), (WINDOW, 0), (0, 0), (0, 0)))
    kw = kpad[:, widx].transpose(0, 3, 1, 2, 4)
    vw = vpad[:, widx].transpose(0, 3, 1, 2, 4)
    qw = qg.reshape(b, g, r, nq, Q_BLOCK, d)
    sw = jnp.einsum('bgriqd,bgikd->bgriqk', qw, kw, preferred_element_type=jnp.float32) * scale
    kpos = widx - WINDOW
    diff = t.reshape(nq, Q_BLOCK)[:, :, None] - kpos[:, None, :]
    wmask = (kpos[:, None, :] >= 0) & (diff >= 0) & (diff < WINDOW)
    pw = jax.nn.softmax(jnp.where(wmask, sw, NEG_INF), axis=-1)
    o_win = jnp.einsum('bgriqk,bgikd->bgriqd', pw.astype(vw.dtype), vw).reshape(b, g, r, s, d)

    gt = jax.nn.sigmoid(gates.astype(jnp.float32)).astype(q.dtype)
    gt = gt.reshape(b, s, g, r, 3).transpose(0, 2, 3, 1, 4)
    o = gt[..., 0:1] * o_cmp + gt[..., 1:2] * o_slc + gt[..., 2:3] * o_win
    return o.transpose(0, 3, 1, 2, 4).reshape(b, s, h, d)


def stick_breaking_attention(q, k, v):
    b, s, h, d = q.shape
    scale = d ** -0.5
    qh, kh, vh = (a.transpose(0, 2, 1, 3) for a in (q, k, v))
    nq = s // Q_BLOCK
    q_c = qh.reshape(b, h, nq, Q_BLOCK, d).transpose(2, 0, 1, 3, 4)
    t_c = jnp.arange(s).reshape(nq, Q_BLOCK)
    kpos = jnp.arange(s)

    def sb_block(args):
        qb, tb = args
        z = jnp.einsum('bhqd,bhkd->bhqk', qb, kh, preferred_element_type=jnp.float32) * scale
        mask = kpos[None, :] < tb[:, None]
        log_keep = jnp.where(mask, jax.nn.log_sigmoid(-z), 0.0)
        after = lax.cumsum(log_keep, axis=3, reverse=True) - log_keep
        a = jnp.where(mask, jnp.exp(jax.nn.log_sigmoid(z) + after), 0.0)
        return jnp.einsum('bhqk,bhkd->bhqd', a.astype(vh.dtype), vh)

    o = lax.map(sb_block, (q_c, t_c))
    return o.transpose(1, 0, 3, 2, 4).reshape(b, s, h, d)


def setup_inputs(seed: int = 0) -> dict:
    key = jax.random.key(seed)
    ks = jax.random.split(key, 32)
    f32 = jnp.float32
    L = DEPTH
    hd = HEAD_DIM
    kv = N_NSA_KV * hd
    in_cols = N_NSA_HEADS * hd + 6 * kv + N_NSA_HEADS * 3 + 3 * N_SB_HEADS * hd
    mix = (N_NSA_HEADS + N_SB_HEADS) * hd

    def nrm(k, shape, fan_in):
        return jax.random.normal(k, shape, f32) * (fan_in ** -0.5)

    def gain(k, shape):
        return 1.0 + 0.1 * jax.random.normal(k, shape, f32)

    return {
        "x": jax.random.normal(ks[0], (BATCH, SEQ, D_MODEL), f32),
        "positions": jnp.broadcast_to(jnp.arange(SEQ, dtype=jnp.int32)[None, :], (BATCH, SEQ)),
        "ffn1_norm": gain(ks[1], (L, D_MODEL)),
        "ffn1_w_gate": nrm(ks[2], (L, D_MODEL, D_FF), D_MODEL),
        "ffn1_w_up": nrm(ks[3], (L, D_MODEL, D_FF), D_MODEL),
        "ffn1_w_down": nrm(ks[4], (L, D_FF, D_MODEL), D_FF),
        "mix_norm": gain(ks[5], (L, D_MODEL)),
        "w_in": nrm(ks[6], (L, D_MODEL, in_cols), D_MODEL),
        "nsa_q_norm": gain(ks[7], (L, hd)),
        "nsa_k_cmp_norm": gain(ks[8], (L, hd)),
        "nsa_k_slc_norm": gain(ks[9], (L, hd)),
        "nsa_k_win_norm": gain(ks[10], (L, hd)),
        "cmp_k_pos": 0.1 * jax.random.normal(ks[11], (L, CMP_BLOCK, hd), f32),
        "cmp_k_w1": nrm(ks[12], (L, CMP_BLOCK * hd, CMP_HIDDEN), CMP_BLOCK * hd),
        "cmp_k_w2": nrm(ks[13], (L, CMP_HIDDEN, hd), CMP_HIDDEN),
        "cmp_v_pos": 0.1 * jax.random.normal(ks[14], (L, CMP_BLOCK, hd), f32),
        "cmp_v_w1": nrm(ks[15], (L, CMP_BLOCK * hd, CMP_HIDDEN), CMP_BLOCK * hd),
        "cmp_v_w2": nrm(ks[16], (L, CMP_HIDDEN, hd), CMP_HIDDEN),
        "nsa_out_norm": gain(ks[17], (L, N_NSA_HEADS, hd)),
        "sb_out_norm": gain(ks[18], (L, N_SB_HEADS, hd)),
        "w_out": nrm(ks[19], (L, mix, D_MODEL), mix),
        "ffn2_norm": gain(ks[20], (L, D_MODEL)),
        "ffn2_w_gate": nrm(ks[21], (L, D_MODEL, D_FF), D_MODEL),
        "ffn2_w_up": nrm(ks[22], (L, D_MODEL, D_FF), D_MODEL),
        "ffn2_w_down": nrm(ks[23], (L, D_FF, D_MODEL), D_FF),
    }


def reference(x, positions, ffn1_norm, ffn1_w_gate, ffn1_w_up, ffn1_w_down, mix_norm, w_in,
              nsa_q_norm, nsa_k_cmp_norm, nsa_k_slc_norm, nsa_k_win_norm,
              cmp_k_pos, cmp_k_w1, cmp_k_w2, cmp_v_pos, cmp_v_w1, cmp_v_w2,
              nsa_out_norm, sb_out_norm, w_out, ffn2_norm, ffn2_w_gate, ffn2_w_up, ffn2_w_down):
    b, s, _ = x.shape
    hd = HEAD_DIM
    kv = N_NSA_KV * hd
    sizes = [N_NSA_HEADS * hd, kv, kv, kv, kv, kv, kv, N_NSA_HEADS * 3,
             N_SB_HEADS * hd, N_SB_HEADS * hd, N_SB_HEADS * hd]
    split_at = np.cumsum(sizes)[:-1].tolist()

    inv_freq = ROPE_THETA ** (-jnp.arange(0, hd, 2, dtype=jnp.float32) / hd)
    ang = positions.astype(jnp.float32)[..., None] * inv_freq
    cos = jnp.cos(ang)[:, :, None, :].astype(x.dtype)
    sin = jnp.sin(ang)[:, :, None, :].astype(x.dtype)

    for l in range(DEPTH):
        x = x + 0.5 * swiglu(rms_norm(x, ffn1_norm[l]), ffn1_w_gate[l], ffn1_w_up[l], ffn1_w_down[l])

        h = rms_norm(x, mix_norm[l])
        parts = jnp.split(h @ w_in[l], split_at, axis=-1)
        q_n, kc_t, vc_t, ks_t, vs_t, kw_t, vw_t, gate_n, q_s, k_s, v_s = parts
        kv_shape = (b, s, N_NSA_KV, hd)

        q_n = apply_rope(rms_norm(q_n.reshape(b, s, N_NSA_HEADS, hd), nsa_q_norm[l]), cos, sin)
        kc = compress_blocks(apply_rope(kc_t.reshape(kv_shape), cos, sin), cmp_k_pos[l], cmp_k_w1[l], cmp_k_w2[l])
        kc = rms_norm(kc, nsa_k_cmp_norm[l])
        vc = compress_blocks(vc_t.reshape(kv_shape), cmp_v_pos[l], cmp_v_w1[l], cmp_v_w2[l])
        k_slc = apply_rope(rms_norm(ks_t.reshape(kv_shape), nsa_k_slc_norm[l]), cos, sin)
        k_win = apply_rope(rms_norm(kw_t.reshape(kv_shape), nsa_k_win_norm[l]), cos, sin)
        o_nsa = nsa_attention(q_n, kc, vc, k_slc, vs_t.reshape(kv_shape), k_win,
                              vw_t.reshape(kv_shape), gate_n.reshape(b, s, N_NSA_HEADS, 3))

        sb_shape = (b, s, N_SB_HEADS, hd)
        o_sb = stick_breaking_attention(q_s.reshape(sb_shape), k_s.reshape(sb_shape), v_s.reshape(sb_shape))

        y = jnp.concatenate([rms_norm(o_nsa, nsa_out_norm[l]).reshape(b, s, -1),
                             rms_norm(o_sb, sb_out_norm[l]).reshape(b, s, -1)], axis=-1)
        x = x + y @ w_out[l]

        x = x + 0.5 * swiglu(rms_norm(x, ffn2_norm[l]), ffn2_w_gate[l], ffn2_w_up[l], ffn2_w_down[l])
    return x
```

```cpp
#include <hip/hip_runtime.h>
#include <cstdio>
#include <cstdint>

#define SB_COMPACT 0
#define FOLD_GAINS 1
#define FUSE_NORMS 0
#define NSA_OPAQUE 0
#define REP_P0 1
#define REP_P1 1
#define REP_P2 1
#define REP_P4 1
#define REP_CMP 1
#define REP_NSA 1
#define REP_SB 1
#define PROBE_SB_MODE 0
#define TAIL_CONVERT 1
#define PROBE_P1K 0
#define PROBE_PP 0

#define GAS __attribute__((address_space(1)))
#define LAS __attribute__((address_space(3)))
typedef unsigned short bf16;
typedef unsigned v4u __attribute__((ext_vector_type(4)));
typedef unsigned v2u __attribute__((ext_vector_type(2)));
typedef float f32x4 __attribute__((ext_vector_type(4)));
typedef float f32x2 __attribute__((ext_vector_type(2)));

constexpr int NBATCH = 4, SEQ = 4096, M = NBATCH * SEQ, D = 2048, FF = 5632, HD = 128;
constexpr int NCMP = 255;
constexpr int IN_COLS = 5656;
constexpr int NP = 5888;
constexpr int C_QN = 0, C_KC = 1024, C_VC = 1280, C_KS = 1536, C_VS = 1792, C_KW = 2048, C_VW = 2304, C_QS = 2560, C_KSB = 3584, C_VSB = 4608, C_GATE = 5632;
constexpr float EPS = 1e-6f;
constexpr float SCALE = 0.08838834764831845f;
constexpr float NEG_INF = -1e30f;
constexpr float QSCALE = 0.08838834764831845f * 1.4426950408889634f;

constexpr size_t MiB = 1u << 20;
constexpr size_t WS_CTL = 0, CTL_ZERO_BYTES = 1 * MiB;
constexpr size_t WS_W1GU = 2 * MiB, WS_W1D = 46 * MiB, WS_W2GU = 68 * MiB, WS_W2D = 112 * MiB, WS_WIN = 134 * MiB, WS_WOUT = 157 * MiB;
constexpr size_t WS_WC1K = 165 * MiB, WS_WC1V = 167 * MiB, WS_WC2K = 169 * MiB, WS_WC2V = 169 * MiB + 65536, WS_PBIAS = 169 * MiB + 131072;
constexpr size_t WS_COS = 170 * MiB, WS_SIN = 174 * MiB, WS_KC = 178 * MiB, WS_VC = 178 * MiB + 524288;
constexpr size_t WS_HB = 180 * MiB, WS_BIG = 244 * MiB, WS_SCR = 428 * MiB, WS_PART = 492 * MiB, WS_END = 494 * MiB;
constexpr size_t WS_SB_DUMMY_KV = WS_W2GU;
constexpr int CW_BAR = 4096;

constexpr int NWAVES = 8, NTHREADS = 512;
constexpr int LDS_BYTES = 163840;
constexpr int LDSCTL_OFF = 163840 - 1024;

__device__ __forceinline__ unsigned f2bf(float f) { unsigned u = __builtin_bit_cast(unsigned, f); return (u + 0x7fffu + ((u >> 16) & 1u)) >> 16; }
__device__ __forceinline__ unsigned pk2(float lo, float hi) { return f2bf(lo) | (f2bf(hi) << 16); }
__device__ __forceinline__ float bf2f(unsigned h) { return __builtin_bit_cast(float, h << 16); }
__device__ __forceinline__ float bflo(unsigned w) { return __builtin_bit_cast(float, w << 16); }
__device__ __forceinline__ float bfhi(unsigned w) { return __builtin_bit_cast(float, w & 0xffff0000u); }
__device__ __forceinline__ float wave_sum(float v) {
#pragma unroll
    for (int o = 1; o < 64; o <<= 1) v += __shfl_xor(v, o);
    return v;
}
__device__ __forceinline__ float wave_max(float v) {
#pragma unroll
    for (int o = 1; o < 64; o <<= 1) v = fmaxf(v, __shfl_xor(v, o));
    return v;
}
__device__ __forceinline__ float softplusf(float z) { return fmaxf(z, 0.f) + log1pf(expf(-fabsf(z))); }
__device__ __forceinline__ float sigmoidf(float z) { return 1.f / (1.f + expf(-z)); }
__device__ __forceinline__ float gelu_tanh(float x) { const float u = 0.7978845608028654f * (x + 0.044715f * x * x * x); return 0.5f * x * (1.f + tanhf(u)); }

#define XB_TMO      128
#define XB_XCNT(j)  (256  + 64 * (j))
#define XB_XSUB(j)  (1280 + 64 * (j))
#define XB_XGEN(j)  (2304 + 64 * (j))
#define XB_TOP      3328
#define XB_TOPGEN   3392
#define XCD_BAR_WORDS 3456
#define XB_SPIN_CAP (1u << 22)

__device__ __forceinline__ unsigned xb_ld(unsigned* p)              { return __hip_atomic_load(p, __ATOMIC_RELAXED, __HIP_MEMORY_SCOPE_AGENT); }
__device__ __forceinline__ unsigned xb_add(unsigned* p, unsigned v) { return __hip_atomic_fetch_add(p, v, __ATOMIC_RELAXED, __HIP_MEMORY_SCOPE_AGENT); }
__device__ __forceinline__ unsigned xb_xcc_id() { return (unsigned)__builtin_amdgcn_s_getreg((3 << 11) | 20) & 0xFu; }
#define XB_SPIN(cond, bar) do { unsigned _sp = 0; while (cond) { __builtin_amdgcn_s_sleep(1); \
    if ((++_sp & 255u) == 0u) { if (xb_ld(&(bar)[XB_TMO])) break; if (_sp > XB_SPIN_CAP) { atomicAdd(&(bar)[XB_TMO], 1u); break; } } } } while (0)

struct XcdBarrier { unsigned* bar; unsigned x; volatile LAS unsigned* st; };

__device__ __forceinline__ XcdBarrier xcd_barrier_post(unsigned* bar, volatile LAS unsigned* st) {
    XcdBarrier b; b.bar = bar; b.x = xb_xcc_id(); b.st = st;
    if (threadIdx.x == 0) (void)xb_add(&bar[XB_XCNT(b.x)], 1u);
    return b;
}
__device__ __forceinline__ void xcd_barrier_complete(unsigned* bar, unsigned x, unsigned& nloc, unsigned& nx) {
    const unsigned G = gridDim.x * gridDim.y * gridDim.z;
    unsigned sum, cnt, mine, sp = 0u;
    for (;;) {
        sum = 0u; cnt = 0u; mine = 0u;
#pragma unroll
        for (unsigned j = 0; j < 16; ++j) { const unsigned c = xb_ld(&bar[XB_XCNT(j)]); sum += c; cnt += (c > 0u) ? 1u : 0u; mine = (j == x) ? c : mine; }
        if (sum == G) break;
        __builtin_amdgcn_s_sleep(1);
        if ((++sp & 255u) == 0u) { if (xb_ld(&bar[XB_TMO])) break; if (sp > XB_SPIN_CAP) { atomicAdd(&bar[XB_TMO], 1u); break; } }
    }
    nloc = mine > 0u ? mine : 1u; nx = cnt > 0u ? cnt : 1u;
}
__device__ __forceinline__ void xcd_barrier(const XcdBarrier& b) {
    asm volatile("s_waitcnt vmcnt(0)" ::: "memory");
    __syncthreads();
    if (threadIdx.x == 0) {
        unsigned* bar = b.bar;
        __builtin_amdgcn_s_waitcnt(0);
        unsigned nloc = b.st[0], nx = b.st[1];
        if (nloc == 0u) { xcd_barrier_complete(bar, b.x, nloc, nx); b.st[0] = nloc; b.st[1] = nx; }
        const unsigned old = xb_add(&bar[XB_XSUB(b.x)], 1u);
        const unsigned gen = old / nloc;
        if (old + 1u == (gen + 1u) * nloc) {
            __builtin_amdgcn_fence(__ATOMIC_RELEASE, "agent");
            asm volatile("s_waitcnt vmcnt(0)" ::: "memory");
            const unsigned og = xb_add(&bar[XB_TOP], 1u);
            const unsigned tg = og / nx;
            if (og + 1u == (tg + 1u) * nx) xb_add(&bar[XB_TOPGEN], 1u);
            else XB_SPIN(xb_ld(&bar[XB_TOPGEN]) == tg, bar);
            __builtin_amdgcn_fence(__ATOMIC_ACQUIRE, "agent");
            xb_add(&bar[XB_XGEN(b.x)], 1u);
            asm volatile("s_waitcnt vmcnt(0)" ::: "memory");
        } else {
            XB_SPIN(xb_ld(&bar[XB_XGEN(b.x)]) == gen, bar);
            __builtin_amdgcn_fence(__ATOMIC_ACQUIRE, "agent");
            asm volatile("s_waitcnt vmcnt(0)" ::: "memory");
        }
    }
    __syncthreads();
}

namespace pg8 {
#define PG8_LAS __attribute__((address_space(3)))
typedef unsigned short bf16_t;
typedef short bf16x8 __attribute__((ext_vector_type(8)));
typedef float f32x4 __attribute__((ext_vector_type(4)));
typedef unsigned u32x4 __attribute__((ext_vector_type(4)));
constexpr int BM = 256, BK = 64, HALF = 128, HTB = HALF * BK * 2  , STAGE_BYTES = 8 * HTB, NXCD = 8, WGM = 8;

__host__ __device__ __forceinline__ int lds_byte(int r, int c) { const int st = (r >> 4) * 2 + (c >> 5), rr = r & 15, cc = c & 31, ob = rr * 64 + cc * 2; return st * 1024 + (ob ^ (((ob >> 9) & 1) << 5)); }
__host__ __device__ __forceinline__ void stage_rc(int b, int& R, int& C) { const int st = b / 1024, sb = b % 1024, swz = sb ^ (((sb >> 9) & 1) << 5); R = (st >> 1) * 16 + swz / 64; C = (st & 1) * 32 + (swz % 64) / 2; }
__host__ __device__ __forceinline__ int perm32(int rho) { const int n = rho >> 4, i = rho & 15; return 8 * (i >> 2) + 4 * n + (i & 3); }

struct Unit { int pm, pn, ord; };
struct Gemm { const bf16_t* A; const bf16_t* Bt; int M, N, K; int kshift = 0; };

struct StaticOrder {
    int nM, nN, nwg, G, c; int zero = 0;
    __host__ __device__ void init(int M, int N, int G_, int c_) { nM = M / BM; nN = N / BM; nwg = nM * nN; G = G_; c = c_; }
    __host__ __device__ bool next(int i, Unit& u) const {
        const long L = (long)i * G + c; if (L >= nwg) return false;
        int wgid = (int)L; { const int q = nwg / NXCD, r = nwg % NXCD, xcd = wgid % NXCD, off = wgid / NXCD; wgid = (xcd < r ? xcd * (q + 1) : r * (q + 1) + (xcd - r) * q) + off; }
        const int nig = WGM * nN, gid = wgid / nig, fm = gid * WGM, gsz = (nM - fm) < WGM ? (nM - fm) : WGM;
        u.pm = fm + ((wgid % nig) % gsz); u.pn = (wgid % nig) / gsz; u.ord = i;
        if (zero) { u.pm = 0; u.pn = 0; }
        return true;
    }
    __device__ __forceinline__ void a_ready(const Unit&) const {}
    __device__ __forceinline__ void done(const Unit&) const {}
};


__device__ __forceinline__ unsigned cvt_pk_bf16(float lo, float hi) { unsigned r; asm volatile("v_cvt_pk_bf16_f32 %0, %1, %2" : "=v"(r) : "v"(lo), "v"(hi)); return r; }
__device__ __forceinline__ float silu_mul(float g, float u) { return g * u * __builtin_amdgcn_rcpf(1.0f + __builtin_amdgcn_exp2f(-1.4426950408889634f * g)); }
__device__ __forceinline__ void row_scale_table(PG8_LAS float* rs, const float* part, const Unit& u, float inv_n, float eps) {
    asm volatile("s_waitcnt lgkmcnt(0)" ::: "memory"); __builtin_amdgcn_s_barrier(); asm volatile("" ::: "memory");
    const int t = threadIdx.x;
    if (t < 256) { const f32x4* p = (const f32x4*)(part + (size_t)(u.pm * BM + t) * 32); f32x4 a = p[0];
#pragma unroll
        for (int i = 1; i < 8; ++i) a = a + p[i];
        rs[t] = rsqrtf(((a[0] + a[1]) + (a[2] + a[3])) * inv_n + eps); }
    asm volatile("s_waitcnt lgkmcnt(0)" ::: "memory"); __builtin_amdgcn_s_barrier(); asm volatile("" ::: "memory");
}
__device__ __forceinline__ float row_factor(const float* part, int row) {
    const unsigned long long q = ((const unsigned long long*)part)[row];
    return rsqrtf((float)q * (1.0f / 16777216.0f) * (1.0f / 2048.0f) + 1e-6f);
}
template <class Sched>
__device__ __forceinline__ void row_factor_table(PG8_LAS float* rs, const float* part, const Sched& S) {
    int t = threadIdx.x; asm volatile("" : "+v"(t));
    Unit u;
    for (int i = 0; S.next(i, u); ++i) if (t < 256) rs[i * 256 + t] = row_factor(part, u.pm * BM + t);
    asm volatile("s_waitcnt vmcnt(0) lgkmcnt(0)" ::: "memory"); __builtin_amdgcn_s_barrier(); asm volatile("" ::: "memory");
}
struct EpiSwiglu {
    static constexpr bool PERM = true, AFTER_DRAIN = false;
    bf16_t* O; int ldo;
    const float* part; PG8_LAS float* rs;
    static __device__ __forceinline__ unsigned silu_mul2(f32x2 g, f32x2 u) {
        const f32x2 t = g * (-1.4426950408889634f);
        f32x2 e; e.x = __builtin_amdgcn_exp2f(t.x); e.y = __builtin_amdgcn_exp2f(t.y);
        const f32x2 d = e + 1.0f;
        f32x2 rc; rc.x = __builtin_amdgcn_rcpf(d.x); rc.y = __builtin_amdgcn_rcpf(d.y);
        const f32x2 r = (g * u) * rc;
        typedef __bf16 bf16x2_t __attribute__((ext_vector_type(2)));
        return __builtin_bit_cast(unsigned, __builtin_convertvector(r, bf16x2_t));
    }
    __device__ __forceinline__ void operator()(const f32x4 (&acc)[2][2][4][2], const Unit& u, int wr, int wc, int fr, int fq) const {
        const int row0 = u.pm * BM + wr * 64 + fr, col0 = u.pn * HALF + wc * 32 + 8 * fq;
        float rf[2][4];
#pragma unroll
        for (int ai = 0; ai < 2; ++ai)
#pragma unroll
            for (int m = 0; m < 4; ++m) rf[ai][m] = part ? rs[u.ord * 256 + wr * 64 + fr + ai * HALF + m * 16] : 1.0f;
#pragma unroll
        for (int ai = 0; ai < 2; ++ai)
#pragma unroll
            for (int m = 0; m < 4; ++m) {
                const float r = rf[ai][m];
                const f32x4 g0 = acc[ai][0][m][0] * r, g1 = acc[ai][0][m][1] * r, u0 = acc[ai][1][m][0] * r, u1 = acc[ai][1][m][1] * r;
                u32x4 w;
                w.x = silu_mul2((f32x2){g0[0], g0[1]}, (f32x2){u0[0], u0[1]}); w.y = silu_mul2((f32x2){g0[2], g0[3]}, (f32x2){u0[2], u0[3]});
                w.z = silu_mul2((f32x2){g1[0], g1[1]}, (f32x2){u1[0], u1[1]}); w.w = silu_mul2((f32x2){g1[2], g1[3]}, (f32x2){u1[2], u1[3]});
                *(u32x4*)(O + (size_t)(row0 + ai * HALF + m * 16) * ldo + col0) = w;
            }
    }
};
struct EpiResid {
    static constexpr bool PERM = false, AFTER_DRAIN = false;
    const float* base; float* out; int ldc; float alpha;
    bf16_t* XG; const float* gain; float* part;
    __device__ __forceinline__ void operator()(const f32x4 (&acc)[2][2][4][2], const Unit& u, int wr, int wc, int fr, int fq) const {
        const int row0 = u.pm * BM + wr * 64 + fr, col0 = u.pn * BM + wc * 32 + 4 * fq;
        f32x4 gg[2][2];
#pragma unroll
        for (int bj = 0; bj < 2; ++bj)
#pragma unroll
            for (int n = 0; n < 2; ++n) gg[bj][n] = XG ? *(const f32x4*)(gain + col0 + bj * HALF + 16 * n) : (f32x4){0.f, 0.f, 0.f, 0.f};
#pragma unroll
        for (int ai = 0; ai < 2; ++ai) {
            f32x4 b[4][2][2];
#pragma unroll
            for (int m = 0; m < 4; ++m)
#pragma unroll
                for (int bj = 0; bj < 2; ++bj)
#pragma unroll
                    for (int n = 0; n < 2; ++n) b[m][bj][n] = *(const f32x4*)(base + (size_t)(row0 + ai * HALF + m * 16) * ldc + col0 + bj * HALF + 16 * n);
#pragma unroll
            for (int m = 0; m < 4; ++m) { const int row = row0 + ai * HALF + m * 16; const size_t ro = (size_t)row * ldc + col0; float ssq = 0.f;
#pragma unroll
                for (int bj = 0; bj < 2; ++bj)
#pragma unroll
                    for (int n = 0; n < 2; ++n) { const size_t o = ro + bj * HALF + 16 * n; const f32x4 v = b[m][bj][n] + acc[ai][bj][m][n] * alpha; *(f32x4*)(out + o) = v;
                        if (XG) { const f32x4 g4 = gg[bj][n]; ssq += (v[0] * v[0] + v[1] * v[1]) + (v[2] * v[2] + v[3] * v[3]);
                            typedef unsigned u32x2 __attribute__((ext_vector_type(2))); u32x2 w; w.x = cvt_pk_bf16(v[0] * g4[0], v[1] * g4[1]); w.y = cvt_pk_bf16(v[2] * g4[2], v[3] * g4[3]); *(u32x2*)(XG + o) = w; } }
                if (XG) { ssq += __shfl_xor(ssq, 16); ssq += __shfl_xor(ssq, 32);
                    if (fq == 0) __hip_atomic_fetch_add((unsigned long long*)part + row, (unsigned long long)(ssq * 16777216.0f), __ATOMIC_RELAXED, __HIP_MEMORY_SCOPE_AGENT); } }
        }
    }
};
template <bool BB, bool OB>
struct EpiResidMix {
    static constexpr bool PERM = false, AFTER_DRAIN = false;
    const void* base; void* out; int ldc; float alpha;
    unsigned long long* rowsq;
    __device__ __forceinline__ void operator()(const f32x4 (&acc)[2][2][4][2], const Unit& u, int wr, int wc, int fr, int fq) const {
        typedef unsigned u32x2 __attribute__((ext_vector_type(2)));
        const int row0 = u.pm * BM + wr * 64 + fr, col0 = u.pn * BM + wc * 32 + 4 * fq;
#pragma unroll
        for (int ai = 0; ai < 2; ++ai) {
            f32x4 b[4][2][2];
#pragma unroll
            for (int m = 0; m < 4; ++m)
#pragma unroll
                for (int bj = 0; bj < 2; ++bj)
#pragma unroll
                    for (int n = 0; n < 2; ++n) { const size_t o = (size_t)(row0 + ai * HALF + m * 16) * ldc + col0 + bj * HALF + 16 * n;
                        if (BB) { const u32x2 w = *(const u32x2*)((const bf16_t*)base + o);
                            b[m][bj][n] = (f32x4){__builtin_bit_cast(float, w.x << 16), __builtin_bit_cast(float, w.x & 0xffff0000u), __builtin_bit_cast(float, w.y << 16), __builtin_bit_cast(float, w.y & 0xffff0000u)}; }
                        else b[m][bj][n] = *(const f32x4*)((const float*)base + o); }
#pragma unroll
            for (int m = 0; m < 4; ++m) { float ssq = 0.f;
#pragma unroll
                for (int bj = 0; bj < 2; ++bj)
#pragma unroll
                    for (int n = 0; n < 2; ++n) { const size_t o = (size_t)(row0 + ai * HALF + m * 16) * ldc + col0 + bj * HALF + 16 * n; const f32x4 v = b[m][bj][n] + acc[ai][bj][m][n] * alpha;
                        ssq += (v[0] * v[0] + v[1] * v[1]) + (v[2] * v[2] + v[3] * v[3]);
                        if (OB) { u32x2 w; w.x = cvt_pk_bf16(v[0], v[1]); w.y = cvt_pk_bf16(v[2], v[3]); *(u32x2*)((bf16_t*)out + o) = w; }
                        else *(f32x4*)((float*)out + o) = v; }
                if (rowsq) { ssq += __shfl_xor(ssq, 16); ssq += __shfl_xor(ssq, 32);
                    if (fq == 0) __hip_atomic_fetch_add(rowsq + (row0 + ai * HALF + m * 16), (unsigned long long)(ssq * 16777216.0f), __ATOMIC_RELAXED, __HIP_MEMORY_SCOPE_AGENT); } }
        }
    }
};
struct EpiStoreBf16 {
    static constexpr bool PERM = true, AFTER_DRAIN = false;
    bf16_t* O; int ldo; int sc_lo, sc_hi; float sc;
    const float* part; PG8_LAS float* rs;
    bf16_t* KVC; int kv_lo, kv_hi;
    __device__ __forceinline__ void operator()(const f32x4 (&acc)[2][2][4][2], const Unit& u, int wr, int wc, int fr, int fq) const {
        const int row0 = u.pm * BM + wr * 64 + fr, col0 = u.pn * BM + wc * 32 + 8 * fq;
        const float scl0 = (u.pn >= sc_lo && u.pn < sc_hi) ? sc : 1.0f;
        const bool kv = u.pn >= kv_lo && u.pn < kv_hi;
        const int which = (u.pn - kv_lo) >> 2, h0 = 2 * ((u.pn - kv_lo) & 3);
        float rf[2][4];
#pragma unroll
        for (int ai = 0; ai < 2; ++ai)
#pragma unroll
            for (int m = 0; m < 4; ++m) rf[ai][m] = part ? rs[u.ord * 256 + wr * 64 + fr + ai * HALF + m * 16] : 1.0f;
#pragma unroll
        for (int ai = 0; ai < 2; ++ai)
#pragma unroll
            for (int m = 0; m < 4; ++m) { const int row = row0 + ai * HALF + m * 16; bf16_t* rowp = O + (size_t)row * ldo + col0;
                const float scl = scl0 * rf[ai][m];
                bf16_t* kvp = KVC + ((size_t)((which * 4 + (row >> 12)) * 8 + h0) * 4096 + (row & 4095)) * 128 + wc * 32 + 8 * fq;
#pragma unroll
                for (int bj = 0; bj < 2; ++bj) { const f32x4 v0 = acc[ai][bj][m][0] * scl, v1 = acc[ai][bj][m][1] * scl;
                    u32x4 w; w.x = cvt_pk_bf16(v0[0], v0[1]); w.y = cvt_pk_bf16(v0[2], v0[3]); w.z = cvt_pk_bf16(v1[0], v1[1]); w.w = cvt_pk_bf16(v1[2], v1[3]);
                    if (kv) *(u32x4*)(kvp + (size_t)bj * 4096 * 128) = w; else *(u32x4*)(rowp + bj * HALF) = w; } }
    }
};
template <class Epi, class Sched, bool ALIGN_EPI = false, bool SP2 = false>
__device__ __forceinline__ void gemm_phase(PG8_LAS unsigned char* lds, const Gemm g, const Sched& S, const Epi& E) {
    int tid_ = threadIdx.x; asm volatile("" : "+v"(tid_));
    const int tid = tid_, wid = __builtin_amdgcn_readfirstlane(tid >> 6), lane = tid & 63, wr = wid >> 2, wc = wid & 3, fr = lane & 15, fq = lane >> 4;
    const int K = g.K, nt = (K / BK) >> g.kshift;
    unsigned voffA[2], voffB[2];
#pragma unroll
    for (int i = 0; i < 2; ++i) { int R, C; stage_rc(tid * 16 + i * 8192, R, C); const int Rb = Epi::PERM ? ((R & ~31) + perm32(R & 31)) : R;
        voffA[i] = (unsigned)(R * K + C) * 2u; voffB[i] = (unsigned)(Rb * K + C) * 2u; }
    const size_t kstep = (size_t)(BK * 2);
    const size_t hstep = (size_t)HALF * K * 2;
    const size_t tstep = 2 * hstep;
    const unsigned ldsw = (unsigned)wid * 1024u;
    const int aoff = lds_byte(wr * 64 + fr, fq * 8), boff = lds_byte(wc * 32 + fr, fq * 8);
#define PG8_SA(b, h) (((b) * 2 + (h)) * HTB)
#define PG8_SB(b, h) ((4 + (b) * 2 + (h)) * HTB)
#define PG8_STAGE(bufoff, gbase, voff) do { _Pragma("unroll") for (int _i = 0; _i < 2; ++_i) \
        __builtin_amdgcn_global_load_lds((const unsigned*)((const char*)(gbase) + (voff)[_i]), (PG8_LAS unsigned*)(lds + (bufoff) + ldsw + _i * 8192), 16, 0, 0); } while (0)
#define PG8_LDA(dst, b, h) do { _Pragma("unroll") for (int m = 0; m < 4; ++m) _Pragma("unroll") for (int k = 0; k < 2; ++k) dst[m][k] = *(const PG8_LAS bf16x8*)(lds + PG8_SA(b, h) + aoff + m * 2048 + k * 1024); } while (0)
#define PG8_LDB(dst, b, h) do { _Pragma("unroll") for (int n = 0; n < 2; ++n) _Pragma("unroll") for (int k = 0; k < 2; ++k) dst[n][k] = *(const PG8_LAS bf16x8*)(lds + PG8_SB(b, h) + boff + n * 2048 + k * 1024); } while (0)
#define PG8_MMA(ai, bj, At, Bt) do { __builtin_amdgcn_s_setprio(1); _Pragma("unroll") for (int m = 0; m < 4; ++m) _Pragma("unroll") for (int n = 0; n < 2; ++n) _Pragma("unroll") for (int k = 0; k < 2; ++k) \
        acc[ai][bj][m][n] = __builtin_amdgcn_mfma_f32_16x16x32_bf16(Bt[n][k], At[m][k], acc[ai][bj][m][n], 0, 0, 0); __builtin_amdgcn_s_setprio(0); } while (0)
#define PG8_WAIT_V(n) asm volatile("s_waitcnt vmcnt(" #n ")" ::: "memory")
#define PG8_WAIT_L(n) asm volatile("s_waitcnt lgkmcnt(" #n ")" ::: "memory")
#define PG8_BAR __builtin_amdgcn_s_barrier()
#define PG8_SCHED __builtin_amdgcn_sched_barrier(0)
    Unit cur, nxt; int ui = 0;
    if (!S.next(0, cur)) return;
    f32x4 acc[2][2][4][2];
#pragma unroll
    for (int a = 0; a < 2; ++a)
#pragma unroll
        for (int b = 0; b < 2; ++b)
#pragma unroll
            for (int m = 0; m < 4; ++m)
#pragma unroll
                for (int n = 0; n < 2; ++n) acc[a][b][m][n] = (f32x4){0.f, 0.f, 0.f, 0.f};
    bf16x8 At[4][2], B0[2][2], B1[2][2];
    const char* cA = (const char*)g.A + (size_t)cur.pm * tstep; const char* cB = (const char*)g.Bt + (size_t)cur.pn * tstep;
    S.a_ready(cur);
    if constexpr (SP2) {
        PG8_STAGE(PG8_SB(0, 0), cB, voffB); PG8_STAGE(PG8_SB(0, 1), cB + hstep, voffB); PG8_STAGE(PG8_SA(0, 0), cA, voffA); PG8_STAGE(PG8_SA(0, 1), cA + hstep, voffA);
        if (wr == 1) PG8_BAR;
        PG8_WAIT_V(2); PG8_BAR;
        PG8_STAGE(PG8_SB(1, 0), cB + kstep, voffB); PG8_STAGE(PG8_SA(1, 0), cA + kstep, voffA); PG8_STAGE(PG8_SB(1, 1), cB + hstep + kstep, voffB);
        PG8_WAIT_V(6); PG8_BAR;
    } else {
        PG8_STAGE(PG8_SB(0, 0), cB, voffB); PG8_STAGE(PG8_SA(0, 0), cA, voffA); PG8_STAGE(PG8_SB(0, 1), cB + hstep, voffB); PG8_STAGE(PG8_SA(0, 1), cA + hstep, voffA);
        if (wr == 1) PG8_BAR;
        PG8_WAIT_V(4); PG8_BAR;
        PG8_STAGE(PG8_SB(1, 0), cB + kstep, voffB); PG8_STAGE(PG8_SA(1, 0), cA + kstep, voffA); PG8_STAGE(PG8_SB(1, 1), cB + hstep + kstep, voffB);
        PG8_WAIT_V(6); PG8_BAR;
    }
    for (;;) {
        const bool has_next = S.next(ui + 1, nxt);
        const char* nA = has_next ? (const char*)g.A + (size_t)nxt.pm * tstep : cA; const char* nB = has_next ? (const char*)g.Bt + (size_t)nxt.pn * tstep : cB;
        for (int t = 0; t < nt; t += 2) {
            const bool last = (t == nt - 2);
            const char* a1 = cA + (size_t)(t + 1) * kstep;
            const char* a2 = last ? nA : cA + (size_t)(t + 2) * kstep; const char* b2 = last ? nB : cB + (size_t)(t + 2) * kstep;
            const char* a3 = a2 + kstep; const char* b3 = b2 + kstep;
            if (last && has_next) S.a_ready(nxt);
            if constexpr (SP2) {
            PG8_LDB(B0, 0, 0); PG8_LDB(B1, 0, 1); PG8_SCHED; PG8_LDA(At, 0, 0); PG8_STAGE(PG8_SA(1, 1), a1 + hstep, voffA);
            PG8_WAIT_V(8); PG8_WAIT_L(0); PG8_BAR; PG8_MMA(0, 0, At, B0); PG8_MMA(0, 1, At, B1); PG8_BAR; PG8_SCHED;
            PG8_LDA(At, 0, 1); PG8_STAGE(PG8_SB(0, 0), b2, voffB); PG8_STAGE(PG8_SB(0, 1), b2 + hstep, voffB); PG8_STAGE(PG8_SA(0, 0), a2, voffA);
            PG8_WAIT_V(8); PG8_WAIT_L(0); PG8_BAR; PG8_MMA(1, 0, At, B0); PG8_MMA(1, 1, At, B1); PG8_BAR; PG8_SCHED;
            PG8_LDB(B0, 1, 0); PG8_LDB(B1, 1, 1); PG8_SCHED; PG8_LDA(At, 1, 0); PG8_STAGE(PG8_SA(0, 1), a2 + hstep, voffA);
            PG8_WAIT_V(8); PG8_WAIT_L(0); PG8_BAR; PG8_MMA(0, 0, At, B0); PG8_MMA(0, 1, At, B1); PG8_BAR; PG8_SCHED;
            PG8_LDA(At, 1, 1); PG8_STAGE(PG8_SB(1, 0), b3, voffB); PG8_STAGE(PG8_SB(1, 1), b3 + hstep, voffB); PG8_STAGE(PG8_SA(1, 0), a3, voffA);
            PG8_WAIT_V(8); PG8_WAIT_L(0); PG8_BAR; PG8_MMA(1, 0, At, B0); PG8_MMA(1, 1, At, B1); PG8_BAR; PG8_SCHED;
            } else {
            PG8_LDB(B0, 0, 0); PG8_SCHED; PG8_LDA(At, 0, 0); PG8_STAGE(PG8_SA(1, 1), a1 + hstep, voffA);
            PG8_WAIT_L(8); PG8_BAR; PG8_WAIT_L(0); PG8_MMA(0, 0, At, B0); PG8_BAR; PG8_SCHED;
            PG8_LDB(B1, 0, 1); PG8_STAGE(PG8_SB(0, 0), b2, voffB);
            PG8_BAR; PG8_WAIT_L(0); PG8_MMA(0, 1, At, B1); PG8_BAR;
            PG8_LDA(At, 0, 1); PG8_STAGE(PG8_SA(0, 0), a2, voffA);
            PG8_BAR; PG8_WAIT_L(0); PG8_MMA(1, 0, At, B0); PG8_BAR; PG8_SCHED;
            PG8_STAGE(PG8_SB(0, 1), b2 + hstep, voffB);
            PG8_WAIT_V(6); PG8_BAR; PG8_MMA(1, 1, At, B1); PG8_BAR;
            PG8_LDB(B0, 1, 0); PG8_SCHED; PG8_LDA(At, 1, 0); PG8_STAGE(PG8_SA(0, 1), a2 + hstep, voffA);
            PG8_WAIT_L(8); PG8_BAR; PG8_WAIT_L(0); PG8_MMA(0, 0, At, B0); PG8_BAR; PG8_SCHED;
            PG8_LDB(B1, 1, 1); PG8_STAGE(PG8_SB(1, 0), b3, voffB);
            PG8_BAR; PG8_WAIT_L(0); PG8_MMA(0, 1, At, B1); PG8_BAR;
            PG8_LDA(At, 1, 1); PG8_STAGE(PG8_SA(1, 0), a3, voffA);
            PG8_BAR; PG8_WAIT_L(0); PG8_MMA(1, 0, At, B0); PG8_BAR; PG8_SCHED;
            PG8_STAGE(PG8_SB(1, 1), b3 + hstep, voffB);
            PG8_WAIT_V(6); PG8_BAR; PG8_MMA(1, 1, At, B1); PG8_BAR;
            }
        }
        if constexpr (ALIGN_EPI) { if (wr == 0) PG8_BAR; }
        if constexpr (!Epi::AFTER_DRAIN) { E(acc, cur, wr, wc, fr, fq); S.done(cur); }
        if (!has_next) break;
#pragma unroll
        for (int a = 0; a < 2; ++a)
#pragma unroll
            for (int b = 0; b < 2; ++b)
#pragma unroll
                for (int m = 0; m < 4; ++m)
#pragma unroll
                    for (int n = 0; n < 2; ++n) acc[a][b][m][n] = (f32x4){0.f, 0.f, 0.f, 0.f};
        cur = nxt; cA = nA; cB = nB; ++ui;
        if constexpr (ALIGN_EPI) { if (wr == 1) PG8_BAR; }
    }
    PG8_WAIT_V(0);
    if constexpr (!ALIGN_EPI) { if (wr == 0) PG8_BAR; }
    PG8_BAR;
    if constexpr (Epi::AFTER_DRAIN) { E.fused(acc, cur, wr, wc, fr, fq, lds, wid, lane); S.done(cur); }
#undef PG8_SA
#undef PG8_SB
#undef PG8_STAGE
#undef PG8_LDA
#undef PG8_LDB
#undef PG8_MMA
#undef PG8_WAIT_V
#undef PG8_WAIT_L
#undef PG8_BAR
#undef PG8_SCHED
}
}

struct Params {
    const float* x; const int* pos;
    const float *ffn1_norm, *ffn1_wg, *ffn1_wu, *ffn1_wd, *mix_norm, *w_in, *q_norm, *kc_norm, *ks_norm, *kw_norm;
    const float *ck_pos, *ck_w1, *ck_w2, *cv_pos, *cv_w1, *cv_w2, *nsa_on, *sb_on, *w_out, *ffn2_norm, *ffn2_wg, *ffn2_wu, *ffn2_wd;
    float* out; unsigned char* ws;
};


__device__ __forceinline__ void rmsnorm_rows(const float* X, const float* g, bf16* Y) {
    int tid = threadIdx.x; asm volatile("" : "+v"(tid));
    const int lane = tid & 63, gw = blockIdx.x * NWAVES + (tid >> 6), NGW = gridDim.x * NWAVES;
    f32x4 gg[8];
#pragma unroll
    for (int j = 0; j < 8; ++j) gg[j] = ((const f32x4*)g)[lane + 64 * j];
    for (int m0 = gw; m0 < M; m0 += 2 * NGW) {
        const int m1 = m0 + NGW; const bool ok1 = m1 < M;
        const f32x4* x0 = (const f32x4*)(X + (size_t)m0 * D) + lane; const f32x4* x1 = (const f32x4*)(X + (size_t)(ok1 ? m1 : m0) * D) + lane;
        f32x4 v0[8], v1[8]; float s0 = 0.f, s1 = 0.f;
#pragma unroll
        for (int j = 0; j < 8; ++j) { v0[j] = x0[64 * j]; v1[j] = x1[64 * j]; }
#pragma unroll
        for (int j = 0; j < 8; ++j) { s0 += (v0[j].x * v0[j].x + v0[j].y * v0[j].y) + (v0[j].z * v0[j].z + v0[j].w * v0[j].w); s1 += (v1[j].x * v1[j].x + v1[j].y * v1[j].y) + (v1[j].z * v1[j].z + v1[j].w * v1[j].w); }
        const float r0 = rsqrtf(wave_sum(s0) * (1.f / D) + EPS), r1 = rsqrtf(wave_sum(s1) * (1.f / D) + EPS);
        v2u* o0 = (v2u*)(Y + (size_t)m0 * D) + lane; v2u* o1 = (v2u*)(Y + (size_t)m1 * D) + lane;
#pragma unroll
        for (int j = 0; j < 8; ++j) { v2u w; w.x = pk2(v0[j].x * r0 * gg[j].x, v0[j].y * r0 * gg[j].y); w.y = pk2(v0[j].z * r0 * gg[j].z, v0[j].w * r0 * gg[j].w); o0[64 * j] = w; }
        if (ok1) {
#pragma unroll
            for (int j = 0; j < 8; ++j) { v2u w; w.x = pk2(v1[j].x * r1 * gg[j].x, v1[j].y * r1 * gg[j].y); w.y = pk2(v1[j].z * r1 * gg[j].z, v1[j].w * r1 * gg[j].w); o1[64 * j] = w; }
        }
    }
}

__device__ __forceinline__ void cast_rows(const float* X, bf16* Y, unsigned long long* rowsq) {
    int tid = threadIdx.x; asm volatile("" : "+v"(tid));
    const int lane = tid & 63, gw = blockIdx.x * NWAVES + (tid >> 6), NGW = gridDim.x * NWAVES;
    for (int m0 = gw; m0 < M; m0 += 2 * NGW) {
        const int m1 = m0 + NGW; const bool ok1 = m1 < M;
        const f32x4* x0 = (const f32x4*)(X + (size_t)m0 * D) + lane; const f32x4* x1 = (const f32x4*)(X + (size_t)(ok1 ? m1 : m0) * D) + lane;
        f32x4 v0[8], v1[8]; float s0 = 0.f, s1 = 0.f;
#pragma unroll
        for (int j = 0; j < 8; ++j) { v0[j] = x0[64 * j]; v1[j] = x1[64 * j]; }
#pragma unroll
        for (int j = 0; j < 8; ++j) { s0 += (v0[j].x * v0[j].x + v0[j].y * v0[j].y) + (v0[j].z * v0[j].z + v0[j].w * v0[j].w); s1 += (v1[j].x * v1[j].x + v1[j].y * v1[j].y) + (v1[j].z * v1[j].z + v1[j].w * v1[j].w); }
        s0 = wave_sum(s0); s1 = wave_sum(s1);
        if (lane == 0) { rowsq[m0] = (unsigned long long)(s0 * 16777216.0f); if (ok1) rowsq[m1] = (unsigned long long)(s1 * 16777216.0f); }
        v2u* o0 = (v2u*)(Y + (size_t)m0 * D) + lane; v2u* o1 = (v2u*)(Y + (size_t)m1 * D) + lane;
#pragma unroll
        for (int j = 0; j < 8; ++j) { v2u w; w.x = pk2(v0[j].x, v0[j].y); w.y = pk2(v0[j].z, v0[j].w); o0[64 * j] = w; }
        if (ok1) {
#pragma unroll
            for (int j = 0; j < 8; ++j) { v2u w; w.x = pk2(v1[j].x, v1[j].y); w.y = pk2(v1[j].z, v1[j].w); o1[64 * j] = w; }
        }
    }
}
__device__ __forceinline__ void rmsnorm_rows_bf16(const bf16* X, const float* g, bf16* Y) {
    int tid = threadIdx.x; asm volatile("" : "+v"(tid));
    const int lane = tid & 63, gw = blockIdx.x * NWAVES + (tid >> 6), NGW = gridDim.x * NWAVES;
    f32x4 ga[4], gb[4];
#pragma unroll
    for (int j = 0; j < 4; ++j) { ga[j] = *(const f32x4*)(g + 8 * (lane + 64 * j)); gb[j] = *(const f32x4*)(g + 8 * (lane + 64 * j) + 4); }
    for (int m0 = gw; m0 < M; m0 += 2 * NGW) {
        const int m1 = m0 + NGW; const bool ok1 = m1 < M;
        const v4u* x0 = (const v4u*)(X + (size_t)m0 * D) + lane; const v4u* x1 = (const v4u*)(X + (size_t)(ok1 ? m1 : m0) * D) + lane;
        v4u r0[4], r1[4];
#pragma unroll
        for (int j = 0; j < 4; ++j) { r0[j] = x0[64 * j]; r1[j] = x1[64 * j]; }
        float s0 = 0.f, s1 = 0.f;
#pragma unroll
        for (int j = 0; j < 4; ++j) {
            s0 += (bflo(r0[j].x) * bflo(r0[j].x) + bfhi(r0[j].x) * bfhi(r0[j].x)) + (bflo(r0[j].y) * bflo(r0[j].y) + bfhi(r0[j].y) * bfhi(r0[j].y)) + (bflo(r0[j].z) * bflo(r0[j].z) + bfhi(r0[j].z) * bfhi(r0[j].z)) + (bflo(r0[j].w) * bflo(r0[j].w) + bfhi(r0[j].w) * bfhi(r0[j].w));
            s1 += (bflo(r1[j].x) * bflo(r1[j].x) + bfhi(r1[j].x) * bfhi(r1[j].x)) + (bflo(r1[j].y) * bflo(r1[j].y) + bfhi(r1[j].y) * bfhi(r1[j].y)) + (bflo(r1[j].z) * bflo(r1[j].z) + bfhi(r1[j].z) * bfhi(r1[j].z)) + (bflo(r1[j].w) * bflo(r1[j].w) + bfhi(r1[j].w) * bfhi(r1[j].w));
        }
        const float q0 = rsqrtf(wave_sum(s0) * (1.f / D) + EPS), q1 = rsqrtf(wave_sum(s1) * (1.f / D) + EPS);
        v4u* o0 = (v4u*)(Y + (size_t)m0 * D) + lane; v4u* o1 = (v4u*)(Y + (size_t)m1 * D) + lane;
#pragma unroll
        for (int j = 0; j < 4; ++j) { v4u w; w.x = pk2(bflo(r0[j].x) * q0 * ga[j].x, bfhi(r0[j].x) * q0 * ga[j].y); w.y = pk2(bflo(r0[j].y) * q0 * ga[j].z, bfhi(r0[j].y) * q0 * ga[j].w);
            w.z = pk2(bflo(r0[j].z) * q0 * gb[j].x, bfhi(r0[j].z) * q0 * gb[j].y); w.w = pk2(bflo(r0[j].w) * q0 * gb[j].z, bfhi(r0[j].w) * q0 * gb[j].w); o0[64 * j] = w; }
        if (ok1) {
#pragma unroll
            for (int j = 0; j < 4; ++j) { v4u w; w.x = pk2(bflo(r1[j].x) * q1 * ga[j].x, bfhi(r1[j].x) * q1 * ga[j].y); w.y = pk2(bflo(r1[j].y) * q1 * ga[j].z, bfhi(r1[j].y) * q1 * ga[j].w);
                w.z = pk2(bflo(r1[j].z) * q1 * gb[j].x, bfhi(r1[j].z) * q1 * gb[j].y); w.w = pk2(bflo(r1[j].w) * q1 * gb[j].z, bfhi(r1[j].w) * q1 * gb[j].w); o1[64 * j] = w; }
        }
    }
}

__device__ __forceinline__ void rope_tables(const int* pos, float* cs, float* sn) {
    int tid = threadIdx.x; asm volatile("" : "+v"(tid));
    const int gt = blockIdx.x * NTHREADS + tid, NGT = gridDim.x * NTHREADS;
    for (int i = gt; i < M * 64; i += NGT) {
        const int m = i >> 6, f = i & 63;
        const float inv = powf(10000.f, -(float)(2 * f) / 128.f);
        const float ang = (float)pos[m] * inv;
        cs[i] = cosf(ang); sn[i] = sinf(ang);
    }
}

__device__ __forceinline__ void postproj_naive(const Params& P, bf16* PROJ, const float* cs, const float* sn) {
    int tid = threadIdx.x; asm volatile("" : "+v"(tid));
    const int lane = tid & 63, sub = lane & 15, gw = blockIdx.x * NWAVES + (tid >> 6), NGW = gridDim.x * NWAVES;
    constexpr int NG = M * 12 / 4;
    for (int g0 = gw; g0 < NG; g0 += 2 * NGW) {
        v2u lo[2], hi[2]; f32x4 cv[2], sv[2]; bf16* pp[2]; const float* gp[2]; float qs[2]; bool ok[2];
#pragma unroll
        for (int u = 0; u < 2; ++u) {
            const int g = g0 + u * NGW; ok[u] = g < NG;
            const int task = ok[u] ? 4 * g + (lane >> 4) : 0, m = task / 12, sl = task % 12;
            int col;
            if (sl < 8) { col = C_QN + sl * 128; gp[u] = P.q_norm; } else if (sl < 10) { col = C_KS + (sl - 8) * 128; gp[u] = P.ks_norm; } else { col = C_KW + (sl - 10) * 128; gp[u] = P.kw_norm; }
            qs[u] = sl < 8 ? QSCALE : 1.0f;
            pp[u] = PROJ + (size_t)m * NP + col + 4 * sub;
            lo[u] = *(const v2u*)pp[u]; hi[u] = *(const v2u*)(pp[u] + 64);
            cv[u] = *(const f32x4*)(cs + m * 64 + 4 * sub); sv[u] = *(const f32x4*)(sn + m * 64 + 4 * sub);
        }
#pragma unroll
        for (int u = 0; u < 2; ++u) {
            float a[4], b[4];
            a[0] = bflo(lo[u].x); a[1] = bfhi(lo[u].x); a[2] = bflo(lo[u].y); a[3] = bfhi(lo[u].y);
            b[0] = bflo(hi[u].x); b[1] = bfhi(hi[u].x); b[2] = bflo(hi[u].y); b[3] = bfhi(hi[u].y);
            float ss = (a[0] * a[0] + a[1] * a[1]) + (a[2] * a[2] + a[3] * a[3]) + (b[0] * b[0] + b[1] * b[1]) + (b[2] * b[2] + b[3] * b[3]);
            ss += __shfl_xor(ss, 1); ss += __shfl_xor(ss, 2); ss += __shfl_xor(ss, 4); ss += __shfl_xor(ss, 8);
            const float r = rsqrtf(ss * (1.f / 128.f) + EPS) * qs[u];
            const f32x4 ga = *(const f32x4*)(gp[u] + 4 * sub), gb = *(const f32x4*)(gp[u] + 64 + 4 * sub);
            float oa[4], ob[4];
#pragma unroll
            for (int e = 0; e < 4; ++e) { const float x = a[e] * r * ga[e], y = b[e] * r * gb[e]; oa[e] = x * cv[u][e] - y * sv[u][e]; ob[e] = y * cv[u][e] + x * sv[u][e]; }
            if (ok[u]) { v2u wa, wb; wa.x = pk2(oa[0], oa[1]); wa.y = pk2(oa[2], oa[3]); wb.x = pk2(ob[0], ob[1]); wb.y = pk2(ob[2], ob[3]); *(v2u*)pp[u] = wa; *(v2u*)(pp[u] + 64) = wb; }
        }
    }
}

namespace att {
typedef short bf16x8 __attribute__((ext_vector_type(8)));
typedef short s16x4 __attribute__((ext_vector_type(4)));
constexpr float C1 = 0.08838834764831845f * 1.4426950408889634f;
typedef __bf16 bf16x2_t __attribute__((ext_vector_type(2)));
__device__ __forceinline__ unsigned cvt_pk_bf16(float lo, float hi) { const bf16x2_t v = __builtin_convertvector((f32x2){lo, hi}, bf16x2_t); return __builtin_bit_cast(unsigned, v); }
__device__ __forceinline__ int offK(int key, int dc) { return key * 256 + 16 * (dc ^ ((key & 3) | (((key >> 4) & 3) << 2))); }
__device__ __forceinline__ int offV(int key, int dc) { return key * 256 + 32 * ((dc >> 1) ^ ((key & 3) | (((key >> 4) & 1) << 2))) + 16 * (dc & 1); }
struct TileRegs { v4u k[2], v[2]; };
__device__ __forceinline__ void tile_load(TileRegs& r, const bf16* kp, const bf16* vp, int ld, int tid) {
#if NSA_OPAQUE
    asm volatile("" : "+v"(tid));
#endif
#pragma unroll
    for (int i = 0; i < 2; ++i) { const int id = tid + 512 * i, key = id >> 4, dc = id & 15; r.k[i] = *(const v4u*)(kp + (size_t)key * ld + dc * 8); r.v[i] = *(const v4u*)(vp + (size_t)key * ld + dc * 8); }
}
__device__ __forceinline__ void tile_store(const TileRegs& r, LAS unsigned char* kb, LAS unsigned char* vb, int tid) {
#if NSA_OPAQUE
    asm volatile("" : "+v"(tid));
#endif
#pragma unroll
    for (int i = 0; i < 2; ++i) { const int id = tid + 512 * i, key = id >> 4, dc = id & 15; *(LAS v4u*)(kb + offK(key, dc)) = r.k[i]; *(LAS v4u*)(vb + offV(key, dc)) = r.v[i]; }
}
__device__ __forceinline__ void tile_dma(const bf16* kp, const bf16* vp, int ld, LAS unsigned char* kb, LAS unsigned char* vb, int w, int lane) {
    asm volatile("" : "+v"(lane));
#pragma unroll
    for (int i = 0; i < 2; ++i) {
        const int p = 2 * w + i, key = 4 * p + (lane >> 4), sl = lane & 15;
        const int dck = sl ^ ((key & 3) | (((key >> 4) & 3) << 2));
        const int dcv = 2 * ((sl >> 1) ^ ((key & 3) | (((key >> 4) & 1) << 2))) + (sl & 1);
        __builtin_amdgcn_global_load_lds((const unsigned*)(kp + (size_t)key * ld + dck * 8), (LAS unsigned*)(kb + 1024 * p), 16, 0, 0);
        __builtin_amdgcn_global_load_lds((const unsigned*)(vp + (size_t)key * ld + dcv * 8), (LAS unsigned*)(vb + 1024 * p), 16, 0, 0);
    }
}
__device__ __forceinline__ void dma_k4(const bf16* kp, int ld, LAS unsigned char* kb, int w, int lane) {
    asm volatile("" : "+v"(lane));
#pragma unroll
    for (int i = 0; i < 4; ++i) {
        const int p = 4 * w + i, key = 4 * p + (lane >> 4), sl = lane & 15;
        const int dck = sl ^ ((key & 3) | (((key >> 4) & 3) << 2));
        __builtin_amdgcn_global_load_lds((const unsigned*)(kp + (size_t)key * ld + dck * 8), (LAS unsigned*)(kb + 1024 * p), 16, 0, 0);
    }
}
__device__ __forceinline__ void dma_v4(const bf16* vp, int ld, LAS unsigned char* vb, int w, int lane) {
    asm volatile("" : "+v"(lane));
#pragma unroll
    for (int i = 0; i < 4; ++i) {
        const int p = 4 * w + i, key = 4 * p + (lane >> 4), sl = lane & 15;
        const int dcv = 2 * ((sl >> 1) ^ ((key & 3) | (((key >> 4) & 1) << 2))) + (sl & 1);
        __builtin_amdgcn_global_load_lds((const unsigned*)(vp + (size_t)key * ld + dcv * 8), (LAS unsigned*)(vb + 1024 * p), 16, 0, 0);
    }
}
#define ATT_WAIT_V(n) asm volatile("s_waitcnt vmcnt(" #n ")" ::: "memory")
#define ATT_BAR() do { asm volatile("s_waitcnt lgkmcnt(0)" ::: "memory"); __builtin_amdgcn_s_barrier(); asm volatile("" ::: "memory"); } while (0)
template <bool OPAQUE = true>
__device__ __forceinline__ void qk_tile(f32x4 (&s)[2][4], const bf16x8 (&qf)[2][4], const LAS unsigned char* kb, int c, int q4) {
    if (OPAQUE) asm volatile("" : "+v"(c), "+v"(q4));
    const int rowoff = (16 * (c >> 2) + (c & 3)) * 256, lowp = 16 * (q4 ^ (c & 3));
#pragma unroll
    for (int kt = 0; kt < 4; ++kt) { s[0][kt] = (f32x4){0.f, 0.f, 0.f, 0.f}; s[1][kt] = (f32x4){0.f, 0.f, 0.f, 0.f}; }
#pragma unroll
    for (int ks = 0; ks < 4; ++ks) {
        const int a = rowoff + 64 * (ks ^ (c >> 2)) + lowp;
#pragma unroll
        for (int kt = 0; kt < 4; ++kt) {
            const bf16x8 kf = *(const LAS bf16x8*)(kb + a + kt * 1024);
            s[0][kt] = __builtin_amdgcn_mfma_f32_16x16x32_bf16(kf, qf[0][ks], s[0][kt], 0, 0, 0);
            s[1][kt] = __builtin_amdgcn_mfma_f32_16x16x32_bf16(kf, qf[1][ks], s[1][kt], 0, 0, 0);
        }
    }
}
__device__ __forceinline__ void qk_tile_lq(f32x4 (&s)[2][4], const LAS unsigned char* qb, const LAS unsigned char* kb, int c, int q4, int lane) {
#if NSA_OPAQUE
    asm volatile("" : "+v"(c), "+v"(q4), "+v"(lane));
#endif
    const int rowoff = (16 * (c >> 2) + (c & 3)) * 256, lowp = 16 * (q4 ^ (c & 3));
#pragma unroll
    for (int kt = 0; kt < 4; ++kt) { s[0][kt] = (f32x4){0.f, 0.f, 0.f, 0.f}; s[1][kt] = (f32x4){0.f, 0.f, 0.f, 0.f}; }
#pragma unroll
    for (int ks = 0; ks < 4; ++ks) {
        const int a = rowoff + 64 * (ks ^ (c >> 2)) + lowp;
        const bf16x8 q0 = *(const LAS bf16x8*)(qb + (ks * 64 + lane) * 16), q1 = *(const LAS bf16x8*)(qb + ((4 + ks) * 64 + lane) * 16);
#pragma unroll
        for (int kt = 0; kt < 4; ++kt) {
            const bf16x8 kf = *(const LAS bf16x8*)(kb + a + kt * 1024);
            s[0][kt] = __builtin_amdgcn_mfma_f32_16x16x32_bf16(kf, q0, s[0][kt], 0, 0, 0);
            s[1][kt] = __builtin_amdgcn_mfma_f32_16x16x32_bf16(kf, q1, s[1][kt], 0, 0, 0);
        }
    }
}
__device__ __forceinline__ void pv_tile(f32x4 (&o)[8][2], const bf16x8 (&pf)[2][2], const LAS unsigned char* vb, int c, int q4) {
#if NSA_OPAQUE
    asm volatile("" : "+v"(c), "+v"(q4));
#endif
    const int p = c & 3;
#pragma unroll
    for (int s2 = 0; s2 < 2; ++s2) {
        const int key0 = 16 * q4 + 8 * s2 + (c >> 2);
        const int g = (key0 & 3) | (((key0 >> 4) & 1) << 2);
        const int base = key0 * 256 + 16 * (p >> 1) + 8 * (p & 1);
#pragma unroll
        for (int dt = 0; dt < 8; ++dt) {
            const LAS unsigned char* a0 = vb + base + 32 * (dt ^ g);
            const s16x4 lo = __builtin_amdgcn_ds_read_tr16_b64_v4i16((LAS s16x4*)a0);
            const s16x4 hi = __builtin_amdgcn_ds_read_tr16_b64_v4i16((LAS s16x4*)(a0 + 1024));
            const bf16x8 vf = __builtin_shufflevector(lo, hi, 0, 1, 2, 3, 4, 5, 6, 7);
            o[dt][0] = __builtin_amdgcn_mfma_f32_16x16x32_bf16(vf, pf[0][s2], o[dt][0], 0, 0, 0);
            o[dt][1] = __builtin_amdgcn_mfma_f32_16x16x32_bf16(vf, pf[1][s2], o[dt][1], 0, 0, 0);
        }
    }
}
__device__ __forceinline__ s16x4 tr_read_asm(unsigned addr) { s16x4 r; asm volatile("ds_read_b64_tr_b16 %0, %1" : "=v"(r) : "v"(addr) : "memory"); return r; }
__device__ __forceinline__ s16x4 tr_read_asm_1k(unsigned addr) { s16x4 r; asm volatile("ds_read_b64_tr_b16 %0, %1 offset:1024" : "=v"(r) : "v"(addr) : "memory"); return r; }
template <bool OPAQUE = true>
__device__ __forceinline__ void pv_tile_asm(f32x4 (&o)[8][2], const bf16x8 (&pf)[2][2], const LAS unsigned char* vb, int c, int q4) {
    if (OPAQUE) asm volatile("" : "+v"(c), "+v"(q4));
    const int p = c & 3;
#pragma unroll
    for (int s2 = 0; s2 < 2; ++s2) {
        const int key0 = 16 * q4 + 8 * s2 + (c >> 2);
        const int g = (key0 & 3) | (((key0 >> 4) & 1) << 2);
        const unsigned base = (unsigned)(size_t)vb + key0 * 256 + 16 * (p >> 1) + 8 * (p & 1);
        s16x4 lo[8], hi[8];
#pragma unroll
        for (int dt = 0; dt < 8; ++dt) { const unsigned a0 = base + 32 * (dt ^ g); lo[dt] = tr_read_asm(a0); hi[dt] = tr_read_asm_1k(a0); }
        asm volatile("s_waitcnt lgkmcnt(0)" ::: "memory");
        __builtin_amdgcn_sched_barrier(0);
#pragma unroll
        for (int dt = 0; dt < 8; ++dt) {
            const bf16x8 vf = __builtin_shufflevector(lo[dt], hi[dt], 0, 1, 2, 3, 4, 5, 6, 7);
            o[dt][0] = __builtin_amdgcn_mfma_f32_16x16x32_bf16(vf, pf[0][s2], o[dt][0], 0, 0, 0);
            o[dt][1] = __builtin_amdgcn_mfma_f32_16x16x32_bf16(vf, pf[1][s2], o[dt][1], 0, 0, 0);
        }
    }
}
struct VGroup { s16x4 lo[4], hi[4]; };
template <int G>
__device__ __forceinline__ void pv_issue(VGroup& v, const LAS unsigned char* vb, int c, int q4) {
    constexpr int s2 = G >> 1, d0 = 4 * (G & 1);
    const int p = c & 3, key0 = 16 * q4 + 8 * s2 + (c >> 2), g = (key0 & 3) | (((key0 >> 4) & 1) << 2);
    const unsigned base = (unsigned)(size_t)vb + key0 * 256 + 16 * (p >> 1) + 8 * (p & 1);
#pragma unroll
    for (int i = 0; i < 4; ++i) { const unsigned a0 = base + 32 * ((d0 + i) ^ g); v.lo[i] = tr_read_asm(a0); v.hi[i] = tr_read_asm_1k(a0); }
}
template <int G>
__device__ __forceinline__ void pv_mma(f32x4 (&o)[8][2], const VGroup& v, const bf16x8 (&pf)[2][2]) {
    constexpr int s2 = G >> 1, d0 = 4 * (G & 1);
#pragma unroll
    for (int i = 0; i < 4; ++i) {
        const bf16x8 vf = __builtin_shufflevector(v.lo[i], v.hi[i], 0, 1, 2, 3, 4, 5, 6, 7);
        o[d0 + i][0] = __builtin_amdgcn_mfma_f32_16x16x32_bf16(vf, pf[0][s2], o[d0 + i][0], 0, 0, 0);
        o[d0 + i][1] = __builtin_amdgcn_mfma_f32_16x16x32_bf16(vf, pf[1][s2], o[d0 + i][1], 0, 0, 0);
    }
}
#define PV_WAIT() do { asm volatile("s_waitcnt lgkmcnt(0)" ::: "memory"); __builtin_amdgcn_sched_barrier(0); } while (0)
__device__ __forceinline__ void pv_tile_rest(f32x4 (&o)[8][2], VGroup& va, const bf16x8 (&pf)[2][2], const LAS unsigned char* vb, int c, int q4) {
    VGroup vb2;
    PV_WAIT(); pv_issue<1>(vb2, vb, c, q4); __builtin_amdgcn_sched_barrier(0); pv_mma<0>(o, va, pf);
    PV_WAIT(); pv_issue<2>(va, vb, c, q4);  __builtin_amdgcn_sched_barrier(0); pv_mma<1>(o, vb2, pf);
    PV_WAIT(); pv_issue<3>(vb2, vb, c, q4); __builtin_amdgcn_sched_barrier(0); pv_mma<2>(o, va, pf);
    PV_WAIT(); pv_mma<3>(o, vb2, pf);
}
__device__ __forceinline__ bf16x8 pack8(float a0, float a1, float a2, float a3, float a4, float a5, float a6, float a7) {
    v4u w; w.x = cvt_pk_bf16(a0, a1); w.y = cvt_pk_bf16(a2, a3); w.z = cvt_pk_bf16(a4, a5); w.w = cvt_pk_bf16(a6, a7);
    return __builtin_bit_cast(bf16x8, w);
}


template <bool MASK>
__device__ __forceinline__ void sb_elem(const f32x4 (&s)[4], float& R, bf16x8 (&pf)[2], const int kdiff, const int c, const int q4) {
    f32x2 a2[8]; f32x2 t2 = (f32x2){1.f, 1.f};
#pragma unroll
    for (int k = 0; k < 8; ++k) {
        f32x2 e;
        e.x = __builtin_amdgcn_exp2f(s[k >> 2][k & 3]); e.y = __builtin_amdgcn_exp2f(s[2 + (k >> 2)][k & 3]);
        if (MASK) { e.x = (k < kdiff) ? e.x : 0.f; e.y = (k + 8 < kdiff) ? e.y : 0.f; }
        a2[k] = e * t2; t2 = t2 * (e + 1.0f);
    }
    const float l0 = __builtin_amdgcn_logf(t2.x), l1 = __builtin_amdgcn_logf(t2.y), run = l0 + l1;
    const float u1 = __shfl_down(run, 16), u2 = __shfl_down(run, 32), u3 = __shfl_down(run, 48);
    const float X = (q4 < 3 ? u1 : 0.f) + (q4 < 2 ? u2 : 0.f) + (q4 < 1 ? u3 : 0.f);
    const float tot = __shfl(run + X, c);
    const float base = R + X + l1;
    f32x2 sc; sc.y = __builtin_amdgcn_exp2f(-base); sc.x = __builtin_amdgcn_exp2f(-(base + l0));
    R += tot;
#pragma unroll
    for (int k = 0; k < 8; ++k) a2[k] = a2[k] * sc;
    pf[0] = pack8(a2[0].x, a2[1].x, a2[2].x, a2[3].x, a2[4].x, a2[5].x, a2[6].x, a2[7].x);
    pf[1] = pack8(a2[0].y, a2[1].y, a2[2].y, a2[3].y, a2[4].y, a2[5].y, a2[6].y, a2[7].y);
}

template <int MODE = 31>
__device__ __forceinline__ void sb_unit(const Params& P, LAS unsigned char* lds, const bf16* PROJ, const bf16* KVC, bf16* Y, int b, int h, int tqq) {
    int tid = threadIdx.x; asm volatile("" : "+v"(tid));
    const int lane = tid & 63, w = __builtin_amdgcn_readfirstlane(tid >> 6), c = lane & 15, q4 = lane >> 4;
    const int qbase = 256 * tqq + 32 * w;
    bf16x8 qf[2][4];
#pragma unroll
    for (int qt = 0; qt < 2; ++qt)
#pragma unroll
        for (int ks = 0; ks < 4; ++ks) qf[qt][ks] = *(const bf16x8*)(PROJ + (size_t)(b * SEQ + qbase + 16 * qt + c) * NP + C_QS + h * 128 + 32 * ks + 8 * q4);
#pragma unroll
    for (int qt = 0; qt < 2; ++qt)
#pragma unroll
        for (int ks = 0; ks < 4; ++ks) asm volatile("" : "+v"(qf[qt][ks]));
    f32x4 o[8][2];
#pragma unroll
    for (int dt = 0; dt < 8; ++dt) { o[dt][0] = (f32x4){0.f, 0.f, 0.f, 0.f}; o[dt][1] = (f32x4){0.f, 0.f, 0.f, 0.f}; }
    float R[2] = {0.f, 0.f};
#if SB_COMPACT
    const bf16* kg = KVC + (size_t)((b * 8 + h) * 4096) * 128; const bf16* vg = KVC + (size_t)((32 + b * 8 + h) * 4096) * 128;
    constexpr int KLD = 128;
#else
    const bf16* kg = PROJ + (size_t)(b * SEQ) * NP + C_KSB + h * 128; const bf16* vg = PROJ + (size_t)(b * SEQ) * NP + C_VSB + h * 128;
    constexpr int KLD = NP;
#endif
    const int nkt = 4 * tqq + 4;
    const bool isA = w < 4;
    if (isA && (MODE & 8)) { dma_k4(kg + (size_t)(nkt - 1) * 64 * KLD, KLD, lds, w, lane); dma_v4(vg + (size_t)(nkt - 1) * 64 * KLD, KLD, lds + 32768, w, lane); ATT_WAIT_V(0); }
    ATT_BAR();
    if (!isA) ATT_BAR();
    for (int it = 0; it < nkt; ++it) {
        const int kt64 = nkt - 1 - it, kb0 = 64 * kt64, cur = it & 1;
        const bool has = it + 1 < nkt, active = kb0 <= qbase + 30, need_mask = (kb0 + 63 >= qbase);
        const LAS unsigned char* kb = lds + cur * 16384; const LAS unsigned char* vb = lds + 32768 + cur * 16384;
        f32x4 s[2][4]; bf16x8 pf[2][2];
        if (isA && has && (MODE & 8)) dma_k4(kg + (size_t)(kt64 - 1) * 64 * KLD, KLD, lds + (cur ^ 1) * 16384, w, lane);
        if (active) {
            if (MODE & 1) qk_tile<false>(s, qf, kb, c, q4);
            else {
#pragma unroll
                for (int kt = 0; kt < 4; ++kt) { s[0][kt] = (f32x4){0.1f, -0.2f, 0.3f, R[0]}; s[1][kt] = (f32x4){-0.1f, 0.2f, -0.3f, R[1]}; asm volatile("" : "+v"(s[0][kt]), "+v"(s[1][kt])); } }
            if (MODE & 2) { if (need_mask) sb_elem<true>(s[0], R[0], pf[0], qbase + c - kb0 - 16 * q4, c, q4); else sb_elem<false>(s[0], R[0], pf[0], 64, c, q4); }
            else { pf[0][0] = __builtin_bit_cast(bf16x8, s[0][0]); pf[0][1] = __builtin_bit_cast(bf16x8, s[0][1]); R[0] += s[0][2][0] + s[0][3][1]; }
        }
        if (isA) { if (has) ATT_WAIT_V(4); else ATT_WAIT_V(0); }
        if (MODE & 16) ATT_BAR();
        if (isA && has && (MODE & 8)) dma_v4(vg + (size_t)(kt64 - 1) * 64 * KLD, KLD, lds + 32768 + (cur ^ 1) * 16384, w, lane);
        if (active) {
            VGroup vg0;
            if (MODE & 4) { pv_issue<0>(vg0, vb, c, q4); __builtin_amdgcn_sched_barrier(0); }
            if (MODE & 2) { if (need_mask) sb_elem<true>(s[1], R[1], pf[1], qbase + 16 + c - kb0 - 16 * q4, c, q4); else sb_elem<false>(s[1], R[1], pf[1], 64, c, q4); }
            else { pf[1][0] = __builtin_bit_cast(bf16x8, s[1][0]); pf[1][1] = __builtin_bit_cast(bf16x8, s[1][1]); R[1] += s[1][2][0] + s[1][3][1]; }
            if (MODE & 4) pv_tile_rest(o, vg0, pf, vb, c, q4);
            else { o[0][0] = o[0][0] + __builtin_bit_cast(f32x4, pf[0][0]) + __builtin_bit_cast(f32x4, pf[0][1]); o[0][1] = o[0][1] + __builtin_bit_cast(f32x4, pf[1][0]) + __builtin_bit_cast(f32x4, pf[1][1]); }
        }
        if (isA) { if (has) ATT_WAIT_V(4); else ATT_WAIT_V(0); }
        if (MODE & 16) ATT_BAR();
    }
    if (isA) ATT_BAR();
    f32x4 gsb[8];
#pragma unroll
    for (int dt = 0; dt < 8; ++dt) gsb[dt] = *(const f32x4*)(P.sb_on + h * 128 + 4 * q4 + 16 * dt);
#pragma unroll
    for (int qt = 0; qt < 2; ++qt) {
        float ss = 0.f;
#pragma unroll
        for (int dt = 0; dt < 8; ++dt) { const f32x4 v = o[dt][qt]; ss += (v[0] * v[0] + v[1] * v[1]) + (v[2] * v[2] + v[3] * v[3]); }
        ss += __shfl_xor(ss, 16); ss += __shfl_xor(ss, 32);
        const float r = rsqrtf(ss * (1.f / 128.f) + EPS);
        bf16* yrow = Y + (size_t)(b * SEQ + qbase + 16 * qt + c) * D + 1024 + h * 128 + 4 * q4;
#pragma unroll
        for (int dt = 0; dt < 8; ++dt) { const f32x4 v = o[dt][qt]; const f32x4 gg = gsb[dt];
            v2u wv; wv.x = cvt_pk_bf16(v[0] * r * gg[0], v[1] * r * gg[1]); wv.y = cvt_pk_bf16(v[2] * r * gg[2], v[3] * r * gg[3]);
            *(v2u*)(yrow + 16 * dt) = wv; }
    }
}

__device__ __forceinline__ void osm_step(const f32x4 (&s)[4], const bool bsel, const bool masked, const int lo, const int hi, float& m, float& l, f32x4 (&o)[8][2], const int qt, bf16x8 (&pf)[2]) {
    float v[16];
#pragma unroll
    for (int idx = 0; idx < 16; ++idx) v[idx] = s[idx >> 2][idx & 3];
    if (masked) {
#pragma unroll
        for (int idx = 0; idx < 16; ++idx) v[idx] = (idx >= lo && idx <= hi) ? v[idx] : -1e30f;
    }
    float tm = fmaxf(fmaxf(fmaxf(v[0], v[1]), fmaxf(v[2], v[3])), fmaxf(fmaxf(v[4], v[5]), fmaxf(v[6], v[7])));
    tm = fmaxf(tm, fmaxf(fmaxf(fmaxf(v[8], v[9]), fmaxf(v[10], v[11])), fmaxf(fmaxf(v[12], v[13]), fmaxf(v[14], v[15]))));
    tm = fmaxf(tm, __shfl_xor(tm, 16)); tm = fmaxf(tm, __shfl_xor(tm, 32));
    tm = bsel ? tm : -1e30f;
    const bool grow = tm > m + 8.0f;
    if (__any(grow)) {
        const float mn = grow ? tm : m, alpha = __builtin_amdgcn_exp2f(m - mn);
        l *= alpha; m = mn;
#pragma unroll
        for (int dt = 0; dt < 8; ++dt) o[dt][qt] = o[dt][qt] * alpha;
    }
    const float sub = bsel ? m : 1e30f;
    float sum = 0.f;
#pragma unroll
    for (int idx = 0; idx < 16; ++idx) { v[idx] = __builtin_amdgcn_exp2f(v[idx] - sub); sum += v[idx]; }
    l += sum;
    pf[0] = pack8(v[0], v[1], v[2], v[3], v[4], v[5], v[6], v[7]);
    pf[1] = pack8(v[8], v[9], v[10], v[11], v[12], v[13], v[14], v[15]);
}
#define ATT_TILE_PROLOGUE(KP, VP, LD) do { tile_load(tr, (KP), (VP), (LD), tid); __syncthreads(); tile_store(tr, lds, lds + 32768, tid); __syncthreads(); } while (0)
#define ATT_TILE_NEXT(HAS, KP, VP, LD) do { if (HAS) tile_load(tr, (KP), (VP), (LD), tid); } while (0)
#define ATT_TILE_END(HAS, CUR) do { if (HAS) tile_store(tr, lds + ((CUR) ^ 1) * 16384, lds + 32768 + ((CUR) ^ 1) * 16384, tid); __syncthreads(); } while (0)

__device__ __forceinline__ void nsa_unit(const Params& P, LAS unsigned char* lds, const bf16* PROJ, const bf16* KC, const bf16* VC, bf16* Y, f32x4* scr, int b, int g, int tq) {
    int tid = threadIdx.x; asm volatile("" : "+v"(tid));
    const int lane = tid & 63, w = __builtin_amdgcn_readfirstlane(tid >> 6), c = lane & 15, q4 = lane >> 4;
    const int bg = b * 2 + g, t0 = 64 * tq, hg = g * 4 + (c & 3);
    LAS float* pslc = (LAS float*)(lds + 131072);
    LAS unsigned long long* selm = (LAS unsigned long long*)(lds + 147456);
    LAS unsigned char* qb = lds + 65536 + w * 8192;
    scr += (size_t)w * 32 * 64;
    int ql[2]; ql[0] = 8 * w + (c >> 2); ql[1] = ql[0] + 4;
#pragma unroll
    for (int i = 0; i < 8; ++i) pslc[(8 * w + i) * 64 + lane] = 0.f;
    bf16x8 qf[2][4];
#pragma unroll
    for (int qt = 0; qt < 2; ++qt) {
        const bf16* prow = PROJ + (size_t)(b * SEQ + t0 + ql[qt]) * NP;
#pragma unroll
        for (int ks = 0; ks < 4; ++ks) qf[qt][ks] = *(const bf16x8*)(prow + C_QN + hg * 128 + 32 * ks + 8 * q4);
    }
#pragma unroll
    for (int qt = 0; qt < 2; ++qt)
#pragma unroll
        for (int ks = 0; ks < 4; ++ks) asm volatile("" : "+v"(qf[qt][ks]));
    float gates[2][3];
    {
        bf16 graw[2][3];
#pragma unroll
        for (int qt = 0; qt < 2; ++qt)
#pragma unroll
            for (int br = 0; br < 3; ++br) graw[qt][br] = PROJ[(size_t)(b * SEQ + t0 + ql[qt]) * NP + C_GATE + hg * 3 + br];
#pragma unroll
        for (int qt = 0; qt < 2; ++qt)
#pragma unroll
            for (int br = 0; br < 3; ++br) gates[qt][br] = 1.f / (1.f + __expf(-bf2f(graw[qt][br])));
    }
    TileRegs tr;
    f32x4 o[8][2];
    float mx[2], ls[2];
    const bf16* kcg = KC + (size_t)bg * 256 * 128; const bf16* vcg = VC + (size_t)bg * 256 * 128;
    const int nvmax = min(NCMP, 4 * tq + 3), ntc = (nvmax + 63) >> 6;
    mx[0] = mx[1] = -1e20f; ls[0] = ls[1] = 0.f;
    ATT_TILE_PROLOGUE(kcg, vcg, 128);
    for (int it = 0; it < ntc; ++it) {
        const int cur = it & 1; const bool has = it + 1 < ntc;
        ATT_TILE_NEXT(has, kcg + (size_t)(it + 1) * 64 * 128, vcg + (size_t)(it + 1) * 64 * 128, 128);
        {
            f32x4 s[2][4];
            qk_tile<false>(s, qf, lds + cur * 16384, c, q4);
#pragma unroll
            for (int qt = 0; qt < 2; ++qt) {
                const int lim = t0 + ql[qt] - 31 - 16 * (64 * it + 16 * q4);
                float tm = -1e30f, v[16];
#pragma unroll
                for (int kt = 0; kt < 4; ++kt)
#pragma unroll
                    for (int i = 0; i < 4; ++i) { v[4 * kt + i] = (16 * (4 * kt + i) <= lim) ? s[qt][kt][i] : -1e30f; tm = fmaxf(tm, v[4 * kt + i]); }
                tm = fmaxf(tm, __shfl_xor(tm, 16)); tm = fmaxf(tm, __shfl_xor(tm, 32));
                const float mn = fmaxf(mx[qt], tm); float sum = 0.f;
#pragma unroll
                for (int i = 0; i < 16; ++i) sum += __builtin_amdgcn_exp2f(v[i] - mn);
                ls[qt] = ls[qt] * __builtin_amdgcn_exp2f(mx[qt] - mn) + sum; mx[qt] = mn;
            }
        }
        ATT_TILE_END(has, cur);
    }
    float inv[2];
#pragma unroll
    for (int qt = 0; qt < 2; ++qt) { float l = ls[qt]; l += __shfl_xor(l, 16); l += __shfl_xor(l, 32); inv[qt] = l > 0.f ? 1.f / l : 0.f; }
    float g0v[2]; g0v[0] = gates[0][0]; g0v[1] = gates[1][0];
#pragma unroll
    for (int dt = 0; dt < 8; ++dt) { o[dt][0] = (f32x4){0.f, 0.f, 0.f, 0.f}; o[dt][1] = (f32x4){0.f, 0.f, 0.f, 0.f}; }
    ATT_TILE_PROLOGUE(kcg, vcg, 128);
    for (int it = 0; it < ntc; ++it) {
        const int cur = it & 1; const bool has = it + 1 < ntc;
        ATT_TILE_NEXT(has, kcg + (size_t)(it + 1) * 64 * 128, vcg + (size_t)(it + 1) * 64 * 128, 128);
        {
            f32x4 s[2][4];
            qk_tile<false>(s, qf, lds + cur * 16384, c, q4);
            bf16x8 pf[2][2];
#pragma unroll
            for (int qt = 0; qt < 2; ++qt) {
                const int lim = t0 + ql[qt] - 31 - 16 * (64 * it + 16 * q4);
                float p[16];
#pragma unroll
                for (int kt = 0; kt < 4; ++kt)
#pragma unroll
                    for (int i = 0; i < 4; ++i) p[4 * kt + i] = (16 * (4 * kt + i) <= lim) ? __builtin_amdgcn_exp2f(s[qt][kt][i] - mx[qt]) * inv[qt] : 0.f;
                const int jb = 16 * it + 4 * q4;
#pragma unroll
                for (int kt = 0; kt < 4; ++kt) {
                    float gs = (p[4 * kt] + p[4 * kt + 1]) + (p[4 * kt + 2] + p[4 * kt + 3]), e3 = p[4 * kt + 3];
                    gs += __shfl_xor(gs, 1); gs += __shfl_xor(gs, 2); e3 += __shfl_xor(e3, 1); e3 += __shfl_xor(e3, 2);
                    if ((c & 3) == 0) {
                        LAS float* row = pslc + ql[qt] * 64;
                        __hip_atomic_fetch_add(row + jb + kt, gs, __ATOMIC_RELAXED, __HIP_MEMORY_SCOPE_WORKGROUP);
                        if (jb + kt + 1 < 64) __hip_atomic_fetch_add(row + jb + kt + 1, e3, __ATOMIC_RELAXED, __HIP_MEMORY_SCOPE_WORKGROUP);
                    }
                }
                const float g0 = g0v[qt];
                pf[qt][0] = pack8(p[0] * g0, p[1] * g0, p[2] * g0, p[3] * g0, p[4] * g0, p[5] * g0, p[6] * g0, p[7] * g0);
                pf[qt][1] = pack8(p[8] * g0, p[9] * g0, p[10] * g0, p[11] * g0, p[12] * g0, p[13] * g0, p[14] * g0, p[15] * g0);
            }
            pv_tile(o, pf, lds + 32768 + cur * 16384, c, q4);
        }
        ATT_TILE_END(has, cur);
    }
#pragma unroll
    for (int dt = 0; dt < 8; ++dt) { scr[lane * 32 + 2 * dt] = o[dt][0]; scr[lane * 32 + 2 * dt + 1] = o[dt][1]; }
    asm volatile("s_waitcnt lgkmcnt(0)" ::: "memory");
    {
        unsigned long long wor = 0ull;
        const int j = lane;
        const bool causal = j <= tq, forced = (j == 0) || (j == tq) || (j == tq - 1);
        const unsigned long long cmask = __ballot(causal);
        for (int i = 0; i < 8; ++i) {
            const float pv = pslc[(8 * w + i) * 64 + j];
            const unsigned key = causal ? (forced ? 0xFFFFFFFFu : __float_as_uint(pv) + 1u) : 0u;
            unsigned T = 0u;
#pragma unroll
            for (int bit = 31; bit >= 0; --bit) { const unsigned cand = T | (1u << bit); if (__popcll(__ballot(key >= cand)) >= 16) T = cand; }
            const unsigned long long gt = __ballot(key > T); unsigned long long eq = __ballot(key == T), take = 0ull;
            for (int need = 16 - __popcll(gt); need > 0 && eq != 0ull; --need) { const unsigned long long low = eq & (~eq + 1ull); take |= low; eq ^= low; }
            const unsigned long long mask = (gt | take) & cmask;
            if (lane == 0) selm[8 * w + i] = mask;
            wor |= mask;
        }
        if (lane == 0) selm[64 + w] = wor;
    }
    __syncthreads();
    unsigned long long uni = 0ull;
#pragma unroll
    for (int i = 0; i < 8; ++i) uni |= selm[64 + i];
    uni = ((unsigned long long)__builtin_amdgcn_readfirstlane((unsigned)(uni >> 32)) << 32) | (unsigned long long)__builtin_amdgcn_readfirstlane((unsigned)uni);
    {
#pragma unroll
        for (int dt = 0; dt < 8; ++dt) { o[dt][0] = (f32x4){0.f, 0.f, 0.f, 0.f}; o[dt][1] = (f32x4){0.f, 0.f, 0.f, 0.f}; }
        mx[0] = mx[1] = -1e20f; ls[0] = ls[1] = 0.f;
        const bf16* kg = PROJ + (size_t)(b * SEQ) * NP + C_KS + g * 128; const bf16* vg = PROJ + (size_t)(b * SEQ) * NP + C_VS + g * 128;
        unsigned long long rem = uni;
        int j = __builtin_ctzll(rem); rem &= rem - 1ull;
        ATT_TILE_PROLOGUE(kg + (size_t)j * 64 * NP, vg + (size_t)j * 64 * NP, NP);
        for (int it = 0;; ++it) {
            const int cur = it & 1; const bool has = rem != 0ull;
            const int jn = has ? __builtin_ctzll(rem) : 0; rem &= rem - 1ull;
            ATT_TILE_NEXT(has, kg + (size_t)jn * 64 * NP, vg + (size_t)jn * 64 * NP, NP);
            const bool b0 = (selm[ql[0]] >> j) & 1ull, b1 = (selm[ql[1]] >> j) & 1ull;
            if (__ballot(b0 || b1) != 0ull) {
                f32x4 s[2][4];
                qk_tile<false>(s, qf, lds + cur * 16384, c, q4);
                bf16x8 pf[2][2];
                osm_step(s[0], b0, j == tq, -64, ql[0] - 16 * q4, mx[0], ls[0], o, 0, pf[0]);
                osm_step(s[1], b1, j == tq, -64, ql[1] - 16 * q4, mx[1], ls[1], o, 1, pf[1]);
                pv_tile(o, pf, lds + 32768 + cur * 16384, c, q4);
            }
            ATT_TILE_END(has, cur);
            if (!has) break;
            j = jn;
        }
#pragma unroll
        for (int qt = 0; qt < 2; ++qt) {
            float l = ls[qt]; l += __shfl_xor(l, 16); l += __shfl_xor(l, 32);
            const float cb = gates[qt][1] / l;
#pragma unroll
            for (int dt = 0; dt < 8; ++dt) scr[lane * 32 + 16 + 2 * dt + qt] = o[dt][qt] * cb;
        }
    }
    {
#pragma unroll
        for (int dt = 0; dt < 8; ++dt) { o[dt][0] = (f32x4){0.f, 0.f, 0.f, 0.f}; o[dt][1] = (f32x4){0.f, 0.f, 0.f, 0.f}; }
        mx[0] = mx[1] = -1e20f; ls[0] = ls[1] = 0.f;
        const bf16* kg = PROJ + (size_t)(b * SEQ) * NP + C_KW + g * 128; const bf16* vg = PROJ + (size_t)(b * SEQ) * NP + C_VW + g * 128;
        const int k0 = max(0, tq - 8), nw = tq - k0 + 1;
        ATT_TILE_PROLOGUE(kg + (size_t)k0 * 64 * NP, vg + (size_t)k0 * 64 * NP, NP);
        for (int it = 0; it < nw; ++it) {
            const int cur = it & 1, kt64 = k0 + it; const bool has = it + 1 < nw;
            ATT_TILE_NEXT(has, kg + (size_t)(kt64 + 1) * 64 * NP, vg + (size_t)(kt64 + 1) * 64 * NP, NP);
            {
                f32x4 s[2][4];
                qk_tile<false>(s, qf, lds + cur * 16384, c, q4);
                bf16x8 pf[2][2];
                {
                    const int d0 = ql[0] - 16 * q4, d1 = ql[1] - 16 * q4;
                    const bool first = (kt64 == tq - 8), edge = first || (kt64 == tq);
                    osm_step(s[0], true, edge, first ? d0 + 1 : -64, first ? 64 : d0, mx[0], ls[0], o, 0, pf[0]);
                    osm_step(s[1], true, edge, first ? d1 + 1 : -64, first ? 64 : d1, mx[1], ls[1], o, 1, pf[1]);
                }
                pv_tile(o, pf, lds + 32768 + cur * 16384, c, q4);
            }
            ATT_TILE_END(has, cur);
        }
    }
    f32x4 gns[8];
#pragma unroll
    for (int dt = 0; dt < 8; ++dt) gns[dt] = *(const f32x4*)(P.nsa_on + hg * 128 + 4 * q4 + 16 * dt);
#pragma unroll
    for (int qt = 0; qt < 2; ++qt) {
        float l = ls[qt]; l += __shfl_xor(l, 16); l += __shfl_xor(l, 32);
        const float cb = gates[qt][2] / l;
        float ss = 0.f;
#pragma unroll
        for (int dt = 0; dt < 8; ++dt) { const f32x4 a = (scr[lane * 32 + 2 * dt + qt] + scr[lane * 32 + 16 + 2 * dt + qt]) + o[dt][qt] * cb; o[dt][qt] = a; ss += (a[0] * a[0] + a[1] * a[1]) + (a[2] * a[2] + a[3] * a[3]); if ((dt & 3) == 3) __builtin_amdgcn_sched_barrier(0); }
        ss += __shfl_xor(ss, 16); ss += __shfl_xor(ss, 32);
        const float r = rsqrtf(ss * (1.f / 128.f) + EPS);
        bf16* yrow = Y + (size_t)(b * SEQ + t0 + ql[qt]) * D + hg * 128 + 4 * q4;
#pragma unroll
        for (int dt = 0; dt < 8; ++dt) { const f32x4 v = o[dt][qt]; const f32x4 gg = gns[dt];
            v2u wv; wv.x = cvt_pk_bf16(v[0] * r * gg[0], v[1] * r * gg[1]); wv.y = cvt_pk_bf16(v[2] * r * gg[2], v[3] * r * gg[3]);
            *(v2u*)(yrow + 16 * dt) = wv; if (dt & 1) __builtin_amdgcn_sched_barrier(0); }
    }
    __syncthreads();
}
__device__ __forceinline__ void nsa_phase(const Params& P, LAS unsigned char* lds, const bf16* PROJ, const bf16* KC, const bf16* VC, bf16* Y, f32x4* scratch) {
    for (int i = blockIdx.x; i < 512; i += gridDim.x) {
        const int u = (i < 256) ? i : 767 - i;
        const int tq = 63 - (u >> 3), bg = u & 7;
        nsa_unit(P, lds, PROJ, KC, VC, Y, scratch + (size_t)blockIdx.x * 16384, bg >> 1, bg & 1, tq);
    }
}

__device__ __forceinline__ void compress_unit(const Params& P, LAS unsigned char* lds, const bf16* PROJ, const float* cs, const float* sn, bf16* KC, bf16* VC, int which, int bg, int n0) {
    int tid = threadIdx.x; asm volatile("" : "+v"(tid));
    const int lane = tid & 63, w = __builtin_amdgcn_readfirstlane(tid >> 6), c = lane & 15, q4 = lane >> 4;
    const int b = bg >> 1, g = bg & 1, col = (which ? C_VC : C_KC) + g * 128;
    constexpr int XS = 272;
    __syncthreads();
    for (int i = tid; i < 272 * 8; i += NTHREADS) {
        const int tk = i >> 3, ch = i & 7, s = 16 * n0 + tk;
        v4u lo = (v4u){0u, 0u, 0u, 0u}, hi = (v4u){0u, 0u, 0u, 0u};
        if (s < SEQ) {
            const int m = b * SEQ + s;
            lo = *(const v4u*)(PROJ + (size_t)m * NP + col + 8 * ch); hi = *(const v4u*)(PROJ + (size_t)m * NP + col + 64 + 8 * ch);
            if (!which) {
                const f32x4 c0 = *(const f32x4*)(cs + m * 64 + 8 * ch), c1 = *(const f32x4*)(cs + m * 64 + 8 * ch + 4), s0 = *(const f32x4*)(sn + m * 64 + 8 * ch), s1 = *(const f32x4*)(sn + m * 64 + 8 * ch + 4);
                float a[8], d[8];
                a[0] = bflo(lo.x); a[1] = bfhi(lo.x); a[2] = bflo(lo.y); a[3] = bfhi(lo.y); a[4] = bflo(lo.z); a[5] = bfhi(lo.z); a[6] = bflo(lo.w); a[7] = bfhi(lo.w);
                d[0] = bflo(hi.x); d[1] = bfhi(hi.x); d[2] = bflo(hi.y); d[3] = bfhi(hi.y); d[4] = bflo(hi.z); d[5] = bfhi(hi.z); d[6] = bflo(hi.w); d[7] = bfhi(hi.w);
                float ra[8], rd[8];
#pragma unroll
                for (int e = 0; e < 8; ++e) { const float cc = e < 4 ? c0[e] : c1[e - 4], ss = e < 4 ? s0[e] : s1[e - 4]; ra[e] = a[e] * cc - d[e] * ss; rd[e] = d[e] * cc + a[e] * ss; }
                lo.x = cvt_pk_bf16(ra[0], ra[1]); lo.y = cvt_pk_bf16(ra[2], ra[3]); lo.z = cvt_pk_bf16(ra[4], ra[5]); lo.w = cvt_pk_bf16(ra[6], ra[7]);
                hi.x = cvt_pk_bf16(rd[0], rd[1]); hi.y = cvt_pk_bf16(rd[2], rd[3]); hi.z = cvt_pk_bf16(rd[4], rd[5]); hi.w = cvt_pk_bf16(rd[6], rd[7]);
            }
        }
        *(LAS v4u*)(lds + tk * XS + 16 * ch) = lo; *(LAS v4u*)(lds + tk * XS + 128 + 16 * ch) = hi;
    }
    __syncthreads();
    const bf16* w1t = (const bf16*)(P.ws + (which ? WS_WC1V : WS_WC1K)) + (size_t)(32 * w + c) * 4096 + 8 * q4;
    f32x4 h0 = (f32x4){0.f, 0.f, 0.f, 0.f}, h1 = (f32x4){0.f, 0.f, 0.f, 0.f};
    const LAS unsigned char* xb = lds + (16 * c) * XS + 16 * q4;
#pragma unroll 16
    for (int ks = 0; ks < 128; ++ks) {
        const bf16x8 xf = *(const LAS bf16x8*)(xb + (ks >> 2) * XS + (ks & 3) * 64);
        const bf16x8 a0 = *(const bf16x8*)(w1t + 32 * ks), a1 = *(const bf16x8*)(w1t + 16 * 4096 + 32 * ks);
        h0 = __builtin_amdgcn_mfma_f32_16x16x32_bf16(a0, xf, h0, 0, 0, 0);
        h1 = __builtin_amdgcn_mfma_f32_16x16x32_bf16(a1, xf, h1, 0, 0, 0);
    }
    const float* pb = (const float*)(P.ws + WS_PBIAS + 65536) + which * 256 + 32 * w + 4 * q4;
    const f32x4 pb0 = *(const f32x4*)pb, pb1 = *(const f32x4*)(pb + 16);
    const bf16x8 hf = pack8(gelu_tanh(h0[0] + pb0[0]), gelu_tanh(h0[1] + pb0[1]), gelu_tanh(h0[2] + pb0[2]), gelu_tanh(h0[3] + pb0[3]),
                            gelu_tanh(h1[0] + pb1[0]), gelu_tanh(h1[1] + pb1[1]), gelu_tanh(h1[2] + pb1[2]), gelu_tanh(h1[3] + pb1[3]));
    const bf16* w2t = (const bf16*)(P.ws + (which ? WS_WC2V : WS_WC2K)) + (size_t)c * 256 + 32 * w + 4 * q4;
    __syncthreads();
    LAS float* part = (LAS float*)lds;
#pragma unroll
    for (int dt = 0; dt < 8; ++dt) {
        const v2u wa = *(const v2u*)(w2t + (size_t)(16 * dt) * 256), wb = *(const v2u*)(w2t + (size_t)(16 * dt) * 256 + 16);
        v4u wv; wv.x = wa.x; wv.y = wa.y; wv.z = wb.x; wv.w = wb.y;
        const f32x4 oa = __builtin_amdgcn_mfma_f32_16x16x32_bf16(__builtin_bit_cast(bf16x8, wv), hf, (f32x4){0.f, 0.f, 0.f, 0.f}, 0, 0, 0);
        *(LAS f32x4*)(part + (w * 16 + c) * 128 + 16 * dt + 4 * q4) = oa;
    }
    __syncthreads();
#pragma unroll
    for (int r = 0; r < 2; ++r) {
        const int n = 2 * w + r;
        float a = 0.f, d = 0.f;
#pragma unroll
        for (int ww = 0; ww < 8; ++ww) { a += part[(ww * 16 + n) * 128 + lane]; d += part[(ww * 16 + n) * 128 + 64 + lane]; }
        if (!which) { const float rr = rsqrtf(wave_sum(a * a + d * d) * (1.f / 128.f) + EPS); a = a * rr * P.kc_norm[lane]; d = d * rr * P.kc_norm[lane + 64]; }
        bf16* op = (which ? VC : KC) + ((size_t)bg * 256 + n0 + n) * 128;
        if (n0 + n < NCMP) { op[lane] = (bf16)f2bf(a); op[lane + 64] = (bf16)f2bf(d); } else { op[lane] = 0; op[lane + 64] = 0; }
    }
}
__device__ __forceinline__ void compress_phase(const Params& P, LAS unsigned char* lds, const bf16* PROJ, const float* cs, const float* sn, bf16* KC, bf16* VC) {
    for (int u = blockIdx.x; u < 256; u += gridDim.x) compress_unit(P, lds, PROJ, cs, sn, KC, VC, u >> 7, (u >> 4) & 7, (u & 15) * 16);
    __syncthreads();
}
template <int MODE = 31>
__device__ __forceinline__ void sb_phase(const Params& P, LAS unsigned char* lds, const bf16* PROJ, const bf16* KVC, bf16* Y) {
    for (int i = blockIdx.x; i < 512; i += gridDim.x) {
        const int u = (i < 256) ? i : 767 - i;
        const int tqq = 15 - (u >> 5), bh = u & 31;
        sb_unit<MODE>(P, lds, PROJ, KVC, Y, bh >> 3, bh & 7, tqq);
    }
}
}

template <class RowFn>
__device__ __forceinline__ void transpose_item(const float* W, int K, int N, bf16* WT, RowFn rowfn, LAS float* scr, int item, int lane, const float* kscale = nullptr) {
    const int nblk = (N + 63) / 64, kb = item / nblk, nb = item % nblk, k0 = 64 * kb, n0 = 64 * nb;
    const int nn = n0 + 4 * (lane & 15), kr = lane >> 4;
    f32x4 v[16];
#pragma unroll
    for (int i = 0; i < 16; ++i) v[i] = nn < N ? __builtin_nontemporal_load((const f32x4*)(W + (size_t)(k0 + 4 * i + kr) * N + nn)) : (f32x4){0.f, 0.f, 0.f, 0.f};
#pragma unroll
    for (int i = 0; i < 16; ++i) { if (kscale) v[i] = v[i] * kscale[k0 + 4 * i + kr];
        LAS float* d = scr + (4 * i + kr) * 65 + 4 * (lane & 15); d[0] = v[i][0]; d[1] = v[i][1]; d[2] = v[i][2]; d[3] = v[i][3]; }
    asm volatile("s_waitcnt lgkmcnt(0)" ::: "memory");
    const int c = lane & 7;
#pragma unroll
    for (int jj = 0; jj < 8; ++jj) { const int n = (lane >> 3) + 8 * jj; const LAS float* s = scr + (8 * c) * 65 + n;
        v4u o; o.x = pk2(s[0 * 65], s[1 * 65]); o.y = pk2(s[2 * 65], s[3 * 65]); o.z = pk2(s[4 * 65], s[5 * 65]); o.w = pk2(s[6 * 65], s[7 * 65]);
        if (n0 + n < N) *(v4u*)(WT + (size_t)rowfn(n0 + n) * K + k0 + 8 * c) = o; }
    asm volatile("s_waitcnt lgkmcnt(0)" ::: "memory");
}
__device__ __forceinline__ int row_gate(int n) { return (n >> 7) * 256 + (n & 127); }
__device__ __forceinline__ int row_up(int n) { return (n >> 7) * 256 + 128 + (n & 127); }
__device__ __forceinline__ int row_id(int n) { return n; }
__device__ __forceinline__ int row_win(int oc) { return oc < 2560 ? oc : (oc < 2584 ? oc - 2560 + C_GATE : oc - 24); }
constexpr int CW_I_GU = (D / 64) * (FF / 64), CW_I_IN = (D / 64) * ((IN_COLS + 63) / 64), CW_I_OUT = (D / 64) * (D / 64), CW_I_C1 = (4096 / 64) * (256 / 64), CW_I_C2 = (256 / 64) * (128 / 64);
constexpr int CW_EARLY = 3 * CW_I_GU + CW_I_IN + CW_I_OUT + 2 * CW_I_C1 + 2 * CW_I_C2, CW_ITEMS = CW_EARLY + 3 * CW_I_GU;
__device__ __forceinline__ void convert_items(const Params& P, LAS unsigned char* lds, int lo, int hi, int gw, int NGW) {
    unsigned char* ws = P.ws;
    int tid = threadIdx.x; asm volatile("" : "+v"(tid));
    const int lane = tid & 63, wave = tid >> 6;
    LAS float* scr = (LAS float*)(lds + wave * 16640);
    constexpr int I_GU = CW_I_GU, I_DN = CW_I_GU, I_IN = CW_I_IN, I_OUT = CW_I_OUT, I_C1 = CW_I_C1, I_C2 = CW_I_C2;
    for (int it = lo + gw; it < hi; it += NGW) {
        int r = it;
        if (r < I_GU) { transpose_item(P.ffn1_wg, D, FF, (bf16*)(ws + WS_W1GU), row_gate, scr, r, lane, FOLD_GAINS ? P.ffn1_norm : nullptr); continue; } r -= I_GU;
        if (r < I_GU) { transpose_item(P.ffn1_wu, D, FF, (bf16*)(ws + WS_W1GU), row_up, scr, r, lane, FOLD_GAINS ? P.ffn1_norm : nullptr); continue; } r -= I_GU;
        if (r < I_DN) { transpose_item(P.ffn1_wd, FF, D, (bf16*)(ws + WS_W1D), row_id, scr, r, lane); continue; } r -= I_DN;
        if (r < I_IN) { transpose_item(P.w_in, D, IN_COLS, (bf16*)(ws + WS_WIN), row_win, scr, r, lane, FOLD_GAINS ? P.mix_norm : nullptr); continue; } r -= I_IN;
        if (r < I_OUT) { transpose_item(P.w_out, D, D, (bf16*)(ws + WS_WOUT), row_id, scr, r, lane); continue; } r -= I_OUT;
        if (r < I_C1) { transpose_item(P.ck_w1, 4096, 256, (bf16*)(ws + WS_WC1K), row_id, scr, r, lane); continue; } r -= I_C1;
        if (r < I_C1) { transpose_item(P.cv_w1, 4096, 256, (bf16*)(ws + WS_WC1V), row_id, scr, r, lane); continue; } r -= I_C1;
        if (r < I_C2) { transpose_item(P.ck_w2, 256, 128, (bf16*)(ws + WS_WC2K), row_id, scr, r, lane); continue; } r -= I_C2;
        if (r < I_C2) { transpose_item(P.cv_w2, 256, 128, (bf16*)(ws + WS_WC2V), row_id, scr, r, lane); continue; } r -= I_C2;
        if (r < I_GU) { transpose_item(P.ffn2_wg, D, FF, (bf16*)(ws + WS_W2GU), row_gate, scr, r, lane, FOLD_GAINS ? P.ffn2_norm : nullptr); continue; } r -= I_GU;
        if (r < I_GU) { transpose_item(P.ffn2_wu, D, FF, (bf16*)(ws + WS_W2GU), row_up, scr, r, lane, FOLD_GAINS ? P.ffn2_norm : nullptr); continue; } r -= I_GU;
        transpose_item(P.ffn2_wd, FF, D, (bf16*)(ws + WS_W2D), row_id, scr, r, lane);
    }
}
__device__ __forceinline__ void convert_weights(const Params& P, LAS unsigned char* lds) {
    unsigned char* ws = P.ws;
    convert_items(P, lds, 0, TAIL_CONVERT ? CW_EARLY : CW_ITEMS, blockIdx.x * NWAVES + (threadIdx.x >> 6), gridDim.x * NWAVES);
    if (blockIdx.x < 32) {
        const int which = blockIdx.x >> 4, part = (blockIdx.x & 15) * 2 + (threadIdx.x >> 8), j = threadIdx.x & 255;
        const float* pos = which ? P.cv_pos : P.ck_pos; const float* w1 = which ? P.cv_w1 : P.ck_w1;
        float a = 0.f;
#pragma unroll 32
        for (int k = 128 * part; k < 128 * part + 128; ++k) a += pos[k] * w1[(size_t)k * 256 + j];
        ((float*)(ws + WS_PBIAS))[(which * 32 + part) * 256 + j] = a;
    }
    { v4u* z = (v4u*)((bf16*)(ws + WS_WIN) + (size_t)IN_COLS * D); const int n16 = (NP - IN_COLS) * D / 8;
      for (int i = blockIdx.x * NTHREADS + threadIdx.x; i < n16; i += gridDim.x * NTHREADS) z[i] = (v4u){0u, 0u, 0u, 0u}; }
}

__global__ void __launch_bounds__(NTHREADS, 2) fwd_kernel(Params P) {
    extern __shared__ __attribute__((aligned(16))) unsigned char lds_raw[];
    LAS unsigned char* lds = (LAS unsigned char*)lds_raw;
    const int tid = threadIdx.x;
    for (int u = tid; u < (LDS_BYTES - LDSCTL_OFF) / 4; u += NTHREADS) ((LAS unsigned*)(lds + LDSCTL_OFF))[u] = 0u;
    __syncthreads();
    unsigned char* ws = P.ws;
    XcdBarrier bar = xcd_barrier_post((unsigned*)(ws + WS_CTL) + CW_BAR, (volatile LAS unsigned*)(lds + LDSCTL_OFF + 64));
    bf16* HB = (bf16*)(ws + WS_HB); bf16* BIG = (bf16*)(ws + WS_BIG);
    float* cs = (float*)(ws + WS_COS); float* sn = (float*)(ws + WS_SIN);
    bf16* KC = (bf16*)(ws + WS_KC); bf16* VC = (bf16*)(ws + WS_VC);
    float* XR = P.out;
    bf16* X1B = (bf16*)P.out;
    bf16* X2B = (bf16*)(ws + WS_W1GU);
    float* PART = (float*)(ws + WS_PART);
    float* PART2 = (float*)(ws + WS_PART + (size_t)M * 8);
    float* PART0 = (float*)(ws + WS_PART + (size_t)M * 16);
    PG8_LAS float* RS = (PG8_LAS float*)(lds + 131072);

#define REP(n) _Pragma("unroll") for (int rep_ = 0; rep_ < (n); ++rep_)
#if FOLD_GAINS
    REP(REP_P0) { rope_tables(P.pos, cs, sn); cast_rows(P.x, HB, (unsigned long long*)PART0); convert_weights(P, lds); }
#else
    REP(REP_P0) { rope_tables(P.pos, cs, sn); rmsnorm_rows(P.x, P.ffn1_norm, HB); convert_weights(P, lds); }
#endif
#if FUSE_NORMS || FOLD_GAINS
    for (int i = blockIdx.x * NTHREADS + tid; i < 2 * M; i += gridDim.x * NTHREADS) ((unsigned long long*)PART)[i] = 0ull;
#endif
    xcd_barrier(bar);
#if PROBE_P1K
    for (int pass = 0; pass < 2; ++pass) {
        pg8::Gemm g{HB, (const bf16*)(ws + WS_W1GU), M, 2 * FF, D, pass == 0 ? (PROBE_P1K >= 4 ? PROBE_P1K - 4 : PROBE_P1K - 1) : 0}; pg8::StaticOrder S; S.init(M, 2 * FF, gridDim.x, (int)blockIdx.x); S.zero = (pass == 0 && PROBE_P1K >= 4);
        if (FOLD_GAINS) pg8::row_factor_table(RS, PART0, S);
        pg8::EpiSwiglu E{BIG, FF, FOLD_GAINS ? PART0 : nullptr, RS};
        pg8::gemm_phase<pg8::EpiSwiglu, pg8::StaticOrder, true, true>(lds, g, S, E);
        if (pass == 0) xcd_barrier(bar);
    }
#else
    REP(REP_P1) {
        pg8::Gemm g{HB, (const bf16*)(ws + WS_W1GU), M, 2 * FF, D}; pg8::StaticOrder S; S.init(M, 2 * FF, gridDim.x, (int)blockIdx.x);
        if (FOLD_GAINS) pg8::row_factor_table(RS, PART0, S);
        pg8::EpiSwiglu E{BIG, FF, FOLD_GAINS ? PART0 : nullptr, RS};
        pg8::gemm_phase<pg8::EpiSwiglu, pg8::StaticOrder, true, true>(lds, g, S, E);
    }
#endif
    xcd_barrier(bar);
    REP(REP_P2) {
        pg8::Gemm g{BIG, (const bf16*)(ws + WS_W1D), M, D, FF}; pg8::StaticOrder S; S.init(M, D, gridDim.x, (int)blockIdx.x);
#if FUSE_NORMS
        pg8::EpiResid E{P.x, XR, D, 0.5f, HB, P.mix_norm, PART};
#else
        pg8::EpiResidMix<FOLD_GAINS != 0, true> E{FOLD_GAINS ? (const void*)HB : (const void*)P.x, X1B, D, 0.5f, FOLD_GAINS ? (unsigned long long*)PART : nullptr};
#endif
        pg8::gemm_phase<pg8::EpiResidMix<FOLD_GAINS != 0, true>, pg8::StaticOrder, true, true>(lds, g, S, E);
    }
    xcd_barrier(bar);
    if (blockIdx.x == gridDim.x - 1) { const float* pp = (const float*)(ws + WS_PBIAS); const int which = tid >> 8, j = tid & 255; float t[32];
#pragma unroll
        for (int part = 0; part < 32; ++part) t[part] = pp[(which * 32 + part) * 256 + j];
        float a = 0.f;
#pragma unroll
        for (int part = 0; part < 32; ++part) a += t[part];
        ((float*)(ws + WS_PBIAS + 65536))[tid] = a; }
#if !FUSE_NORMS && !FOLD_GAINS
    rmsnorm_rows_bf16(X1B, P.mix_norm, HB);
    xcd_barrier(bar);
#endif
    REP(REP_P4) {
        pg8::Gemm g{FOLD_GAINS ? (const bf16*)X1B : (const bf16*)HB, (const bf16*)(ws + WS_WIN), M, NP, D}; pg8::StaticOrder S; S.init(M, NP, gridDim.x, (int)blockIdx.x);
        if (FUSE_NORMS || FOLD_GAINS) pg8::row_factor_table(RS, PART, S);
        pg8::EpiStoreBf16 E{BIG, NP, C_QS / 256, (C_QS + 1024) / 256, att::C1, (FUSE_NORMS || FOLD_GAINS) ? PART : nullptr, RS, (bf16*)(ws + WS_W1GU), SB_COMPACT ? C_KSB / 256 : 0, SB_COMPACT ? (C_VSB + 1024) / 256 : 0};
        pg8::gemm_phase<pg8::EpiStoreBf16, pg8::StaticOrder, true, true>(lds, g, S, E);
#if TAIL_CONVERT
        {
            const int G = (int)gridDim.x, rem = S.nwg % G;
            if (rem == 0) convert_items(P, lds, CW_EARLY, CW_ITEMS, (int)blockIdx.x * NWAVES + (tid >> 6), G * NWAVES);
            else if ((int)blockIdx.x >= rem) convert_items(P, lds, CW_EARLY, CW_ITEMS, ((int)blockIdx.x - rem) * NWAVES + (tid >> 6), (G - rem) * NWAVES);
        }
#endif
    }
    xcd_barrier(bar);
    postproj_naive(P, BIG, cs, sn);
    REP(REP_CMP) att::compress_phase(P, lds, BIG, cs, sn, KC, VC);
    xcd_barrier(bar);
    REP(REP_NSA) att::nsa_phase(P, lds, BIG, KC, VC, HB, (f32x4*)(ws + WS_SCR));
    REP(REP_SB) att::sb_phase(P, lds, BIG, (const bf16*)(ws + WS_W1GU), HB);
    xcd_barrier(bar);
    {
        pg8::Gemm g{HB, (const bf16*)(ws + WS_WOUT), M, D, D}; pg8::StaticOrder S; S.init(M, D, gridDim.x, (int)blockIdx.x);
#if FUSE_NORMS
        pg8::EpiResid E{XR, XR, D, 1.0f, (bf16*)(ws + WS_W1GU), P.ffn2_norm, PART2};
#else
        pg8::EpiResidMix<true, true> E{X1B, X2B, D, 1.0f, FOLD_GAINS ? (unsigned long long*)PART2 : nullptr};
#endif
        pg8::gemm_phase<pg8::EpiResidMix<true, true>, pg8::StaticOrder, true, true>(lds, g, S, E);
    }
    xcd_barrier(bar);
#if !FUSE_NORMS && !FOLD_GAINS
    rmsnorm_rows_bf16(X2B, P.ffn2_norm, HB);
    xcd_barrier(bar);
#endif
    {
        pg8::Gemm g{(FUSE_NORMS || FOLD_GAINS) ? (const bf16*)(ws + WS_W1GU) : (const bf16*)HB, (const bf16*)(ws + WS_W2GU), M, 2 * FF, D}; pg8::StaticOrder S; S.init(M, 2 * FF, gridDim.x, (int)blockIdx.x);
        if (FUSE_NORMS || FOLD_GAINS) pg8::row_factor_table(RS, PART2, S);
        pg8::EpiSwiglu E{BIG, FF, (FUSE_NORMS || FOLD_GAINS) ? PART2 : nullptr, RS};
        pg8::gemm_phase<pg8::EpiSwiglu, pg8::StaticOrder, true, true>(lds, g, S, E);
    }
    xcd_barrier(bar);
    {
        pg8::Gemm g{BIG, (const bf16*)(ws + WS_W2D), M, D, FF}; pg8::StaticOrder S; S.init(M, D, gridDim.x, (int)blockIdx.x);
        pg8::EpiResidMix<true, false> E{X2B, XR, D, 0.5f, nullptr};
        pg8::gemm_phase<pg8::EpiResidMix<true, false>, pg8::StaticOrder, true, true>(lds, g, S, E);
    }
#if PROBE_PP
    xcd_barrier(bar);
    postproj_naive(P, BIG, cs, sn);
#endif
#if PROBE_SB_MODE
    __syncthreads();
    att::sb_phase<PROBE_SB_MODE>(P, lds, BIG, (const bf16*)(ws + WS_SB_DUMMY_KV), (bf16*)(ws + WS_HB));
#endif
}

extern "C" void kernel_launch(void* const* d_in, const int* in_sizes, int n_in, void* d_out, int out_size, void* d_ws, size_t ws_size, hipStream_t stream) {
    static int grid = 0;
    if (grid == 0) {
        if (n_in != 25 || out_size != M * D || ws_size < WS_END) { fprintf(stderr, "kernel_launch: unexpected shapes: n_in %d out %d ws %zu\n", n_in, out_size, ws_size); grid = -1; return; }
        int dev = 0, cus = 0, per_cu = 0;
        hipGetDevice(&dev); hipDeviceGetAttribute(&cus, hipDeviceAttributeMultiprocessorCount, dev);
        if (hipFuncSetAttribute((const void*)fwd_kernel, hipFuncAttributeMaxDynamicSharedMemorySize, LDS_BYTES) != hipSuccess) { fprintf(stderr, "kernel_launch: hipFuncSetAttribute failed\n"); grid = -1; return; }
        hipOccupancyMaxActiveBlocksPerMultiprocessor(&per_cu, (const void*)fwd_kernel, NTHREADS, LDS_BYTES);
        (void)hipGetLastError();
        if (per_cu < 1) fprintf(stderr, "kernel_launch: occupancy query says %d\n", per_cu);
        grid = cus;
    }
    if (grid < 0) return;
    hipMemsetAsync((char*)d_ws + WS_CTL, 0, CTL_ZERO_BYTES, stream);
    Params p{};
    p.x = (const float*)d_in[0]; p.pos = (const int*)d_in[1];
    p.ffn1_norm = (const float*)d_in[2]; p.ffn1_wg = (const float*)d_in[3]; p.ffn1_wu = (const float*)d_in[4]; p.ffn1_wd = (const float*)d_in[5];
    p.mix_norm = (const float*)d_in[6]; p.w_in = (const float*)d_in[7]; p.q_norm = (const float*)d_in[8]; p.kc_norm = (const float*)d_in[9];
    p.ks_norm = (const float*)d_in[10]; p.kw_norm = (const float*)d_in[11]; p.ck_pos = (const float*)d_in[12]; p.ck_w1 = (const float*)d_in[13];
    p.ck_w2 = (const float*)d_in[14]; p.cv_pos = (const float*)d_in[15]; p.cv_w1 = (const float*)d_in[16]; p.cv_w2 = (const float*)d_in[17];
    p.nsa_on = (const float*)d_in[18]; p.sb_on = (const float*)d_in[19]; p.w_out = (const float*)d_in[20]; p.ffn2_norm = (const float*)d_in[21];
    p.ffn2_wg = (const float*)d_in[22]; p.ffn2_wu = (const float*)d_in[23]; p.ffn2_wd = (const float*)d_in[24];
    p.out = (float*)d_out; p.ws = (unsigned char*)d_ws;
    hipLaunchKernelGGL(fwd_kernel, dim3(grid), dim3(NTHREADS), LDS_BYTES, stream, p);
}
```

```cpp
#include <hip/hip_runtime.h>
#include <cstdio>
#include <cstdint>

#define SB_COMPACT 0
#define FOLD_GAINS 1
#define FUSE_NORMS 0
#define NSA_OPAQUE 1
#define REP_P0 1
#define REP_P1 1
#define REP_P2 1
#define REP_P4 1
#define REP_CMP 1
#define REP_NSA 1
#define REP_SB 1
#define PROBE_SB_MODE 0
#define TAIL_CONVERT 1
#define FFN2_FP8 1
#define PROBE_P1K 0
#define PROBE_PP 0

#define GAS __attribute__((address_space(1)))
#define LAS __attribute__((address_space(3)))
typedef unsigned short bf16;
typedef unsigned v4u __attribute__((ext_vector_type(4)));
typedef unsigned v2u __attribute__((ext_vector_type(2)));
typedef float f32x4 __attribute__((ext_vector_type(4)));
typedef float f32x2 __attribute__((ext_vector_type(2)));

constexpr int NBATCH = 4, SEQ = 4096, M = NBATCH * SEQ, D = 2048, FF = 5632, HD = 128;
constexpr int NCMP = 255;
constexpr int IN_COLS = 5656;
constexpr int NP = 5888;
constexpr int C_QN = 0, C_KC = 1024, C_VC = 1280, C_KS = 1536, C_VS = 1792, C_KW = 2048, C_VW = 2304, C_QS = 2560, C_KSB = 3584, C_VSB = 4608, C_GATE = 5632;
constexpr float EPS = 1e-6f;
constexpr float SCALE = 0.08838834764831845f;
constexpr float NEG_INF = -1e30f;
constexpr float QSCALE = 0.08838834764831845f * 1.4426950408889634f;

constexpr size_t MiB = 1u << 20;
constexpr size_t WS_CTL = 0, CTL_ZERO_BYTES = 1 * MiB;
constexpr size_t WS_W1GU = 2 * MiB, WS_W1D = 46 * MiB, WS_W2GU = 68 * MiB, WS_W2D = 112 * MiB, WS_WIN = 134 * MiB, WS_WOUT = 157 * MiB;
constexpr size_t WS_WC1K = 165 * MiB, WS_WC1V = 167 * MiB, WS_WC2K = 169 * MiB, WS_WC2V = 169 * MiB + 65536, WS_PBIAS = 169 * MiB + 131072;
constexpr size_t WS_COS = 170 * MiB, WS_SIN = 174 * MiB, WS_KC = 178 * MiB, WS_VC = 178 * MiB + 524288;
constexpr size_t WS_HB = 180 * MiB, WS_BIG = 244 * MiB, WS_SCR = 428 * MiB, WS_PART = 492 * MiB, WS_END = 494 * MiB;
constexpr size_t WS_SB_DUMMY_KV = WS_W2GU;
constexpr int CW_BAR = 4096;

constexpr int NWAVES = 8, NTHREADS = 512;
constexpr int LDS_BYTES = 163840;
constexpr int LDSCTL_OFF = 163840 - 1024;

__device__ __forceinline__ unsigned f2bf(float f) { unsigned u = __builtin_bit_cast(unsigned, f); return (u + 0x7fffu + ((u >> 16) & 1u)) >> 16; }
__device__ __forceinline__ unsigned pk2(float lo, float hi) { return f2bf(lo) | (f2bf(hi) << 16); }
__device__ __forceinline__ float bf2f(unsigned h) { return __builtin_bit_cast(float, h << 16); }
__device__ __forceinline__ float bflo(unsigned w) { return __builtin_bit_cast(float, w << 16); }
__device__ __forceinline__ float bfhi(unsigned w) { return __builtin_bit_cast(float, w & 0xffff0000u); }
__device__ __forceinline__ float wave_sum(float v) {
#pragma unroll
    for (int o = 1; o < 64; o <<= 1) v += __shfl_xor(v, o);
    return v;
}
__device__ __forceinline__ float wave_max(float v) {
#pragma unroll
    for (int o = 1; o < 64; o <<= 1) v = fmaxf(v, __shfl_xor(v, o));
    return v;
}
__device__ __forceinline__ float softplusf(float z) { return fmaxf(z, 0.f) + log1pf(expf(-fabsf(z))); }
__device__ __forceinline__ float sigmoidf(float z) { return 1.f / (1.f + expf(-z)); }
__device__ __forceinline__ float gelu_tanh(float x) { const float u = 0.7978845608028654f * (x + 0.044715f * x * x * x); return 0.5f * x * (1.f + tanhf(u)); }

#define XB_TMO      128
#define XB_XCNT(j)  (256  + 64 * (j))
#define XB_XSUB(j)  (1280 + 64 * (j))
#define XB_XGEN(j)  (2304 + 64 * (j))
#define XB_TOP      3328
#define XB_TOPGEN   3392
#define XCD_BAR_WORDS 3456
#define XB_SPIN_CAP (1u << 22)

__device__ __forceinline__ unsigned xb_ld(unsigned* p)              { return __hip_atomic_load(p, __ATOMIC_RELAXED, __HIP_MEMORY_SCOPE_AGENT); }
__device__ __forceinline__ unsigned xb_add(unsigned* p, unsigned v) { return __hip_atomic_fetch_add(p, v, __ATOMIC_RELAXED, __HIP_MEMORY_SCOPE_AGENT); }
__device__ __forceinline__ unsigned xb_xcc_id() { return (unsigned)__builtin_amdgcn_s_getreg((3 << 11) | 20) & 0xFu; }
#define XB_SPIN(cond, bar) do { unsigned _sp = 0; while (cond) { __builtin_amdgcn_s_sleep(1); \
    if ((++_sp & 255u) == 0u) { if (xb_ld(&(bar)[XB_TMO])) break; if (_sp > XB_SPIN_CAP) { atomicAdd(&(bar)[XB_TMO], 1u); break; } } } } while (0)

struct XcdBarrier { unsigned* bar; unsigned x; volatile LAS unsigned* st; };

__device__ __forceinline__ XcdBarrier xcd_barrier_post(unsigned* bar, volatile LAS unsigned* st) {
    XcdBarrier b; b.bar = bar; b.x = xb_xcc_id(); b.st = st;
    if (threadIdx.x == 0) (void)xb_add(&bar[XB_XCNT(b.x)], 1u);
    return b;
}
__device__ __forceinline__ void xcd_barrier_complete(unsigned* bar, unsigned x, unsigned& nloc, unsigned& nx) {
    const unsigned G = gridDim.x * gridDim.y * gridDim.z;
    unsigned sum, cnt, mine, sp = 0u;
    for (;;) {
        sum = 0u; cnt = 0u; mine = 0u;
#pragma unroll
        for (unsigned j = 0; j < 16; ++j) { const unsigned c = xb_ld(&bar[XB_XCNT(j)]); sum += c; cnt += (c > 0u) ? 1u : 0u; mine = (j == x) ? c : mine; }
        if (sum == G) break;
        __builtin_amdgcn_s_sleep(1);
        if ((++sp & 255u) == 0u) { if (xb_ld(&bar[XB_TMO])) break; if (sp > XB_SPIN_CAP) { atomicAdd(&bar[XB_TMO], 1u); break; } }
    }
    nloc = mine > 0u ? mine : 1u; nx = cnt > 0u ? cnt : 1u;
}
__device__ __forceinline__ void xcd_barrier(const XcdBarrier& b) {
    asm volatile("s_waitcnt vmcnt(0)" ::: "memory");
    __syncthreads();
    if (threadIdx.x == 0) {
        unsigned* bar = b.bar;
        __builtin_amdgcn_s_waitcnt(0);
        unsigned nloc = b.st[0], nx = b.st[1];
        if (nloc == 0u) { xcd_barrier_complete(bar, b.x, nloc, nx); b.st[0] = nloc; b.st[1] = nx; }
        const unsigned old = xb_add(&bar[XB_XSUB(b.x)], 1u);
        const unsigned gen = old / nloc;
        if (old + 1u == (gen + 1u) * nloc) {
            __builtin_amdgcn_fence(__ATOMIC_RELEASE, "agent");
            asm volatile("s_waitcnt vmcnt(0)" ::: "memory");
            const unsigned og = xb_add(&bar[XB_TOP], 1u);
            const unsigned tg = og / nx;
            if (og + 1u == (tg + 1u) * nx) xb_add(&bar[XB_TOPGEN], 1u);
            else XB_SPIN(xb_ld(&bar[XB_TOPGEN]) == tg, bar);
            __builtin_amdgcn_fence(__ATOMIC_ACQUIRE, "agent");
            xb_add(&bar[XB_XGEN(b.x)], 1u);
            asm volatile("s_waitcnt vmcnt(0)" ::: "memory");
        } else {
            XB_SPIN(xb_ld(&bar[XB_XGEN(b.x)]) == gen, bar);
            __builtin_amdgcn_fence(__ATOMIC_ACQUIRE, "agent");
            asm volatile("s_waitcnt vmcnt(0)" ::: "memory");
        }
    }
    __syncthreads();
}

namespace pg8 {
#define PG8_LAS __attribute__((address_space(3)))
typedef unsigned short bf16_t;
typedef short bf16x8 __attribute__((ext_vector_type(8)));
typedef float f32x4 __attribute__((ext_vector_type(4)));
typedef unsigned u32x4 __attribute__((ext_vector_type(4)));
constexpr int BM = 256, BK = 64, HALF = 128, HTB = HALF * BK * 2  , STAGE_BYTES = 8 * HTB, NXCD = 8, WGM = 8;

__host__ __device__ __forceinline__ int lds_byte(int r, int c) { const int st = (r >> 4) * 2 + (c >> 5), rr = r & 15, cc = c & 31, ob = rr * 64 + cc * 2; return st * 1024 + (ob ^ (((ob >> 9) & 1) << 5)); }
__host__ __device__ __forceinline__ void stage_rc(int b, int& R, int& C) { const int st = b / 1024, sb = b % 1024, swz = sb ^ (((sb >> 9) & 1) << 5); R = (st >> 1) * 16 + swz / 64; C = (st & 1) * 32 + (swz % 64) / 2; }
__host__ __device__ __forceinline__ int perm32(int rho) { const int n = rho >> 4, i = rho & 15; return 8 * (i >> 2) + 4 * n + (i & 3); }

typedef int v4i_t __attribute__((ext_vector_type(4)));
typedef int v8i_t __attribute__((ext_vector_type(8)));
__device__ __forceinline__ unsigned pk4_fp8(float a, float b, float c, float d) {
    a = __builtin_amdgcn_fmed3f(a, -448.f, 448.f); b = __builtin_amdgcn_fmed3f(b, -448.f, 448.f); c = __builtin_amdgcn_fmed3f(c, -448.f, 448.f); d = __builtin_amdgcn_fmed3f(d, -448.f, 448.f);
    int w = 0; w = __builtin_amdgcn_cvt_pk_fp8_f32(a, b, w, false); w = __builtin_amdgcn_cvt_pk_fp8_f32(c, d, w, true); return (unsigned)w;
}
constexpr float F8_WSCALE = 256.0f, F8_HSCALE = 16.0f;
struct Unit { int pm, pn, ord; };
struct Gemm { const bf16_t* A; const bf16_t* Bt; int M, N, K; int kshift = 0; };

struct StaticOrder {
    int nM, nN, nwg, G, c; int zero = 0;
    __host__ __device__ void init(int M, int N, int G_, int c_) { nM = M / BM; nN = N / BM; nwg = nM * nN; G = G_; c = c_; }
    __host__ __device__ bool next(int i, Unit& u) const {
        const long L = (long)i * G + c; if (L >= nwg) return false;
        int wgid = (int)L; { const int q = nwg / NXCD, r = nwg % NXCD, xcd = wgid % NXCD, off = wgid / NXCD; wgid = (xcd < r ? xcd * (q + 1) : r * (q + 1) + (xcd - r) * q) + off; }
        const int nig = WGM * nN, gid = wgid / nig, fm = gid * WGM, gsz = (nM - fm) < WGM ? (nM - fm) : WGM;
        u.pm = fm + ((wgid % nig) % gsz); u.pn = (wgid % nig) / gsz; u.ord = i;
        if (zero) { u.pm = 0; u.pn = 0; }
        return true;
    }
    __device__ __forceinline__ void a_ready(const Unit&) const {}
    __device__ __forceinline__ void done(const Unit&) const {}
};


__device__ __forceinline__ unsigned cvt_pk_bf16(float lo, float hi) { unsigned r; asm volatile("v_cvt_pk_bf16_f32 %0, %1, %2" : "=v"(r) : "v"(lo), "v"(hi)); return r; }
__device__ __forceinline__ float silu_mul(float g, float u) { return g * u * __builtin_amdgcn_rcpf(1.0f + __builtin_amdgcn_exp2f(-1.4426950408889634f * g)); }
__device__ __forceinline__ void row_scale_table(PG8_LAS float* rs, const float* part, const Unit& u, float inv_n, float eps) {
    asm volatile("s_waitcnt lgkmcnt(0)" ::: "memory"); __builtin_amdgcn_s_barrier(); asm volatile("" ::: "memory");
    const int t = threadIdx.x;
    if (t < 256) { const f32x4* p = (const f32x4*)(part + (size_t)(u.pm * BM + t) * 32); f32x4 a = p[0];
#pragma unroll
        for (int i = 1; i < 8; ++i) a = a + p[i];
        rs[t] = rsqrtf(((a[0] + a[1]) + (a[2] + a[3])) * inv_n + eps); }
    asm volatile("s_waitcnt lgkmcnt(0)" ::: "memory"); __builtin_amdgcn_s_barrier(); asm volatile("" ::: "memory");
}
__device__ __forceinline__ float row_factor(const float* part, int row) {
    const unsigned long long q = ((const unsigned long long*)part)[row];
    return rsqrtf((float)q * (1.0f / 16777216.0f) * (1.0f / 2048.0f) + 1e-6f);
}
template <class Sched>
__device__ __forceinline__ void row_factor_table(PG8_LAS float* rs, const float* part, const Sched& S) {
    int t = threadIdx.x; asm volatile("" : "+v"(t));
    Unit u;
    for (int i = 0; S.next(i, u); ++i) if (t < 256) rs[i * 256 + t] = row_factor(part, u.pm * BM + t);
    asm volatile("s_waitcnt vmcnt(0) lgkmcnt(0)" ::: "memory"); __builtin_amdgcn_s_barrier(); asm volatile("" ::: "memory");
}
template <bool F8 = false>
struct EpiSwigluT {
    static constexpr bool PERM = true, AFTER_DRAIN = false;
    bf16_t* O; int ldo;
    const float* part; PG8_LAS float* rs;
    static __device__ __forceinline__ unsigned silu_mul2(f32x2 g, f32x2 u) {
        const f32x2 t = g * (-1.4426950408889634f);
        f32x2 e; e.x = __builtin_amdgcn_exp2f(t.x); e.y = __builtin_amdgcn_exp2f(t.y);
        const f32x2 d = e + 1.0f;
        f32x2 rc; rc.x = __builtin_amdgcn_rcpf(d.x); rc.y = __builtin_amdgcn_rcpf(d.y);
        const f32x2 r = (g * u) * rc;
        typedef __bf16 bf16x2_t __attribute__((ext_vector_type(2)));
        return __builtin_bit_cast(unsigned, __builtin_convertvector(r, bf16x2_t));
    }
    static __device__ __forceinline__ f32x2 silu_mul2f(f32x2 g, f32x2 u) {
        const f32x2 t = g * (-1.4426950408889634f);
        f32x2 e; e.x = __builtin_amdgcn_exp2f(t.x); e.y = __builtin_amdgcn_exp2f(t.y);
        const f32x2 d = e + 1.0f;
        f32x2 rc; rc.x = __builtin_amdgcn_rcpf(d.x); rc.y = __builtin_amdgcn_rcpf(d.y);
        return (g * u) * rc;
    }
    __device__ __forceinline__ void operator()(const f32x4 (&acc)[2][2][4][2], const Unit& u, int wr, int wc, int fr, int fq) const {
        const int row0 = u.pm * BM + wr * 64 + fr, col0 = u.pn * HALF + wc * 32 + 8 * fq;
        float rf[2][4];
#pragma unroll
        for (int ai = 0; ai < 2; ++ai)
#pragma unroll
            for (int m = 0; m < 4; ++m) rf[ai][m] = part ? rs[u.ord * 256 + wr * 64 + fr + ai * HALF + m * 16] : 1.0f;
#pragma unroll
        for (int ai = 0; ai < 2; ++ai)
#pragma unroll
            for (int m = 0; m < 4; ++m) {
                if constexpr (F8) {
                    const float rg = rf[ai][m] * (1.0f / F8_WSCALE), ru = rg * F8_HSCALE;
                    const f32x4 g0 = acc[ai][0][m][0] * rg, g1 = acc[ai][0][m][1] * rg, u0 = acc[ai][1][m][0] * ru, u1 = acc[ai][1][m][1] * ru;
                    const f32x2 h0 = silu_mul2f((f32x2){g0[0], g0[1]}, (f32x2){u0[0], u0[1]}), h1 = silu_mul2f((f32x2){g0[2], g0[3]}, (f32x2){u0[2], u0[3]});
                    const f32x2 h2 = silu_mul2f((f32x2){g1[0], g1[1]}, (f32x2){u1[0], u1[1]}), h3 = silu_mul2f((f32x2){g1[2], g1[3]}, (f32x2){u1[2], u1[3]});
                    typedef unsigned u32x2 __attribute__((ext_vector_type(2))); u32x2 w; w.x = pk4_fp8(h0.x, h0.y, h1.x, h1.y); w.y = pk4_fp8(h2.x, h2.y, h3.x, h3.y);
                    *(u32x2*)((unsigned char*)O + (size_t)(row0 + ai * HALF + m * 16) * ldo + col0) = w;
                } else {
                const float r = rf[ai][m];
                const f32x4 g0 = acc[ai][0][m][0] * r, g1 = acc[ai][0][m][1] * r, u0 = acc[ai][1][m][0] * r, u1 = acc[ai][1][m][1] * r;
                u32x4 w;
                w.x = silu_mul2((f32x2){g0[0], g0[1]}, (f32x2){u0[0], u0[1]}); w.y = silu_mul2((f32x2){g0[2], g0[3]}, (f32x2){u0[2], u0[3]});
                w.z = silu_mul2((f32x2){g1[0], g1[1]}, (f32x2){u1[0], u1[1]}); w.w = silu_mul2((f32x2){g1[2], g1[3]}, (f32x2){u1[2], u1[3]});
                *(u32x4*)(O + (size_t)(row0 + ai * HALF + m * 16) * ldo + col0) = w;
                }
            }
    }
};
typedef EpiSwigluT<false> EpiSwiglu;
struct EpiResid {
    static constexpr bool PERM = false, AFTER_DRAIN = false;
    const float* base; float* out; int ldc; float alpha;
    bf16_t* XG; const float* gain; float* part;
    __device__ __forceinline__ void operator()(const f32x4 (&acc)[2][2][4][2], const Unit& u, int wr, int wc, int fr, int fq) const {
        const int row0 = u.pm * BM + wr * 64 + fr, col0 = u.pn * BM + wc * 32 + 4 * fq;
        f32x4 gg[2][2];
#pragma unroll
        for (int bj = 0; bj < 2; ++bj)
#pragma unroll
            for (int n = 0; n < 2; ++n) gg[bj][n] = XG ? *(const f32x4*)(gain + col0 + bj * HALF + 16 * n) : (f32x4){0.f, 0.f, 0.f, 0.f};
#pragma unroll
        for (int ai = 0; ai < 2; ++ai) {
            f32x4 b[4][2][2];
#pragma unroll
            for (int m = 0; m < 4; ++m)
#pragma unroll
                for (int bj = 0; bj < 2; ++bj)
#pragma unroll
                    for (int n = 0; n < 2; ++n) b[m][bj][n] = *(const f32x4*)(base + (size_t)(row0 + ai * HALF + m * 16) * ldc + col0 + bj * HALF + 16 * n);
#pragma unroll
            for (int m = 0; m < 4; ++m) { const int row = row0 + ai * HALF + m * 16; const size_t ro = (size_t)row * ldc + col0; float ssq = 0.f;
#pragma unroll
                for (int bj = 0; bj < 2; ++bj)
#pragma unroll
                    for (int n = 0; n < 2; ++n) { const size_t o = ro + bj * HALF + 16 * n; const f32x4 v = b[m][bj][n] + acc[ai][bj][m][n] * alpha; *(f32x4*)(out + o) = v;
                        if (XG) { const f32x4 g4 = gg[bj][n]; ssq += (v[0] * v[0] + v[1] * v[1]) + (v[2] * v[2] + v[3] * v[3]);
                            typedef unsigned u32x2 __attribute__((ext_vector_type(2))); u32x2 w; w.x = cvt_pk_bf16(v[0] * g4[0], v[1] * g4[1]); w.y = cvt_pk_bf16(v[2] * g4[2], v[3] * g4[3]); *(u32x2*)(XG + o) = w; } }
                if (XG) { ssq += __shfl_xor(ssq, 16); ssq += __shfl_xor(ssq, 32);
                    if (fq == 0) __hip_atomic_fetch_add((unsigned long long*)part + row, (unsigned long long)(ssq * 16777216.0f), __ATOMIC_RELAXED, __HIP_MEMORY_SCOPE_AGENT); } }
        }
    }
};
template <bool BB, bool OB>
struct EpiResidMix {
    static constexpr bool PERM = false, AFTER_DRAIN = false;
    const void* base; void* out; int ldc; float alpha;
    unsigned long long* rowsq;
    unsigned char* out8;
    __device__ __forceinline__ void operator()(const f32x4 (&acc)[2][2][4][2], const Unit& u, int wr, int wc, int fr, int fq) const {
        typedef unsigned u32x2 __attribute__((ext_vector_type(2)));
        const int row0 = u.pm * BM + wr * 64 + fr, col0 = u.pn * BM + wc * 32 + 4 * fq;
#pragma unroll
        for (int ai = 0; ai < 2; ++ai) {
            f32x4 b[4][2][2];
#pragma unroll
            for (int m = 0; m < 4; ++m)
#pragma unroll
                for (int bj = 0; bj < 2; ++bj)
#pragma unroll
                    for (int n = 0; n < 2; ++n) { const size_t o = (size_t)(row0 + ai * HALF + m * 16) * ldc + col0 + bj * HALF + 16 * n;
                        if (BB) { const u32x2 w = *(const u32x2*)((const bf16_t*)base + o);
                            b[m][bj][n] = (f32x4){__builtin_bit_cast(float, w.x << 16), __builtin_bit_cast(float, w.x & 0xffff0000u), __builtin_bit_cast(float, w.y << 16), __builtin_bit_cast(float, w.y & 0xffff0000u)}; }
                        else b[m][bj][n] = *(const f32x4*)((const float*)base + o); }
#pragma unroll
            for (int m = 0; m < 4; ++m) { float ssq = 0.f;
#pragma unroll
                for (int bj = 0; bj < 2; ++bj)
#pragma unroll
                    for (int n = 0; n < 2; ++n) { const size_t o = (size_t)(row0 + ai * HALF + m * 16) * ldc + col0 + bj * HALF + 16 * n; const f32x4 v = b[m][bj][n] + acc[ai][bj][m][n] * alpha;
                        ssq += (v[0] * v[0] + v[1] * v[1]) + (v[2] * v[2] + v[3] * v[3]);
                        if (OB) { u32x2 w; w.x = cvt_pk_bf16(v[0], v[1]); w.y = cvt_pk_bf16(v[2], v[3]); *(u32x2*)((bf16_t*)out + o) = w; }
                        else *(f32x4*)((float*)out + o) = v;
                        if (out8) *(unsigned*)(out8 + o) = pk4_fp8(v[0], v[1], v[2], v[3]); }
                if (rowsq) { ssq += __shfl_xor(ssq, 16); ssq += __shfl_xor(ssq, 32);
                    if (fq == 0) __hip_atomic_fetch_add(rowsq + (row0 + ai * HALF + m * 16), (unsigned long long)(ssq * 16777216.0f), __ATOMIC_RELAXED, __HIP_MEMORY_SCOPE_AGENT); } }
        }
    }
};
struct EpiStoreBf16 {
    static constexpr bool PERM = true, AFTER_DRAIN = false;
    bf16_t* O; int ldo; int sc_lo, sc_hi; float sc;
    const float* part; PG8_LAS float* rs;
    bf16_t* KVC; int kv_lo, kv_hi;
    __device__ __forceinline__ void operator()(const f32x4 (&acc)[2][2][4][2], const Unit& u, int wr, int wc, int fr, int fq) const {
        const int row0 = u.pm * BM + wr * 64 + fr, col0 = u.pn * BM + wc * 32 + 8 * fq;
        const float scl0 = (u.pn >= sc_lo && u.pn < sc_hi) ? sc : 1.0f;
        const bool kv = u.pn >= kv_lo && u.pn < kv_hi;
        const int which = (u.pn - kv_lo) >> 2, h0 = 2 * ((u.pn - kv_lo) & 3);
        float rf[2][4];
#pragma unroll
        for (int ai = 0; ai < 2; ++ai)
#pragma unroll
            for (int m = 0; m < 4; ++m) rf[ai][m] = part ? rs[u.ord * 256 + wr * 64 + fr + ai * HALF + m * 16] : 1.0f;
#pragma unroll
        for (int ai = 0; ai < 2; ++ai)
#pragma unroll
            for (int m = 0; m < 4; ++m) { const int row = row0 + ai * HALF + m * 16; bf16_t* rowp = O + (size_t)row * ldo + col0;
                const float scl = scl0 * rf[ai][m];
                bf16_t* kvp = KVC + ((size_t)((which * 4 + (row >> 12)) * 8 + h0) * 4096 + (row & 4095)) * 128 + wc * 32 + 8 * fq;
#pragma unroll
                for (int bj = 0; bj < 2; ++bj) { const f32x4 v0 = acc[ai][bj][m][0] * scl, v1 = acc[ai][bj][m][1] * scl;
                    u32x4 w; w.x = cvt_pk_bf16(v0[0], v0[1]); w.y = cvt_pk_bf16(v0[2], v0[3]); w.z = cvt_pk_bf16(v1[0], v1[1]); w.w = cvt_pk_bf16(v1[2], v1[3]);
                    if (kv) *(u32x4*)(kvp + (size_t)bj * 4096 * 128) = w; else *(u32x4*)(rowp + bj * HALF) = w; } }
    }
};
template <class Epi, class Sched, bool ALIGN_EPI = false, bool SP2 = false, bool FP8 = false>
__device__ __forceinline__ void gemm_phase(PG8_LAS unsigned char* lds, const Gemm g, const Sched& S, const Epi& E) {
    int tid_ = threadIdx.x; asm volatile("" : "+v"(tid_));
    const int tid = tid_, wid = __builtin_amdgcn_readfirstlane(tid >> 6), lane = tid & 63, wr = wid >> 2, wc = wid & 3, fr = lane & 15, fq = lane >> 4;
    const int K = g.K, nt = (K / BK) >> g.kshift;
    unsigned voffA[2], voffB[2];
#pragma unroll
    for (int i = 0; i < 2; ++i) { int R, C; stage_rc(tid * 16 + i * 8192, R, C); const int Rb = Epi::PERM ? ((R & ~31) + perm32(R & 31)) : R;
        voffA[i] = (unsigned)(R * K + C) * 2u; voffB[i] = (unsigned)(Rb * K + C) * 2u; }
    const size_t kstep = (size_t)(BK * 2);
    const size_t hstep = (size_t)HALF * K * 2;
    const size_t tstep = 2 * hstep;
    const unsigned ldsw = (unsigned)wid * 1024u;
    const int aoff = lds_byte(wr * 64 + fr, fq * 8), boff = lds_byte(wc * 32 + fr, fq * 8);
#define PG8_SA(b, h) (((b) * 2 + (h)) * HTB)
#define PG8_SB(b, h) ((4 + (b) * 2 + (h)) * HTB)
#define PG8_STAGE(bufoff, gbase, voff) do { _Pragma("unroll") for (int _i = 0; _i < 2; ++_i) \
        __builtin_amdgcn_global_load_lds((const unsigned*)((const char*)(gbase) + (voff)[_i]), (PG8_LAS unsigned*)(lds + (bufoff) + ldsw + _i * 8192), 16, 0, 0); } while (0)
#define PG8_LDA(dst, b, h) do { _Pragma("unroll") for (int m = 0; m < 4; ++m) _Pragma("unroll") for (int k = 0; k < 2; ++k) dst[m][k] = *(const PG8_LAS bf16x8*)(lds + PG8_SA(b, h) + aoff + m * 2048 + k * 1024); } while (0)
#define PG8_LDB(dst, b, h) do { _Pragma("unroll") for (int n = 0; n < 2; ++n) _Pragma("unroll") for (int k = 0; k < 2; ++k) dst[n][k] = *(const PG8_LAS bf16x8*)(lds + PG8_SB(b, h) + boff + n * 2048 + k * 1024); } while (0)
#define PG8_MMA(ai, bj, At, Bt) do { __builtin_amdgcn_s_setprio(1); _Pragma("unroll") for (int m = 0; m < 4; ++m) _Pragma("unroll") for (int n = 0; n < 2; ++n) _Pragma("unroll") for (int k = 0; k < 2; ++k) \
        acc[ai][bj][m][n] = __builtin_amdgcn_mfma_f32_16x16x32_bf16(Bt[n][k], At[m][k], acc[ai][bj][m][n], 0, 0, 0); __builtin_amdgcn_s_setprio(0); } while (0)
#define PG8_RD8(p) __builtin_shufflevector(*(const PG8_LAS v4i_t*)(p), *(const PG8_LAS v4i_t*)((p) + 1024), 0, 1, 2, 3, 4, 5, 6, 7)
#define PG8_LDA8(dst, b, h) do { _Pragma("unroll") for (int m = 0; m < 4; ++m) dst[m] = PG8_RD8(lds + PG8_SA(b, h) + aoff + m * 2048); } while (0)
#define PG8_LDB8(dst, b, h) do { _Pragma("unroll") for (int n = 0; n < 2; ++n) dst[n] = PG8_RD8(lds + PG8_SB(b, h) + boff + n * 2048); } while (0)
#define PG8_MQ(V, SW, b, a) V.SW = __builtin_amdgcn_mfma_scale_f32_16x16x128_f8f6f4(b, a, V.SW, 0, 0, 0, 0, 0, 0)
#define PG8_MMA8(ai, bj, At, Bt) do { __builtin_amdgcn_s_setprio(1); \
        PG8_MQ(accv[ai][bj][0], s0123, Bt[0], At[0]); PG8_MQ(accv[ai][bj][0], s4567, Bt[1], At[0]); PG8_MQ(accv[ai][bj][0], s89ab, Bt[0], At[1]); PG8_MQ(accv[ai][bj][0], scdef, Bt[1], At[1]); \
        PG8_MQ(accv[ai][bj][1], s0123, Bt[0], At[2]); PG8_MQ(accv[ai][bj][1], s4567, Bt[1], At[2]); PG8_MQ(accv[ai][bj][1], s89ab, Bt[0], At[3]); PG8_MQ(accv[ai][bj][1], scdef, Bt[1], At[3]); \
        __builtin_amdgcn_s_setprio(0); } while (0)
#define PG8_MM(ai, bj, At, Bt) do { if constexpr (FP8) PG8_MMA8(ai, bj, At##8, Bt##8); else PG8_MMA(ai, bj, At, Bt); } while (0)
#define PG8_LA(dst, b, h) do { if constexpr (FP8) PG8_LDA8(dst##8, b, h); else PG8_LDA(dst, b, h); } while (0)
#define PG8_LB(dst, b, h) do { if constexpr (FP8) PG8_LDB8(dst##8, b, h); else PG8_LDB(dst, b, h); } while (0)
#define PG8_WAIT_V(n) asm volatile("s_waitcnt vmcnt(" #n ")" ::: "memory")
#define PG8_WAIT_L(n) asm volatile("s_waitcnt lgkmcnt(" #n ")" ::: "memory")
#define PG8_BAR __builtin_amdgcn_s_barrier()
#define PG8_SCHED __builtin_amdgcn_sched_barrier(0)
    Unit cur, nxt; int ui = 0;
    if (!S.next(0, cur)) return;
    f32x4 acc[2][2][4][2];
    float zf = 0.f; asm volatile("" : "+v"(zf));
#pragma unroll
    for (int a = 0; a < 2; ++a)
#pragma unroll
        for (int b = 0; b < 2; ++b)
#pragma unroll
            for (int m = 0; m < 4; ++m)
#pragma unroll
                for (int n = 0; n < 2; ++n) acc[a][b][m][n] = (f32x4){zf, zf, zf, zf};
    bf16x8 At[4][2], B0[2][2], B1[2][2];
    typedef float f32x16_t __attribute__((ext_vector_type(16)));
    f32x16_t accv[2][2][2];
    if constexpr (FP8) {
#pragma unroll
        for (int a = 0; a < 2; ++a)
#pragma unroll
            for (int b = 0; b < 2; ++b)
#pragma unroll
                for (int h = 0; h < 2; ++h) accv[a][b][h] = (f32x16_t)(zf);
    }
    v8i_t At8[4], B08[2], B18[2];
    const char* cA = (const char*)g.A + (size_t)cur.pm * tstep; const char* cB = (const char*)g.Bt + (size_t)cur.pn * tstep;
    S.a_ready(cur);
    if constexpr (SP2) {
        PG8_STAGE(PG8_SB(0, 0), cB, voffB); PG8_STAGE(PG8_SB(0, 1), cB + hstep, voffB); PG8_STAGE(PG8_SA(0, 0), cA, voffA); PG8_STAGE(PG8_SA(0, 1), cA + hstep, voffA);
        if (wr == 1) PG8_BAR;
        PG8_WAIT_V(2); PG8_BAR;
        PG8_STAGE(PG8_SB(1, 0), cB + kstep, voffB); PG8_STAGE(PG8_SA(1, 0), cA + kstep, voffA); PG8_STAGE(PG8_SB(1, 1), cB + hstep + kstep, voffB);
        PG8_WAIT_V(6); PG8_BAR;
    } else {
        PG8_STAGE(PG8_SB(0, 0), cB, voffB); PG8_STAGE(PG8_SA(0, 0), cA, voffA); PG8_STAGE(PG8_SB(0, 1), cB + hstep, voffB); PG8_STAGE(PG8_SA(0, 1), cA + hstep, voffA);
        if (wr == 1) PG8_BAR;
        PG8_WAIT_V(4); PG8_BAR;
        PG8_STAGE(PG8_SB(1, 0), cB + kstep, voffB); PG8_STAGE(PG8_SA(1, 0), cA + kstep, voffA); PG8_STAGE(PG8_SB(1, 1), cB + hstep + kstep, voffB);
        PG8_WAIT_V(6); PG8_BAR;
    }
    for (;;) {
        const bool has_next = S.next(ui + 1, nxt);
        const char* nA = has_next ? (const char*)g.A + (size_t)nxt.pm * tstep : cA; const char* nB = has_next ? (const char*)g.Bt + (size_t)nxt.pn * tstep : cB;
        for (int t = 0; t < nt; t += 2) {
            const bool last = (t == nt - 2);
            const char* a1 = cA + (size_t)(t + 1) * kstep;
            const char* a2 = last ? nA : cA + (size_t)(t + 2) * kstep; const char* b2 = last ? nB : cB + (size_t)(t + 2) * kstep;
            const char* a3 = a2 + kstep; const char* b3 = b2 + kstep;
            if (last && has_next) S.a_ready(nxt);
            if constexpr (SP2) {
            PG8_LB(B0, 0, 0); PG8_LB(B1, 0, 1); PG8_SCHED; PG8_LA(At, 0, 0); PG8_STAGE(PG8_SA(1, 1), a1 + hstep, voffA);
            PG8_WAIT_V(8); PG8_WAIT_L(0); PG8_BAR; PG8_MM(0, 0, At, B0); PG8_MM(0, 1, At, B1); PG8_BAR; PG8_SCHED;
            PG8_LA(At, 0, 1); PG8_STAGE(PG8_SB(0, 0), b2, voffB); PG8_STAGE(PG8_SB(0, 1), b2 + hstep, voffB); PG8_STAGE(PG8_SA(0, 0), a2, voffA);
            PG8_WAIT_V(8); PG8_WAIT_L(0); PG8_BAR; PG8_MM(1, 0, At, B0); PG8_MM(1, 1, At, B1); PG8_BAR; PG8_SCHED;
            PG8_LB(B0, 1, 0); PG8_LB(B1, 1, 1); PG8_SCHED; PG8_LA(At, 1, 0); PG8_STAGE(PG8_SA(0, 1), a2 + hstep, voffA);
            PG8_WAIT_V(8); PG8_WAIT_L(0); PG8_BAR; PG8_MM(0, 0, At, B0); PG8_MM(0, 1, At, B1); PG8_BAR; PG8_SCHED;
            PG8_LA(At, 1, 1); PG8_STAGE(PG8_SB(1, 0), b3, voffB); PG8_STAGE(PG8_SB(1, 1), b3 + hstep, voffB); PG8_STAGE(PG8_SA(1, 0), a3, voffA);
            PG8_WAIT_V(8); PG8_WAIT_L(0); PG8_BAR; PG8_MM(1, 0, At, B0); PG8_MM(1, 1, At, B1); PG8_BAR; PG8_SCHED;
            } else {
            PG8_LB(B0, 0, 0); PG8_SCHED; PG8_LA(At, 0, 0); PG8_STAGE(PG8_SA(1, 1), a1 + hstep, voffA);
            PG8_WAIT_L(8); PG8_BAR; PG8_WAIT_L(0); PG8_MM(0, 0, At, B0); PG8_BAR; PG8_SCHED;
            PG8_LB(B1, 0, 1); PG8_STAGE(PG8_SB(0, 0), b2, voffB);
            PG8_BAR; PG8_WAIT_L(0); PG8_MM(0, 1, At, B1); PG8_BAR;
            PG8_LA(At, 0, 1); PG8_STAGE(PG8_SA(0, 0), a2, voffA);
            PG8_BAR; PG8_WAIT_L(0); PG8_MM(1, 0, At, B0); PG8_BAR; PG8_SCHED;
            PG8_STAGE(PG8_SB(0, 1), b2 + hstep, voffB);
            PG8_WAIT_V(6); PG8_BAR; PG8_MM(1, 1, At, B1); PG8_BAR;
            PG8_LB(B0, 1, 0); PG8_SCHED; PG8_LA(At, 1, 0); PG8_STAGE(PG8_SA(0, 1), a2 + hstep, voffA);
            PG8_WAIT_L(8); PG8_BAR; PG8_WAIT_L(0); PG8_MM(0, 0, At, B0); PG8_BAR; PG8_SCHED;
            PG8_LB(B1, 1, 1); PG8_STAGE(PG8_SB(1, 0), b3, voffB);
            PG8_BAR; PG8_WAIT_L(0); PG8_MM(0, 1, At, B1); PG8_BAR;
            PG8_LA(At, 1, 1); PG8_STAGE(PG8_SA(1, 0), a3, voffA);
            PG8_BAR; PG8_WAIT_L(0); PG8_MM(1, 0, At, B0); PG8_BAR; PG8_SCHED;
            PG8_STAGE(PG8_SB(1, 1), b3 + hstep, voffB);
            PG8_WAIT_V(6); PG8_BAR; PG8_MM(1, 1, At, B1); PG8_BAR;
            }
        }
        if constexpr (ALIGN_EPI) { if (wr == 0) PG8_BAR; }
        if constexpr (FP8) {
#pragma unroll
            for (int a = 0; a < 2; ++a)
#pragma unroll
                for (int b = 0; b < 2; ++b)
#pragma unroll
                    for (int h = 0; h < 2; ++h) { const f32x16_t v = accv[a][b][h]; acc[a][b][2 * h][0] = v.s0123; acc[a][b][2 * h][1] = v.s4567; acc[a][b][2 * h + 1][0] = v.s89ab; acc[a][b][2 * h + 1][1] = v.scdef; accv[a][b][h] = (f32x16_t)(zf); }
        }
        if constexpr (!Epi::AFTER_DRAIN) { E(acc, cur, wr, wc, fr, fq); S.done(cur); }
        if (!has_next) break;
#pragma unroll
        for (int a = 0; a < 2; ++a)
#pragma unroll
            for (int b = 0; b < 2; ++b)
#pragma unroll
                for (int m = 0; m < 4; ++m)
#pragma unroll
                    for (int n = 0; n < 2; ++n) acc[a][b][m][n] = (f32x4){zf, zf, zf, zf};
        cur = nxt; cA = nA; cB = nB; ++ui;
        if constexpr (ALIGN_EPI) { if (wr == 1) PG8_BAR; }
    }
    PG8_WAIT_V(0);
    if constexpr (!ALIGN_EPI) { if (wr == 0) PG8_BAR; }
    PG8_BAR;
    if constexpr (Epi::AFTER_DRAIN) { E.fused(acc, cur, wr, wc, fr, fq, lds, wid, lane); S.done(cur); }
#undef PG8_SA
#undef PG8_SB
#undef PG8_STAGE
#undef PG8_LDA
#undef PG8_LDB
#undef PG8_MMA
#undef PG8_MMA8
#undef PG8_MQ
#undef PG8_MM
#undef PG8_RD8
#undef PG8_LDA8
#undef PG8_LDB8
#undef PG8_LA
#undef PG8_LB
#undef PG8_WAIT_V
#undef PG8_WAIT_L
#undef PG8_BAR
#undef PG8_SCHED
}
}

struct Params {
    const float* x; const int* pos;
    const float *ffn1_norm, *ffn1_wg, *ffn1_wu, *ffn1_wd, *mix_norm, *w_in, *q_norm, *kc_norm, *ks_norm, *kw_norm;
    const float *ck_pos, *ck_w1, *ck_w2, *cv_pos, *cv_w1, *cv_w2, *nsa_on, *sb_on, *w_out, *ffn2_norm, *ffn2_wg, *ffn2_wu, *ffn2_wd;
    float* out; unsigned char* ws;
};


__device__ __forceinline__ void rmsnorm_rows(const float* X, const float* g, bf16* Y) {
    int tid = threadIdx.x; asm volatile("" : "+v"(tid));
    const int lane = tid & 63, gw = blockIdx.x * NWAVES + (tid >> 6), NGW = gridDim.x * NWAVES;
    f32x4 gg[8];
#pragma unroll
    for (int j = 0; j < 8; ++j) gg[j] = ((const f32x4*)g)[lane + 64 * j];
    for (int m0 = gw; m0 < M; m0 += 2 * NGW) {
        const int m1 = m0 + NGW; const bool ok1 = m1 < M;
        const f32x4* x0 = (const f32x4*)(X + (size_t)m0 * D) + lane; const f32x4* x1 = (const f32x4*)(X + (size_t)(ok1 ? m1 : m0) * D) + lane;
        f32x4 v0[8], v1[8]; float s0 = 0.f, s1 = 0.f;
#pragma unroll
        for (int j = 0; j < 8; ++j) { v0[j] = x0[64 * j]; v1[j] = x1[64 * j]; }
#pragma unroll
        for (int j = 0; j < 8; ++j) { s0 += (v0[j].x * v0[j].x + v0[j].y * v0[j].y) + (v0[j].z * v0[j].z + v0[j].w * v0[j].w); s1 += (v1[j].x * v1[j].x + v1[j].y * v1[j].y) + (v1[j].z * v1[j].z + v1[j].w * v1[j].w); }
        const float r0 = rsqrtf(wave_sum(s0) * (1.f / D) + EPS), r1 = rsqrtf(wave_sum(s1) * (1.f / D) + EPS);
        v2u* o0 = (v2u*)(Y + (size_t)m0 * D) + lane; v2u* o1 = (v2u*)(Y + (size_t)m1 * D) + lane;
#pragma unroll
        for (int j = 0; j < 8; ++j) { v2u w; w.x = pk2(v0[j].x * r0 * gg[j].x, v0[j].y * r0 * gg[j].y); w.y = pk2(v0[j].z * r0 * gg[j].z, v0[j].w * r0 * gg[j].w); o0[64 * j] = w; }
        if (ok1) {
#pragma unroll
            for (int j = 0; j < 8; ++j) { v2u w; w.x = pk2(v1[j].x * r1 * gg[j].x, v1[j].y * r1 * gg[j].y); w.y = pk2(v1[j].z * r1 * gg[j].z, v1[j].w * r1 * gg[j].w); o1[64 * j] = w; }
        }
    }
}

__device__ __forceinline__ void cast_rows(const float* X, bf16* Y, unsigned long long* rowsq) {
    int tid = threadIdx.x; asm volatile("" : "+v"(tid));
    const int lane = tid & 63, gw = blockIdx.x * NWAVES + (tid >> 6), NGW = gridDim.x * NWAVES;
    for (int m0 = gw; m0 < M; m0 += 2 * NGW) {
        const int m1 = m0 + NGW; const bool ok1 = m1 < M;
        const f32x4* x0 = (const f32x4*)(X + (size_t)m0 * D) + lane; const f32x4* x1 = (const f32x4*)(X + (size_t)(ok1 ? m1 : m0) * D) + lane;
        f32x4 v0[8], v1[8]; float s0 = 0.f, s1 = 0.f;
#pragma unroll
        for (int j = 0; j < 8; ++j) { v0[j] = x0[64 * j]; v1[j] = x1[64 * j]; }
#pragma unroll
        for (int j = 0; j < 8; ++j) { s0 += (v0[j].x * v0[j].x + v0[j].y * v0[j].y) + (v0[j].z * v0[j].z + v0[j].w * v0[j].w); s1 += (v1[j].x * v1[j].x + v1[j].y * v1[j].y) + (v1[j].z * v1[j].z + v1[j].w * v1[j].w); }
        s0 = wave_sum(s0); s1 = wave_sum(s1);
        if (lane == 0) { rowsq[m0] = (unsigned long long)(s0 * 16777216.0f); if (ok1) rowsq[m1] = (unsigned long long)(s1 * 16777216.0f); }
        v2u* o0 = (v2u*)(Y + (size_t)m0 * D) + lane; v2u* o1 = (v2u*)(Y + (size_t)m1 * D) + lane;
#pragma unroll
        for (int j = 0; j < 8; ++j) { v2u w; w.x = pk2(v0[j].x, v0[j].y); w.y = pk2(v0[j].z, v0[j].w); o0[64 * j] = w; }
        if (ok1) {
#pragma unroll
            for (int j = 0; j < 8; ++j) { v2u w; w.x = pk2(v1[j].x, v1[j].y); w.y = pk2(v1[j].z, v1[j].w); o1[64 * j] = w; }
        }
    }
}
__device__ __forceinline__ void rmsnorm_rows_bf16(const bf16* X, const float* g, bf16* Y) {
    int tid = threadIdx.x; asm volatile("" : "+v"(tid));
    const int lane = tid & 63, gw = blockIdx.x * NWAVES + (tid >> 6), NGW = gridDim.x * NWAVES;
    f32x4 ga[4], gb[4];
#pragma unroll
    for (int j = 0; j < 4; ++j) { ga[j] = *(const f32x4*)(g + 8 * (lane + 64 * j)); gb[j] = *(const f32x4*)(g + 8 * (lane + 64 * j) + 4); }
    for (int m0 = gw; m0 < M; m0 += 2 * NGW) {
        const int m1 = m0 + NGW; const bool ok1 = m1 < M;
        const v4u* x0 = (const v4u*)(X + (size_t)m0 * D) + lane; const v4u* x1 = (const v4u*)(X + (size_t)(ok1 ? m1 : m0) * D) + lane;
        v4u r0[4], r1[4];
#pragma unroll
        for (int j = 0; j < 4; ++j) { r0[j] = x0[64 * j]; r1[j] = x1[64 * j]; }
        float s0 = 0.f, s1 = 0.f;
#pragma unroll
        for (int j = 0; j < 4; ++j) {
            s0 += (bflo(r0[j].x) * bflo(r0[j].x) + bfhi(r0[j].x) * bfhi(r0[j].x)) + (bflo(r0[j].y) * bflo(r0[j].y) + bfhi(r0[j].y) * bfhi(r0[j].y)) + (bflo(r0[j].z) * bflo(r0[j].z) + bfhi(r0[j].z) * bfhi(r0[j].z)) + (bflo(r0[j].w) * bflo(r0[j].w) + bfhi(r0[j].w) * bfhi(r0[j].w));
            s1 += (bflo(r1[j].x) * bflo(r1[j].x) + bfhi(r1[j].x) * bfhi(r1[j].x)) + (bflo(r1[j].y) * bflo(r1[j].y) + bfhi(r1[j].y) * bfhi(r1[j].y)) + (bflo(r1[j].z) * bflo(r1[j].z) + bfhi(r1[j].z) * bfhi(r1[j].z)) + (bflo(r1[j].w) * bflo(r1[j].w) + bfhi(r1[j].w) * bfhi(r1[j].w));
        }
        const float q0 = rsqrtf(wave_sum(s0) * (1.f / D) + EPS), q1 = rsqrtf(wave_sum(s1) * (1.f / D) + EPS);
        v4u* o0 = (v4u*)(Y + (size_t)m0 * D) + lane; v4u* o1 = (v4u*)(Y + (size_t)m1 * D) + lane;
#pragma unroll
        for (int j = 0; j < 4; ++j) { v4u w; w.x = pk2(bflo(r0[j].x) * q0 * ga[j].x, bfhi(r0[j].x) * q0 * ga[j].y); w.y = pk2(bflo(r0[j].y) * q0 * ga[j].z, bfhi(r0[j].y) * q0 * ga[j].w);
            w.z = pk2(bflo(r0[j].z) * q0 * gb[j].x, bfhi(r0[j].z) * q0 * gb[j].y); w.w = pk2(bflo(r0[j].w) * q0 * gb[j].z, bfhi(r0[j].w) * q0 * gb[j].w); o0[64 * j] = w; }
        if (ok1) {
#pragma unroll
            for (int j = 0; j < 4; ++j) { v4u w; w.x = pk2(bflo(r1[j].x) * q1 * ga[j].x, bfhi(r1[j].x) * q1 * ga[j].y); w.y = pk2(bflo(r1[j].y) * q1 * ga[j].z, bfhi(r1[j].y) * q1 * ga[j].w);
                w.z = pk2(bflo(r1[j].z) * q1 * gb[j].x, bfhi(r1[j].z) * q1 * gb[j].y); w.w = pk2(bflo(r1[j].w) * q1 * gb[j].z, bfhi(r1[j].w) * q1 * gb[j].w); o1[64 * j] = w; }
        }
    }
}

__device__ __forceinline__ void rope_tables(const int* pos, float* cs, float* sn) {
    int tid = threadIdx.x; asm volatile("" : "+v"(tid));
    const int gt = blockIdx.x * NTHREADS + tid, NGT = gridDim.x * NTHREADS;
    for (int i = gt; i < M * 64; i += NGT) {
        const int m = i >> 6, f = i & 63;
        const float inv = powf(10000.f, -(float)(2 * f) / 128.f);
        const float ang = (float)pos[m] * inv;
        cs[i] = cosf(ang); sn[i] = sinf(ang);
    }
}

__device__ __forceinline__ void postproj_naive(const Params& P, bf16* PROJ, const float* cs, const float* sn) {
    int tid = threadIdx.x; asm volatile("" : "+v"(tid));
    const int lane = tid & 63, sub = lane & 15, gw = blockIdx.x * NWAVES + (tid >> 6), NGW = gridDim.x * NWAVES;
    constexpr int NG = M * 12 / 4;
    for (int g0 = gw; g0 < NG; g0 += 2 * NGW) {
        v2u lo[2], hi[2]; f32x4 cv[2], sv[2]; bf16* pp[2]; const float* gp[2]; float qs[2]; bool ok[2];
#pragma unroll
        for (int u = 0; u < 2; ++u) {
            const int g = g0 + u * NGW; ok[u] = g < NG;
            const int task = ok[u] ? 4 * g + (lane >> 4) : 0, m = task / 12, sl = task % 12;
            int col;
            if (sl < 8) { col = C_QN + sl * 128; gp[u] = P.q_norm; } else if (sl < 10) { col = C_KS + (sl - 8) * 128; gp[u] = P.ks_norm; } else { col = C_KW + (sl - 10) * 128; gp[u] = P.kw_norm; }
            qs[u] = sl < 8 ? QSCALE : 1.0f;
            pp[u] = PROJ + (size_t)m * NP + col + 4 * sub;
            lo[u] = *(const v2u*)pp[u]; hi[u] = *(const v2u*)(pp[u] + 64);
            cv[u] = *(const f32x4*)(cs + m * 64 + 4 * sub); sv[u] = *(const f32x4*)(sn + m * 64 + 4 * sub);
        }
#pragma unroll
        for (int u = 0; u < 2; ++u) {
            float a[4], b[4];
            a[0] = bflo(lo[u].x); a[1] = bfhi(lo[u].x); a[2] = bflo(lo[u].y); a[3] = bfhi(lo[u].y);
            b[0] = bflo(hi[u].x); b[1] = bfhi(hi[u].x); b[2] = bflo(hi[u].y); b[3] = bfhi(hi[u].y);
            float ss = (a[0] * a[0] + a[1] * a[1]) + (a[2] * a[2] + a[3] * a[3]) + (b[0] * b[0] + b[1] * b[1]) + (b[2] * b[2] + b[3] * b[3]);
            ss += __shfl_xor(ss, 1); ss += __shfl_xor(ss, 2); ss += __shfl_xor(ss, 4); ss += __shfl_xor(ss, 8);
            const float r = rsqrtf(ss * (1.f / 128.f) + EPS) * qs[u];
            const f32x4 ga = *(const f32x4*)(gp[u] + 4 * sub), gb = *(const f32x4*)(gp[u] + 64 + 4 * sub);
            float oa[4], ob[4];
#pragma unroll
            for (int e = 0; e < 4; ++e) { const float x = a[e] * r * ga[e], y = b[e] * r * gb[e]; oa[e] = x * cv[u][e] - y * sv[u][e]; ob[e] = y * cv[u][e] + x * sv[u][e]; }
            if (ok[u]) { v2u wa, wb; wa.x = pk2(oa[0], oa[1]); wa.y = pk2(oa[2], oa[3]); wb.x = pk2(ob[0], ob[1]); wb.y = pk2(ob[2], ob[3]); *(v2u*)pp[u] = wa; *(v2u*)(pp[u] + 64) = wb; }
        }
    }
}

namespace att {
typedef short bf16x8 __attribute__((ext_vector_type(8)));
typedef short s16x4 __attribute__((ext_vector_type(4)));
constexpr float C1 = 0.08838834764831845f * 1.4426950408889634f;
typedef __bf16 bf16x2_t __attribute__((ext_vector_type(2)));
__device__ __forceinline__ unsigned cvt_pk_bf16(float lo, float hi) { const bf16x2_t v = __builtin_convertvector((f32x2){lo, hi}, bf16x2_t); return __builtin_bit_cast(unsigned, v); }
__device__ __forceinline__ int offK(int key, int dc) { return key * 256 + 16 * (dc ^ ((key & 3) | (((key >> 4) & 3) << 2))); }
__device__ __forceinline__ int offV(int key, int dc) { return key * 256 + 32 * ((dc >> 1) ^ ((key & 3) | (((key >> 4) & 1) << 2))) + 16 * (dc & 1); }
struct TileRegs { v4u k[2], v[2]; };
__device__ __forceinline__ void tile_load(TileRegs& r, const bf16* kp, const bf16* vp, int ld, int tid) {
#if NSA_OPAQUE
    asm volatile("" : "+v"(tid));
#endif
#pragma unroll
    for (int i = 0; i < 2; ++i) { const int id = tid + 512 * i, key = id >> 4, dc = id & 15; r.k[i] = *(const v4u*)(kp + (size_t)key * ld + dc * 8); r.v[i] = *(const v4u*)(vp + (size_t)key * ld + dc * 8); }
}
__device__ __forceinline__ void tile_store(const TileRegs& r, LAS unsigned char* kb, LAS unsigned char* vb, int tid) {
#if NSA_OPAQUE
    asm volatile("" : "+v"(tid));
#endif
#pragma unroll
    for (int i = 0; i < 2; ++i) { const int id = tid + 512 * i, key = id >> 4, dc = id & 15; *(LAS v4u*)(kb + offK(key, dc)) = r.k[i]; *(LAS v4u*)(vb + offV(key, dc)) = r.v[i]; }
}
__device__ __forceinline__ void tile_dma(const bf16* kp, const bf16* vp, int ld, LAS unsigned char* kb, LAS unsigned char* vb, int w, int lane) {
    asm volatile("" : "+v"(lane));
#pragma unroll
    for (int i = 0; i < 2; ++i) {
        const int p = 2 * w + i, key = 4 * p + (lane >> 4), sl = lane & 15;
        const int dck = sl ^ ((key & 3) | (((key >> 4) & 3) << 2));
        const int dcv = 2 * ((sl >> 1) ^ ((key & 3) | (((key >> 4) & 1) << 2))) + (sl & 1);
        __builtin_amdgcn_global_load_lds((const unsigned*)(kp + (size_t)key * ld + dck * 8), (LAS unsigned*)(kb + 1024 * p), 16, 0, 0);
        __builtin_amdgcn_global_load_lds((const unsigned*)(vp + (size_t)key * ld + dcv * 8), (LAS unsigned*)(vb + 1024 * p), 16, 0, 0);
    }
}
__device__ __forceinline__ void dma_k4(const bf16* kp, int ld, LAS unsigned char* kb, int w, int lane) {
    asm volatile("" : "+v"(lane));
#pragma unroll
    for (int i = 0; i < 4; ++i) {
        const int p = 4 * w + i, key = 4 * p + (lane >> 4), sl = lane & 15;
        const int dck = sl ^ ((key & 3) | (((key >> 4) & 3) << 2));
        __builtin_amdgcn_global_load_lds((const unsigned*)(kp + (size_t)key * ld + dck * 8), (LAS unsigned*)(kb + 1024 * p), 16, 0, 0);
    }
}
__device__ __forceinline__ void dma_v4(const bf16* vp, int ld, LAS unsigned char* vb, int w, int lane) {
    asm volatile("" : "+v"(lane));
#pragma unroll
    for (int i = 0; i < 4; ++i) {
        const int p = 4 * w + i, key = 4 * p + (lane >> 4), sl = lane & 15;
        const int dcv = 2 * ((sl >> 1) ^ ((key & 3) | (((key >> 4) & 1) << 2))) + (sl & 1);
        __builtin_amdgcn_global_load_lds((const unsigned*)(vp + (size_t)key * ld + dcv * 8), (LAS unsigned*)(vb + 1024 * p), 16, 0, 0);
    }
}
#define ATT_WAIT_V(n) asm volatile("s_waitcnt vmcnt(" #n ")" ::: "memory")
#define ATT_BAR() do { asm volatile("s_waitcnt lgkmcnt(0)" ::: "memory"); __builtin_amdgcn_s_barrier(); asm volatile("" ::: "memory"); } while (0)
template <bool OPAQUE = true>
__device__ __forceinline__ void qk_tile(f32x4 (&s)[2][4], const bf16x8 (&qf)[2][4], const LAS unsigned char* kb, int c, int q4) {
    if (OPAQUE) asm volatile("" : "+v"(c), "+v"(q4));
    const int rowoff = (16 * (c >> 2) + (c & 3)) * 256, lowp = 16 * (q4 ^ (c & 3));
#pragma unroll
    for (int kt = 0; kt < 4; ++kt) { s[0][kt] = (f32x4){0.f, 0.f, 0.f, 0.f}; s[1][kt] = (f32x4){0.f, 0.f, 0.f, 0.f}; }
#pragma unroll
    for (int ks = 0; ks < 4; ++ks) {
        const int a = rowoff + 64 * (ks ^ (c >> 2)) + lowp;
#pragma unroll
        for (int kt = 0; kt < 4; ++kt) {
            const bf16x8 kf = *(const LAS bf16x8*)(kb + a + kt * 1024);
            s[0][kt] = __builtin_amdgcn_mfma_f32_16x16x32_bf16(kf, qf[0][ks], s[0][kt], 0, 0, 0);
            s[1][kt] = __builtin_amdgcn_mfma_f32_16x16x32_bf16(kf, qf[1][ks], s[1][kt], 0, 0, 0);
        }
    }
}
__device__ __forceinline__ void qk_tile_lq(f32x4 (&s)[2][4], const LAS unsigned char* qb, const LAS unsigned char* kb, int c, int q4, int lane) {
#if NSA_OPAQUE
    asm volatile("" : "+v"(c), "+v"(q4), "+v"(lane));
#endif
    const int rowoff = (16 * (c >> 2) + (c & 3)) * 256, lowp = 16 * (q4 ^ (c & 3));
#pragma unroll
    for (int kt = 0; kt < 4; ++kt) { s[0][kt] = (f32x4){0.f, 0.f, 0.f, 0.f}; s[1][kt] = (f32x4){0.f, 0.f, 0.f, 0.f}; }
#pragma unroll
    for (int ks = 0; ks < 4; ++ks) {
        const int a = rowoff + 64 * (ks ^ (c >> 2)) + lowp;
        const bf16x8 q0 = *(const LAS bf16x8*)(qb + (ks * 64 + lane) * 16), q1 = *(const LAS bf16x8*)(qb + ((4 + ks) * 64 + lane) * 16);
#pragma unroll
        for (int kt = 0; kt < 4; ++kt) {
            const bf16x8 kf = *(const LAS bf16x8*)(kb + a + kt * 1024);
            s[0][kt] = __builtin_amdgcn_mfma_f32_16x16x32_bf16(kf, q0, s[0][kt], 0, 0, 0);
            s[1][kt] = __builtin_amdgcn_mfma_f32_16x16x32_bf16(kf, q1, s[1][kt], 0, 0, 0);
        }
    }
}
__device__ __forceinline__ void pv_tile(f32x4 (&o)[8][2], const bf16x8 (&pf)[2][2], const LAS unsigned char* vb, int c, int q4) {
#if NSA_OPAQUE
    asm volatile("" : "+v"(c), "+v"(q4));
#endif
    const int p = c & 3;
#pragma unroll
    for (int s2 = 0; s2 < 2; ++s2) {
        const int key0 = 16 * q4 + 8 * s2 + (c >> 2);
        const int g = (key0 & 3) | (((key0 >> 4) & 1) << 2);
        const int base = key0 * 256 + 16 * (p >> 1) + 8 * (p & 1);
#pragma unroll
        for (int dt = 0; dt < 8; ++dt) {
            const LAS unsigned char* a0 = vb + base + 32 * (dt ^ g);
            const s16x4 lo = __builtin_amdgcn_ds_read_tr16_b64_v4i16((LAS s16x4*)a0);
            const s16x4 hi = __builtin_amdgcn_ds_read_tr16_b64_v4i16((LAS s16x4*)(a0 + 1024));
            const bf16x8 vf = __builtin_shufflevector(lo, hi, 0, 1, 2, 3, 4, 5, 6, 7);
            o[dt][0] = __builtin_amdgcn_mfma_f32_16x16x32_bf16(vf, pf[0][s2], o[dt][0], 0, 0, 0);
            o[dt][1] = __builtin_amdgcn_mfma_f32_16x16x32_bf16(vf, pf[1][s2], o[dt][1], 0, 0, 0);
        }
    }
}
__device__ __forceinline__ s16x4 tr_read_asm(unsigned addr) { s16x4 r; asm volatile("ds_read_b64_tr_b16 %0, %1" : "=v"(r) : "v"(addr) : "memory"); return r; }
__device__ __forceinline__ s16x4 tr_read_asm_1k(unsigned addr) { s16x4 r; asm volatile("ds_read_b64_tr_b16 %0, %1 offset:1024" : "=v"(r) : "v"(addr) : "memory"); return r; }
template <bool OPAQUE = true>
__device__ __forceinline__ void pv_tile_asm(f32x4 (&o)[8][2], const bf16x8 (&pf)[2][2], const LAS unsigned char* vb, int c, int q4) {
    if (OPAQUE) asm volatile("" : "+v"(c), "+v"(q4));
    const int p = c & 3;
#pragma unroll
    for (int s2 = 0; s2 < 2; ++s2) {
        const int key0 = 16 * q4 + 8 * s2 + (c >> 2);
        const int g = (key0 & 3) | (((key0 >> 4) & 1) << 2);
        const unsigned base = (unsigned)(size_t)vb + key0 * 256 + 16 * (p >> 1) + 8 * (p & 1);
        s16x4 lo[8], hi[8];
#pragma unroll
        for (int dt = 0; dt < 8; ++dt) { const unsigned a0 = base + 32 * (dt ^ g); lo[dt] = tr_read_asm(a0); hi[dt] = tr_read_asm_1k(a0); }
        asm volatile("s_waitcnt lgkmcnt(0)" ::: "memory");
        __builtin_amdgcn_sched_barrier(0);
#pragma unroll
        for (int dt = 0; dt < 8; ++dt) {
            const bf16x8 vf = __builtin_shufflevector(lo[dt], hi[dt], 0, 1, 2, 3, 4, 5, 6, 7);
            o[dt][0] = __builtin_amdgcn_mfma_f32_16x16x32_bf16(vf, pf[0][s2], o[dt][0], 0, 0, 0);
            o[dt][1] = __builtin_amdgcn_mfma_f32_16x16x32_bf16(vf, pf[1][s2], o[dt][1], 0, 0, 0);
        }
    }
}
struct VGroup { s16x4 lo[4], hi[4]; };
template <int G>
__device__ __forceinline__ void pv_issue(VGroup& v, const LAS unsigned char* vb, int c, int q4) {
    constexpr int s2 = G >> 1, d0 = 4 * (G & 1);
    const int p = c & 3, key0 = 16 * q4 + 8 * s2 + (c >> 2), g = (key0 & 3) | (((key0 >> 4) & 1) << 2);
    const unsigned base = (unsigned)(size_t)vb + key0 * 256 + 16 * (p >> 1) + 8 * (p & 1);
#pragma unroll
    for (int i = 0; i < 4; ++i) { const unsigned a0 = base + 32 * ((d0 + i) ^ g); v.lo[i] = tr_read_asm(a0); v.hi[i] = tr_read_asm_1k(a0); }
}
template <int G>
__device__ __forceinline__ void pv_mma(f32x4 (&o)[8][2], const VGroup& v, const bf16x8 (&pf)[2][2]) {
    constexpr int s2 = G >> 1, d0 = 4 * (G & 1);
#pragma unroll
    for (int i = 0; i < 4; ++i) {
        const bf16x8 vf = __builtin_shufflevector(v.lo[i], v.hi[i], 0, 1, 2, 3, 4, 5, 6, 7);
        o[d0 + i][0] = __builtin_amdgcn_mfma_f32_16x16x32_bf16(vf, pf[0][s2], o[d0 + i][0], 0, 0, 0);
        o[d0 + i][1] = __builtin_amdgcn_mfma_f32_16x16x32_bf16(vf, pf[1][s2], o[d0 + i][1], 0, 0, 0);
    }
}
#define PV_WAIT() do { asm volatile("s_waitcnt lgkmcnt(0)" ::: "memory"); __builtin_amdgcn_sched_barrier(0); } while (0)
__device__ __forceinline__ void pv_tile_rest(f32x4 (&o)[8][2], VGroup& va, const bf16x8 (&pf)[2][2], const LAS unsigned char* vb, int c, int q4) {
    VGroup vb2;
    PV_WAIT(); pv_issue<1>(vb2, vb, c, q4); __builtin_amdgcn_sched_barrier(0); pv_mma<0>(o, va, pf);
    PV_WAIT(); pv_issue<2>(va, vb, c, q4);  __builtin_amdgcn_sched_barrier(0); pv_mma<1>(o, vb2, pf);
    PV_WAIT(); pv_issue<3>(vb2, vb, c, q4); __builtin_amdgcn_sched_barrier(0); pv_mma<2>(o, va, pf);
    PV_WAIT(); pv_mma<3>(o, vb2, pf);
}
__device__ __forceinline__ bf16x8 pack8(float a0, float a1, float a2, float a3, float a4, float a5, float a6, float a7) {
    v4u w; w.x = cvt_pk_bf16(a0, a1); w.y = cvt_pk_bf16(a2, a3); w.z = cvt_pk_bf16(a4, a5); w.w = cvt_pk_bf16(a6, a7);
    return __builtin_bit_cast(bf16x8, w);
}


template <bool MASK>
__device__ __forceinline__ void sb_elem(const f32x4 (&s)[4], float& R, bf16x8 (&pf)[2], const int kdiff, const int c, const int q4) {
    f32x2 a2[8]; f32x2 t2 = (f32x2){1.f, 1.f};
#pragma unroll
    for (int k = 0; k < 8; ++k) {
        f32x2 e;
        e.x = __builtin_amdgcn_exp2f(s[k >> 2][k & 3]); e.y = __builtin_amdgcn_exp2f(s[2 + (k >> 2)][k & 3]);
        if (MASK) { e.x = (k < kdiff) ? e.x : 0.f; e.y = (k + 8 < kdiff) ? e.y : 0.f; }
        a2[k] = e * t2; t2 = t2 * (e + 1.0f);
    }
    const float l0 = __builtin_amdgcn_logf(t2.x), l1 = __builtin_amdgcn_logf(t2.y), run = l0 + l1;
    const float u1 = __shfl_down(run, 16), u2 = __shfl_down(run, 32), u3 = __shfl_down(run, 48);
    const float X = (q4 < 3 ? u1 : 0.f) + (q4 < 2 ? u2 : 0.f) + (q4 < 1 ? u3 : 0.f);
    const float tot = __shfl(run + X, c);
    const float base = R + X + l1;
    f32x2 sc; sc.y = __builtin_amdgcn_exp2f(-base); sc.x = __builtin_amdgcn_exp2f(-(base + l0));
    R += tot;
#pragma unroll
    for (int k = 0; k < 8; ++k) a2[k] = a2[k] * sc;
    pf[0] = pack8(a2[0].x, a2[1].x, a2[2].x, a2[3].x, a2[4].x, a2[5].x, a2[6].x, a2[7].x);
    pf[1] = pack8(a2[0].y, a2[1].y, a2[2].y, a2[3].y, a2[4].y, a2[5].y, a2[6].y, a2[7].y);
}

template <int MODE = 31>
__device__ __forceinline__ void sb_unit(const Params& P, LAS unsigned char* lds, const bf16* PROJ, const bf16* KVC, bf16* Y, int b, int h, int tqq) {
    int tid = threadIdx.x; asm volatile("" : "+v"(tid));
    const int lane = tid & 63, w = __builtin_amdgcn_readfirstlane(tid >> 6), c = lane & 15, q4 = lane >> 4;
    const int qbase = 256 * tqq + 32 * w;
    bf16x8 qf[2][4];
#pragma unroll
    for (int qt = 0; qt < 2; ++qt)
#pragma unroll
        for (int ks = 0; ks < 4; ++ks) qf[qt][ks] = *(const bf16x8*)(PROJ + (size_t)(b * SEQ + qbase + 16 * qt + c) * NP + C_QS + h * 128 + 32 * ks + 8 * q4);
#pragma unroll
    for (int qt = 0; qt < 2; ++qt)
#pragma unroll
        for (int ks = 0; ks < 4; ++ks) asm volatile("" : "+v"(qf[qt][ks]));
    f32x4 o[8][2];
#pragma unroll
    for (int dt = 0; dt < 8; ++dt) { o[dt][0] = (f32x4){0.f, 0.f, 0.f, 0.f}; o[dt][1] = (f32x4){0.f, 0.f, 0.f, 0.f}; }
    float R[2] = {0.f, 0.f};
#if SB_COMPACT
    const bf16* kg = KVC + (size_t)((b * 8 + h) * 4096) * 128; const bf16* vg = KVC + (size_t)((32 + b * 8 + h) * 4096) * 128;
    constexpr int KLD = 128;
#else
    const bf16* kg = PROJ + (size_t)(b * SEQ) * NP + C_KSB + h * 128; const bf16* vg = PROJ + (size_t)(b * SEQ) * NP + C_VSB + h * 128;
    constexpr int KLD = NP;
#endif
    const int nkt = 4 * tqq + 4;
    const bool isA = w < 4;
    if (isA && (MODE & 8)) { dma_k4(kg + (size_t)(nkt - 1) * 64 * KLD, KLD, lds, w, lane); dma_v4(vg + (size_t)(nkt - 1) * 64 * KLD, KLD, lds + 32768, w, lane); ATT_WAIT_V(0); }
    ATT_BAR();
    if (!isA) ATT_BAR();
    for (int it = 0; it < nkt; ++it) {
        const int kt64 = nkt - 1 - it, kb0 = 64 * kt64, cur = it & 1;
        const bool has = it + 1 < nkt, active = kb0 <= qbase + 30, need_mask = (kb0 + 63 >= qbase);
        const LAS unsigned char* kb = lds + cur * 16384; const LAS unsigned char* vb = lds + 32768 + cur * 16384;
        f32x4 s[2][4]; bf16x8 pf[2][2];
        if (isA && has && (MODE & 8)) dma_k4(kg + (size_t)(kt64 - 1) * 64 * KLD, KLD, lds + (cur ^ 1) * 16384, w, lane);
        if (active) {
            if (MODE & 1) qk_tile<false>(s, qf, kb, c, q4);
            else {
#pragma unroll
                for (int kt = 0; kt < 4; ++kt) { s[0][kt] = (f32x4){0.1f, -0.2f, 0.3f, R[0]}; s[1][kt] = (f32x4){-0.1f, 0.2f, -0.3f, R[1]}; asm volatile("" : "+v"(s[0][kt]), "+v"(s[1][kt])); } }
            if (MODE & 2) { if (need_mask) sb_elem<true>(s[0], R[0], pf[0], qbase + c - kb0 - 16 * q4, c, q4); else sb_elem<false>(s[0], R[0], pf[0], 64, c, q4); }
            else { pf[0][0] = __builtin_bit_cast(bf16x8, s[0][0]); pf[0][1] = __builtin_bit_cast(bf16x8, s[0][1]); R[0] += s[0][2][0] + s[0][3][1]; }
        }
        if (isA) { if (has) ATT_WAIT_V(4); else ATT_WAIT_V(0); }
        if (MODE & 16) ATT_BAR();
        if (isA && has && (MODE & 8)) dma_v4(vg + (size_t)(kt64 - 1) * 64 * KLD, KLD, lds + 32768 + (cur ^ 1) * 16384, w, lane);
        if (active) {
            VGroup vg0;
            if (MODE & 4) { pv_issue<0>(vg0, vb, c, q4); __builtin_amdgcn_sched_barrier(0); }
            if (MODE & 2) { if (need_mask) sb_elem<true>(s[1], R[1], pf[1], qbase + 16 + c - kb0 - 16 * q4, c, q4); else sb_elem<false>(s[1], R[1], pf[1], 64, c, q4); }
            else { pf[1][0] = __builtin_bit_cast(bf16x8, s[1][0]); pf[1][1] = __builtin_bit_cast(bf16x8, s[1][1]); R[1] += s[1][2][0] + s[1][3][1]; }
            if (MODE & 4) pv_tile_rest(o, vg0, pf, vb, c, q4);
            else { o[0][0] = o[0][0] + __builtin_bit_cast(f32x4, pf[0][0]) + __builtin_bit_cast(f32x4, pf[0][1]); o[0][1] = o[0][1] + __builtin_bit_cast(f32x4, pf[1][0]) + __builtin_bit_cast(f32x4, pf[1][1]); }
        }
        if (isA) { if (has) ATT_WAIT_V(4); else ATT_WAIT_V(0); }
        if (MODE & 16) ATT_BAR();
    }
    if (isA) ATT_BAR();
    f32x4 gsb[8];
#pragma unroll
    for (int dt = 0; dt < 8; ++dt) gsb[dt] = *(const f32x4*)(P.sb_on + h * 128 + 4 * q4 + 16 * dt);
#pragma unroll
    for (int qt = 0; qt < 2; ++qt) {
        float ss = 0.f;
#pragma unroll
        for (int dt = 0; dt < 8; ++dt) { const f32x4 v = o[dt][qt]; ss += (v[0] * v[0] + v[1] * v[1]) + (v[2] * v[2] + v[3] * v[3]); }
        ss += __shfl_xor(ss, 16); ss += __shfl_xor(ss, 32);
        const float r = rsqrtf(ss * (1.f / 128.f) + EPS);
        bf16* yrow = Y + (size_t)(b * SEQ + qbase + 16 * qt + c) * D + 1024 + h * 128 + 4 * q4;
#pragma unroll
        for (int dt = 0; dt < 8; ++dt) { const f32x4 v = o[dt][qt]; const f32x4 gg = gsb[dt];
            v2u wv; wv.x = cvt_pk_bf16(v[0] * r * gg[0], v[1] * r * gg[1]); wv.y = cvt_pk_bf16(v[2] * r * gg[2], v[3] * r * gg[3]);
            *(v2u*)(yrow + 16 * dt) = wv; }
    }
}

__device__ __forceinline__ void osm_step(const f32x4 (&s)[4], const bool bsel, const bool masked, const int lo, const int hi, float& m, float& l, f32x4 (&o)[8][2], const int qt, bf16x8 (&pf)[2]) {
    float v[16];
#pragma unroll
    for (int idx = 0; idx < 16; ++idx) v[idx] = s[idx >> 2][idx & 3];
    if (masked) {
#pragma unroll
        for (int idx = 0; idx < 16; ++idx) v[idx] = (idx >= lo && idx <= hi) ? v[idx] : -1e30f;
    }
    float tm = fmaxf(fmaxf(fmaxf(v[0], v[1]), fmaxf(v[2], v[3])), fmaxf(fmaxf(v[4], v[5]), fmaxf(v[6], v[7])));
    tm = fmaxf(tm, fmaxf(fmaxf(fmaxf(v[8], v[9]), fmaxf(v[10], v[11])), fmaxf(fmaxf(v[12], v[13]), fmaxf(v[14], v[15]))));
    tm = fmaxf(tm, __shfl_xor(tm, 16)); tm = fmaxf(tm, __shfl_xor(tm, 32));
    tm = bsel ? tm : -1e30f;
    const bool grow = tm > m + 8.0f;
    if (__any(grow)) {
        const float mn = grow ? tm : m, alpha = __builtin_amdgcn_exp2f(m - mn);
        l *= alpha; m = mn;
#pragma unroll
        for (int dt = 0; dt < 8; ++dt) o[dt][qt] = o[dt][qt] * alpha;
    }
    const float sub = bsel ? m : 1e30f;
    float sum = 0.f;
#pragma unroll
    for (int idx = 0; idx < 16; ++idx) { v[idx] = __builtin_amdgcn_exp2f(v[idx] - sub); sum += v[idx]; }
    l += sum;
    pf[0] = pack8(v[0], v[1], v[2], v[3], v[4], v[5], v[6], v[7]);
    pf[1] = pack8(v[8], v[9], v[10], v[11], v[12], v[13], v[14], v[15]);
}
#define ATT_TILE_PROLOGUE(KP, VP, LD) do { tile_load(tr, (KP), (VP), (LD), tid); __syncthreads(); tile_store(tr, lds, lds + 32768, tid); __syncthreads(); } while (0)
#define ATT_TILE_NEXT(HAS, KP, VP, LD) do { if (HAS) tile_load(tr, (KP), (VP), (LD), tid); } while (0)
#define ATT_TILE_END(HAS, CUR) do { if (HAS) tile_store(tr, lds + ((CUR) ^ 1) * 16384, lds + 32768 + ((CUR) ^ 1) * 16384, tid); __syncthreads(); } while (0)

__device__ __forceinline__ void nsa_unit(const Params& P, LAS unsigned char* lds, const bf16* PROJ, const bf16* KC, const bf16* VC, bf16* Y, f32x4* scr, int b, int g, int tq) {
    int tid = threadIdx.x; asm volatile("" : "+v"(tid));
    const int lane = tid & 63, w = __builtin_amdgcn_readfirstlane(tid >> 6), c = lane & 15, q4 = lane >> 4;
    const int bg = b * 2 + g, t0 = 64 * tq, hg = g * 4 + (c & 3);
    LAS float* pslc = (LAS float*)(lds + 131072);
    LAS unsigned long long* selm = (LAS unsigned long long*)(lds + 147456);
    LAS unsigned char* qb = lds + 65536 + w * 8192;
    scr += (size_t)w * 32 * 64;
    int ql[2]; ql[0] = 8 * w + (c >> 2); ql[1] = ql[0] + 4;
#pragma unroll
    for (int i = 0; i < 8; ++i) pslc[(8 * w + i) * 64 + lane] = 0.f;
    bf16x8 qf[2][4];
#pragma unroll
    for (int qt = 0; qt < 2; ++qt) {
        const bf16* prow = PROJ + (size_t)(b * SEQ + t0 + ql[qt]) * NP;
#pragma unroll
        for (int ks = 0; ks < 4; ++ks) qf[qt][ks] = *(const bf16x8*)(prow + C_QN + hg * 128 + 32 * ks + 8 * q4);
    }
#pragma unroll
    for (int qt = 0; qt < 2; ++qt)
#pragma unroll
        for (int ks = 0; ks < 4; ++ks) asm volatile("" : "+v"(qf[qt][ks]));
    float gates[2][3];
    {
        bf16 graw[2][3];
#pragma unroll
        for (int qt = 0; qt < 2; ++qt)
#pragma unroll
            for (int br = 0; br < 3; ++br) graw[qt][br] = PROJ[(size_t)(b * SEQ + t0 + ql[qt]) * NP + C_GATE + hg * 3 + br];
#pragma unroll
        for (int qt = 0; qt < 2; ++qt)
#pragma unroll
            for (int br = 0; br < 3; ++br) gates[qt][br] = 1.f / (1.f + __expf(-bf2f(graw[qt][br])));
    }
    TileRegs tr;
    f32x4 o[8][2];
    float mx[2], ls[2];
    const bf16* kcg = KC + (size_t)bg * 256 * 128; const bf16* vcg = VC + (size_t)bg * 256 * 128;
    const int nvmax = min(NCMP, 4 * tq + 3), ntc = (nvmax + 63) >> 6;
    mx[0] = mx[1] = -1e20f; ls[0] = ls[1] = 0.f;
    ATT_TILE_PROLOGUE(kcg, vcg, 128);
    for (int it = 0; it < ntc; ++it) {
        const int cur = it & 1; const bool has = it + 1 < ntc;
        ATT_TILE_NEXT(has, kcg + (size_t)(it + 1) * 64 * 128, vcg + (size_t)(it + 1) * 64 * 128, 128);
        {
            f32x4 s[2][4];
            qk_tile<false>(s, qf, lds + cur * 16384, c, q4);
#pragma unroll
            for (int qt = 0; qt < 2; ++qt) {
                const int lim = t0 + ql[qt] - 31 - 16 * (64 * it + 16 * q4);
                float tm = -1e30f, v[16];
#pragma unroll
                for (int kt = 0; kt < 4; ++kt)
#pragma unroll
                    for (int i = 0; i < 4; ++i) { v[4 * kt + i] = (16 * (4 * kt + i) <= lim) ? s[qt][kt][i] : -1e30f; tm = fmaxf(tm, v[4 * kt + i]); }
                tm = fmaxf(tm, __shfl_xor(tm, 16)); tm = fmaxf(tm, __shfl_xor(tm, 32));
                const float mn = fmaxf(mx[qt], tm); float sum = 0.f;
#pragma unroll
                for (int i = 0; i < 16; ++i) sum += __builtin_amdgcn_exp2f(v[i] - mn);
                ls[qt] = ls[qt] * __builtin_amdgcn_exp2f(mx[qt] - mn) + sum; mx[qt] = mn;
            }
        }
        ATT_TILE_END(has, cur);
    }
    float inv[2];
#pragma unroll
    for (int qt = 0; qt < 2; ++qt) { float l = ls[qt]; l += __shfl_xor(l, 16); l += __shfl_xor(l, 32); inv[qt] = l > 0.f ? 1.f / l : 0.f; }
    float g0v[2]; g0v[0] = gates[0][0]; g0v[1] = gates[1][0];
#pragma unroll
    for (int dt = 0; dt < 8; ++dt) { o[dt][0] = (f32x4){0.f, 0.f, 0.f, 0.f}; o[dt][1] = (f32x4){0.f, 0.f, 0.f, 0.f}; }
    ATT_TILE_PROLOGUE(kcg, vcg, 128);
    for (int it = 0; it < ntc; ++it) {
        const int cur = it & 1; const bool has = it + 1 < ntc;
        ATT_TILE_NEXT(has, kcg + (size_t)(it + 1) * 64 * 128, vcg + (size_t)(it + 1) * 64 * 128, 128);
        {
            f32x4 s[2][4];
            qk_tile<false>(s, qf, lds + cur * 16384, c, q4);
            bf16x8 pf[2][2];
#pragma unroll
            for (int qt = 0; qt < 2; ++qt) {
                const int lim = t0 + ql[qt] - 31 - 16 * (64 * it + 16 * q4);
                float p[16];
#pragma unroll
                for (int kt = 0; kt < 4; ++kt)
#pragma unroll
                    for (int i = 0; i < 4; ++i) p[4 * kt + i] = (16 * (4 * kt + i) <= lim) ? __builtin_amdgcn_exp2f(s[qt][kt][i] - mx[qt]) * inv[qt] : 0.f;
                const int jb = 16 * it + 4 * q4;
#pragma unroll
                for (int kt = 0; kt < 4; ++kt) {
                    float gs = (p[4 * kt] + p[4 * kt + 1]) + (p[4 * kt + 2] + p[4 * kt + 3]), e3 = p[4 * kt + 3];
                    gs += __shfl_xor(gs, 1); gs += __shfl_xor(gs, 2); e3 += __shfl_xor(e3, 1); e3 += __shfl_xor(e3, 2);
                    if ((c & 3) == 0) {
                        LAS float* row = pslc + ql[qt] * 64;
                        __hip_atomic_fetch_add(row + jb + kt, gs, __ATOMIC_RELAXED, __HIP_MEMORY_SCOPE_WORKGROUP);
                        if (jb + kt + 1 < 64) __hip_atomic_fetch_add(row + jb + kt + 1, e3, __ATOMIC_RELAXED, __HIP_MEMORY_SCOPE_WORKGROUP);
                    }
                }
                const float g0 = g0v[qt];
                pf[qt][0] = pack8(p[0] * g0, p[1] * g0, p[2] * g0, p[3] * g0, p[4] * g0, p[5] * g0, p[6] * g0, p[7] * g0);
                pf[qt][1] = pack8(p[8] * g0, p[9] * g0, p[10] * g0, p[11] * g0, p[12] * g0, p[13] * g0, p[14] * g0, p[15] * g0);
            }
            pv_tile(o, pf, lds + 32768 + cur * 16384, c, q4);
        }
        ATT_TILE_END(has, cur);
    }
#pragma unroll
    for (int dt = 0; dt < 8; ++dt) { scr[lane * 32 + 2 * dt] = o[dt][0]; scr[lane * 32 + 2 * dt + 1] = o[dt][1]; }
    asm volatile("s_waitcnt lgkmcnt(0)" ::: "memory");
    {
        unsigned long long wor = 0ull;
        const int j = lane;
        const bool causal = j <= tq, forced = (j == 0) || (j == tq) || (j == tq - 1);
        const unsigned long long cmask = __ballot(causal);
        for (int i = 0; i < 8; ++i) {
            const float pv = pslc[(8 * w + i) * 64 + j];
            const unsigned key = causal ? (forced ? 0xFFFFFFFFu : __float_as_uint(pv) + 1u) : 0u;
            unsigned T = 0u;
#pragma unroll
            for (int bit = 31; bit >= 0; --bit) { const unsigned cand = T | (1u << bit); if (__popcll(__ballot(key >= cand)) >= 16) T = cand; }
            const unsigned long long gt = __ballot(key > T); unsigned long long eq = __ballot(key == T), take = 0ull;
            for (int need = 16 - __popcll(gt); need > 0 && eq != 0ull; --need) { const unsigned long long low = eq & (~eq + 1ull); take |= low; eq ^= low; }
            const unsigned long long mask = (gt | take) & cmask;
            if (lane == 0) selm[8 * w + i] = mask;
            wor |= mask;
        }
        if (lane == 0) selm[64 + w] = wor;
    }
    __syncthreads();
    unsigned long long uni = 0ull;
#pragma unroll
    for (int i = 0; i < 8; ++i) uni |= selm[64 + i];
    uni = ((unsigned long long)__builtin_amdgcn_readfirstlane((unsigned)(uni >> 32)) << 32) | (unsigned long long)__builtin_amdgcn_readfirstlane((unsigned)uni);
    {
#pragma unroll
        for (int dt = 0; dt < 8; ++dt) { o[dt][0] = (f32x4){0.f, 0.f, 0.f, 0.f}; o[dt][1] = (f32x4){0.f, 0.f, 0.f, 0.f}; }
        mx[0] = mx[1] = -1e20f; ls[0] = ls[1] = 0.f;
        const bf16* kg = PROJ + (size_t)(b * SEQ) * NP + C_KS + g * 128; const bf16* vg = PROJ + (size_t)(b * SEQ) * NP + C_VS + g * 128;
        unsigned long long rem = uni;
        int j = __builtin_ctzll(rem); rem &= rem - 1ull;
        ATT_TILE_PROLOGUE(kg + (size_t)j * 64 * NP, vg + (size_t)j * 64 * NP, NP);
        for (int it = 0;; ++it) {
            const int cur = it & 1; const bool has = rem != 0ull;
            const int jn = has ? __builtin_ctzll(rem) : 0; rem &= rem - 1ull;
            ATT_TILE_NEXT(has, kg + (size_t)jn * 64 * NP, vg + (size_t)jn * 64 * NP, NP);
            const bool b0 = (selm[ql[0]] >> j) & 1ull, b1 = (selm[ql[1]] >> j) & 1ull;
            if (__ballot(b0 || b1) != 0ull) {
                f32x4 s[2][4];
                qk_tile<false>(s, qf, lds + cur * 16384, c, q4);
                bf16x8 pf[2][2];
                osm_step(s[0], b0, j == tq, -64, ql[0] - 16 * q4, mx[0], ls[0], o, 0, pf[0]);
                osm_step(s[1], b1, j == tq, -64, ql[1] - 16 * q4, mx[1], ls[1], o, 1, pf[1]);
                pv_tile(o, pf, lds + 32768 + cur * 16384, c, q4);
            }
            ATT_TILE_END(has, cur);
            if (!has) break;
            j = jn;
        }
#pragma unroll
        for (int qt = 0; qt < 2; ++qt) {
            float l = ls[qt]; l += __shfl_xor(l, 16); l += __shfl_xor(l, 32);
            const float cb = gates[qt][1] / l;
#pragma unroll
            for (int dt = 0; dt < 8; ++dt) scr[lane * 32 + 16 + 2 * dt + qt] = o[dt][qt] * cb;
        }
    }
    {
#pragma unroll
        for (int dt = 0; dt < 8; ++dt) { o[dt][0] = (f32x4){0.f, 0.f, 0.f, 0.f}; o[dt][1] = (f32x4){0.f, 0.f, 0.f, 0.f}; }
        mx[0] = mx[1] = -1e20f; ls[0] = ls[1] = 0.f;
        const bf16* kg = PROJ + (size_t)(b * SEQ) * NP + C_KW + g * 128; const bf16* vg = PROJ + (size_t)(b * SEQ) * NP + C_VW + g * 128;
        const int k0 = max(0, tq - 8), nw = tq - k0 + 1;
        ATT_TILE_PROLOGUE(kg + (size_t)k0 * 64 * NP, vg + (size_t)k0 * 64 * NP, NP);
        for (int it = 0; it < nw; ++it) {
            const int cur = it & 1, kt64 = k0 + it; const bool has = it + 1 < nw;
            ATT_TILE_NEXT(has, kg + (size_t)(kt64 + 1) * 64 * NP, vg + (size_t)(kt64 + 1) * 64 * NP, NP);
            {
                f32x4 s[2][4];
                qk_tile<false>(s, qf, lds + cur * 16384, c, q4);
                bf16x8 pf[2][2];
                {
                    const int d0 = ql[0] - 16 * q4, d1 = ql[1] - 16 * q4;
                    const bool first = (kt64 == tq - 8), edge = first || (kt64 == tq);
                    osm_step(s[0], true, edge, first ? d0 + 1 : -64, first ? 64 : d0, mx[0], ls[0], o, 0, pf[0]);
                    osm_step(s[1], true, edge, first ? d1 + 1 : -64, first ? 64 : d1, mx[1], ls[1], o, 1, pf[1]);
                }
                pv_tile(o, pf, lds + 32768 + cur * 16384, c, q4);
            }
            ATT_TILE_END(has, cur);
        }
    }
    f32x4 gns[8];
#pragma unroll
    for (int dt = 0; dt < 8; ++dt) gns[dt] = *(const f32x4*)(P.nsa_on + hg * 128 + 4 * q4 + 16 * dt);
#pragma unroll
    for (int qt = 0; qt < 2; ++qt) {
        float l = ls[qt]; l += __shfl_xor(l, 16); l += __shfl_xor(l, 32);
        const float cb = gates[qt][2] / l;
        float ss = 0.f;
#pragma unroll
        for (int dt = 0; dt < 8; ++dt) { const f32x4 a = (scr[lane * 32 + 2 * dt + qt] + scr[lane * 32 + 16 + 2 * dt + qt]) + o[dt][qt] * cb; o[dt][qt] = a; ss += (a[0] * a[0] + a[1] * a[1]) + (a[2] * a[2] + a[3] * a[3]); if ((dt & 3) == 3) __builtin_amdgcn_sched_barrier(0); }
        ss += __shfl_xor(ss, 16); ss += __shfl_xor(ss, 32);
        const float r = rsqrtf(ss * (1.f / 128.f) + EPS);
        bf16* yrow = Y + (size_t)(b * SEQ + t0 + ql[qt]) * D + hg * 128 + 4 * q4;
#pragma unroll
        for (int dt = 0; dt < 8; ++dt) { const f32x4 v = o[dt][qt]; const f32x4 gg = gns[dt];
            v2u wv; wv.x = cvt_pk_bf16(v[0] * r * gg[0], v[1] * r * gg[1]); wv.y = cvt_pk_bf16(v[2] * r * gg[2], v[3] * r * gg[3]);
            *(v2u*)(yrow + 16 * dt) = wv; if (dt & 1) __builtin_amdgcn_sched_barrier(0); }
    }
    __syncthreads();
}
__device__ __forceinline__ void nsa_phase(const Params& P, LAS unsigned char* lds, const bf16* PROJ, const bf16* KC, const bf16* VC, bf16* Y, f32x4* scratch) {
    for (int i = blockIdx.x; i < 512; i += gridDim.x) {
        const int u = (i < 256) ? i : 767 - i;
        const int tq = 63 - (u >> 3), bg = u & 7;
        nsa_unit(P, lds, PROJ, KC, VC, Y, scratch + (size_t)blockIdx.x * 16384, bg >> 1, bg & 1, tq);
    }
}

__device__ __forceinline__ void compress_unit(const Params& P, LAS unsigned char* lds, const bf16* PROJ, const float* cs, const float* sn, bf16* KC, bf16* VC, int which, int bg, int n0) {
    int tid = threadIdx.x; asm volatile("" : "+v"(tid));
    const int lane = tid & 63, w = __builtin_amdgcn_readfirstlane(tid >> 6), c = lane & 15, q4 = lane >> 4;
    const int b = bg >> 1, g = bg & 1, col = (which ? C_VC : C_KC) + g * 128;
    constexpr int XS = 272;
    __syncthreads();
    for (int i = tid; i < 272 * 8; i += NTHREADS) {
        const int tk = i >> 3, ch = i & 7, s = 16 * n0 + tk;
        v4u lo = (v4u){0u, 0u, 0u, 0u}, hi = (v4u){0u, 0u, 0u, 0u};
        if (s < SEQ) {
            const int m = b * SEQ + s;
            lo = *(const v4u*)(PROJ + (size_t)m * NP + col + 8 * ch); hi = *(const v4u*)(PROJ + (size_t)m * NP + col + 64 + 8 * ch);
            if (!which) {
                const f32x4 c0 = *(const f32x4*)(cs + m * 64 + 8 * ch), c1 = *(const f32x4*)(cs + m * 64 + 8 * ch + 4), s0 = *(const f32x4*)(sn + m * 64 + 8 * ch), s1 = *(const f32x4*)(sn + m * 64 + 8 * ch + 4);
                float a[8], d[8];
                a[0] = bflo(lo.x); a[1] = bfhi(lo.x); a[2] = bflo(lo.y); a[3] = bfhi(lo.y); a[4] = bflo(lo.z); a[5] = bfhi(lo.z); a[6] = bflo(lo.w); a[7] = bfhi(lo.w);
                d[0] = bflo(hi.x); d[1] = bfhi(hi.x); d[2] = bflo(hi.y); d[3] = bfhi(hi.y); d[4] = bflo(hi.z); d[5] = bfhi(hi.z); d[6] = bflo(hi.w); d[7] = bfhi(hi.w);
                float ra[8], rd[8];
#pragma unroll
                for (int e = 0; e < 8; ++e) { const float cc = e < 4 ? c0[e] : c1[e - 4], ss = e < 4 ? s0[e] : s1[e - 4]; ra[e] = a[e] * cc - d[e] * ss; rd[e] = d[e] * cc + a[e] * ss; }
                lo.x = cvt_pk_bf16(ra[0], ra[1]); lo.y = cvt_pk_bf16(ra[2], ra[3]); lo.z = cvt_pk_bf16(ra[4], ra[5]); lo.w = cvt_pk_bf16(ra[6], ra[7]);
                hi.x = cvt_pk_bf16(rd[0], rd[1]); hi.y = cvt_pk_bf16(rd[2], rd[3]); hi.z = cvt_pk_bf16(rd[4], rd[5]); hi.w = cvt_pk_bf16(rd[6], rd[7]);
            }
        }
        *(LAS v4u*)(lds + tk * XS + 16 * ch) = lo; *(LAS v4u*)(lds + tk * XS + 128 + 16 * ch) = hi;
    }
    __syncthreads();
    const bf16* w1t = (const bf16*)(P.ws + (which ? WS_WC1V : WS_WC1K)) + (size_t)(32 * w + c) * 4096 + 8 * q4;
    f32x4 h0 = (f32x4){0.f, 0.f, 0.f, 0.f}, h1 = (f32x4){0.f, 0.f, 0.f, 0.f};
    const LAS unsigned char* xb = lds + (16 * c) * XS + 16 * q4;
#pragma unroll 16
    for (int ks = 0; ks < 128; ++ks) {
        const bf16x8 xf = *(const LAS bf16x8*)(xb + (ks >> 2) * XS + (ks & 3) * 64);
        const bf16x8 a0 = *(const bf16x8*)(w1t + 32 * ks), a1 = *(const bf16x8*)(w1t + 16 * 4096 + 32 * ks);
        h0 = __builtin_amdgcn_mfma_f32_16x16x32_bf16(a0, xf, h0, 0, 0, 0);
        h1 = __builtin_amdgcn_mfma_f32_16x16x32_bf16(a1, xf, h1, 0, 0, 0);
    }
    const float* pb = (const float*)(P.ws + WS_PBIAS + 65536) + which * 256 + 32 * w + 4 * q4;
    const f32x4 pb0 = *(const f32x4*)pb, pb1 = *(const f32x4*)(pb + 16);
    const bf16x8 hf = pack8(gelu_tanh(h0[0] + pb0[0]), gelu_tanh(h0[1] + pb0[1]), gelu_tanh(h0[2] + pb0[2]), gelu_tanh(h0[3] + pb0[3]),
                            gelu_tanh(h1[0] + pb1[0]), gelu_tanh(h1[1] + pb1[1]), gelu_tanh(h1[2] + pb1[2]), gelu_tanh(h1[3] + pb1[3]));
    const bf16* w2t = (const bf16*)(P.ws + (which ? WS_WC2V : WS_WC2K)) + (size_t)c * 256 + 32 * w + 4 * q4;
    __syncthreads();
    LAS float* part = (LAS float*)lds;
#pragma unroll
    for (int dt = 0; dt < 8; ++dt) {
        const v2u wa = *(const v2u*)(w2t + (size_t)(16 * dt) * 256), wb = *(const v2u*)(w2t + (size_t)(16 * dt) * 256 + 16);
        v4u wv; wv.x = wa.x; wv.y = wa.y; wv.z = wb.x; wv.w = wb.y;
        const f32x4 oa = __builtin_amdgcn_mfma_f32_16x16x32_bf16(__builtin_bit_cast(bf16x8, wv), hf, (f32x4){0.f, 0.f, 0.f, 0.f}, 0, 0, 0);
        *(LAS f32x4*)(part + (w * 16 + c) * 128 + 16 * dt + 4 * q4) = oa;
    }
    __syncthreads();
#pragma unroll
    for (int r = 0; r < 2; ++r) {
        const int n = 2 * w + r;
        float a = 0.f, d = 0.f;
#pragma unroll
        for (int ww = 0; ww < 8; ++ww) { a += part[(ww * 16 + n) * 128 + lane]; d += part[(ww * 16 + n) * 128 + 64 + lane]; }
        if (!which) { const float rr = rsqrtf(wave_sum(a * a + d * d) * (1.f / 128.f) + EPS); a = a * rr * P.kc_norm[lane]; d = d * rr * P.kc_norm[lane + 64]; }
        bf16* op = (which ? VC : KC) + ((size_t)bg * 256 + n0 + n) * 128;
        if (n0 + n < NCMP) { op[lane] = (bf16)f2bf(a); op[lane + 64] = (bf16)f2bf(d); } else { op[lane] = 0; op[lane + 64] = 0; }
    }
}
__device__ __forceinline__ void compress_phase(const Params& P, LAS unsigned char* lds, const bf16* PROJ, const float* cs, const float* sn, bf16* KC, bf16* VC) {
    for (int u = blockIdx.x; u < 256; u += gridDim.x) compress_unit(P, lds, PROJ, cs, sn, KC, VC, u >> 7, (u >> 4) & 7, (u & 15) * 16);
    __syncthreads();
}
template <int MODE = 31>
__device__ __forceinline__ void sb_phase(const Params& P, LAS unsigned char* lds, const bf16* PROJ, const bf16* KVC, bf16* Y) {
    for (int i = blockIdx.x; i < 512; i += gridDim.x) {
        const int u = (i < 256) ? i : 767 - i;
        const int tqq = 15 - (u >> 5), bh = u & 31;
        sb_unit<MODE>(P, lds, PROJ, KVC, Y, bh >> 3, bh & 7, tqq);
    }
}
}

template <bool F8 = false, class RowFn>
__device__ __forceinline__ void transpose_item(const float* W, int K, int N, bf16* WT, RowFn rowfn, LAS float* scr, int item, int lane, const float* kscale = nullptr) {
    const int nblk = (N + 63) / 64, kb = item / nblk, nb = item % nblk, k0 = 64 * kb, n0 = 64 * nb;
    const int nn = n0 + 4 * (lane & 15), kr = lane >> 4;
    f32x4 v[16];
#pragma unroll
    for (int i = 0; i < 16; ++i) v[i] = nn < N ? __builtin_nontemporal_load((const f32x4*)(W + (size_t)(k0 + 4 * i + kr) * N + nn)) : (f32x4){0.f, 0.f, 0.f, 0.f};
#pragma unroll
    for (int i = 0; i < 16; ++i) { if (kscale) v[i] = v[i] * kscale[k0 + 4 * i + kr];
        if (F8) v[i] = v[i] * pg8::F8_WSCALE;
        LAS float* d = scr + (4 * i + kr) * 65 + 4 * (lane & 15); d[0] = v[i][0]; d[1] = v[i][1]; d[2] = v[i][2]; d[3] = v[i][3]; }
    asm volatile("s_waitcnt lgkmcnt(0)" ::: "memory");
    const int c = lane & 7;
#pragma unroll
    for (int jj = 0; jj < 8; ++jj) { const int n = (lane >> 3) + 8 * jj; const LAS float* s = scr + (8 * c) * 65 + n;
        if constexpr (F8) { v2u o; o.x = pg8::pk4_fp8(s[0 * 65], s[1 * 65], s[2 * 65], s[3 * 65]); o.y = pg8::pk4_fp8(s[4 * 65], s[5 * 65], s[6 * 65], s[7 * 65]);
            if (n0 + n < N) *(v2u*)((unsigned char*)WT + (size_t)rowfn(n0 + n) * K + k0 + 8 * c) = o; }
        else {
        v4u o; o.x = pk2(s[0 * 65], s[1 * 65]); o.y = pk2(s[2 * 65], s[3 * 65]); o.z = pk2(s[4 * 65], s[5 * 65]); o.w = pk2(s[6 * 65], s[7 * 65]);
        if (n0 + n < N) *(v4u*)(WT + (size_t)rowfn(n0 + n) * K + k0 + 8 * c) = o; } }
    asm volatile("s_waitcnt lgkmcnt(0)" ::: "memory");
}
__device__ __forceinline__ int row_gate(int n) { return (n >> 7) * 256 + (n & 127); }
__device__ __forceinline__ int row_up(int n) { return (n >> 7) * 256 + 128 + (n & 127); }
__device__ __forceinline__ int row_id(int n) { return n; }
__device__ __forceinline__ int row_win(int oc) { return oc < 2560 ? oc : (oc < 2584 ? oc - 2560 + C_GATE : oc - 24); }
constexpr int CW_I_GU = (D / 64) * (FF / 64), CW_I_IN = (D / 64) * ((IN_COLS + 63) / 64), CW_I_OUT = (D / 64) * (D / 64), CW_I_C1 = (4096 / 64) * (256 / 64), CW_I_C2 = (256 / 64) * (128 / 64);
constexpr int CW_EARLY = 3 * CW_I_GU + CW_I_IN + CW_I_OUT + 2 * CW_I_C1 + 2 * CW_I_C2, CW_ITEMS = CW_EARLY + 3 * CW_I_GU;
__device__ __forceinline__ void convert_items(const Params& P, LAS unsigned char* lds, int lo, int hi, int gw, int NGW) {
    unsigned char* ws = P.ws;
    int tid = threadIdx.x; asm volatile("" : "+v"(tid));
    const int lane = tid & 63, wave = tid >> 6;
    LAS float* scr = (LAS float*)(lds + wave * 16640);
    constexpr int I_GU = CW_I_GU, I_DN = CW_I_GU, I_IN = CW_I_IN, I_OUT = CW_I_OUT, I_C1 = CW_I_C1, I_C2 = CW_I_C2;
    for (int it = lo + gw; it < hi; it += NGW) {
        int r = it;
        if (r < I_GU) { transpose_item(P.ffn1_wg, D, FF, (bf16*)(ws + WS_W1GU), row_gate, scr, r, lane, FOLD_GAINS ? P.ffn1_norm : nullptr); continue; } r -= I_GU;
        if (r < I_GU) { transpose_item(P.ffn1_wu, D, FF, (bf16*)(ws + WS_W1GU), row_up, scr, r, lane, FOLD_GAINS ? P.ffn1_norm : nullptr); continue; } r -= I_GU;
        if (r < I_DN) { transpose_item(P.ffn1_wd, FF, D, (bf16*)(ws + WS_W1D), row_id, scr, r, lane); continue; } r -= I_DN;
        if (r < I_IN) { transpose_item(P.w_in, D, IN_COLS, (bf16*)(ws + WS_WIN), row_win, scr, r, lane, FOLD_GAINS ? P.mix_norm : nullptr); continue; } r -= I_IN;
        if (r < I_OUT) { transpose_item(P.w_out, D, D, (bf16*)(ws + WS_WOUT), row_id, scr, r, lane); continue; } r -= I_OUT;
        if (r < I_C1) { transpose_item(P.ck_w1, 4096, 256, (bf16*)(ws + WS_WC1K), row_id, scr, r, lane); continue; } r -= I_C1;
        if (r < I_C1) { transpose_item(P.cv_w1, 4096, 256, (bf16*)(ws + WS_WC1V), row_id, scr, r, lane); continue; } r -= I_C1;
        if (r < I_C2) { transpose_item(P.ck_w2, 256, 128, (bf16*)(ws + WS_WC2K), row_id, scr, r, lane); continue; } r -= I_C2;
        if (r < I_C2) { transpose_item(P.cv_w2, 256, 128, (bf16*)(ws + WS_WC2V), row_id, scr, r, lane); continue; } r -= I_C2;
        if (r < I_GU) { transpose_item<FFN2_FP8 != 0>(P.ffn2_wg, D, FF, (bf16*)(ws + WS_W2GU), row_gate, scr, r, lane, FOLD_GAINS ? P.ffn2_norm : nullptr); continue; } r -= I_GU;
        if (r < I_GU) { transpose_item<FFN2_FP8 != 0>(P.ffn2_wu, D, FF, (bf16*)(ws + WS_W2GU), row_up, scr, r, lane, FOLD_GAINS ? P.ffn2_norm : nullptr); continue; } r -= I_GU;
        transpose_item<FFN2_FP8 != 0>(P.ffn2_wd, FF, D, (bf16*)(ws + WS_W2D), row_id, scr, r, lane);
    }
}
__device__ __forceinline__ void convert_weights(const Params& P, LAS unsigned char* lds) {
    unsigned char* ws = P.ws;
    convert_items(P, lds, 0, TAIL_CONVERT ? CW_EARLY : CW_ITEMS, blockIdx.x * NWAVES + (threadIdx.x >> 6), gridDim.x * NWAVES);
    if (blockIdx.x < 32) {
        const int which = blockIdx.x >> 4, part = (blockIdx.x & 15) * 2 + (threadIdx.x >> 8), j = threadIdx.x & 255;
        const float* pos = which ? P.cv_pos : P.ck_pos; const float* w1 = which ? P.cv_w1 : P.ck_w1;
        float a = 0.f;
#pragma unroll 32
        for (int k = 128 * part; k < 128 * part + 128; ++k) a += pos[k] * w1[(size_t)k * 256 + j];
        ((float*)(ws + WS_PBIAS))[(which * 32 + part) * 256 + j] = a;
    }
    { v4u* z = (v4u*)((bf16*)(ws + WS_WIN) + (size_t)IN_COLS * D); const int n16 = (NP - IN_COLS) * D / 8;
      for (int i = blockIdx.x * NTHREADS + threadIdx.x; i < n16; i += gridDim.x * NTHREADS) z[i] = (v4u){0u, 0u, 0u, 0u}; }
}

__global__ void __launch_bounds__(NTHREADS, 2) fwd_kernel(Params P) {
    extern __shared__ __attribute__((aligned(16))) unsigned char lds_raw[];
    LAS unsigned char* lds = (LAS unsigned char*)lds_raw;
    const int tid = threadIdx.x;
    for (int u = tid; u < (LDS_BYTES - LDSCTL_OFF) / 4; u += NTHREADS) ((LAS unsigned*)(lds + LDSCTL_OFF))[u] = 0u;
    __syncthreads();
    unsigned char* ws = P.ws;
    XcdBarrier bar = xcd_barrier_post((unsigned*)(ws + WS_CTL) + CW_BAR, (volatile LAS unsigned*)(lds + LDSCTL_OFF + 64));
    bf16* HB = (bf16*)(ws + WS_HB); bf16* BIG = (bf16*)(ws + WS_BIG);
    float* cs = (float*)(ws + WS_COS); float* sn = (float*)(ws + WS_SIN);
    bf16* KC = (bf16*)(ws + WS_KC); bf16* VC = (bf16*)(ws + WS_VC);
    float* XR = P.out;
    bf16* X1B = (bf16*)P.out;
    bf16* X2B = (bf16*)(ws + WS_W1GU);
    unsigned char* X2F8 = ws + WS_SCR;
    float* PART = (float*)(ws + WS_PART);
    float* PART2 = (float*)(ws + WS_PART + (size_t)M * 8);
    float* PART0 = (float*)(ws + WS_PART + (size_t)M * 16);
    PG8_LAS float* RS = (PG8_LAS float*)(lds + 131072);

#define REP(n) _Pragma("unroll") for (int rep_ = 0; rep_ < (n); ++rep_)
#if FOLD_GAINS
    REP(REP_P0) { rope_tables(P.pos, cs, sn); cast_rows(P.x, HB, (unsigned long long*)PART0); convert_weights(P, lds); }
#else
    REP(REP_P0) { rope_tables(P.pos, cs, sn); rmsnorm_rows(P.x, P.ffn1_norm, HB); convert_weights(P, lds); }
#endif
#if FUSE_NORMS || FOLD_GAINS
    for (int i = blockIdx.x * NTHREADS + tid; i < 2 * M; i += gridDim.x * NTHREADS) ((unsigned long long*)PART)[i] = 0ull;
#endif
    xcd_barrier(bar);
#if PROBE_P1K
    for (int pass = 0; pass < 2; ++pass) {
        pg8::Gemm g{HB, (const bf16*)(ws + WS_W1GU), M, 2 * FF, D, pass == 0 ? (PROBE_P1K >= 4 ? PROBE_P1K - 4 : PROBE_P1K - 1) : 0}; pg8::StaticOrder S; S.init(M, 2 * FF, gridDim.x, (int)blockIdx.x); S.zero = (pass == 0 && PROBE_P1K >= 4);
        if (FOLD_GAINS) pg8::row_factor_table(RS, PART0, S);
        pg8::EpiSwiglu E{BIG, FF, FOLD_GAINS ? PART0 : nullptr, RS};
        pg8::gemm_phase<pg8::EpiSwiglu, pg8::StaticOrder, true, true>(lds, g, S, E);
        if (pass == 0) xcd_barrier(bar);
    }
#else
    REP(REP_P1) {
        pg8::Gemm g{HB, (const bf16*)(ws + WS_W1GU), M, 2 * FF, D}; pg8::StaticOrder S; S.init(M, 2 * FF, gridDim.x, (int)blockIdx.x);
        if (FOLD_GAINS) pg8::row_factor_table(RS, PART0, S);
        pg8::EpiSwiglu E{BIG, FF, FOLD_GAINS ? PART0 : nullptr, RS};
        pg8::gemm_phase<pg8::EpiSwiglu, pg8::StaticOrder, true, true>(lds, g, S, E);
    }
#endif
    xcd_barrier(bar);
    REP(REP_P2) {
        pg8::Gemm g{BIG, (const bf16*)(ws + WS_W1D), M, D, FF}; pg8::StaticOrder S; S.init(M, D, gridDim.x, (int)blockIdx.x);
#if FUSE_NORMS
        pg8::EpiResid E{P.x, XR, D, 0.5f, HB, P.mix_norm, PART};
#else
        pg8::EpiResidMix<FOLD_GAINS != 0, true> E{FOLD_GAINS ? (const void*)HB : (const void*)P.x, X1B, D, 0.5f, FOLD_GAINS ? (unsigned long long*)PART : nullptr};
#endif
        pg8::gemm_phase<pg8::EpiResidMix<FOLD_GAINS != 0, true>, pg8::StaticOrder, true, true>(lds, g, S, E);
    }
    xcd_barrier(bar);
    if (blockIdx.x == gridDim.x - 1) { const float* pp = (const float*)(ws + WS_PBIAS); const int which = tid >> 8, j = tid & 255; float t[32];
#pragma unroll
        for (int part = 0; part < 32; ++part) t[part] = pp[(which * 32 + part) * 256 + j];
        float a = 0.f;
#pragma unroll
        for (int part = 0; part < 32; ++part) a += t[part];
        ((float*)(ws + WS_PBIAS + 65536))[tid] = a; }
#if !FUSE_NORMS && !FOLD_GAINS
    rmsnorm_rows_bf16(X1B, P.mix_norm, HB);
    xcd_barrier(bar);
#endif
    REP(REP_P4) {
        pg8::Gemm g{FOLD_GAINS ? (const bf16*)X1B : (const bf16*)HB, (const bf16*)(ws + WS_WIN), M, NP, D}; pg8::StaticOrder S; S.init(M, NP, gridDim.x, (int)blockIdx.x);
        if (FUSE_NORMS || FOLD_GAINS) pg8::row_factor_table(RS, PART, S);
        pg8::EpiStoreBf16 E{BIG, NP, C_QS / 256, (C_QS + 1024) / 256, att::C1, (FUSE_NORMS || FOLD_GAINS) ? PART : nullptr, RS, (bf16*)(ws + WS_W1GU), SB_COMPACT ? C_KSB / 256 : 0, SB_COMPACT ? (C_VSB + 1024) / 256 : 0};
        pg8::gemm_phase<pg8::EpiStoreBf16, pg8::StaticOrder, true, true>(lds, g, S, E);
#if TAIL_CONVERT
        {
            const int G = (int)gridDim.x, rem = S.nwg % G;
            if (rem == 0) convert_items(P, lds, CW_EARLY, CW_ITEMS, (int)blockIdx.x * NWAVES + (tid >> 6), G * NWAVES);
            else if ((int)blockIdx.x >= rem) convert_items(P, lds, CW_EARLY, CW_ITEMS, ((int)blockIdx.x - rem) * NWAVES + (tid >> 6), (G - rem) * NWAVES);
        }
#endif
    }
    xcd_barrier(bar);
    postproj_naive(P, BIG, cs, sn);
    REP(REP_CMP) att::compress_phase(P, lds, BIG, cs, sn, KC, VC);
    xcd_barrier(bar);
    REP(REP_NSA) att::nsa_phase(P, lds, BIG, KC, VC, HB, (f32x4*)(ws + WS_SCR));
    REP(REP_SB) att::sb_phase(P, lds, BIG, (const bf16*)(ws + WS_W1GU), HB);
    xcd_barrier(bar);
    {
        pg8::Gemm g{HB, (const bf16*)(ws + WS_WOUT), M, D, D}; pg8::StaticOrder S; S.init(M, D, gridDim.x, (int)blockIdx.x);
#if FUSE_NORMS
        pg8::EpiResid E{XR, XR, D, 1.0f, (bf16*)(ws + WS_W1GU), P.ffn2_norm, PART2};
#else
        pg8::EpiResidMix<true, true> E{X1B, X2B, D, 1.0f, FOLD_GAINS ? (unsigned long long*)PART2 : nullptr, FFN2_FP8 ? X2F8 : nullptr};
#endif
        pg8::gemm_phase<pg8::EpiResidMix<true, true>, pg8::StaticOrder, true, true>(lds, g, S, E);
    }
    xcd_barrier(bar);
#if !FUSE_NORMS && !FOLD_GAINS
    rmsnorm_rows_bf16(X2B, P.ffn2_norm, HB);
    xcd_barrier(bar);
#endif
    {
#if FFN2_FP8
        pg8::Gemm g{(const bf16*)X2F8, (const bf16*)(ws + WS_W2GU), M, 2 * FF, D / 2}; pg8::StaticOrder S; S.init(M, 2 * FF, gridDim.x, (int)blockIdx.x);
        pg8::row_factor_table(RS, PART2, S);
        pg8::EpiSwigluT<true> E{BIG, FF, PART2, RS};
        pg8::gemm_phase<pg8::EpiSwigluT<true>, pg8::StaticOrder, true, true, true>(lds, g, S, E);
#else
        pg8::Gemm g{(FUSE_NORMS || FOLD_GAINS) ? (const bf16*)(ws + WS_W1GU) : (const bf16*)HB, (const bf16*)(ws + WS_W2GU), M, 2 * FF, D}; pg8::StaticOrder S; S.init(M, 2 * FF, gridDim.x, (int)blockIdx.x);
        if (FUSE_NORMS || FOLD_GAINS) pg8::row_factor_table(RS, PART2, S);
        pg8::EpiSwiglu E{BIG, FF, (FUSE_NORMS || FOLD_GAINS) ? PART2 : nullptr, RS};
        pg8::gemm_phase<pg8::EpiSwiglu, pg8::StaticOrder, true, true>(lds, g, S, E);
#endif
    }
    xcd_barrier(bar);
    {
#if FFN2_FP8
        pg8::Gemm g{BIG, (const bf16*)(ws + WS_W2D), M, D, FF / 2}; pg8::StaticOrder S; S.init(M, D, gridDim.x, (int)blockIdx.x);
        pg8::EpiResidMix<true, false> E{X2B, XR, D, 0.5f / (pg8::F8_WSCALE * pg8::F8_HSCALE), nullptr};
        pg8::gemm_phase<pg8::EpiResidMix<true, false>, pg8::StaticOrder, true, true, true>(lds, g, S, E);
#else
        pg8::Gemm g{BIG, (const bf16*)(ws + WS_W2D), M, D, FF}; pg8::StaticOrder S; S.init(M, D, gridDim.x, (int)blockIdx.x);
        pg8::EpiResidMix<true, false> E{X2B, XR, D, 0.5f, nullptr};
        pg8::gemm_phase<pg8::EpiResidMix<true, false>, pg8::StaticOrder, true, true>(lds, g, S, E);
#endif
    }
#if PROBE_PP
    xcd_barrier(bar);
    postproj_naive(P, BIG, cs, sn);
#endif
#if PROBE_SB_MODE
    __syncthreads();
    att::sb_phase<PROBE_SB_MODE>(P, lds, BIG, (const bf16*)(ws + WS_SB_DUMMY_KV), (bf16*)(ws + WS_HB));
#endif
}

extern "C" void kernel_launch(void* const* d_in, const int* in_sizes, int n_in, void* d_out, int out_size, void* d_ws, size_t ws_size, hipStream_t stream) {
    static int grid = 0;
    if (grid == 0) {
        if (n_in != 25 || out_size != M * D || ws_size < WS_END) { fprintf(stderr, "kernel_launch: unexpected shapes: n_in %d out %d ws %zu\n", n_in, out_size, ws_size); grid = -1; return; }
        int dev = 0, cus = 0, per_cu = 0;
        hipGetDevice(&dev); hipDeviceGetAttribute(&cus, hipDeviceAttributeMultiprocessorCount, dev);
        if (hipFuncSetAttribute((const void*)fwd_kernel, hipFuncAttributeMaxDynamicSharedMemorySize, LDS_BYTES) != hipSuccess) { fprintf(stderr, "kernel_launch: hipFuncSetAttribute failed\n"); grid = -1; return; }
        hipOccupancyMaxActiveBlocksPerMultiprocessor(&per_cu, (const void*)fwd_kernel, NTHREADS, LDS_BYTES);
        (void)hipGetLastError();
        if (per_cu < 1) fprintf(stderr, "kernel_launch: occupancy query says %d\n", per_cu);
        grid = cus;
    }
    if (grid < 0) return;
    hipMemsetAsync((char*)d_ws + WS_CTL, 0, CTL_ZERO_BYTES, stream);
    Params p{};
    p.x = (const float*)d_in[0]; p.pos = (const int*)d_in[1];
    p.ffn1_norm = (const float*)d_in[2]; p.ffn1_wg = (const float*)d_in[3]; p.ffn1_wu = (const float*)d_in[4]; p.ffn1_wd = (const float*)d_in[5];
    p.mix_norm = (const float*)d_in[6]; p.w_in = (const float*)d_in[7]; p.q_norm = (const float*)d_in[8]; p.kc_norm = (const float*)d_in[9];
    p.ks_norm = (const float*)d_in[10]; p.kw_norm = (const float*)d_in[11]; p.ck_pos = (const float*)d_in[12]; p.ck_w1 = (const float*)d_in[13];
    p.ck_w2 = (const float*)d_in[14]; p.cv_pos = (const float*)d_in[15]; p.cv_w1 = (const float*)d_in[16]; p.cv_w2 = (const float*)d_in[17];
    p.nsa_on = (const float*)d_in[18]; p.sb_on = (const float*)d_in[19]; p.w_out = (const float*)d_in[20]; p.ffn2_norm = (const float*)d_in[21];
    p.ffn2_wg = (const float*)d_in[22]; p.ffn2_wu = (const float*)d_in[23]; p.ffn2_wd = (const float*)d_in[24];
    p.out = (float*)d_out; p.ws = (unsigned char*)d_ws;
    hipLaunchKernelGGL(fwd_kernel, dim3(grid), dim3(NTHREADS), LDS_BYTES, stream, p);
}
```

```cpp
#include <hip/hip_runtime.h>
#include <cstdio>
#include <cstdint>

#define SB_COMPACT 0
#define FOLD_GAINS 1
#define FUSE_NORMS 0
#define NSA_OPAQUE 1
#define REP_P0 1
#define REP_P1 1
#define REP_P2 1
#define REP_P4 1
#define REP_CMP 1
#define REP_NSA 1
#define REP_SB 1
#define PROBE_SB_MODE 0
#define TAIL_CONVERT 1
#define FFN2_FP8 1
#define FFN1_FP8 1
#define PROBE_P1K 0
#define PROBE_PP 0

#define GAS __attribute__((address_space(1)))
#define LAS __attribute__((address_space(3)))
typedef unsigned short bf16;
typedef unsigned v4u __attribute__((ext_vector_type(4)));
typedef unsigned v2u __attribute__((ext_vector_type(2)));
typedef float f32x4 __attribute__((ext_vector_type(4)));
typedef float f32x2 __attribute__((ext_vector_type(2)));

constexpr int NBATCH = 4, SEQ = 4096, M = NBATCH * SEQ, D = 2048, FF = 5632, HD = 128;
constexpr int NCMP = 255;
constexpr int IN_COLS = 5656;
constexpr int NP = 5888;
constexpr int C_QN = 0, C_KC = 1024, C_VC = 1280, C_KS = 1536, C_VS = 1792, C_KW = 2048, C_VW = 2304, C_QS = 2560, C_KSB = 3584, C_VSB = 4608, C_GATE = 5632;
constexpr float EPS = 1e-6f;
constexpr float SCALE = 0.08838834764831845f;
constexpr float NEG_INF = -1e30f;
constexpr float QSCALE = 0.08838834764831845f * 1.4426950408889634f;

constexpr size_t MiB = 1u << 20;
constexpr size_t WS_CTL = 0, CTL_ZERO_BYTES = 1 * MiB;
constexpr size_t WS_W1GU = 2 * MiB, WS_W1D = 46 * MiB, WS_W2GU = 68 * MiB, WS_W2D = 112 * MiB, WS_WIN = 134 * MiB, WS_WOUT = 157 * MiB;
constexpr size_t WS_WC1K = 165 * MiB, WS_WC1V = 167 * MiB, WS_WC2K = 169 * MiB, WS_WC2V = 169 * MiB + 65536, WS_PBIAS = 169 * MiB + 131072;
constexpr size_t WS_COS = 170 * MiB, WS_SIN = 174 * MiB, WS_KC = 178 * MiB, WS_VC = 178 * MiB + 524288;
constexpr size_t WS_HB = 180 * MiB, WS_BIG = 244 * MiB, WS_SCR = 428 * MiB, WS_PART = 492 * MiB, WS_END = 494 * MiB;
constexpr size_t WS_SB_DUMMY_KV = WS_W2GU;
constexpr int CW_BAR = 4096;

constexpr int NWAVES = 8, NTHREADS = 512;
constexpr int LDS_BYTES = 163840;
constexpr int LDSCTL_OFF = 163840 - 1024;

__device__ __forceinline__ unsigned f2bf(float f) { unsigned u = __builtin_bit_cast(unsigned, f); return (u + 0x7fffu + ((u >> 16) & 1u)) >> 16; }
__device__ __forceinline__ unsigned pk2(float lo, float hi) { return f2bf(lo) | (f2bf(hi) << 16); }
__device__ __forceinline__ float bf2f(unsigned h) { return __builtin_bit_cast(float, h << 16); }
__device__ __forceinline__ float bflo(unsigned w) { return __builtin_bit_cast(float, w << 16); }
__device__ __forceinline__ float bfhi(unsigned w) { return __builtin_bit_cast(float, w & 0xffff0000u); }
__device__ __forceinline__ float wave_sum(float v) {
#pragma unroll
    for (int o = 1; o < 64; o <<= 1) v += __shfl_xor(v, o);
    return v;
}
__device__ __forceinline__ float wave_max(float v) {
#pragma unroll
    for (int o = 1; o < 64; o <<= 1) v = fmaxf(v, __shfl_xor(v, o));
    return v;
}
__device__ __forceinline__ float softplusf(float z) { return fmaxf(z, 0.f) + log1pf(expf(-fabsf(z))); }
__device__ __forceinline__ float sigmoidf(float z) { return 1.f / (1.f + expf(-z)); }
__device__ __forceinline__ float gelu_tanh(float x) { const float u = 0.7978845608028654f * (x + 0.044715f * x * x * x); return 0.5f * x * (1.f + tanhf(u)); }

#define XB_TMO      128
#define XB_XCNT(j)  (256  + 64 * (j))
#define XB_XSUB(j)  (1280 + 64 * (j))
#define XB_XGEN(j)  (2304 + 64 * (j))
#define XB_TOP      3328
#define XB_TOPGEN   3392
#define XCD_BAR_WORDS 3456
#define XB_SPIN_CAP (1u << 22)

__device__ __forceinline__ unsigned xb_ld(unsigned* p)              { return __hip_atomic_load(p, __ATOMIC_RELAXED, __HIP_MEMORY_SCOPE_AGENT); }
__device__ __forceinline__ unsigned xb_add(unsigned* p, unsigned v) { return __hip_atomic_fetch_add(p, v, __ATOMIC_RELAXED, __HIP_MEMORY_SCOPE_AGENT); }
__device__ __forceinline__ unsigned xb_xcc_id() { return (unsigned)__builtin_amdgcn_s_getreg((3 << 11) | 20) & 0xFu; }
#define XB_SPIN(cond, bar) do { unsigned _sp = 0; while (cond) { __builtin_amdgcn_s_sleep(1); \
    if ((++_sp & 255u) == 0u) { if (xb_ld(&(bar)[XB_TMO])) break; if (_sp > XB_SPIN_CAP) { atomicAdd(&(bar)[XB_TMO], 1u); break; } } } } while (0)

struct XcdBarrier { unsigned* bar; unsigned x; volatile LAS unsigned* st; };

__device__ __forceinline__ XcdBarrier xcd_barrier_post(unsigned* bar, volatile LAS unsigned* st) {
    XcdBarrier b; b.bar = bar; b.x = xb_xcc_id(); b.st = st;
    if (threadIdx.x == 0) (void)xb_add(&bar[XB_XCNT(b.x)], 1u);
    return b;
}
__device__ __forceinline__ void xcd_barrier_complete(unsigned* bar, unsigned x, unsigned& nloc, unsigned& nx) {
    const unsigned G = gridDim.x * gridDim.y * gridDim.z;
    unsigned sum, cnt, mine, sp = 0u;
    for (;;) {
        sum = 0u; cnt = 0u; mine = 0u;
#pragma unroll
        for (unsigned j = 0; j < 16; ++j) { const unsigned c = xb_ld(&bar[XB_XCNT(j)]); sum += c; cnt += (c > 0u) ? 1u : 0u; mine = (j == x) ? c : mine; }
        if (sum == G) break;
        __builtin_amdgcn_s_sleep(1);
        if ((++sp & 255u) == 0u) { if (xb_ld(&bar[XB_TMO])) break; if (sp > XB_SPIN_CAP) { atomicAdd(&bar[XB_TMO], 1u); break; } }
    }
    nloc = mine > 0u ? mine : 1u; nx = cnt > 0u ? cnt : 1u;
}
__device__ __forceinline__ void xcd_barrier(const XcdBarrier& b) {
    asm volatile("s_waitcnt vmcnt(0)" ::: "memory");
    __syncthreads();
    if (threadIdx.x == 0) {
        unsigned* bar = b.bar;
        __builtin_amdgcn_s_waitcnt(0);
        unsigned nloc = b.st[0], nx = b.st[1];
        if (nloc == 0u) { xcd_barrier_complete(bar, b.x, nloc, nx); b.st[0] = nloc; b.st[1] = nx; }
        const unsigned old = xb_add(&bar[XB_XSUB(b.x)], 1u);
        const unsigned gen = old / nloc;
        if (old + 1u == (gen + 1u) * nloc) {
            __builtin_amdgcn_fence(__ATOMIC_RELEASE, "agent");
            asm volatile("s_waitcnt vmcnt(0)" ::: "memory");
            const unsigned og = xb_add(&bar[XB_TOP], 1u);
            const unsigned tg = og / nx;
            if (og + 1u == (tg + 1u) * nx) xb_add(&bar[XB_TOPGEN], 1u);
            else XB_SPIN(xb_ld(&bar[XB_TOPGEN]) == tg, bar);
            __builtin_amdgcn_fence(__ATOMIC_ACQUIRE, "agent");
            xb_add(&bar[XB_XGEN(b.x)], 1u);
            asm volatile("s_waitcnt vmcnt(0)" ::: "memory");
        } else {
            XB_SPIN(xb_ld(&bar[XB_XGEN(b.x)]) == gen, bar);
            __builtin_amdgcn_fence(__ATOMIC_ACQUIRE, "agent");
            asm volatile("s_waitcnt vmcnt(0)" ::: "memory");
        }
    }
    __syncthreads();
}

namespace pg8 {
#define PG8_LAS __attribute__((address_space(3)))
typedef unsigned short bf16_t;
typedef short bf16x8 __attribute__((ext_vector_type(8)));
typedef float f32x4 __attribute__((ext_vector_type(4)));
typedef unsigned u32x4 __attribute__((ext_vector_type(4)));
constexpr int BM = 256, BK = 64, HALF = 128, HTB = HALF * BK * 2  , STAGE_BYTES = 8 * HTB, NXCD = 8, WGM = 8;

__host__ __device__ __forceinline__ int lds_byte(int r, int c) { const int st = (r >> 4) * 2 + (c >> 5), rr = r & 15, cc = c & 31, ob = rr * 64 + cc * 2; return st * 1024 + (ob ^ (((ob >> 9) & 1) << 5)); }
__host__ __device__ __forceinline__ void stage_rc(int b, int& R, int& C) { const int st = b / 1024, sb = b % 1024, swz = sb ^ (((sb >> 9) & 1) << 5); R = (st >> 1) * 16 + swz / 64; C = (st & 1) * 32 + (swz % 64) / 2; }
__host__ __device__ __forceinline__ int perm32(int rho) { const int n = rho >> 4, i = rho & 15; return 8 * (i >> 2) + 4 * n + (i & 3); }

typedef int v4i_t __attribute__((ext_vector_type(4)));
typedef int v8i_t __attribute__((ext_vector_type(8)));
__device__ __forceinline__ unsigned pk4_fp8(float a, float b, float c, float d) {
    a = __builtin_amdgcn_fmed3f(a, -448.f, 448.f); b = __builtin_amdgcn_fmed3f(b, -448.f, 448.f); c = __builtin_amdgcn_fmed3f(c, -448.f, 448.f); d = __builtin_amdgcn_fmed3f(d, -448.f, 448.f);
    int w = 0; w = __builtin_amdgcn_cvt_pk_fp8_f32(a, b, w, false); w = __builtin_amdgcn_cvt_pk_fp8_f32(c, d, w, true); return (unsigned)w;
}
constexpr float F8_WSCALE = 256.0f, F8_HSCALE = 16.0f;
struct Unit { int pm, pn, ord; };
struct Gemm { const bf16_t* A; const bf16_t* Bt; int M, N, K; int kshift = 0; };

struct StaticOrder {
    int nM, nN, nwg, G, c; int zero = 0;
    __host__ __device__ void init(int M, int N, int G_, int c_) { nM = M / BM; nN = N / BM; nwg = nM * nN; G = G_; c = c_; }
    __host__ __device__ bool next(int i, Unit& u) const {
        const long L = (long)i * G + c; if (L >= nwg) return false;
        int wgid = (int)L; { const int q = nwg / NXCD, r = nwg % NXCD, xcd = wgid % NXCD, off = wgid / NXCD; wgid = (xcd < r ? xcd * (q + 1) : r * (q + 1) + (xcd - r) * q) + off; }
        const int nig = WGM * nN, gid = wgid / nig, fm = gid * WGM, gsz = (nM - fm) < WGM ? (nM - fm) : WGM;
        u.pm = fm + ((wgid % nig) % gsz); u.pn = (wgid % nig) / gsz; u.ord = i;
        if (zero) { u.pm = 0; u.pn = 0; }
        return true;
    }
    __device__ __forceinline__ void a_ready(const Unit&) const {}
    __device__ __forceinline__ void done(const Unit&) const {}
};


__device__ __forceinline__ unsigned cvt_pk_bf16(float lo, float hi) { unsigned r; asm volatile("v_cvt_pk_bf16_f32 %0, %1, %2" : "=v"(r) : "v"(lo), "v"(hi)); return r; }
__device__ __forceinline__ float silu_mul(float g, float u) { return g * u * __builtin_amdgcn_rcpf(1.0f + __builtin_amdgcn_exp2f(-1.4426950408889634f * g)); }
__device__ __forceinline__ void row_scale_table(PG8_LAS float* rs, const float* part, const Unit& u, float inv_n, float eps) {
    asm volatile("s_waitcnt lgkmcnt(0)" ::: "memory"); __builtin_amdgcn_s_barrier(); asm volatile("" ::: "memory");
    const int t = threadIdx.x;
    if (t < 256) { const f32x4* p = (const f32x4*)(part + (size_t)(u.pm * BM + t) * 32); f32x4 a = p[0];
#pragma unroll
        for (int i = 1; i < 8; ++i) a = a + p[i];
        rs[t] = rsqrtf(((a[0] + a[1]) + (a[2] + a[3])) * inv_n + eps); }
    asm volatile("s_waitcnt lgkmcnt(0)" ::: "memory"); __builtin_amdgcn_s_barrier(); asm volatile("" ::: "memory");
}
__device__ __forceinline__ float row_factor(const float* part, int row) {
    const unsigned long long q = ((const unsigned long long*)part)[row];
    return rsqrtf((float)q * (1.0f / 16777216.0f) * (1.0f / 2048.0f) + 1e-6f);
}
template <class Sched>
__device__ __forceinline__ void row_factor_table(PG8_LAS float* rs, const float* part, const Sched& S) {
    int t = threadIdx.x; asm volatile("" : "+v"(t));
    Unit u;
    for (int i = 0; S.next(i, u); ++i) if (t < 256) rs[i * 256 + t] = row_factor(part, u.pm * BM + t);
    asm volatile("s_waitcnt vmcnt(0) lgkmcnt(0)" ::: "memory"); __builtin_amdgcn_s_barrier(); asm volatile("" ::: "memory");
}
template <bool F8 = false, bool O8 = F8>
struct EpiSwigluT {
    static constexpr bool PERM = true, AFTER_DRAIN = false;
    bf16_t* O; int ldo;
    const float* part; PG8_LAS float* rs;
    static __device__ __forceinline__ unsigned silu_mul2(f32x2 g, f32x2 u) {
        const f32x2 t = g * (-1.4426950408889634f);
        f32x2 e; e.x = __builtin_amdgcn_exp2f(t.x); e.y = __builtin_amdgcn_exp2f(t.y);
        const f32x2 d = e + 1.0f;
        f32x2 rc; rc.x = __builtin_amdgcn_rcpf(d.x); rc.y = __builtin_amdgcn_rcpf(d.y);
        const f32x2 r = (g * u) * rc;
        typedef __bf16 bf16x2_t __attribute__((ext_vector_type(2)));
        return __builtin_bit_cast(unsigned, __builtin_convertvector(r, bf16x2_t));
    }
    static __device__ __forceinline__ f32x2 silu_mul2f(f32x2 g, f32x2 u) {
        const f32x2 t = g * (-1.4426950408889634f);
        f32x2 e; e.x = __builtin_amdgcn_exp2f(t.x); e.y = __builtin_amdgcn_exp2f(t.y);
        const f32x2 d = e + 1.0f;
        f32x2 rc; rc.x = __builtin_amdgcn_rcpf(d.x); rc.y = __builtin_amdgcn_rcpf(d.y);
        return (g * u) * rc;
    }
    __device__ __forceinline__ void operator()(const f32x4 (&acc)[2][2][4][2], const Unit& u, int wr, int wc, int fr, int fq) const {
        const int row0 = u.pm * BM + wr * 64 + fr, col0 = u.pn * HALF + wc * 32 + 8 * fq;
        float rf[2][4];
#pragma unroll
        for (int ai = 0; ai < 2; ++ai)
#pragma unroll
            for (int m = 0; m < 4; ++m) rf[ai][m] = part ? rs[u.ord * 256 + wr * 64 + fr + ai * HALF + m * 16] : 1.0f;
#pragma unroll
        for (int ai = 0; ai < 2; ++ai)
#pragma unroll
            for (int m = 0; m < 4; ++m) {
                if constexpr (F8) {
                    const float rg = rf[ai][m] * (1.0f / F8_WSCALE), ru = O8 ? rg * F8_HSCALE : rg;
                    const f32x4 g0 = acc[ai][0][m][0] * rg, g1 = acc[ai][0][m][1] * rg, u0 = acc[ai][1][m][0] * ru, u1 = acc[ai][1][m][1] * ru;
                    const f32x2 h0 = silu_mul2f((f32x2){g0[0], g0[1]}, (f32x2){u0[0], u0[1]}), h1 = silu_mul2f((f32x2){g0[2], g0[3]}, (f32x2){u0[2], u0[3]});
                    const f32x2 h2 = silu_mul2f((f32x2){g1[0], g1[1]}, (f32x2){u1[0], u1[1]}), h3 = silu_mul2f((f32x2){g1[2], g1[3]}, (f32x2){u1[2], u1[3]});
                    if constexpr (O8) {
                    typedef unsigned u32x2 __attribute__((ext_vector_type(2))); u32x2 w; w.x = pk4_fp8(h0.x, h0.y, h1.x, h1.y); w.y = pk4_fp8(h2.x, h2.y, h3.x, h3.y);
                    *(u32x2*)((unsigned char*)O + (size_t)(row0 + ai * HALF + m * 16) * ldo + col0) = w;
                    } else {
                    typedef __bf16 bf16x2_t __attribute__((ext_vector_type(2)));
                    u32x4 w; w.x = __builtin_bit_cast(unsigned, __builtin_convertvector(h0, bf16x2_t)); w.y = __builtin_bit_cast(unsigned, __builtin_convertvector(h1, bf16x2_t));
                    w.z = __builtin_bit_cast(unsigned, __builtin_convertvector(h2, bf16x2_t)); w.w = __builtin_bit_cast(unsigned, __builtin_convertvector(h3, bf16x2_t));
                    *(u32x4*)(O + (size_t)(row0 + ai * HALF + m * 16) * ldo + col0) = w;
                    }
                } else {
                const float r = rf[ai][m];
                const f32x4 g0 = acc[ai][0][m][0] * r, g1 = acc[ai][0][m][1] * r, u0 = acc[ai][1][m][0] * r, u1 = acc[ai][1][m][1] * r;
                u32x4 w;
                w.x = silu_mul2((f32x2){g0[0], g0[1]}, (f32x2){u0[0], u0[1]}); w.y = silu_mul2((f32x2){g0[2], g0[3]}, (f32x2){u0[2], u0[3]});
                w.z = silu_mul2((f32x2){g1[0], g1[1]}, (f32x2){u1[0], u1[1]}); w.w = silu_mul2((f32x2){g1[2], g1[3]}, (f32x2){u1[2], u1[3]});
                *(u32x4*)(O + (size_t)(row0 + ai * HALF + m * 16) * ldo + col0) = w;
                }
            }
    }
};
typedef EpiSwigluT<false> EpiSwiglu;
struct EpiResid {
    static constexpr bool PERM = false, AFTER_DRAIN = false;
    const float* base; float* out; int ldc; float alpha;
    bf16_t* XG; const float* gain; float* part;
    __device__ __forceinline__ void operator()(const f32x4 (&acc)[2][2][4][2], const Unit& u, int wr, int wc, int fr, int fq) const {
        const int row0 = u.pm * BM + wr * 64 + fr, col0 = u.pn * BM + wc * 32 + 4 * fq;
        f32x4 gg[2][2];
#pragma unroll
        for (int bj = 0; bj < 2; ++bj)
#pragma unroll
            for (int n = 0; n < 2; ++n) gg[bj][n] = XG ? *(const f32x4*)(gain + col0 + bj * HALF + 16 * n) : (f32x4){0.f, 0.f, 0.f, 0.f};
#pragma unroll
        for (int ai = 0; ai < 2; ++ai) {
            f32x4 b[4][2][2];
#pragma unroll
            for (int m = 0; m < 4; ++m)
#pragma unroll
                for (int bj = 0; bj < 2; ++bj)
#pragma unroll
                    for (int n = 0; n < 2; ++n) b[m][bj][n] = *(const f32x4*)(base + (size_t)(row0 + ai * HALF + m * 16) * ldc + col0 + bj * HALF + 16 * n);
#pragma unroll
            for (int m = 0; m < 4; ++m) { const int row = row0 + ai * HALF + m * 16; const size_t ro = (size_t)row * ldc + col0; float ssq = 0.f;
#pragma unroll
                for (int bj = 0; bj < 2; ++bj)
#pragma unroll
                    for (int n = 0; n < 2; ++n) { const size_t o = ro + bj * HALF + 16 * n; const f32x4 v = b[m][bj][n] + acc[ai][bj][m][n] * alpha; *(f32x4*)(out + o) = v;
                        if (XG) { const f32x4 g4 = gg[bj][n]; ssq += (v[0] * v[0] + v[1] * v[1]) + (v[2] * v[2] + v[3] * v[3]);
                            typedef unsigned u32x2 __attribute__((ext_vector_type(2))); u32x2 w; w.x = cvt_pk_bf16(v[0] * g4[0], v[1] * g4[1]); w.y = cvt_pk_bf16(v[2] * g4[2], v[3] * g4[3]); *(u32x2*)(XG + o) = w; } }
                if (XG) { ssq += __shfl_xor(ssq, 16); ssq += __shfl_xor(ssq, 32);
                    if (fq == 0) __hip_atomic_fetch_add((unsigned long long*)part + row, (unsigned long long)(ssq * 16777216.0f), __ATOMIC_RELAXED, __HIP_MEMORY_SCOPE_AGENT); } }
        }
    }
};
template <bool BB, bool OB>
struct EpiResidMix {
    static constexpr bool PERM = false, AFTER_DRAIN = false;
    const void* base; void* out; int ldc; float alpha;
    unsigned long long* rowsq;
    unsigned char* out8;
    __device__ __forceinline__ void operator()(const f32x4 (&acc)[2][2][4][2], const Unit& u, int wr, int wc, int fr, int fq) const {
        typedef unsigned u32x2 __attribute__((ext_vector_type(2)));
        const int row0 = u.pm * BM + wr * 64 + fr, col0 = u.pn * BM + wc * 32 + 4 * fq;
#pragma unroll
        for (int ai = 0; ai < 2; ++ai) {
            f32x4 b[4][2][2];
#pragma unroll
            for (int m = 0; m < 4; ++m)
#pragma unroll
                for (int bj = 0; bj < 2; ++bj)
#pragma unroll
                    for (int n = 0; n < 2; ++n) { const size_t o = (size_t)(row0 + ai * HALF + m * 16) * ldc + col0 + bj * HALF + 16 * n;
                        if (BB) { const u32x2 w = *(const u32x2*)((const bf16_t*)base + o);
                            b[m][bj][n] = (f32x4){__builtin_bit_cast(float, w.x << 16), __builtin_bit_cast(float, w.x & 0xffff0000u), __builtin_bit_cast(float, w.y << 16), __builtin_bit_cast(float, w.y & 0xffff0000u)}; }
                        else b[m][bj][n] = *(const f32x4*)((const float*)base + o); }
#pragma unroll
            for (int m = 0; m < 4; ++m) { float ssq = 0.f;
#pragma unroll
                for (int bj = 0; bj < 2; ++bj)
#pragma unroll
                    for (int n = 0; n < 2; ++n) { const size_t o = (size_t)(row0 + ai * HALF + m * 16) * ldc + col0 + bj * HALF + 16 * n; const f32x4 v = b[m][bj][n] + acc[ai][bj][m][n] * alpha;
                        ssq += (v[0] * v[0] + v[1] * v[1]) + (v[2] * v[2] + v[3] * v[3]);
                        if (OB) { u32x2 w; w.x = cvt_pk_bf16(v[0], v[1]); w.y = cvt_pk_bf16(v[2], v[3]); *(u32x2*)((bf16_t*)out + o) = w; }
                        else *(f32x4*)((float*)out + o) = v;
                        if (out8) *(unsigned*)(out8 + o) = pk4_fp8(v[0], v[1], v[2], v[3]); }
                if (rowsq) { ssq += __shfl_xor(ssq, 16); ssq += __shfl_xor(ssq, 32);
                    if (fq == 0) __hip_atomic_fetch_add(rowsq + (row0 + ai * HALF + m * 16), (unsigned long long)(ssq * 16777216.0f), __ATOMIC_RELAXED, __HIP_MEMORY_SCOPE_AGENT); } }
        }
    }
};
struct EpiStoreBf16 {
    static constexpr bool PERM = true, AFTER_DRAIN = false;
    bf16_t* O; int ldo; int sc_lo, sc_hi; float sc;
    const float* part; PG8_LAS float* rs;
    bf16_t* KVC; int kv_lo, kv_hi;
    __device__ __forceinline__ void operator()(const f32x4 (&acc)[2][2][4][2], const Unit& u, int wr, int wc, int fr, int fq) const {
        const int row0 = u.pm * BM + wr * 64 + fr, col0 = u.pn * BM + wc * 32 + 8 * fq;
        const float scl0 = (u.pn >= sc_lo && u.pn < sc_hi) ? sc : 1.0f;
        const bool kv = u.pn >= kv_lo && u.pn < kv_hi;
        const int which = (u.pn - kv_lo) >> 2, h0 = 2 * ((u.pn - kv_lo) & 3);
        float rf[2][4];
#pragma unroll
        for (int ai = 0; ai < 2; ++ai)
#pragma unroll
            for (int m = 0; m < 4; ++m) rf[ai][m] = part ? rs[u.ord * 256 + wr * 64 + fr + ai * HALF + m * 16] : 1.0f;
#pragma unroll
        for (int ai = 0; ai < 2; ++ai)
#pragma unroll
            for (int m = 0; m < 4; ++m) { const int row = row0 + ai * HALF + m * 16; bf16_t* rowp = O + (size_t)row * ldo + col0;
                const float scl = scl0 * rf[ai][m];
                bf16_t* kvp = KVC + ((size_t)((which * 4 + (row >> 12)) * 8 + h0) * 4096 + (row & 4095)) * 128 + wc * 32 + 8 * fq;
#pragma unroll
                for (int bj = 0; bj < 2; ++bj) { const f32x4 v0 = acc[ai][bj][m][0] * scl, v1 = acc[ai][bj][m][1] * scl;
                    u32x4 w; w.x = cvt_pk_bf16(v0[0], v0[1]); w.y = cvt_pk_bf16(v0[2], v0[3]); w.z = cvt_pk_bf16(v1[0], v1[1]); w.w = cvt_pk_bf16(v1[2], v1[3]);
                    if (kv) *(u32x4*)(kvp + (size_t)bj * 4096 * 128) = w; else *(u32x4*)(rowp + bj * HALF) = w; } }
    }
};
template <class Epi, class Sched, bool ALIGN_EPI = false, bool SP2 = false, bool FP8 = false>
__device__ __forceinline__ void gemm_phase(PG8_LAS unsigned char* lds, const Gemm g, const Sched& S, const Epi& E) {
    int tid_ = threadIdx.x; asm volatile("" : "+v"(tid_));
    const int tid = tid_, wid = __builtin_amdgcn_readfirstlane(tid >> 6), lane = tid & 63, wr = wid >> 2, wc = wid & 3, fr = lane & 15, fq = lane >> 4;
    const int K = g.K, nt = (K / BK) >> g.kshift;
    unsigned voffA[2], voffB[2];
#pragma unroll
    for (int i = 0; i < 2; ++i) { int R, C; stage_rc(tid * 16 + i * 8192, R, C); const int Rb = Epi::PERM ? ((R & ~31) + perm32(R & 31)) : R;
        voffA[i] = (unsigned)(R * K + C) * 2u; voffB[i] = (unsigned)(Rb * K + C) * 2u; }
    const size_t kstep = (size_t)(BK * 2);
    const size_t hstep = (size_t)HALF * K * 2;
    const size_t tstep = 2 * hstep;
    const unsigned ldsw = (unsigned)wid * 1024u;
    const int aoff = lds_byte(wr * 64 + fr, fq * 8), boff = lds_byte(wc * 32 + fr, fq * 8);
#define PG8_SA(b, h) (((b) * 2 + (h)) * HTB)
#define PG8_SB(b, h) ((4 + (b) * 2 + (h)) * HTB)
#define PG8_STAGE(bufoff, gbase, voff) do { _Pragma("unroll") for (int _i = 0; _i < 2; ++_i) \
        __builtin_amdgcn_global_load_lds((const unsigned*)((const char*)(gbase) + (voff)[_i]), (PG8_LAS unsigned*)(lds + (bufoff) + ldsw + _i * 8192), 16, 0, 0); } while (0)
#define PG8_LDA(dst, b, h) do { _Pragma("unroll") for (int m = 0; m < 4; ++m) _Pragma("unroll") for (int k = 0; k < 2; ++k) dst[m][k] = *(const PG8_LAS bf16x8*)(lds + PG8_SA(b, h) + aoff + m * 2048 + k * 1024); } while (0)
#define PG8_LDB(dst, b, h) do { _Pragma("unroll") for (int n = 0; n < 2; ++n) _Pragma("unroll") for (int k = 0; k < 2; ++k) dst[n][k] = *(const PG8_LAS bf16x8*)(lds + PG8_SB(b, h) + boff + n * 2048 + k * 1024); } while (0)
#define PG8_MMA(ai, bj, At, Bt) do { __builtin_amdgcn_s_setprio(1); _Pragma("unroll") for (int m = 0; m < 4; ++m) _Pragma("unroll") for (int n = 0; n < 2; ++n) _Pragma("unroll") for (int k = 0; k < 2; ++k) \
        acc[ai][bj][m][n] = __builtin_amdgcn_mfma_f32_16x16x32_bf16(Bt[n][k], At[m][k], acc[ai][bj][m][n], 0, 0, 0); __builtin_amdgcn_s_setprio(0); } while (0)
#define PG8_RD8(p) __builtin_shufflevector(*(const PG8_LAS v4i_t*)(p), *(const PG8_LAS v4i_t*)((p) + 1024), 0, 1, 2, 3, 4, 5, 6, 7)
#define PG8_LDA8(dst, b, h) do { _Pragma("unroll") for (int m = 0; m < 4; ++m) dst[m] = PG8_RD8(lds + PG8_SA(b, h) + aoff + m * 2048); } while (0)
#define PG8_LDB8(dst, b, h) do { _Pragma("unroll") for (int n = 0; n < 2; ++n) dst[n] = PG8_RD8(lds + PG8_SB(b, h) + boff + n * 2048); } while (0)
#define PG8_MQ(V, SW, b, a) V.SW = __builtin_amdgcn_mfma_scale_f32_16x16x128_f8f6f4(b, a, V.SW, 0, 0, 0, 0, 0, 0)
#define PG8_MMA8(ai, bj, At, Bt) do { __builtin_amdgcn_s_setprio(1); \
        PG8_MQ(accv[ai][bj][0], s0123, Bt[0], At[0]); PG8_MQ(accv[ai][bj][0], s4567, Bt[1], At[0]); PG8_MQ(accv[ai][bj][0], s89ab, Bt[0], At[1]); PG8_MQ(accv[ai][bj][0], scdef, Bt[1], At[1]); \
        PG8_MQ(accv[ai][bj][1], s0123, Bt[0], At[2]); PG8_MQ(accv[ai][bj][1], s4567, Bt[1], At[2]); PG8_MQ(accv[ai][bj][1], s89ab, Bt[0], At[3]); PG8_MQ(accv[ai][bj][1], scdef, Bt[1], At[3]); \
        __builtin_amdgcn_s_setprio(0); } while (0)
#define PG8_MM(ai, bj, At, Bt) do { if constexpr (FP8) PG8_MMA8(ai, bj, At##8, Bt##8); else PG8_MMA(ai, bj, At, Bt); } while (0)
#define PG8_LA(dst, b, h) do { if constexpr (FP8) PG8_LDA8(dst##8, b, h); else PG8_LDA(dst, b, h); } while (0)
#define PG8_LB(dst, b, h) do { if constexpr (FP8) PG8_LDB8(dst##8, b, h); else PG8_LDB(dst, b, h); } while (0)
#define PG8_WAIT_V(n) asm volatile("s_waitcnt vmcnt(" #n ")" ::: "memory")
#define PG8_WAIT_L(n) asm volatile("s_waitcnt lgkmcnt(" #n ")" ::: "memory")
#define PG8_BAR __builtin_amdgcn_s_barrier()
#define PG8_SCHED __builtin_amdgcn_sched_barrier(0)
    Unit cur, nxt; int ui = 0;
    if (!S.next(0, cur)) return;
    f32x4 acc[2][2][4][2];
    float zf = 0.f; asm volatile("" : "+v"(zf));
#pragma unroll
    for (int a = 0; a < 2; ++a)
#pragma unroll
        for (int b = 0; b < 2; ++b)
#pragma unroll
            for (int m = 0; m < 4; ++m)
#pragma unroll
                for (int n = 0; n < 2; ++n) acc[a][b][m][n] = (f32x4){zf, zf, zf, zf};
    bf16x8 At[4][2], B0[2][2], B1[2][2];
    typedef float f32x16_t __attribute__((ext_vector_type(16)));
    f32x16_t accv[2][2][2];
    if constexpr (FP8) {
#pragma unroll
        for (int a = 0; a < 2; ++a)
#pragma unroll
            for (int b = 0; b < 2; ++b)
#pragma unroll
                for (int h = 0; h < 2; ++h) accv[a][b][h] = (f32x16_t)(zf);
    }
    v8i_t At8[4], B08[2], B18[2];
    const char* cA = (const char*)g.A + (size_t)cur.pm * tstep; const char* cB = (const char*)g.Bt + (size_t)cur.pn * tstep;
    S.a_ready(cur);
    if constexpr (SP2) {
        PG8_STAGE(PG8_SB(0, 0), cB, voffB); PG8_STAGE(PG8_SB(0, 1), cB + hstep, voffB); PG8_STAGE(PG8_SA(0, 0), cA, voffA); PG8_STAGE(PG8_SA(0, 1), cA + hstep, voffA);
        if (wr == 1) PG8_BAR;
        PG8_WAIT_V(2); PG8_BAR;
        PG8_STAGE(PG8_SB(1, 0), cB + kstep, voffB); PG8_STAGE(PG8_SA(1, 0), cA + kstep, voffA); PG8_STAGE(PG8_SB(1, 1), cB + hstep + kstep, voffB);
        PG8_WAIT_V(6); PG8_BAR;
    } else {
        PG8_STAGE(PG8_SB(0, 0), cB, voffB); PG8_STAGE(PG8_SA(0, 0), cA, voffA); PG8_STAGE(PG8_SB(0, 1), cB + hstep, voffB); PG8_STAGE(PG8_SA(0, 1), cA + hstep, voffA);
        if (wr == 1) PG8_BAR;
        PG8_WAIT_V(4); PG8_BAR;
        PG8_STAGE(PG8_SB(1, 0), cB + kstep, voffB); PG8_STAGE(PG8_SA(1, 0), cA + kstep, voffA); PG8_STAGE(PG8_SB(1, 1), cB + hstep + kstep, voffB);
        PG8_WAIT_V(6); PG8_BAR;
    }
    for (;;) {
        const bool has_next = S.next(ui + 1, nxt);
        const char* nA = has_next ? (const char*)g.A + (size_t)nxt.pm * tstep : cA; const char* nB = has_next ? (const char*)g.Bt + (size_t)nxt.pn * tstep : cB;
        for (int t = 0; t < nt; t += 2) {
            const bool last = (t == nt - 2);
            const char* a1 = cA + (size_t)(t + 1) * kstep;
            const char* a2 = last ? nA : cA + (size_t)(t + 2) * kstep; const char* b2 = last ? nB : cB + (size_t)(t + 2) * kstep;
            const char* a3 = a2 + kstep; const char* b3 = b2 + kstep;
            if (last && has_next) S.a_ready(nxt);
            if constexpr (SP2) {
            PG8_LB(B0, 0, 0); PG8_LB(B1, 0, 1); PG8_SCHED; PG8_LA(At, 0, 0); PG8_STAGE(PG8_SA(1, 1), a1 + hstep, voffA);
            PG8_WAIT_V(8); PG8_WAIT_L(0); PG8_BAR; PG8_MM(0, 0, At, B0); PG8_MM(0, 1, At, B1); PG8_BAR; PG8_SCHED;
            PG8_LA(At, 0, 1); PG8_STAGE(PG8_SB(0, 0), b2, voffB); PG8_STAGE(PG8_SB(0, 1), b2 + hstep, voffB); PG8_STAGE(PG8_SA(0, 0), a2, voffA);
            PG8_WAIT_V(8); PG8_WAIT_L(0); PG8_BAR; PG8_MM(1, 0, At, B0); PG8_MM(1, 1, At, B1); PG8_BAR; PG8_SCHED;
            PG8_LB(B0, 1, 0); PG8_LB(B1, 1, 1); PG8_SCHED; PG8_LA(At, 1, 0); PG8_STAGE(PG8_SA(0, 1), a2 + hstep, voffA);
            PG8_WAIT_V(8); PG8_WAIT_L(0); PG8_BAR; PG8_MM(0, 0, At, B0); PG8_MM(0, 1, At, B1); PG8_BAR; PG8_SCHED;
            PG8_LA(At, 1, 1); PG8_STAGE(PG8_SB(1, 0), b3, voffB); PG8_STAGE(PG8_SB(1, 1), b3 + hstep, voffB); PG8_STAGE(PG8_SA(1, 0), a3, voffA);
            PG8_WAIT_V(8); PG8_WAIT_L(0); PG8_BAR; PG8_MM(1, 0, At, B0); PG8_MM(1, 1, At, B1); PG8_BAR; PG8_SCHED;
            } else {
            PG8_LB(B0, 0, 0); PG8_SCHED; PG8_LA(At, 0, 0); PG8_STAGE(PG8_SA(1, 1), a1 + hstep, voffA);
            PG8_WAIT_L(8); PG8_BAR; PG8_WAIT_L(0); PG8_MM(0, 0, At, B0); PG8_BAR; PG8_SCHED;
            PG8_LB(B1, 0, 1); PG8_STAGE(PG8_SB(0, 0), b2, voffB);
            PG8_BAR; PG8_WAIT_L(0); PG8_MM(0, 1, At, B1); PG8_BAR;
            PG8_LA(At, 0, 1); PG8_STAGE(PG8_SA(0, 0), a2, voffA);
            PG8_BAR; PG8_WAIT_L(0); PG8_MM(1, 0, At, B0); PG8_BAR; PG8_SCHED;
            PG8_STAGE(PG8_SB(0, 1), b2 + hstep, voffB);
            PG8_WAIT_V(6); PG8_BAR; PG8_MM(1, 1, At, B1); PG8_BAR;
            PG8_LB(B0, 1, 0); PG8_SCHED; PG8_LA(At, 1, 0); PG8_STAGE(PG8_SA(0, 1), a2 + hstep, voffA);
            PG8_WAIT_L(8); PG8_BAR; PG8_WAIT_L(0); PG8_MM(0, 0, At, B0); PG8_BAR; PG8_SCHED;
            PG8_LB(B1, 1, 1); PG8_STAGE(PG8_SB(1, 0), b3, voffB);
            PG8_BAR; PG8_WAIT_L(0); PG8_MM(0, 1, At, B1); PG8_BAR;
            PG8_LA(At, 1, 1); PG8_STAGE(PG8_SA(1, 0), a3, voffA);
            PG8_BAR; PG8_WAIT_L(0); PG8_MM(1, 0, At, B0); PG8_BAR; PG8_SCHED;
            PG8_STAGE(PG8_SB(1, 1), b3 + hstep, voffB);
            PG8_WAIT_V(6); PG8_BAR; PG8_MM(1, 1, At, B1); PG8_BAR;
            }
        }
        if constexpr (ALIGN_EPI) { if (wr == 0) PG8_BAR; }
        if constexpr (FP8) {
#pragma unroll
            for (int a = 0; a < 2; ++a)
#pragma unroll
                for (int b = 0; b < 2; ++b)
#pragma unroll
                    for (int h = 0; h < 2; ++h) { const f32x16_t v = accv[a][b][h]; acc[a][b][2 * h][0] = v.s0123; acc[a][b][2 * h][1] = v.s4567; acc[a][b][2 * h + 1][0] = v.s89ab; acc[a][b][2 * h + 1][1] = v.scdef; accv[a][b][h] = (f32x16_t)(zf); }
        }
        if constexpr (!Epi::AFTER_DRAIN) { E(acc, cur, wr, wc, fr, fq); S.done(cur); }
        if (!has_next) break;
#pragma unroll
        for (int a = 0; a < 2; ++a)
#pragma unroll
            for (int b = 0; b < 2; ++b)
#pragma unroll
                for (int m = 0; m < 4; ++m)
#pragma unroll
                    for (int n = 0; n < 2; ++n) acc[a][b][m][n] = (f32x4){zf, zf, zf, zf};
        cur = nxt; cA = nA; cB = nB; ++ui;
        if constexpr (ALIGN_EPI) { if (wr == 1) PG8_BAR; }
    }
    PG8_WAIT_V(0);
    if constexpr (!ALIGN_EPI) { if (wr == 0) PG8_BAR; }
    PG8_BAR;
    if constexpr (Epi::AFTER_DRAIN) { E.fused(acc, cur, wr, wc, fr, fq, lds, wid, lane); S.done(cur); }
#undef PG8_SA
#undef PG8_SB
#undef PG8_STAGE
#undef PG8_LDA
#undef PG8_LDB
#undef PG8_MMA
#undef PG8_MMA8
#undef PG8_MQ
#undef PG8_MM
#undef PG8_RD8
#undef PG8_LDA8
#undef PG8_LDB8
#undef PG8_LA
#undef PG8_LB
#undef PG8_WAIT_V
#undef PG8_WAIT_L
#undef PG8_BAR
#undef PG8_SCHED
}
}

struct Params {
    const float* x; const int* pos;
    const float *ffn1_norm, *ffn1_wg, *ffn1_wu, *ffn1_wd, *mix_norm, *w_in, *q_norm, *kc_norm, *ks_norm, *kw_norm;
    const float *ck_pos, *ck_w1, *ck_w2, *cv_pos, *cv_w1, *cv_w2, *nsa_on, *sb_on, *w_out, *ffn2_norm, *ffn2_wg, *ffn2_wu, *ffn2_wd;
    float* out; unsigned char* ws;
};


__device__ __forceinline__ void rmsnorm_rows(const float* X, const float* g, bf16* Y) {
    int tid = threadIdx.x; asm volatile("" : "+v"(tid));
    const int lane = tid & 63, gw = blockIdx.x * NWAVES + (tid >> 6), NGW = gridDim.x * NWAVES;
    f32x4 gg[8];
#pragma unroll
    for (int j = 0; j < 8; ++j) gg[j] = ((const f32x4*)g)[lane + 64 * j];
    for (int m0 = gw; m0 < M; m0 += 2 * NGW) {
        const int m1 = m0 + NGW; const bool ok1 = m1 < M;
        const f32x4* x0 = (const f32x4*)(X + (size_t)m0 * D) + lane; const f32x4* x1 = (const f32x4*)(X + (size_t)(ok1 ? m1 : m0) * D) + lane;
        f32x4 v0[8], v1[8]; float s0 = 0.f, s1 = 0.f;
#pragma unroll
        for (int j = 0; j < 8; ++j) { v0[j] = x0[64 * j]; v1[j] = x1[64 * j]; }
#pragma unroll
        for (int j = 0; j < 8; ++j) { s0 += (v0[j].x * v0[j].x + v0[j].y * v0[j].y) + (v0[j].z * v0[j].z + v0[j].w * v0[j].w); s1 += (v1[j].x * v1[j].x + v1[j].y * v1[j].y) + (v1[j].z * v1[j].z + v1[j].w * v1[j].w); }
        const float r0 = rsqrtf(wave_sum(s0) * (1.f / D) + EPS), r1 = rsqrtf(wave_sum(s1) * (1.f / D) + EPS);
        v2u* o0 = (v2u*)(Y + (size_t)m0 * D) + lane; v2u* o1 = (v2u*)(Y + (size_t)m1 * D) + lane;
#pragma unroll
        for (int j = 0; j < 8; ++j) { v2u w; w.x = pk2(v0[j].x * r0 * gg[j].x, v0[j].y * r0 * gg[j].y); w.y = pk2(v0[j].z * r0 * gg[j].z, v0[j].w * r0 * gg[j].w); o0[64 * j] = w; }
        if (ok1) {
#pragma unroll
            for (int j = 0; j < 8; ++j) { v2u w; w.x = pk2(v1[j].x * r1 * gg[j].x, v1[j].y * r1 * gg[j].y); w.y = pk2(v1[j].z * r1 * gg[j].z, v1[j].w * r1 * gg[j].w); o1[64 * j] = w; }
        }
    }
}

__device__ __forceinline__ void cast_rows(const float* X, bf16* Y, unsigned long long* rowsq, unsigned char* Y8 = nullptr) {
    int tid = threadIdx.x; asm volatile("" : "+v"(tid));
    const int lane = tid & 63, gw = blockIdx.x * NWAVES + (tid >> 6), NGW = gridDim.x * NWAVES;
    for (int m0 = gw; m0 < M; m0 += 2 * NGW) {
        const int m1 = m0 + NGW; const bool ok1 = m1 < M;
        const f32x4* x0 = (const f32x4*)(X + (size_t)m0 * D) + lane; const f32x4* x1 = (const f32x4*)(X + (size_t)(ok1 ? m1 : m0) * D) + lane;
        f32x4 v0[8], v1[8]; float s0 = 0.f, s1 = 0.f;
#pragma unroll
        for (int j = 0; j < 8; ++j) { v0[j] = x0[64 * j]; v1[j] = x1[64 * j]; }
#pragma unroll
        for (int j = 0; j < 8; ++j) { s0 += (v0[j].x * v0[j].x + v0[j].y * v0[j].y) + (v0[j].z * v0[j].z + v0[j].w * v0[j].w); s1 += (v1[j].x * v1[j].x + v1[j].y * v1[j].y) + (v1[j].z * v1[j].z + v1[j].w * v1[j].w); }
        s0 = wave_sum(s0); s1 = wave_sum(s1);
        if (lane == 0) { rowsq[m0] = (unsigned long long)(s0 * 16777216.0f); if (ok1) rowsq[m1] = (unsigned long long)(s1 * 16777216.0f); }
        v2u* o0 = (v2u*)(Y + (size_t)m0 * D) + lane; v2u* o1 = (v2u*)(Y + (size_t)m1 * D) + lane;
#pragma unroll
        for (int j = 0; j < 8; ++j) { v2u w; w.x = pk2(v0[j].x, v0[j].y); w.y = pk2(v0[j].z, v0[j].w); o0[64 * j] = w; }
        if (Y8) {
#pragma unroll
            for (int j = 0; j < 8; ++j) ((unsigned*)(Y8 + (size_t)m0 * D))[lane + 64 * j] = pg8::pk4_fp8(v0[j].x, v0[j].y, v0[j].z, v0[j].w);
        }
        if (ok1) {
#pragma unroll
            for (int j = 0; j < 8; ++j) { v2u w; w.x = pk2(v1[j].x, v1[j].y); w.y = pk2(v1[j].z, v1[j].w); o1[64 * j] = w; }
            if (Y8) {
#pragma unroll
                for (int j = 0; j < 8; ++j) ((unsigned*)(Y8 + (size_t)m1 * D))[lane + 64 * j] = pg8::pk4_fp8(v1[j].x, v1[j].y, v1[j].z, v1[j].w);
            }
        }
    }
}
__device__ __forceinline__ void rmsnorm_rows_bf16(const bf16* X, const float* g, bf16* Y) {
    int tid = threadIdx.x; asm volatile("" : "+v"(tid));
    const int lane = tid & 63, gw = blockIdx.x * NWAVES + (tid >> 6), NGW = gridDim.x * NWAVES;
    f32x4 ga[4], gb[4];
#pragma unroll
    for (int j = 0; j < 4; ++j) { ga[j] = *(const f32x4*)(g + 8 * (lane + 64 * j)); gb[j] = *(const f32x4*)(g + 8 * (lane + 64 * j) + 4); }
    for (int m0 = gw; m0 < M; m0 += 2 * NGW) {
        const int m1 = m0 + NGW; const bool ok1 = m1 < M;
        const v4u* x0 = (const v4u*)(X + (size_t)m0 * D) + lane; const v4u* x1 = (const v4u*)(X + (size_t)(ok1 ? m1 : m0) * D) + lane;
        v4u r0[4], r1[4];
#pragma unroll
        for (int j = 0; j < 4; ++j) { r0[j] = x0[64 * j]; r1[j] = x1[64 * j]; }
        float s0 = 0.f, s1 = 0.f;
#pragma unroll
        for (int j = 0; j < 4; ++j) {
            s0 += (bflo(r0[j].x) * bflo(r0[j].x) + bfhi(r0[j].x) * bfhi(r0[j].x)) + (bflo(r0[j].y) * bflo(r0[j].y) + bfhi(r0[j].y) * bfhi(r0[j].y)) + (bflo(r0[j].z) * bflo(r0[j].z) + bfhi(r0[j].z) * bfhi(r0[j].z)) + (bflo(r0[j].w) * bflo(r0[j].w) + bfhi(r0[j].w) * bfhi(r0[j].w));
            s1 += (bflo(r1[j].x) * bflo(r1[j].x) + bfhi(r1[j].x) * bfhi(r1[j].x)) + (bflo(r1[j].y) * bflo(r1[j].y) + bfhi(r1[j].y) * bfhi(r1[j].y)) + (bflo(r1[j].z) * bflo(r1[j].z) + bfhi(r1[j].z) * bfhi(r1[j].z)) + (bflo(r1[j].w) * bflo(r1[j].w) + bfhi(r1[j].w) * bfhi(r1[j].w));
        }
        const float q0 = rsqrtf(wave_sum(s0) * (1.f / D) + EPS), q1 = rsqrtf(wave_sum(s1) * (1.f / D) + EPS);
        v4u* o0 = (v4u*)(Y + (size_t)m0 * D) + lane; v4u* o1 = (v4u*)(Y + (size_t)m1 * D) + lane;
#pragma unroll
        for (int j = 0; j < 4; ++j) { v4u w; w.x = pk2(bflo(r0[j].x) * q0 * ga[j].x, bfhi(r0[j].x) * q0 * ga[j].y); w.y = pk2(bflo(r0[j].y) * q0 * ga[j].z, bfhi(r0[j].y) * q0 * ga[j].w);
            w.z = pk2(bflo(r0[j].z) * q0 * gb[j].x, bfhi(r0[j].z) * q0 * gb[j].y); w.w = pk2(bflo(r0[j].w) * q0 * gb[j].z, bfhi(r0[j].w) * q0 * gb[j].w); o0[64 * j] = w; }
        if (ok1) {
#pragma unroll
            for (int j = 0; j < 4; ++j) { v4u w; w.x = pk2(bflo(r1[j].x) * q1 * ga[j].x, bfhi(r1[j].x) * q1 * ga[j].y); w.y = pk2(bflo(r1[j].y) * q1 * ga[j].z, bfhi(r1[j].y) * q1 * ga[j].w);
                w.z = pk2(bflo(r1[j].z) * q1 * gb[j].x, bfhi(r1[j].z) * q1 * gb[j].y); w.w = pk2(bflo(r1[j].w) * q1 * gb[j].z, bfhi(r1[j].w) * q1 * gb[j].w); o1[64 * j] = w; }
        }
    }
}

__device__ __forceinline__ void rope_tables(const int* pos, float* cs, float* sn) {
    int tid = threadIdx.x; asm volatile("" : "+v"(tid));
    const int gt = blockIdx.x * NTHREADS + tid, NGT = gridDim.x * NTHREADS;
    for (int i = gt; i < M * 64; i += NGT) {
        const int m = i >> 6, f = i & 63;
        const float inv = powf(10000.f, -(float)(2 * f) / 128.f);
        const float ang = (float)pos[m] * inv;
        cs[i] = cosf(ang); sn[i] = sinf(ang);
    }
}

__device__ __forceinline__ void postproj_naive(const Params& P, bf16* PROJ, const float* cs, const float* sn) {
    int tid = threadIdx.x; asm volatile("" : "+v"(tid));
    const int lane = tid & 63, sub = lane & 15, gw = blockIdx.x * NWAVES + (tid >> 6), NGW = gridDim.x * NWAVES;
    constexpr int NG = M * 12 / 4;
    for (int g0 = gw; g0 < NG; g0 += 2 * NGW) {
        v2u lo[2], hi[2]; f32x4 cv[2], sv[2]; bf16* pp[2]; const float* gp[2]; float qs[2]; bool ok[2];
#pragma unroll
        for (int u = 0; u < 2; ++u) {
            const int g = g0 + u * NGW; ok[u] = g < NG;
            const int task = ok[u] ? 4 * g + (lane >> 4) : 0, m = task / 12, sl = task % 12;
            int col;
            if (sl < 8) { col = C_QN + sl * 128; gp[u] = P.q_norm; } else if (sl < 10) { col = C_KS + (sl - 8) * 128; gp[u] = P.ks_norm; } else { col = C_KW + (sl - 10) * 128; gp[u] = P.kw_norm; }
            qs[u] = sl < 8 ? QSCALE : 1.0f;
            pp[u] = PROJ + (size_t)m * NP + col + 4 * sub;
            lo[u] = *(const v2u*)pp[u]; hi[u] = *(const v2u*)(pp[u] + 64);
            cv[u] = *(const f32x4*)(cs + m * 64 + 4 * sub); sv[u] = *(const f32x4*)(sn + m * 64 + 4 * sub);
        }
#pragma unroll
        for (int u = 0; u < 2; ++u) {
            float a[4], b[4];
            a[0] = bflo(lo[u].x); a[1] = bfhi(lo[u].x); a[2] = bflo(lo[u].y); a[3] = bfhi(lo[u].y);
            b[0] = bflo(hi[u].x); b[1] = bfhi(hi[u].x); b[2] = bflo(hi[u].y); b[3] = bfhi(hi[u].y);
            float ss = (a[0] * a[0] + a[1] * a[1]) + (a[2] * a[2] + a[3] * a[3]) + (b[0] * b[0] + b[1] * b[1]) + (b[2] * b[2] + b[3] * b[3]);
            ss += __shfl_xor(ss, 1); ss += __shfl_xor(ss, 2); ss += __shfl_xor(ss, 4); ss += __shfl_xor(ss, 8);
            const float r = rsqrtf(ss * (1.f / 128.f) + EPS) * qs[u];
            const f32x4 ga = *(const f32x4*)(gp[u] + 4 * sub), gb = *(const f32x4*)(gp[u] + 64 + 4 * sub);
            float oa[4], ob[4];
#pragma unroll
            for (int e = 0; e < 4; ++e) { const float x = a[e] * r * ga[e], y = b[e] * r * gb[e]; oa[e] = x * cv[u][e] - y * sv[u][e]; ob[e] = y * cv[u][e] + x * sv[u][e]; }
            if (ok[u]) { v2u wa, wb; wa.x = pk2(oa[0], oa[1]); wa.y = pk2(oa[2], oa[3]); wb.x = pk2(ob[0], ob[1]); wb.y = pk2(ob[2], ob[3]); *(v2u*)pp[u] = wa; *(v2u*)(pp[u] + 64) = wb; }
        }
    }
}

namespace att {
typedef short bf16x8 __attribute__((ext_vector_type(8)));
typedef short s16x4 __attribute__((ext_vector_type(4)));
constexpr float C1 = 0.08838834764831845f * 1.4426950408889634f;
typedef __bf16 bf16x2_t __attribute__((ext_vector_type(2)));
__device__ __forceinline__ unsigned cvt_pk_bf16(float lo, float hi) { const bf16x2_t v = __builtin_convertvector((f32x2){lo, hi}, bf16x2_t); return __builtin_bit_cast(unsigned, v); }
__device__ __forceinline__ int offK(int key, int dc) { return key * 256 + 16 * (dc ^ ((key & 3) | (((key >> 4) & 3) << 2))); }
__device__ __forceinline__ int offV(int key, int dc) { return key * 256 + 32 * ((dc >> 1) ^ ((key & 3) | (((key >> 4) & 1) << 2))) + 16 * (dc & 1); }
struct TileRegs { v4u k[2], v[2]; };
__device__ __forceinline__ void tile_load(TileRegs& r, const bf16* kp, const bf16* vp, int ld, int tid) {
#if NSA_OPAQUE
    asm volatile("" : "+v"(tid));
#endif
#pragma unroll
    for (int i = 0; i < 2; ++i) { const int id = tid + 512 * i, key = id >> 4, dc = id & 15; r.k[i] = *(const v4u*)(kp + (size_t)key * ld + dc * 8); r.v[i] = *(const v4u*)(vp + (size_t)key * ld + dc * 8); }
}
__device__ __forceinline__ void tile_store(const TileRegs& r, LAS unsigned char* kb, LAS unsigned char* vb, int tid) {
#if NSA_OPAQUE
    asm volatile("" : "+v"(tid));
#endif
#pragma unroll
    for (int i = 0; i < 2; ++i) { const int id = tid + 512 * i, key = id >> 4, dc = id & 15; *(LAS v4u*)(kb + offK(key, dc)) = r.k[i]; *(LAS v4u*)(vb + offV(key, dc)) = r.v[i]; }
}
__device__ __forceinline__ void tile_dma(const bf16* kp, const bf16* vp, int ld, LAS unsigned char* kb, LAS unsigned char* vb, int w, int lane) {
    asm volatile("" : "+v"(lane));
#pragma unroll
    for (int i = 0; i < 2; ++i) {
        const int p = 2 * w + i, key = 4 * p + (lane >> 4), sl = lane & 15;
        const int dck = sl ^ ((key & 3) | (((key >> 4) & 3) << 2));
        const int dcv = 2 * ((sl >> 1) ^ ((key & 3) | (((key >> 4) & 1) << 2))) + (sl & 1);
        __builtin_amdgcn_global_load_lds((const unsigned*)(kp + (size_t)key * ld + dck * 8), (LAS unsigned*)(kb + 1024 * p), 16, 0, 0);
        __builtin_amdgcn_global_load_lds((const unsigned*)(vp + (size_t)key * ld + dcv * 8), (LAS unsigned*)(vb + 1024 * p), 16, 0, 0);
    }
}
__device__ __forceinline__ void dma_k4(const bf16* kp, int ld, LAS unsigned char* kb, int w, int lane) {
    asm volatile("" : "+v"(lane));
#pragma unroll
    for (int i = 0; i < 4; ++i) {
        const int p = 4 * w + i, key = 4 * p + (lane >> 4), sl = lane & 15;
        const int dck = sl ^ ((key & 3) | (((key >> 4) & 3) << 2));
        __builtin_amdgcn_global_load_lds((const unsigned*)(kp + (size_t)key * ld + dck * 8), (LAS unsigned*)(kb + 1024 * p), 16, 0, 0);
    }
}
__device__ __forceinline__ void dma_v4(const bf16* vp, int ld, LAS unsigned char* vb, int w, int lane) {
    asm volatile("" : "+v"(lane));
#pragma unroll
    for (int i = 0; i < 4; ++i) {
        const int p = 4 * w + i, key = 4 * p + (lane >> 4), sl = lane & 15;
        const int dcv = 2 * ((sl >> 1) ^ ((key & 3) | (((key >> 4) & 1) << 2))) + (sl & 1);
        __builtin_amdgcn_global_load_lds((const unsigned*)(vp + (size_t)key * ld + dcv * 8), (LAS unsigned*)(vb + 1024 * p), 16, 0, 0);
    }
}
#define ATT_WAIT_V(n) asm volatile("s_waitcnt vmcnt(" #n ")" ::: "memory")
#define ATT_BAR() do { asm volatile("s_waitcnt lgkmcnt(0)" ::: "memory"); __builtin_amdgcn_s_barrier(); asm volatile("" ::: "memory"); } while (0)
template <bool OPAQUE = true>
__device__ __forceinline__ void qk_tile(f32x4 (&s)[2][4], const bf16x8 (&qf)[2][4], const LAS unsigned char* kb, int c, int q4) {
    if (OPAQUE) asm volatile("" : "+v"(c), "+v"(q4));
    const int rowoff = (16 * (c >> 2) + (c & 3)) * 256, lowp = 16 * (q4 ^ (c & 3));
#pragma unroll
    for (int kt = 0; kt < 4; ++kt) { s[0][kt] = (f32x4){0.f, 0.f, 0.f, 0.f}; s[1][kt] = (f32x4){0.f, 0.f, 0.f, 0.f}; }
#pragma unroll
    for (int ks = 0; ks < 4; ++ks) {
        const int a = rowoff + 64 * (ks ^ (c >> 2)) + lowp;
#pragma unroll
        for (int kt = 0; kt < 4; ++kt) {
            const bf16x8 kf = *(const LAS bf16x8*)(kb + a + kt * 1024);
            s[0][kt] = __builtin_amdgcn_mfma_f32_16x16x32_bf16(kf, qf[0][ks], s[0][kt], 0, 0, 0);
            s[1][kt] = __builtin_amdgcn_mfma_f32_16x16x32_bf16(kf, qf[1][ks], s[1][kt], 0, 0, 0);
        }
    }
}
__device__ __forceinline__ void qk_tile_lq(f32x4 (&s)[2][4], const LAS unsigned char* qb, const LAS unsigned char* kb, int c, int q4, int lane) {
#if NSA_OPAQUE
    asm volatile("" : "+v"(c), "+v"(q4), "+v"(lane));
#endif
    const int rowoff = (16 * (c >> 2) + (c & 3)) * 256, lowp = 16 * (q4 ^ (c & 3));
#pragma unroll
    for (int kt = 0; kt < 4; ++kt) { s[0][kt] = (f32x4){0.f, 0.f, 0.f, 0.f}; s[1][kt] = (f32x4){0.f, 0.f, 0.f, 0.f}; }
#pragma unroll
    for (int ks = 0; ks < 4; ++ks) {
        const int a = rowoff + 64 * (ks ^ (c >> 2)) + lowp;
        const bf16x8 q0 = *(const LAS bf16x8*)(qb + (ks * 64 + lane) * 16), q1 = *(const LAS bf16x8*)(qb + ((4 + ks) * 64 + lane) * 16);
#pragma unroll
        for (int kt = 0; kt < 4; ++kt) {
            const bf16x8 kf = *(const LAS bf16x8*)(kb + a + kt * 1024);
            s[0][kt] = __builtin_amdgcn_mfma_f32_16x16x32_bf16(kf, q0, s[0][kt], 0, 0, 0);
            s[1][kt] = __builtin_amdgcn_mfma_f32_16x16x32_bf16(kf, q1, s[1][kt], 0, 0, 0);
        }
    }
}
__device__ __forceinline__ void pv_tile(f32x4 (&o)[8][2], const bf16x8 (&pf)[2][2], const LAS unsigned char* vb, int c, int q4) {
#if NSA_OPAQUE
    asm volatile("" : "+v"(c), "+v"(q4));
#endif
    const int p = c & 3;
#pragma unroll
    for (int s2 = 0; s2 < 2; ++s2) {
        const int key0 = 16 * q4 + 8 * s2 + (c >> 2);
        const int g = (key0 & 3) | (((key0 >> 4) & 1) << 2);
        const int base = key0 * 256 + 16 * (p >> 1) + 8 * (p & 1);
#pragma unroll
        for (int dt = 0; dt < 8; ++dt) {
            const LAS unsigned char* a0 = vb + base + 32 * (dt ^ g);
            const s16x4 lo = __builtin_amdgcn_ds_read_tr16_b64_v4i16((LAS s16x4*)a0);
            const s16x4 hi = __builtin_amdgcn_ds_read_tr16_b64_v4i16((LAS s16x4*)(a0 + 1024));
            const bf16x8 vf = __builtin_shufflevector(lo, hi, 0, 1, 2, 3, 4, 5, 6, 7);
            o[dt][0] = __builtin_amdgcn_mfma_f32_16x16x32_bf16(vf, pf[0][s2], o[dt][0], 0, 0, 0);
            o[dt][1] = __builtin_amdgcn_mfma_f32_16x16x32_bf16(vf, pf[1][s2], o[dt][1], 0, 0, 0);
        }
    }
}
__device__ __forceinline__ s16x4 tr_read_asm(unsigned addr) { s16x4 r; asm volatile("ds_read_b64_tr_b16 %0, %1" : "=v"(r) : "v"(addr) : "memory"); return r; }
__device__ __forceinline__ s16x4 tr_read_asm_1k(unsigned addr) { s16x4 r; asm volatile("ds_read_b64_tr_b16 %0, %1 offset:1024" : "=v"(r) : "v"(addr) : "memory"); return r; }
template <bool OPAQUE = true>
__device__ __forceinline__ void pv_tile_asm(f32x4 (&o)[8][2], const bf16x8 (&pf)[2][2], const LAS unsigned char* vb, int c, int q4) {
    if (OPAQUE) asm volatile("" : "+v"(c), "+v"(q4));
    const int p = c & 3;
#pragma unroll
    for (int s2 = 0; s2 < 2; ++s2) {
        const int key0 = 16 * q4 + 8 * s2 + (c >> 2);
        const int g = (key0 & 3) | (((key0 >> 4) & 1) << 2);
        const unsigned base = (unsigned)(size_t)vb + key0 * 256 + 16 * (p >> 1) + 8 * (p & 1);
        s16x4 lo[8], hi[8];
#pragma unroll
        for (int dt = 0; dt < 8; ++dt) { const unsigned a0 = base + 32 * (dt ^ g); lo[dt] = tr_read_asm(a0); hi[dt] = tr_read_asm_1k(a0); }
        asm volatile("s_waitcnt lgkmcnt(0)" ::: "memory");
        __builtin_amdgcn_sched_barrier(0);
#pragma unroll
        for (int dt = 0; dt < 8; ++dt) {
            const bf16x8 vf = __builtin_shufflevector(lo[dt], hi[dt], 0, 1, 2, 3, 4, 5, 6, 7);
            o[dt][0] = __builtin_amdgcn_mfma_f32_16x16x32_bf16(vf, pf[0][s2], o[dt][0], 0, 0, 0);
            o[dt][1] = __builtin_amdgcn_mfma_f32_16x16x32_bf16(vf, pf[1][s2], o[dt][1], 0, 0, 0);
        }
    }
}
struct VGroup { s16x4 lo[4], hi[4]; };
template <int G>
__device__ __forceinline__ void pv_issue(VGroup& v, const LAS unsigned char* vb, int c, int q4) {
    constexpr int s2 = G >> 1, d0 = 4 * (G & 1);
    const int p = c & 3, key0 = 16 * q4 + 8 * s2 + (c >> 2), g = (key0 & 3) | (((key0 >> 4) & 1) << 2);
    const unsigned base = (unsigned)(size_t)vb + key0 * 256 + 16 * (p >> 1) + 8 * (p & 1);
#pragma unroll
    for (int i = 0; i < 4; ++i) { const unsigned a0 = base + 32 * ((d0 + i) ^ g); v.lo[i] = tr_read_asm(a0); v.hi[i] = tr_read_asm_1k(a0); }
}
template <int G>
__device__ __forceinline__ void pv_mma(f32x4 (&o)[8][2], const VGroup& v, const bf16x8 (&pf)[2][2]) {
    constexpr int s2 = G >> 1, d0 = 4 * (G & 1);
#pragma unroll
    for (int i = 0; i < 4; ++i) {
        const bf16x8 vf = __builtin_shufflevector(v.lo[i], v.hi[i], 0, 1, 2, 3, 4, 5, 6, 7);
        o[d0 + i][0] = __builtin_amdgcn_mfma_f32_16x16x32_bf16(vf, pf[0][s2], o[d0 + i][0], 0, 0, 0);
        o[d0 + i][1] = __builtin_amdgcn_mfma_f32_16x16x32_bf16(vf, pf[1][s2], o[d0 + i][1], 0, 0, 0);
    }
}
#define PV_WAIT() do { asm volatile("s_waitcnt lgkmcnt(0)" ::: "memory"); __builtin_amdgcn_sched_barrier(0); } while (0)
__device__ __forceinline__ void pv_tile_rest(f32x4 (&o)[8][2], VGroup& va, const bf16x8 (&pf)[2][2], const LAS unsigned char* vb, int c, int q4) {
    VGroup vb2;
    PV_WAIT(); pv_issue<1>(vb2, vb, c, q4); __builtin_amdgcn_sched_barrier(0); pv_mma<0>(o, va, pf);
    PV_WAIT(); pv_issue<2>(va, vb, c, q4);  __builtin_amdgcn_sched_barrier(0); pv_mma<1>(o, vb2, pf);
    PV_WAIT(); pv_issue<3>(vb2, vb, c, q4); __builtin_amdgcn_sched_barrier(0); pv_mma<2>(o, va, pf);
    PV_WAIT(); pv_mma<3>(o, vb2, pf);
}
__device__ __forceinline__ bf16x8 pack8(float a0, float a1, float a2, float a3, float a4, float a5, float a6, float a7) {
    v4u w; w.x = cvt_pk_bf16(a0, a1); w.y = cvt_pk_bf16(a2, a3); w.z = cvt_pk_bf16(a4, a5); w.w = cvt_pk_bf16(a6, a7);
    return __builtin_bit_cast(bf16x8, w);
}


template <bool MASK>
__device__ __forceinline__ void sb_elem(const f32x4 (&s)[4], float& R, bf16x8 (&pf)[2], const int kdiff, const int c, const int q4) {
    f32x2 a2[8]; f32x2 t2 = (f32x2){1.f, 1.f};
#pragma unroll
    for (int k = 0; k < 8; ++k) {
        f32x2 e;
        e.x = __builtin_amdgcn_exp2f(s[k >> 2][k & 3]); e.y = __builtin_amdgcn_exp2f(s[2 + (k >> 2)][k & 3]);
        if (MASK) { e.x = (k < kdiff) ? e.x : 0.f; e.y = (k + 8 < kdiff) ? e.y : 0.f; }
        a2[k] = e * t2; t2 = t2 * (e + 1.0f);
    }
    const float l0 = __builtin_amdgcn_logf(t2.x), l1 = __builtin_amdgcn_logf(t2.y), run = l0 + l1;
    const float u1 = __shfl_down(run, 16), u2 = __shfl_down(run, 32), u3 = __shfl_down(run, 48);
    const float X = (q4 < 3 ? u1 : 0.f) + (q4 < 2 ? u2 : 0.f) + (q4 < 1 ? u3 : 0.f);
    const float tot = __shfl(run + X, c);
    const float base = R + X + l1;
    f32x2 sc; sc.y = __builtin_amdgcn_exp2f(-base); sc.x = __builtin_amdgcn_exp2f(-(base + l0));
    R += tot;
#pragma unroll
    for (int k = 0; k < 8; ++k) a2[k] = a2[k] * sc;
    pf[0] = pack8(a2[0].x, a2[1].x, a2[2].x, a2[3].x, a2[4].x, a2[5].x, a2[6].x, a2[7].x);
    pf[1] = pack8(a2[0].y, a2[1].y, a2[2].y, a2[3].y, a2[4].y, a2[5].y, a2[6].y, a2[7].y);
}

template <int MODE = 31>
__device__ __forceinline__ void sb_unit(const Params& P, LAS unsigned char* lds, const bf16* PROJ, const bf16* KVC, bf16* Y, int b, int h, int tqq) {
    int tid = threadIdx.x; asm volatile("" : "+v"(tid));
    const int lane = tid & 63, w = __builtin_amdgcn_readfirstlane(tid >> 6), c = lane & 15, q4 = lane >> 4;
    const int qbase = 256 * tqq + 32 * w;
    bf16x8 qf[2][4];
#pragma unroll
    for (int qt = 0; qt < 2; ++qt)
#pragma unroll
        for (int ks = 0; ks < 4; ++ks) qf[qt][ks] = *(const bf16x8*)(PROJ + (size_t)(b * SEQ + qbase + 16 * qt + c) * NP + C_QS + h * 128 + 32 * ks + 8 * q4);
#pragma unroll
    for (int qt = 0; qt < 2; ++qt)
#pragma unroll
        for (int ks = 0; ks < 4; ++ks) asm volatile("" : "+v"(qf[qt][ks]));
    f32x4 o[8][2];
#pragma unroll
    for (int dt = 0; dt < 8; ++dt) { o[dt][0] = (f32x4){0.f, 0.f, 0.f, 0.f}; o[dt][1] = (f32x4){0.f, 0.f, 0.f, 0.f}; }
    float R[2] = {0.f, 0.f};
#if SB_COMPACT
    const bf16* kg = KVC + (size_t)((b * 8 + h) * 4096) * 128; const bf16* vg = KVC + (size_t)((32 + b * 8 + h) * 4096) * 128;
    constexpr int KLD = 128;
#else
    const bf16* kg = PROJ + (size_t)(b * SEQ) * NP + C_KSB + h * 128; const bf16* vg = PROJ + (size_t)(b * SEQ) * NP + C_VSB + h * 128;
    constexpr int KLD = NP;
#endif
    const int nkt = 4 * tqq + 4;
    const bool isA = w < 4;
    if (isA && (MODE & 8)) { dma_k4(kg + (size_t)(nkt - 1) * 64 * KLD, KLD, lds, w, lane); dma_v4(vg + (size_t)(nkt - 1) * 64 * KLD, KLD, lds + 32768, w, lane); ATT_WAIT_V(0); }
    ATT_BAR();
    if (!isA) ATT_BAR();
    for (int it = 0; it < nkt; ++it) {
        const int kt64 = nkt - 1 - it, kb0 = 64 * kt64, cur = it & 1;
        const bool has = it + 1 < nkt, active = kb0 <= qbase + 30, need_mask = (kb0 + 63 >= qbase);
        const LAS unsigned char* kb = lds + cur * 16384; const LAS unsigned char* vb = lds + 32768 + cur * 16384;
        f32x4 s[2][4]; bf16x8 pf[2][2];
        if (isA && has && (MODE & 8)) dma_k4(kg + (size_t)(kt64 - 1) * 64 * KLD, KLD, lds + (cur ^ 1) * 16384, w, lane);
        if (active) {
            if (MODE & 1) qk_tile<false>(s, qf, kb, c, q4);
            else {
#pragma unroll
                for (int kt = 0; kt < 4; ++kt) { s[0][kt] = (f32x4){0.1f, -0.2f, 0.3f, R[0]}; s[1][kt] = (f32x4){-0.1f, 0.2f, -0.3f, R[1]}; asm volatile("" : "+v"(s[0][kt]), "+v"(s[1][kt])); } }
            if (MODE & 2) { if (need_mask) sb_elem<true>(s[0], R[0], pf[0], qbase + c - kb0 - 16 * q4, c, q4); else sb_elem<false>(s[0], R[0], pf[0], 64, c, q4); }
            else { pf[0][0] = __builtin_bit_cast(bf16x8, s[0][0]); pf[0][1] = __builtin_bit_cast(bf16x8, s[0][1]); R[0] += s[0][2][0] + s[0][3][1]; }
        }
        if (isA) { if (has) ATT_WAIT_V(4); else ATT_WAIT_V(0); }
        if (MODE & 16) ATT_BAR();
        if (isA && has && (MODE & 8)) dma_v4(vg + (size_t)(kt64 - 1) * 64 * KLD, KLD, lds + 32768 + (cur ^ 1) * 16384, w, lane);
        if (active) {
            VGroup vg0;
            if (MODE & 4) { pv_issue<0>(vg0, vb, c, q4); __builtin_amdgcn_sched_barrier(0); }
            if (MODE & 2) { if (need_mask) sb_elem<true>(s[1], R[1], pf[1], qbase + 16 + c - kb0 - 16 * q4, c, q4); else sb_elem<false>(s[1], R[1], pf[1], 64, c, q4); }
            else { pf[1][0] = __builtin_bit_cast(bf16x8, s[1][0]); pf[1][1] = __builtin_bit_cast(bf16x8, s[1][1]); R[1] += s[1][2][0] + s[1][3][1]; }
            if (MODE & 4) pv_tile_rest(o, vg0, pf, vb, c, q4);
            else { o[0][0] = o[0][0] + __builtin_bit_cast(f32x4, pf[0][0]) + __builtin_bit_cast(f32x4, pf[0][1]); o[0][1] = o[0][1] + __builtin_bit_cast(f32x4, pf[1][0]) + __builtin_bit_cast(f32x4, pf[1][1]); }
        }
        if (isA) { if (has) ATT_WAIT_V(4); else ATT_WAIT_V(0); }
        if (MODE & 16) ATT_BAR();
    }
    if (isA) ATT_BAR();
    f32x4 gsb[8];
#pragma unroll
    for (int dt = 0; dt < 8; ++dt) gsb[dt] = *(const f32x4*)(P.sb_on + h * 128 + 4 * q4 + 16 * dt);
#pragma unroll
    for (int qt = 0; qt < 2; ++qt) {
        float ss = 0.f;
#pragma unroll
        for (int dt = 0; dt < 8; ++dt) { const f32x4 v = o[dt][qt]; ss += (v[0] * v[0] + v[1] * v[1]) + (v[2] * v[2] + v[3] * v[3]); }
        ss += __shfl_xor(ss, 16); ss += __shfl_xor(ss, 32);
        const float r = rsqrtf(ss * (1.f / 128.f) + EPS);
        bf16* yrow = Y + (size_t)(b * SEQ + qbase + 16 * qt + c) * D + 1024 + h * 128 + 4 * q4;
#pragma unroll
        for (int dt = 0; dt < 8; ++dt) { const f32x4 v = o[dt][qt]; const f32x4 gg = gsb[dt];
            v2u wv; wv.x = cvt_pk_bf16(v[0] * r * gg[0], v[1] * r * gg[1]); wv.y = cvt_pk_bf16(v[2] * r * gg[2], v[3] * r * gg[3]);
            *(v2u*)(yrow + 16 * dt) = wv; }
    }
}

__device__ __forceinline__ void osm_step(const f32x4 (&s)[4], const bool bsel, const bool masked, const int lo, const int hi, float& m, float& l, f32x4 (&o)[8][2], const int qt, bf16x8 (&pf)[2]) {
    float v[16];
#pragma unroll
    for (int idx = 0; idx < 16; ++idx) v[idx] = s[idx >> 2][idx & 3];
    if (masked) {
#pragma unroll
        for (int idx = 0; idx < 16; ++idx) v[idx] = (idx >= lo && idx <= hi) ? v[idx] : -1e30f;
    }
    float tm = fmaxf(fmaxf(fmaxf(v[0], v[1]), fmaxf(v[2], v[3])), fmaxf(fmaxf(v[4], v[5]), fmaxf(v[6], v[7])));
    tm = fmaxf(tm, fmaxf(fmaxf(fmaxf(v[8], v[9]), fmaxf(v[10], v[11])), fmaxf(fmaxf(v[12], v[13]), fmaxf(v[14], v[15]))));
    tm = fmaxf(tm, __shfl_xor(tm, 16)); tm = fmaxf(tm, __shfl_xor(tm, 32));
    tm = bsel ? tm : -1e30f;
    const bool grow = tm > m + 8.0f;
    if (__any(grow)) {
        const float mn = grow ? tm : m, alpha = __builtin_amdgcn_exp2f(m - mn);
        l *= alpha; m = mn;
#pragma unroll
        for (int dt = 0; dt < 8; ++dt) o[dt][qt] = o[dt][qt] * alpha;
    }
    const float sub = bsel ? m : 1e30f;
    float sum = 0.f;
#pragma unroll
    for (int idx = 0; idx < 16; ++idx) { v[idx] = __builtin_amdgcn_exp2f(v[idx] - sub); sum += v[idx]; }
    l += sum;
    pf[0] = pack8(v[0], v[1], v[2], v[3], v[4], v[5], v[6], v[7]);
    pf[1] = pack8(v[8], v[9], v[10], v[11], v[12], v[13], v[14], v[15]);
}
#define ATT_TILE_PROLOGUE(KP, VP, LD) do { tile_load(tr, (KP), (VP), (LD), tid); __syncthreads(); tile_store(tr, lds, lds + 32768, tid); __syncthreads(); } while (0)
#define ATT_TILE_NEXT(HAS, KP, VP, LD) do { if (HAS) tile_load(tr, (KP), (VP), (LD), tid); } while (0)
#define ATT_TILE_END(HAS, CUR) do { if (HAS) tile_store(tr, lds + ((CUR) ^ 1) * 16384, lds + 32768 + ((CUR) ^ 1) * 16384, tid); __syncthreads(); } while (0)

__device__ __forceinline__ void nsa_unit(const Params& P, LAS unsigned char* lds, const bf16* PROJ, const bf16* KC, const bf16* VC, bf16* Y, f32x4* scr, int b, int g, int tq) {
    int tid = threadIdx.x; asm volatile("" : "+v"(tid));
    const int lane = tid & 63, w = __builtin_amdgcn_readfirstlane(tid >> 6), c = lane & 15, q4 = lane >> 4;
    const int bg = b * 2 + g, t0 = 64 * tq, hg = g * 4 + (c & 3);
    LAS float* pslc = (LAS float*)(lds + 131072);
    LAS unsigned long long* selm = (LAS unsigned long long*)(lds + 147456);
    LAS unsigned char* qb = lds + 65536 + w * 8192;
    scr += (size_t)w * 32 * 64;
    int ql[2]; ql[0] = 8 * w + (c >> 2); ql[1] = ql[0] + 4;
#pragma unroll
    for (int i = 0; i < 8; ++i) pslc[(8 * w + i) * 64 + lane] = 0.f;
    bf16x8 qf[2][4];
#pragma unroll
    for (int qt = 0; qt < 2; ++qt) {
        const bf16* prow = PROJ + (size_t)(b * SEQ + t0 + ql[qt]) * NP;
#pragma unroll
        for (int ks = 0; ks < 4; ++ks) qf[qt][ks] = *(const bf16x8*)(prow + C_QN + hg * 128 + 32 * ks + 8 * q4);
    }
#pragma unroll
    for (int qt = 0; qt < 2; ++qt)
#pragma unroll
        for (int ks = 0; ks < 4; ++ks) asm volatile("" : "+v"(qf[qt][ks]));
    float gates[2][3];
    {
        bf16 graw[2][3];
#pragma unroll
        for (int qt = 0; qt < 2; ++qt)
#pragma unroll
            for (int br = 0; br < 3; ++br) graw[qt][br] = PROJ[(size_t)(b * SEQ + t0 + ql[qt]) * NP + C_GATE + hg * 3 + br];
#pragma unroll
        for (int qt = 0; qt < 2; ++qt)
#pragma unroll
            for (int br = 0; br < 3; ++br) gates[qt][br] = 1.f / (1.f + __expf(-bf2f(graw[qt][br])));
    }
    TileRegs tr;
    f32x4 o[8][2];
    float mx[2], ls[2];
    const bf16* kcg = KC + (size_t)bg * 256 * 128; const bf16* vcg = VC + (size_t)bg * 256 * 128;
    const int nvmax = min(NCMP, 4 * tq + 3), ntc = (nvmax + 63) >> 6;
    mx[0] = mx[1] = -1e20f; ls[0] = ls[1] = 0.f;
    ATT_TILE_PROLOGUE(kcg, vcg, 128);
    for (int it = 0; it < ntc; ++it) {
        const int cur = it & 1; const bool has = it + 1 < ntc;
        ATT_TILE_NEXT(has, kcg + (size_t)(it + 1) * 64 * 128, vcg + (size_t)(it + 1) * 64 * 128, 128);
        {
            f32x4 s[2][4];
            qk_tile<false>(s, qf, lds + cur * 16384, c, q4);
#pragma unroll
            for (int qt = 0; qt < 2; ++qt) {
                const int lim = t0 + ql[qt] - 31 - 16 * (64 * it + 16 * q4);
                float tm = -1e30f, v[16];
#pragma unroll
                for (int kt = 0; kt < 4; ++kt)
#pragma unroll
                    for (int i = 0; i < 4; ++i) { v[4 * kt + i] = (16 * (4 * kt + i) <= lim) ? s[qt][kt][i] : -1e30f; tm = fmaxf(tm, v[4 * kt + i]); }
                tm = fmaxf(tm, __shfl_xor(tm, 16)); tm = fmaxf(tm, __shfl_xor(tm, 32));
                const float mn = fmaxf(mx[qt], tm); float sum = 0.f;
#pragma unroll
                for (int i = 0; i < 16; ++i) sum += __builtin_amdgcn_exp2f(v[i] - mn);
                ls[qt] = ls[qt] * __builtin_amdgcn_exp2f(mx[qt] - mn) + sum; mx[qt] = mn;
            }
        }
        ATT_TILE_END(has, cur);
    }
    float inv[2];
#pragma unroll
    for (int qt = 0; qt < 2; ++qt) { float l = ls[qt]; l += __shfl_xor(l, 16); l += __shfl_xor(l, 32); inv[qt] = l > 0.f ? 1.f / l : 0.f; }
    float g0v[2]; g0v[0] = gates[0][0]; g0v[1] = gates[1][0];
#pragma unroll
    for (int dt = 0; dt < 8; ++dt) { o[dt][0] = (f32x4){0.f, 0.f, 0.f, 0.f}; o[dt][1] = (f32x4){0.f, 0.f, 0.f, 0.f}; }
    ATT_TILE_PROLOGUE(kcg, vcg, 128);
    for (int it = 0; it < ntc; ++it) {
        const int cur = it & 1; const bool has = it + 1 < ntc;
        ATT_TILE_NEXT(has, kcg + (size_t)(it + 1) * 64 * 128, vcg + (size_t)(it + 1) * 64 * 128, 128);
        {
            f32x4 s[2][4];
            qk_tile<false>(s, qf, lds + cur * 16384, c, q4);
            bf16x8 pf[2][2];
#pragma unroll
            for (int qt = 0; qt < 2; ++qt) {
                const int lim = t0 + ql[qt] - 31 - 16 * (64 * it + 16 * q4);
                float p[16];
#pragma unroll
                for (int kt = 0; kt < 4; ++kt)
#pragma unroll
                    for (int i = 0; i < 4; ++i) p[4 * kt + i] = (16 * (4 * kt + i) <= lim) ? __builtin_amdgcn_exp2f(s[qt][kt][i] - mx[qt]) * inv[qt] : 0.f;
                const int jb = 16 * it + 4 * q4;
#pragma unroll
                for (int kt = 0; kt < 4; ++kt) {
                    float gs = (p[4 * kt] + p[4 * kt + 1]) + (p[4 * kt + 2] + p[4 * kt + 3]), e3 = p[4 * kt + 3];
                    gs += __shfl_xor(gs, 1); gs += __shfl_xor(gs, 2); e3 += __shfl_xor(e3, 1); e3 += __shfl_xor(e3, 2);
                    if ((c & 3) == 0) {
                        LAS float* row = pslc + ql[qt] * 64;
                        __hip_atomic_fetch_add(row + jb + kt, gs, __ATOMIC_RELAXED, __HIP_MEMORY_SCOPE_WORKGROUP);
                        if (jb + kt + 1 < 64) __hip_atomic_fetch_add(row + jb + kt + 1, e3, __ATOMIC_RELAXED, __HIP_MEMORY_SCOPE_WORKGROUP);
                    }
                }
                const float g0 = g0v[qt];
                pf[qt][0] = pack8(p[0] * g0, p[1] * g0, p[2] * g0, p[3] * g0, p[4] * g0, p[5] * g0, p[6] * g0, p[7] * g0);
                pf[qt][1] = pack8(p[8] * g0, p[9] * g0, p[10] * g0, p[11] * g0, p[12] * g0, p[13] * g0, p[14] * g0, p[15] * g0);
            }
            pv_tile(o, pf, lds + 32768 + cur * 16384, c, q4);
        }
        ATT_TILE_END(has, cur);
    }
#pragma unroll
    for (int dt = 0; dt < 8; ++dt) { scr[lane * 32 + 2 * dt] = o[dt][0]; scr[lane * 32 + 2 * dt + 1] = o[dt][1]; }
    asm volatile("s_waitcnt lgkmcnt(0)" ::: "memory");
    {
        unsigned long long wor = 0ull;
        const int j = lane;
        const bool causal = j <= tq, forced = (j == 0) || (j == tq) || (j == tq - 1);
        const unsigned long long cmask = __ballot(causal);
        for (int i = 0; i < 8; ++i) {
            const float pv = pslc[(8 * w + i) * 64 + j];
            const unsigned key = causal ? (forced ? 0xFFFFFFFFu : __float_as_uint(pv) + 1u) : 0u;
            unsigned T = 0u;
#pragma unroll
            for (int bit = 31; bit >= 0; --bit) { const unsigned cand = T | (1u << bit); if (__popcll(__ballot(key >= cand)) >= 16) T = cand; }
            const unsigned long long gt = __ballot(key > T); unsigned long long eq = __ballot(key == T), take = 0ull;
            for (int need = 16 - __popcll(gt); need > 0 && eq != 0ull; --need) { const unsigned long long low = eq & (~eq + 1ull); take |= low; eq ^= low; }
            const unsigned long long mask = (gt | take) & cmask;
            if (lane == 0) selm[8 * w + i] = mask;
            wor |= mask;
        }
        if (lane == 0) selm[64 + w] = wor;
    }
    __syncthreads();
    unsigned long long uni = 0ull;
#pragma unroll
    for (int i = 0; i < 8; ++i) uni |= selm[64 + i];
    uni = ((unsigned long long)__builtin_amdgcn_readfirstlane((unsigned)(uni >> 32)) << 32) | (unsigned long long)__builtin_amdgcn_readfirstlane((unsigned)uni);
    {
#pragma unroll
        for (int dt = 0; dt < 8; ++dt) { o[dt][0] = (f32x4){0.f, 0.f, 0.f, 0.f}; o[dt][1] = (f32x4){0.f, 0.f, 0.f, 0.f}; }
        mx[0] = mx[1] = -1e20f; ls[0] = ls[1] = 0.f;
        const bf16* kg = PROJ + (size_t)(b * SEQ) * NP + C_KS + g * 128; const bf16* vg = PROJ + (size_t)(b * SEQ) * NP + C_VS + g * 128;
        unsigned long long rem = uni;
        int j = __builtin_ctzll(rem); rem &= rem - 1ull;
        ATT_TILE_PROLOGUE(kg + (size_t)j * 64 * NP, vg + (size_t)j * 64 * NP, NP);
        for (int it = 0;; ++it) {
            const int cur = it & 1; const bool has = rem != 0ull;
            const int jn = has ? __builtin_ctzll(rem) : 0; rem &= rem - 1ull;
            ATT_TILE_NEXT(has, kg + (size_t)jn * 64 * NP, vg + (size_t)jn * 64 * NP, NP);
            const bool b0 = (selm[ql[0]] >> j) & 1ull, b1 = (selm[ql[1]] >> j) & 1ull;
            if (__ballot(b0 || b1) != 0ull) {
                f32x4 s[2][4];
                qk_tile<false>(s, qf, lds + cur * 16384, c, q4);
                bf16x8 pf[2][2];
                osm_step(s[0], b0, j == tq, -64, ql[0] - 16 * q4, mx[0], ls[0], o, 0, pf[0]);
                osm_step(s[1], b1, j == tq, -64, ql[1] - 16 * q4, mx[1], ls[1], o, 1, pf[1]);
                pv_tile(o, pf, lds + 32768 + cur * 16384, c, q4);
            }
            ATT_TILE_END(has, cur);
            if (!has) break;
            j = jn;
        }
#pragma unroll
        for (int qt = 0; qt < 2; ++qt) {
            float l = ls[qt]; l += __shfl_xor(l, 16); l += __shfl_xor(l, 32);
            const float cb = gates[qt][1] / l;
#pragma unroll
            for (int dt = 0; dt < 8; ++dt) scr[lane * 32 + 16 + 2 * dt + qt] = o[dt][qt] * cb;
        }
    }
    {
#pragma unroll
        for (int dt = 0; dt < 8; ++dt) { o[dt][0] = (f32x4){0.f, 0.f, 0.f, 0.f}; o[dt][1] = (f32x4){0.f, 0.f, 0.f, 0.f}; }
        mx[0] = mx[1] = -1e20f; ls[0] = ls[1] = 0.f;
        const bf16* kg = PROJ + (size_t)(b * SEQ) * NP + C_KW + g * 128; const bf16* vg = PROJ + (size_t)(b * SEQ) * NP + C_VW + g * 128;
        const int k0 = max(0, tq - 8), nw = tq - k0 + 1;
        ATT_TILE_PROLOGUE(kg + (size_t)k0 * 64 * NP, vg + (size_t)k0 * 64 * NP, NP);
        for (int it = 0; it < nw; ++it) {
            const int cur = it & 1, kt64 = k0 + it; const bool has = it + 1 < nw;
            ATT_TILE_NEXT(has, kg + (size_t)(kt64 + 1) * 64 * NP, vg + (size_t)(kt64 + 1) * 64 * NP, NP);
            {
                f32x4 s[2][4];
                qk_tile<false>(s, qf, lds + cur * 16384, c, q4);
                bf16x8 pf[2][2];
                {
                    const int d0 = ql[0] - 16 * q4, d1 = ql[1] - 16 * q4;
                    const bool first = (kt64 == tq - 8), edge = first || (kt64 == tq);
                    osm_step(s[0], true, edge, first ? d0 + 1 : -64, first ? 64 : d0, mx[0], ls[0], o, 0, pf[0]);
                    osm_step(s[1], true, edge, first ? d1 + 1 : -64, first ? 64 : d1, mx[1], ls[1], o, 1, pf[1]);
                }
                pv_tile(o, pf, lds + 32768 + cur * 16384, c, q4);
            }
            ATT_TILE_END(has, cur);
        }
    }
    f32x4 gns[8];
#pragma unroll
    for (int dt = 0; dt < 8; ++dt) gns[dt] = *(const f32x4*)(P.nsa_on + hg * 128 + 4 * q4 + 16 * dt);
#pragma unroll
    for (int qt = 0; qt < 2; ++qt) {
        float l = ls[qt]; l += __shfl_xor(l, 16); l += __shfl_xor(l, 32);
        const float cb = gates[qt][2] / l;
        float ss = 0.f;
#pragma unroll
        for (int dt = 0; dt < 8; ++dt) { const f32x4 a = (scr[lane * 32 + 2 * dt + qt] + scr[lane * 32 + 16 + 2 * dt + qt]) + o[dt][qt] * cb; o[dt][qt] = a; ss += (a[0] * a[0] + a[1] * a[1]) + (a[2] * a[2] + a[3] * a[3]); if ((dt & 3) == 3) __builtin_amdgcn_sched_barrier(0); }
        ss += __shfl_xor(ss, 16); ss += __shfl_xor(ss, 32);
        const float r = rsqrtf(ss * (1.f / 128.f) + EPS);
        bf16* yrow = Y + (size_t)(b * SEQ + t0 + ql[qt]) * D + hg * 128 + 4 * q4;
#pragma unroll
        for (int dt = 0; dt < 8; ++dt) { const f32x4 v = o[dt][qt]; const f32x4 gg = gns[dt];
            v2u wv; wv.x = cvt_pk_bf16(v[0] * r * gg[0], v[1] * r * gg[1]); wv.y = cvt_pk_bf16(v[2] * r * gg[2], v[3] * r * gg[3]);
            *(v2u*)(yrow + 16 * dt) = wv; if (dt & 1) __builtin_amdgcn_sched_barrier(0); }
    }
    __syncthreads();
}
__device__ __forceinline__ void nsa_phase(const Params& P, LAS unsigned char* lds, const bf16* PROJ, const bf16* KC, const bf16* VC, bf16* Y, f32x4* scratch) {
    for (int i = blockIdx.x; i < 512; i += gridDim.x) {
        const int u = (i < 256) ? i : 767 - i;
        const int tq = 63 - (u >> 3), bg = u & 7;
        nsa_unit(P, lds, PROJ, KC, VC, Y, scratch + (size_t)blockIdx.x * 16384, bg >> 1, bg & 1, tq);
    }
}

__device__ __forceinline__ void compress_unit(const Params& P, LAS unsigned char* lds, const bf16* PROJ, const float* cs, const float* sn, bf16* KC, bf16* VC, int which, int bg, int n0) {
    int tid = threadIdx.x; asm volatile("" : "+v"(tid));
    const int lane = tid & 63, w = __builtin_amdgcn_readfirstlane(tid >> 6), c = lane & 15, q4 = lane >> 4;
    const int b = bg >> 1, g = bg & 1, col = (which ? C_VC : C_KC) + g * 128;
    constexpr int XS = 272;
    __syncthreads();
    for (int i = tid; i < 272 * 8; i += NTHREADS) {
        const int tk = i >> 3, ch = i & 7, s = 16 * n0 + tk;
        v4u lo = (v4u){0u, 0u, 0u, 0u}, hi = (v4u){0u, 0u, 0u, 0u};
        if (s < SEQ) {
            const int m = b * SEQ + s;
            lo = *(const v4u*)(PROJ + (size_t)m * NP + col + 8 * ch); hi = *(const v4u*)(PROJ + (size_t)m * NP + col + 64 + 8 * ch);
            if (!which) {
                const f32x4 c0 = *(const f32x4*)(cs + m * 64 + 8 * ch), c1 = *(const f32x4*)(cs + m * 64 + 8 * ch + 4), s0 = *(const f32x4*)(sn + m * 64 + 8 * ch), s1 = *(const f32x4*)(sn + m * 64 + 8 * ch + 4);
                float a[8], d[8];
                a[0] = bflo(lo.x); a[1] = bfhi(lo.x); a[2] = bflo(lo.y); a[3] = bfhi(lo.y); a[4] = bflo(lo.z); a[5] = bfhi(lo.z); a[6] = bflo(lo.w); a[7] = bfhi(lo.w);
                d[0] = bflo(hi.x); d[1] = bfhi(hi.x); d[2] = bflo(hi.y); d[3] = bfhi(hi.y); d[4] = bflo(hi.z); d[5] = bfhi(hi.z); d[6] = bflo(hi.w); d[7] = bfhi(hi.w);
                float ra[8], rd[8];
#pragma unroll
                for (int e = 0; e < 8; ++e) { const float cc = e < 4 ? c0[e] : c1[e - 4], ss = e < 4 ? s0[e] : s1[e - 4]; ra[e] = a[e] * cc - d[e] * ss; rd[e] = d[e] * cc + a[e] * ss; }
                lo.x = cvt_pk_bf16(ra[0], ra[1]); lo.y = cvt_pk_bf16(ra[2], ra[3]); lo.z = cvt_pk_bf16(ra[4], ra[5]); lo.w = cvt_pk_bf16(ra[6], ra[7]);
                hi.x = cvt_pk_bf16(rd[0], rd[1]); hi.y = cvt_pk_bf16(rd[2], rd[3]); hi.z = cvt_pk_bf16(rd[4], rd[5]); hi.w = cvt_pk_bf16(rd[6], rd[7]);
            }
        }
        *(LAS v4u*)(lds + tk * XS + 16 * ch) = lo; *(LAS v4u*)(lds + tk * XS + 128 + 16 * ch) = hi;
    }
    __syncthreads();
    const bf16* w1t = (const bf16*)(P.ws + (which ? WS_WC1V : WS_WC1K)) + (size_t)(32 * w + c) * 4096 + 8 * q4;
    f32x4 h0 = (f32x4){0.f, 0.f, 0.f, 0.f}, h1 = (f32x4){0.f, 0.f, 0.f, 0.f};
    const LAS unsigned char* xb = lds + (16 * c) * XS + 16 * q4;
#pragma unroll 16
    for (int ks = 0; ks < 128; ++ks) {
        const bf16x8 xf = *(const LAS bf16x8*)(xb + (ks >> 2) * XS + (ks & 3) * 64);
        const bf16x8 a0 = *(const bf16x8*)(w1t + 32 * ks), a1 = *(const bf16x8*)(w1t + 16 * 4096 + 32 * ks);
        h0 = __builtin_amdgcn_mfma_f32_16x16x32_bf16(a0, xf, h0, 0, 0, 0);
        h1 = __builtin_amdgcn_mfma_f32_16x16x32_bf16(a1, xf, h1, 0, 0, 0);
    }
    const float* pb = (const float*)(P.ws + WS_PBIAS + 65536) + which * 256 + 32 * w + 4 * q4;
    const f32x4 pb0 = *(const f32x4*)pb, pb1 = *(const f32x4*)(pb + 16);
    const bf16x8 hf = pack8(gelu_tanh(h0[0] + pb0[0]), gelu_tanh(h0[1] + pb0[1]), gelu_tanh(h0[2] + pb0[2]), gelu_tanh(h0[3] + pb0[3]),
                            gelu_tanh(h1[0] + pb1[0]), gelu_tanh(h1[1] + pb1[1]), gelu_tanh(h1[2] + pb1[2]), gelu_tanh(h1[3] + pb1[3]));
    const bf16* w2t = (const bf16*)(P.ws + (which ? WS_WC2V : WS_WC2K)) + (size_t)c * 256 + 32 * w + 4 * q4;
    __syncthreads();
    LAS float* part = (LAS float*)lds;
#pragma unroll
    for (int dt = 0; dt < 8; ++dt) {
        const v2u wa = *(const v2u*)(w2t + (size_t)(16 * dt) * 256), wb = *(const v2u*)(w2t + (size_t)(16 * dt) * 256 + 16);
        v4u wv; wv.x = wa.x; wv.y = wa.y; wv.z = wb.x; wv.w = wb.y;
        const f32x4 oa = __builtin_amdgcn_mfma_f32_16x16x32_bf16(__builtin_bit_cast(bf16x8, wv), hf, (f32x4){0.f, 0.f, 0.f, 0.f}, 0, 0, 0);
        *(LAS f32x4*)(part + (w * 16 + c) * 128 + 16 * dt + 4 * q4) = oa;
    }
    __syncthreads();
#pragma unroll
    for (int r = 0; r < 2; ++r) {
        const int n = 2 * w + r;
        float a = 0.f, d = 0.f;
#pragma unroll
        for (int ww = 0; ww < 8; ++ww) { a += part[(ww * 16 + n) * 128 + lane]; d += part[(ww * 16 + n) * 128 + 64 + lane]; }
        if (!which) { const float rr = rsqrtf(wave_sum(a * a + d * d) * (1.f / 128.f) + EPS); a = a * rr * P.kc_norm[lane]; d = d * rr * P.kc_norm[lane + 64]; }
        bf16* op = (which ? VC : KC) + ((size_t)bg * 256 + n0 + n) * 128;
        if (n0 + n < NCMP) { op[lane] = (bf16)f2bf(a); op[lane + 64] = (bf16)f2bf(d); } else { op[lane] = 0; op[lane + 64] = 0; }
    }
}
__device__ __forceinline__ void compress_phase(const Params& P, LAS unsigned char* lds, const bf16* PROJ, const float* cs, const float* sn, bf16* KC, bf16* VC) {
    for (int u = blockIdx.x; u < 256; u += gridDim.x) compress_unit(P, lds, PROJ, cs, sn, KC, VC, u >> 7, (u >> 4) & 7, (u & 15) * 16);
    __syncthreads();
}
template <int MODE = 31>
__device__ __forceinline__ void sb_phase(const Params& P, LAS unsigned char* lds, const bf16* PROJ, const bf16* KVC, bf16* Y) {
    for (int i = blockIdx.x; i < 512; i += gridDim.x) {
        const int u = (i < 256) ? i : 767 - i;
        const int tqq = 15 - (u >> 5), bh = u & 31;
        sb_unit<MODE>(P, lds, PROJ, KVC, Y, bh >> 3, bh & 7, tqq);
    }
}
}

template <bool F8 = false, class RowFn>
__device__ __forceinline__ void transpose_item(const float* W, int K, int N, bf16* WT, RowFn rowfn, LAS float* scr, int item, int lane, const float* kscale = nullptr) {
    const int nblk = (N + 63) / 64, kb = item / nblk, nb = item % nblk, k0 = 64 * kb, n0 = 64 * nb;
    const int nn = n0 + 4 * (lane & 15), kr = lane >> 4;
    f32x4 v[16];
#pragma unroll
    for (int i = 0; i < 16; ++i) v[i] = nn < N ? __builtin_nontemporal_load((const f32x4*)(W + (size_t)(k0 + 4 * i + kr) * N + nn)) : (f32x4){0.f, 0.f, 0.f, 0.f};
#pragma unroll
    for (int i = 0; i < 16; ++i) { if (kscale) v[i] = v[i] * kscale[k0 + 4 * i + kr];
        if (F8) v[i] = v[i] * pg8::F8_WSCALE;
        LAS float* d = scr + (4 * i + kr) * 65 + 4 * (lane & 15); d[0] = v[i][0]; d[1] = v[i][1]; d[2] = v[i][2]; d[3] = v[i][3]; }
    asm volatile("s_waitcnt lgkmcnt(0)" ::: "memory");
    const int c = lane & 7;
#pragma unroll
    for (int jj = 0; jj < 8; ++jj) { const int n = (lane >> 3) + 8 * jj; const LAS float* s = scr + (8 * c) * 65 + n;
        if constexpr (F8) { v2u o; o.x = pg8::pk4_fp8(s[0 * 65], s[1 * 65], s[2 * 65], s[3 * 65]); o.y = pg8::pk4_fp8(s[4 * 65], s[5 * 65], s[6 * 65], s[7 * 65]);
            if (n0 + n < N) *(v2u*)((unsigned char*)WT + (size_t)rowfn(n0 + n) * K + k0 + 8 * c) = o; }
        else {
        v4u o; o.x = pk2(s[0 * 65], s[1 * 65]); o.y = pk2(s[2 * 65], s[3 * 65]); o.z = pk2(s[4 * 65], s[5 * 65]); o.w = pk2(s[6 * 65], s[7 * 65]);
        if (n0 + n < N) *(v4u*)(WT + (size_t)rowfn(n0 + n) * K + k0 + 8 * c) = o; } }
    asm volatile("s_waitcnt lgkmcnt(0)" ::: "memory");
}
__device__ __forceinline__ int row_gate(int n) { return (n >> 7) * 256 + (n & 127); }
__device__ __forceinline__ int row_up(int n) { return (n >> 7) * 256 + 128 + (n & 127); }
__device__ __forceinline__ int row_id(int n) { return n; }
__device__ __forceinline__ int row_win(int oc) { return oc < 2560 ? oc : (oc < 2584 ? oc - 2560 + C_GATE : oc - 24); }
constexpr int CW_I_GU = (D / 64) * (FF / 64), CW_I_IN = (D / 64) * ((IN_COLS + 63) / 64), CW_I_OUT = (D / 64) * (D / 64), CW_I_C1 = (4096 / 64) * (256 / 64), CW_I_C2 = (256 / 64) * (128 / 64);
constexpr int CW_EARLY = 3 * CW_I_GU + CW_I_IN + CW_I_OUT + 2 * CW_I_C1 + 2 * CW_I_C2, CW_ITEMS = CW_EARLY + 3 * CW_I_GU;
__device__ __forceinline__ void convert_items(const Params& P, LAS unsigned char* lds, int lo, int hi, int gw, int NGW) {
    unsigned char* ws = P.ws;
    int tid = threadIdx.x; asm volatile("" : "+v"(tid));
    const int lane = tid & 63, wave = tid >> 6;
    LAS float* scr = (LAS float*)(lds + wave * 16640);
    constexpr int I_GU = CW_I_GU, I_DN = CW_I_GU, I_IN = CW_I_IN, I_OUT = CW_I_OUT, I_C1 = CW_I_C1, I_C2 = CW_I_C2;
    for (int it = lo + gw; it < hi; it += NGW) {
        int r = it;
        if (r < I_GU) { transpose_item<FFN1_FP8 != 0>(P.ffn1_wg, D, FF, (bf16*)(ws + WS_W1GU), row_gate, scr, r, lane, FOLD_GAINS ? P.ffn1_norm : nullptr); continue; } r -= I_GU;
        if (r < I_GU) { transpose_item<FFN1_FP8 != 0>(P.ffn1_wu, D, FF, (bf16*)(ws + WS_W1GU), row_up, scr, r, lane, FOLD_GAINS ? P.ffn1_norm : nullptr); continue; } r -= I_GU;
        if (r < I_DN) { transpose_item<FFN1_FP8 == 2>(P.ffn1_wd, FF, D, (bf16*)(ws + WS_W1D), row_id, scr, r, lane); continue; } r -= I_DN;
        if (r < I_IN) { transpose_item(P.w_in, D, IN_COLS, (bf16*)(ws + WS_WIN), row_win, scr, r, lane, FOLD_GAINS ? P.mix_norm : nullptr); continue; } r -= I_IN;
        if (r < I_OUT) { transpose_item(P.w_out, D, D, (bf16*)(ws + WS_WOUT), row_id, scr, r, lane); continue; } r -= I_OUT;
        if (r < I_C1) { transpose_item(P.ck_w1, 4096, 256, (bf16*)(ws + WS_WC1K), row_id, scr, r, lane); continue; } r -= I_C1;
        if (r < I_C1) { transpose_item(P.cv_w1, 4096, 256, (bf16*)(ws + WS_WC1V), row_id, scr, r, lane); continue; } r -= I_C1;
        if (r < I_C2) { transpose_item(P.ck_w2, 256, 128, (bf16*)(ws + WS_WC2K), row_id, scr, r, lane); continue; } r -= I_C2;
        if (r < I_C2) { transpose_item(P.cv_w2, 256, 128, (bf16*)(ws + WS_WC2V), row_id, scr, r, lane); continue; } r -= I_C2;
        if (r < I_GU) { transpose_item<FFN2_FP8 != 0>(P.ffn2_wg, D, FF, (bf16*)(ws + WS_W2GU), row_gate, scr, r, lane, FOLD_GAINS ? P.ffn2_norm : nullptr); continue; } r -= I_GU;
        if (r < I_GU) { transpose_item<FFN2_FP8 != 0>(P.ffn2_wu, D, FF, (bf16*)(ws + WS_W2GU), row_up, scr, r, lane, FOLD_GAINS ? P.ffn2_norm : nullptr); continue; } r -= I_GU;
        transpose_item<FFN2_FP8 != 0>(P.ffn2_wd, FF, D, (bf16*)(ws + WS_W2D), row_id, scr, r, lane);
    }
}
__device__ __forceinline__ void convert_weights(const Params& P, LAS unsigned char* lds) {
    unsigned char* ws = P.ws;
    convert_items(P, lds, 0, TAIL_CONVERT ? CW_EARLY : CW_ITEMS, blockIdx.x * NWAVES + (threadIdx.x >> 6), gridDim.x * NWAVES);
    if (blockIdx.x < 32) {
        const int which = blockIdx.x >> 4, part = (blockIdx.x & 15) * 2 + (threadIdx.x >> 8), j = threadIdx.x & 255;
        const float* pos = which ? P.cv_pos : P.ck_pos; const float* w1 = which ? P.cv_w1 : P.ck_w1;
        float a = 0.f;
#pragma unroll 32
        for (int k = 128 * part; k < 128 * part + 128; ++k) a += pos[k] * w1[(size_t)k * 256 + j];
        ((float*)(ws + WS_PBIAS))[(which * 32 + part) * 256 + j] = a;
    }
    { v4u* z = (v4u*)((bf16*)(ws + WS_WIN) + (size_t)IN_COLS * D); const int n16 = (NP - IN_COLS) * D / 8;
      for (int i = blockIdx.x * NTHREADS + threadIdx.x; i < n16; i += gridDim.x * NTHREADS) z[i] = (v4u){0u, 0u, 0u, 0u}; }
}

__global__ void __launch_bounds__(NTHREADS, 2) fwd_kernel(Params P) {
    extern __shared__ __attribute__((aligned(16))) unsigned char lds_raw[];
    LAS unsigned char* lds = (LAS unsigned char*)lds_raw;
    const int tid = threadIdx.x;
    for (int u = tid; u < (LDS_BYTES - LDSCTL_OFF) / 4; u += NTHREADS) ((LAS unsigned*)(lds + LDSCTL_OFF))[u] = 0u;
    __syncthreads();
    unsigned char* ws = P.ws;
    XcdBarrier bar = xcd_barrier_post((unsigned*)(ws + WS_CTL) + CW_BAR, (volatile LAS unsigned*)(lds + LDSCTL_OFF + 64));
    bf16* HB = (bf16*)(ws + WS_HB); bf16* BIG = (bf16*)(ws + WS_BIG);
    float* cs = (float*)(ws + WS_COS); float* sn = (float*)(ws + WS_SIN);
    bf16* KC = (bf16*)(ws + WS_KC); bf16* VC = (bf16*)(ws + WS_VC);
    float* XR = P.out;
    bf16* X1B = (bf16*)P.out;
    bf16* X2B = (bf16*)(ws + WS_W1GU);
    unsigned char* X0F8 = ws + WS_SCR + ((size_t)32 << 20);
    unsigned char* X2F8 = ws + WS_SCR;
    float* PART = (float*)(ws + WS_PART);
    float* PART2 = (float*)(ws + WS_PART + (size_t)M * 8);
    float* PART0 = (float*)(ws + WS_PART + (size_t)M * 16);
    PG8_LAS float* RS = (PG8_LAS float*)(lds + 131072);

#define REP(n) _Pragma("unroll") for (int rep_ = 0; rep_ < (n); ++rep_)
#if FOLD_GAINS
    REP(REP_P0) { rope_tables(P.pos, cs, sn); cast_rows(P.x, HB, (unsigned long long*)PART0, FFN1_FP8 ? X0F8 : nullptr); convert_weights(P, lds); }
#else
    REP(REP_P0) { rope_tables(P.pos, cs, sn); rmsnorm_rows(P.x, P.ffn1_norm, HB); convert_weights(P, lds); }
#endif
#if FUSE_NORMS || FOLD_GAINS
    for (int i = blockIdx.x * NTHREADS + tid; i < 2 * M; i += gridDim.x * NTHREADS) ((unsigned long long*)PART)[i] = 0ull;
#endif
    xcd_barrier(bar);
#if PROBE_P1K
    for (int pass = 0; pass < 2; ++pass) {
        pg8::Gemm g{HB, (const bf16*)(ws + WS_W1GU), M, 2 * FF, D, pass == 0 ? (PROBE_P1K >= 4 ? PROBE_P1K - 4 : PROBE_P1K - 1) : 0}; pg8::StaticOrder S; S.init(M, 2 * FF, gridDim.x, (int)blockIdx.x); S.zero = (pass == 0 && PROBE_P1K >= 4);
        if (FOLD_GAINS) pg8::row_factor_table(RS, PART0, S);
        pg8::EpiSwiglu E{BIG, FF, FOLD_GAINS ? PART0 : nullptr, RS};
        pg8::gemm_phase<pg8::EpiSwiglu, pg8::StaticOrder, true, true>(lds, g, S, E);
        if (pass == 0) xcd_barrier(bar);
    }
#else
    REP(REP_P1) {
#if FFN1_FP8
        pg8::Gemm g{(const bf16*)X0F8, (const bf16*)(ws + WS_W1GU), M, 2 * FF, D / 2}; pg8::StaticOrder S; S.init(M, 2 * FF, gridDim.x, (int)blockIdx.x);
        pg8::row_factor_table(RS, PART0, S);
        pg8::EpiSwigluT<true, FFN1_FP8 == 2> E{BIG, FF, PART0, RS};
        pg8::gemm_phase<pg8::EpiSwigluT<true, FFN1_FP8 == 2>, pg8::StaticOrder, true, true, true>(lds, g, S, E);
#else
        pg8::Gemm g{HB, (const bf16*)(ws + WS_W1GU), M, 2 * FF, D}; pg8::StaticOrder S; S.init(M, 2 * FF, gridDim.x, (int)blockIdx.x);
        if (FOLD_GAINS) pg8::row_factor_table(RS, PART0, S);
        pg8::EpiSwiglu E{BIG, FF, FOLD_GAINS ? PART0 : nullptr, RS};
        pg8::gemm_phase<pg8::EpiSwiglu, pg8::StaticOrder, true, true>(lds, g, S, E);
#endif
    }
#endif
    xcd_barrier(bar);
    REP(REP_P2) {
        pg8::Gemm g{BIG, (const bf16*)(ws + WS_W1D), M, D, FFN1_FP8 == 2 ? FF / 2 : FF}; pg8::StaticOrder S; S.init(M, D, gridDim.x, (int)blockIdx.x);
#if FUSE_NORMS
        pg8::EpiResid E{P.x, XR, D, 0.5f, HB, P.mix_norm, PART};
#else
        pg8::EpiResidMix<FOLD_GAINS != 0, true> E{FOLD_GAINS ? (const void*)HB : (const void*)P.x, X1B, D, FFN1_FP8 == 2 ? 0.5f / (pg8::F8_WSCALE * pg8::F8_HSCALE) : 0.5f, FOLD_GAINS ? (unsigned long long*)PART : nullptr};
#endif
        pg8::gemm_phase<pg8::EpiResidMix<FOLD_GAINS != 0, true>, pg8::StaticOrder, true, true, FFN1_FP8 == 2>(lds, g, S, E);
    }
    xcd_barrier(bar);
    if (blockIdx.x == gridDim.x - 1) { const float* pp = (const float*)(ws + WS_PBIAS); const int which = tid >> 8, j = tid & 255; float t[32];
#pragma unroll
        for (int part = 0; part < 32; ++part) t[part] = pp[(which * 32 + part) * 256 + j];
        float a = 0.f;
#pragma unroll
        for (int part = 0; part < 32; ++part) a += t[part];
        ((float*)(ws + WS_PBIAS + 65536))[tid] = a; }
#if !FUSE_NORMS && !FOLD_GAINS
    rmsnorm_rows_bf16(X1B, P.mix_norm, HB);
    xcd_barrier(bar);
#endif
    REP(REP_P4) {
        pg8::Gemm g{FOLD_GAINS ? (const bf16*)X1B : (const bf16*)HB, (const bf16*)(ws + WS_WIN), M, NP, D}; pg8::StaticOrder S; S.init(M, NP, gridDim.x, (int)blockIdx.x);
        if (FUSE_NORMS || FOLD_GAINS) pg8::row_factor_table(RS, PART, S);
        pg8::EpiStoreBf16 E{BIG, NP, C_QS / 256, (C_QS + 1024) / 256, att::C1, (FUSE_NORMS || FOLD_GAINS) ? PART : nullptr, RS, (bf16*)(ws + WS_W1GU), SB_COMPACT ? C_KSB / 256 : 0, SB_COMPACT ? (C_VSB + 1024) / 256 : 0};
        pg8::gemm_phase<pg8::EpiStoreBf16, pg8::StaticOrder, true, true>(lds, g, S, E);
#if TAIL_CONVERT
        {
            const int G = (int)gridDim.x, rem = S.nwg % G;
            if (rem == 0) convert_items(P, lds, CW_EARLY, CW_ITEMS, (int)blockIdx.x * NWAVES + (tid >> 6), G * NWAVES);
            else if ((int)blockIdx.x >= rem) convert_items(P, lds, CW_EARLY, CW_ITEMS, ((int)blockIdx.x - rem) * NWAVES + (tid >> 6), (G - rem) * NWAVES);
        }
#endif
    }
    xcd_barrier(bar);
    postproj_naive(P, BIG, cs, sn);
    REP(REP_CMP) att::compress_phase(P, lds, BIG, cs, sn, KC, VC);
    xcd_barrier(bar);
    REP(REP_NSA) att::nsa_phase(P, lds, BIG, KC, VC, HB, (f32x4*)(ws + WS_SCR));
    REP(REP_SB) att::sb_phase(P, lds, BIG, (const bf16*)(ws + WS_W1GU), HB);
    xcd_barrier(bar);
    {
        pg8::Gemm g{HB, (const bf16*)(ws + WS_WOUT), M, D, D}; pg8::StaticOrder S; S.init(M, D, gridDim.x, (int)blockIdx.x);
#if FUSE_NORMS
        pg8::EpiResid E{XR, XR, D, 1.0f, (bf16*)(ws + WS_W1GU), P.ffn2_norm, PART2};
#else
        pg8::EpiResidMix<true, true> E{X1B, X2B, D, 1.0f, FOLD_GAINS ? (unsigned long long*)PART2 : nullptr, FFN2_FP8 ? X2F8 : nullptr};
#endif
        pg8::gemm_phase<pg8::EpiResidMix<true, true>, pg8::StaticOrder, true, true>(lds, g, S, E);
    }
    xcd_barrier(bar);
#if !FUSE_NORMS && !FOLD_GAINS
    rmsnorm_rows_bf16(X2B, P.ffn2_norm, HB);
    xcd_barrier(bar);
#endif
    {
#if FFN2_FP8
        pg8::Gemm g{(const bf16*)X2F8, (const bf16*)(ws + WS_W2GU), M, 2 * FF, D / 2}; pg8::StaticOrder S; S.init(M, 2 * FF, gridDim.x, (int)blockIdx.x);
        pg8::row_factor_table(RS, PART2, S);
        pg8::EpiSwigluT<true> E{BIG, FF, PART2, RS};
        pg8::gemm_phase<pg8::EpiSwigluT<true>, pg8::StaticOrder, true, true, true>(lds, g, S, E);
#else
        pg8::Gemm g{(FUSE_NORMS || FOLD_GAINS) ? (const bf16*)(ws + WS_W1GU) : (const bf16*)HB, (const bf16*)(ws + WS_W2GU), M, 2 * FF, D}; pg8::StaticOrder S; S.init(M, 2 * FF, gridDim.x, (int)blockIdx.x);
        if (FUSE_NORMS || FOLD_GAINS) pg8::row_factor_table(RS, PART2, S);
        pg8::EpiSwiglu E{BIG, FF, (FUSE_NORMS || FOLD_GAINS) ? PART2 : nullptr, RS};
        pg8::gemm_phase<pg8::EpiSwiglu, pg8::StaticOrder, true, true>(lds, g, S, E);
#endif
    }
    xcd_barrier(bar);
    {
#if FFN2_FP8
        pg8::Gemm g{BIG, (const bf16*)(ws + WS_W2D), M, D, FF / 2}; pg8::StaticOrder S; S.init(M, D, gridDim.x, (int)blockIdx.x);
        pg8::EpiResidMix<true, false> E{X2B, XR, D, 0.5f / (pg8::F8_WSCALE * pg8::F8_HSCALE), nullptr};
        pg8::gemm_phase<pg8::EpiResidMix<true, false>, pg8::StaticOrder, true, true, true>(lds, g, S, E);
#else
        pg8::Gemm g{BIG, (const bf16*)(ws + WS_W2D), M, D, FF}; pg8::StaticOrder S; S.init(M, D, gridDim.x, (int)blockIdx.x);
        pg8::EpiResidMix<true, false> E{X2B, XR, D, 0.5f, nullptr};
        pg8::gemm_phase<pg8::EpiResidMix<true, false>, pg8::StaticOrder, true, true>(lds, g, S, E);
#endif
    }
#if PROBE_PP
    xcd_barrier(bar);
    postproj_naive(P, BIG, cs, sn);
#endif
#if PROBE_SB_MODE
    __syncthreads();
    att::sb_phase<PROBE_SB_MODE>(P, lds, BIG, (const bf16*)(ws + WS_SB_DUMMY_KV), (bf16*)(ws + WS_HB));
#endif
}

extern "C" void kernel_launch(void* const* d_in, const int* in_sizes, int n_in, void* d_out, int out_size, void* d_ws, size_t ws_size, hipStream_t stream) {
    static int grid = 0;
    if (grid == 0) {
        if (n_in != 25 || out_size != M * D || ws_size < WS_END) { fprintf(stderr, "kernel_launch: unexpected shapes: n_in %d out %d ws %zu\n", n_in, out_size, ws_size); grid = -1; return; }
        int dev = 0, cus = 0, per_cu = 0;
        hipGetDevice(&dev); hipDeviceGetAttribute(&cus, hipDeviceAttributeMultiprocessorCount, dev);
        if (hipFuncSetAttribute((const void*)fwd_kernel, hipFuncAttributeMaxDynamicSharedMemorySize, LDS_BYTES) != hipSuccess) { fprintf(stderr, "kernel_launch: hipFuncSetAttribute failed\n"); grid = -1; return; }
        hipOccupancyMaxActiveBlocksPerMultiprocessor(&per_cu, (const void*)fwd_kernel, NTHREADS, LDS_BYTES);
        (void)hipGetLastError();
        if (per_cu < 1) fprintf(stderr, "kernel_launch: occupancy query says %d\n", per_cu);
        grid = cus;
    }
    if (grid < 0) return;
    hipMemsetAsync((char*)d_ws + WS_CTL, 0, CTL_ZERO_BYTES, stream);
    Params p{};
    p.x = (const float*)d_in[0]; p.pos = (const int*)d_in[1];
    p.ffn1_norm = (const float*)d_in[2]; p.ffn1_wg = (const float*)d_in[3]; p.ffn1_wu = (const float*)d_in[4]; p.ffn1_wd = (const float*)d_in[5];
    p.mix_norm = (const float*)d_in[6]; p.w_in = (const float*)d_in[7]; p.q_norm = (const float*)d_in[8]; p.kc_norm = (const float*)d_in[9];
    p.ks_norm = (const float*)d_in[10]; p.kw_norm = (const float*)d_in[11]; p.ck_pos = (const float*)d_in[12]; p.ck_w1 = (const float*)d_in[13];
    p.ck_w2 = (const float*)d_in[14]; p.cv_pos = (const float*)d_in[15]; p.cv_w1 = (const float*)d_in[16]; p.cv_w2 = (const float*)d_in[17];
    p.nsa_on = (const float*)d_in[18]; p.sb_on = (const float*)d_in[19]; p.w_out = (const float*)d_in[20]; p.ffn2_norm = (const float*)d_in[21];
    p.ffn2_wg = (const float*)d_in[22]; p.ffn2_wu = (const float*)d_in[23]; p.ffn2_wd = (const float*)d_in[24];
    p.out = (float*)d_out; p.ws = (unsigned char*)d_ws;
    hipLaunchKernelGGL(fwd_kernel, dim3(grid), dim3(NTHREADS), LDS_BYTES, stream, p);
}
```

```cpp
#include <hip/hip_runtime.h>
#include <cstdio>
#include <cstdint>

#define SB_COMPACT 0
#define FOLD_GAINS 1
#define FUSE_NORMS 0
#define NSA_OPAQUE 1
#define REP_P0 1
#define REP_P1 1
#define REP_P2 1
#define REP_P4 1
#define REP_P9 1
#define REP_P10 1
#define REP_CMP 1
#define REP_NSA 1
#define REP_SB 1
#define PROBE_SB_MODE 0
#define TAIL_CONVERT 1
#define FFN2_FP8 1
#define FFN1_FP8 2
#define FFN1_I8 1
#define PROBE_P1K 0
#define PROBE_PP 0

#define GAS __attribute__((address_space(1)))
#define LAS __attribute__((address_space(3)))
typedef unsigned short bf16;
typedef unsigned v4u __attribute__((ext_vector_type(4)));
typedef unsigned v2u __attribute__((ext_vector_type(2)));
typedef float f32x4 __attribute__((ext_vector_type(4)));
typedef float f32x2 __attribute__((ext_vector_type(2)));

constexpr int NBATCH = 4, SEQ = 4096, M = NBATCH * SEQ, D = 2048, FF = 5632, HD = 128;
constexpr int NCMP = 255;
constexpr int IN_COLS = 5656;
constexpr int NP = 5888;
constexpr int C_QN = 0, C_KC = 1024, C_VC = 1280, C_KS = 1536, C_VS = 1792, C_KW = 2048, C_VW = 2304, C_QS = 2560, C_KSB = 3584, C_VSB = 4608, C_GATE = 5632;
constexpr float EPS = 1e-6f;
constexpr float SCALE = 0.08838834764831845f;
constexpr float NEG_INF = -1e30f;
constexpr float QSCALE = 0.08838834764831845f * 1.4426950408889634f;

constexpr size_t MiB = 1u << 20;
constexpr size_t WS_CTL = 0, CTL_ZERO_BYTES = 1 * MiB;
constexpr size_t WS_CMAX = 512 * 1024;
constexpr size_t WS_W1GU = 2 * MiB, WS_W1D = 46 * MiB, WS_W2GU = 68 * MiB, WS_W2D = 112 * MiB, WS_WIN = 134 * MiB, WS_WOUT = 157 * MiB;
constexpr size_t WS_WC1K = 165 * MiB, WS_WC1V = 167 * MiB, WS_WC2K = 169 * MiB, WS_WC2V = 169 * MiB + 65536, WS_PBIAS = 169 * MiB + 131072;
constexpr size_t WS_COS = 170 * MiB, WS_SIN = 174 * MiB, WS_KC = 178 * MiB, WS_VC = 178 * MiB + 524288;
constexpr size_t WS_HB = 180 * MiB, WS_BIG = 244 * MiB, WS_SCR = 428 * MiB, WS_PART = 492 * MiB, WS_END = 494 * MiB;
constexpr size_t WS_SB_DUMMY_KV = WS_W2GU;
constexpr int CW_BAR = 4096;

constexpr int NWAVES = 8, NTHREADS = 512;
constexpr int LDS_BYTES = 163840;
constexpr int LDSCTL_OFF = 163840 - 1024;

__device__ __forceinline__ unsigned f2bf(float f) { unsigned u = __builtin_bit_cast(unsigned, f); return (u + 0x7fffu + ((u >> 16) & 1u)) >> 16; }
__device__ __forceinline__ unsigned pk2(float lo, float hi) { return f2bf(lo) | (f2bf(hi) << 16); }
__device__ __forceinline__ float bf2f(unsigned h) { return __builtin_bit_cast(float, h << 16); }
__device__ __forceinline__ float bflo(unsigned w) { return __builtin_bit_cast(float, w << 16); }
__device__ __forceinline__ float bfhi(unsigned w) { return __builtin_bit_cast(float, w & 0xffff0000u); }
__device__ __forceinline__ float wave_sum(float v) {
#pragma unroll
    for (int o = 1; o < 64; o <<= 1) v += __shfl_xor(v, o);
    return v;
}
__device__ __forceinline__ float wave_max(float v) {
#pragma unroll
    for (int o = 1; o < 64; o <<= 1) v = fmaxf(v, __shfl_xor(v, o));
    return v;
}
__device__ __forceinline__ float softplusf(float z) { return fmaxf(z, 0.f) + log1pf(expf(-fabsf(z))); }
__device__ __forceinline__ float sigmoidf(float z) { return 1.f / (1.f + expf(-z)); }
__device__ __forceinline__ float gelu_tanh(float x) { const float u = 0.7978845608028654f * (x + 0.044715f * x * x * x); return 0.5f * x * (1.f + tanhf(u)); }

#define XB_TMO      128
#define XB_XCNT(j)  (256  + 64 * (j))
#define XB_XSUB(j)  (1280 + 64 * (j))
#define XB_XGEN(j)  (2304 + 64 * (j))
#define XB_TOP      3328
#define XB_TOPGEN   3392
#define XCD_BAR_WORDS 3456
#define XB_SPIN_CAP (1u << 22)

__device__ __forceinline__ unsigned xb_ld(unsigned* p)              { return __hip_atomic_load(p, __ATOMIC_RELAXED, __HIP_MEMORY_SCOPE_AGENT); }
__device__ __forceinline__ unsigned xb_add(unsigned* p, unsigned v) { return __hip_atomic_fetch_add(p, v, __ATOMIC_RELAXED, __HIP_MEMORY_SCOPE_AGENT); }
__device__ __forceinline__ unsigned xb_xcc_id() { return (unsigned)__builtin_amdgcn_s_getreg((3 << 11) | 20) & 0xFu; }
#define XB_SPIN(cond, bar) do { unsigned _sp = 0; while (cond) { __builtin_amdgcn_s_sleep(1); \
    if ((++_sp & 255u) == 0u) { if (xb_ld(&(bar)[XB_TMO])) break; if (_sp > XB_SPIN_CAP) { atomicAdd(&(bar)[XB_TMO], 1u); break; } } } } while (0)

struct XcdBarrier { unsigned* bar; unsigned x; volatile LAS unsigned* st; };

__device__ __forceinline__ XcdBarrier xcd_barrier_post(unsigned* bar, volatile LAS unsigned* st) {
    XcdBarrier b; b.bar = bar; b.x = xb_xcc_id(); b.st = st;
    if (threadIdx.x == 0) (void)xb_add(&bar[XB_XCNT(b.x)], 1u);
    return b;
}
__device__ __forceinline__ void xcd_barrier_complete(unsigned* bar, unsigned x, unsigned& nloc, unsigned& nx) {
    const unsigned G = gridDim.x * gridDim.y * gridDim.z;
    unsigned sum, cnt, mine, sp = 0u;
    for (;;) {
        sum = 0u; cnt = 0u; mine = 0u;
#pragma unroll
        for (unsigned j = 0; j < 16; ++j) { const unsigned c = xb_ld(&bar[XB_XCNT(j)]); sum += c; cnt += (c > 0u) ? 1u : 0u; mine = (j == x) ? c : mine; }
        if (sum == G) break;
        __builtin_amdgcn_s_sleep(1);
        if ((++sp & 255u) == 0u) { if (xb_ld(&bar[XB_TMO])) break; if (sp > XB_SPIN_CAP) { atomicAdd(&bar[XB_TMO], 1u); break; } }
    }
    nloc = mine > 0u ? mine : 1u; nx = cnt > 0u ? cnt : 1u;
}
__device__ __forceinline__ void xcd_barrier(const XcdBarrier& b) {
    asm volatile("s_waitcnt vmcnt(0)" ::: "memory");
    __syncthreads();
    if (threadIdx.x == 0) {
        unsigned* bar = b.bar;
        __builtin_amdgcn_s_waitcnt(0);
        unsigned nloc = b.st[0], nx = b.st[1];
        if (nloc == 0u) { xcd_barrier_complete(bar, b.x, nloc, nx); b.st[0] = nloc; b.st[1] = nx; }
        const unsigned old = xb_add(&bar[XB_XSUB(b.x)], 1u);
        const unsigned gen = old / nloc;
        if (old + 1u == (gen + 1u) * nloc) {
            __builtin_amdgcn_fence(__ATOMIC_RELEASE, "agent");
            asm volatile("s_waitcnt vmcnt(0)" ::: "memory");
            const unsigned og = xb_add(&bar[XB_TOP], 1u);
            const unsigned tg = og / nx;
            if (og + 1u == (tg + 1u) * nx) xb_add(&bar[XB_TOPGEN], 1u);
            else XB_SPIN(xb_ld(&bar[XB_TOPGEN]) == tg, bar);
            __builtin_amdgcn_fence(__ATOMIC_ACQUIRE, "agent");
            xb_add(&bar[XB_XGEN(b.x)], 1u);
            asm volatile("s_waitcnt vmcnt(0)" ::: "memory");
        } else {
            XB_SPIN(xb_ld(&bar[XB_XGEN(b.x)]) == gen, bar);
            __builtin_amdgcn_fence(__ATOMIC_ACQUIRE, "agent");
            asm volatile("s_waitcnt vmcnt(0)" ::: "memory");
        }
    }
    __syncthreads();
}

namespace pg8 {
#define PG8_LAS __attribute__((address_space(3)))
typedef unsigned short bf16_t;
typedef short bf16x8 __attribute__((ext_vector_type(8)));
typedef float f32x4 __attribute__((ext_vector_type(4)));
typedef unsigned u32x4 __attribute__((ext_vector_type(4)));
constexpr int BM = 256, BK = 64, HALF = 128, HTB = HALF * BK * 2  , STAGE_BYTES = 8 * HTB, NXCD = 8, WGM = 8;

__host__ __device__ __forceinline__ int lds_byte(int r, int c) { const int st = (r >> 4) * 2 + (c >> 5), rr = r & 15, cc = c & 31, ob = rr * 64 + cc * 2; return st * 1024 + (ob ^ (((ob >> 9) & 1) << 5)); }
__host__ __device__ __forceinline__ void stage_rc(int b, int& R, int& C) { const int st = b / 1024, sb = b % 1024, swz = sb ^ (((sb >> 9) & 1) << 5); R = (st >> 1) * 16 + swz / 64; C = (st & 1) * 32 + (swz % 64) / 2; }
__host__ __device__ __forceinline__ int perm32(int rho) { const int n = rho >> 4, i = rho & 15; return 8 * (i >> 2) + 4 * n + (i & 3); }

typedef int v4i_t __attribute__((ext_vector_type(4)));
typedef int v8i_t __attribute__((ext_vector_type(8)));
__device__ __forceinline__ unsigned pk4_fp8(float a, float b, float c, float d) {
    a = __builtin_amdgcn_fmed3f(a, -448.f, 448.f); b = __builtin_amdgcn_fmed3f(b, -448.f, 448.f); c = __builtin_amdgcn_fmed3f(c, -448.f, 448.f); d = __builtin_amdgcn_fmed3f(d, -448.f, 448.f);
    int w = 0; w = __builtin_amdgcn_cvt_pk_fp8_f32(a, b, w, false); w = __builtin_amdgcn_cvt_pk_fp8_f32(c, d, w, true); return (unsigned)w;
}
__device__ __forceinline__ unsigned pk4_i8(float a, float b, float c, float d, float s) {
    const unsigned u0 = __builtin_bit_cast(unsigned, __builtin_fmaf(a, s, 12582912.0f)), u1 = __builtin_bit_cast(unsigned, __builtin_fmaf(b, s, 12582912.0f));
    const unsigned u2 = __builtin_bit_cast(unsigned, __builtin_fmaf(c, s, 12582912.0f)), u3 = __builtin_bit_cast(unsigned, __builtin_fmaf(d, s, 12582912.0f));
    return (u0 & 255u) | ((u1 & 255u) << 8) | ((u2 & 255u) << 16) | (u3 << 24);
}
constexpr float F8_WSCALE = 256.0f, F8_HSCALE = 16.0f;
struct Unit { int pm, pn, ord; };
struct Gemm { const bf16_t* A; const bf16_t* Bt; int M, N, K; int kshift = 0; };

struct StaticOrder {
    int nM, nN, nwg, G, c; int zero = 0;
    __host__ __device__ void init(int M, int N, int G_, int c_) { nM = M / BM; nN = N / BM; nwg = nM * nN; G = G_; c = c_; }
    __host__ __device__ bool next(int i, Unit& u) const {
        const long L = (long)i * G + c; if (L >= nwg) return false;
        int wgid = (int)L; { const int q = nwg / NXCD, r = nwg % NXCD, xcd = wgid % NXCD, off = wgid / NXCD; wgid = (xcd < r ? xcd * (q + 1) : r * (q + 1) + (xcd - r) * q) + off; }
        const int nig = WGM * nN, gid = wgid / nig, fm = gid * WGM, gsz = (nM - fm) < WGM ? (nM - fm) : WGM;
        u.pm = fm + ((wgid % nig) % gsz); u.pn = (wgid % nig) / gsz; u.ord = i;
        if (zero) { u.pm = 0; u.pn = 0; }
        return true;
    }
    __device__ __forceinline__ void a_ready(const Unit&) const {}
    __device__ __forceinline__ void done(const Unit&) const {}
};


__device__ __forceinline__ unsigned cvt_pk_bf16(float lo, float hi) { unsigned r; asm volatile("v_cvt_pk_bf16_f32 %0, %1, %2" : "=v"(r) : "v"(lo), "v"(hi)); return r; }
__device__ __forceinline__ float silu_mul(float g, float u) { return g * u * __builtin_amdgcn_rcpf(1.0f + __builtin_amdgcn_exp2f(-1.4426950408889634f * g)); }
__device__ __forceinline__ void row_scale_table(PG8_LAS float* rs, const float* part, const Unit& u, float inv_n, float eps) {
    asm volatile("s_waitcnt lgkmcnt(0)" ::: "memory"); __builtin_amdgcn_s_barrier(); asm volatile("" ::: "memory");
    const int t = threadIdx.x;
    if (t < 256) { const f32x4* p = (const f32x4*)(part + (size_t)(u.pm * BM + t) * 32); f32x4 a = p[0];
#pragma unroll
        for (int i = 1; i < 8; ++i) a = a + p[i];
        rs[t] = rsqrtf(((a[0] + a[1]) + (a[2] + a[3])) * inv_n + eps); }
    asm volatile("s_waitcnt lgkmcnt(0)" ::: "memory"); __builtin_amdgcn_s_barrier(); asm volatile("" ::: "memory");
}
__device__ __forceinline__ float row_factor(const float* part, int row) {
    const unsigned long long q = ((const unsigned long long*)part)[row];
    return rsqrtf((float)q * (1.0f / 16777216.0f) * (1.0f / 2048.0f) + 1e-6f);
}
template <class Sched>
__device__ __forceinline__ void row_factor_table(PG8_LAS float* rs, const float* part, const Sched& S, const float* rowmul = nullptr) {
    int t = threadIdx.x; asm volatile("" : "+v"(t));
    Unit u;
    for (int i = 0; S.next(i, u); ++i) if (t < 256) rs[i * 256 + t] = row_factor(part, u.pm * BM + t) * (rowmul ? rowmul[u.pm * BM + t] : 1.0f);
    asm volatile("s_waitcnt vmcnt(0) lgkmcnt(0)" ::: "memory"); __builtin_amdgcn_s_barrier(); asm volatile("" ::: "memory");
}
template <bool F8 = false, bool O8 = F8, bool I8 = false>
struct EpiSwigluT {
    static constexpr bool PERM = true, AFTER_DRAIN = false;
    bf16_t* O; int ldo;
    const float* part; PG8_LAS float* rs;
    const float* colmax;
    static __device__ __forceinline__ unsigned silu_mul2(f32x2 g, f32x2 u) {
        const f32x2 t = g * (-1.4426950408889634f);
        f32x2 e; e.x = __builtin_amdgcn_exp2f(t.x); e.y = __builtin_amdgcn_exp2f(t.y);
        const f32x2 d = e + 1.0f;
        f32x2 rc; rc.x = __builtin_amdgcn_rcpf(d.x); rc.y = __builtin_amdgcn_rcpf(d.y);
        const f32x2 r = (g * u) * rc;
        typedef __bf16 bf16x2_t __attribute__((ext_vector_type(2)));
        return __builtin_bit_cast(unsigned, __builtin_convertvector(r, bf16x2_t));
    }
    static __device__ __forceinline__ f32x2 silu_mul2f(f32x2 g, f32x2 u) {
        const f32x2 t = g * (-1.4426950408889634f);
        f32x2 e; e.x = __builtin_amdgcn_exp2f(t.x); e.y = __builtin_amdgcn_exp2f(t.y);
        const f32x2 d = e + 1.0f;
        f32x2 rc; rc.x = __builtin_amdgcn_rcpf(d.x); rc.y = __builtin_amdgcn_rcpf(d.y);
        return (g * u) * rc;
    }
    __device__ __forceinline__ void operator()(const f32x4 (&acc)[2][2][4][2], const Unit& u, int wr, int wc, int fr, int fq) const {
        const int row0 = u.pm * BM + wr * 64 + fr, col0 = u.pn * HALF + wc * 32 + 8 * fq;
        float rf[2][4];
#pragma unroll
        for (int ai = 0; ai < 2; ++ai)
#pragma unroll
            for (int m = 0; m < 4; ++m) rf[ai][m] = part ? rs[u.ord * 256 + wr * 64 + fr + ai * HALF + m * 16] : 1.0f;
        f32x4 cg0, cg1, cu0, cu1;
        if constexpr (I8) { cg0 = *(const f32x4*)(colmax + col0); cg1 = *(const f32x4*)(colmax + col0 + 4); cu0 = *(const f32x4*)(colmax + ldo + col0); cu1 = *(const f32x4*)(colmax + ldo + col0 + 4); }
#pragma unroll
        for (int ai = 0; ai < 2; ++ai)
#pragma unroll
            for (int m = 0; m < 4; ++m) {
                if constexpr (F8) {
                    f32x4 g0, g1, u0, u1;
                    if constexpr (I8) {
                        const float rg = rf[ai][m] * (1.0f / 127.0f), ru = O8 ? rg * F8_HSCALE : rg;
                        g0 = __builtin_convertvector(__builtin_bit_cast(v4i_t, acc[ai][0][m][0]), f32x4) * (cg0 * rg); g1 = __builtin_convertvector(__builtin_bit_cast(v4i_t, acc[ai][0][m][1]), f32x4) * (cg1 * rg);
                        u0 = __builtin_convertvector(__builtin_bit_cast(v4i_t, acc[ai][1][m][0]), f32x4) * (cu0 * ru); u1 = __builtin_convertvector(__builtin_bit_cast(v4i_t, acc[ai][1][m][1]), f32x4) * (cu1 * ru);
                    } else {
                    const float rg = rf[ai][m] * (1.0f / F8_WSCALE), ru = O8 ? rg * F8_HSCALE : rg;
                    g0 = acc[ai][0][m][0] * rg; g1 = acc[ai][0][m][1] * rg; u0 = acc[ai][1][m][0] * ru; u1 = acc[ai][1][m][1] * ru;
                    }
                    const f32x2 h0 = silu_mul2f((f32x2){g0[0], g0[1]}, (f32x2){u0[0], u0[1]}), h1 = silu_mul2f((f32x2){g0[2], g0[3]}, (f32x2){u0[2], u0[3]});
                    const f32x2 h2 = silu_mul2f((f32x2){g1[0], g1[1]}, (f32x2){u1[0], u1[1]}), h3 = silu_mul2f((f32x2){g1[2], g1[3]}, (f32x2){u1[2], u1[3]});
                    if constexpr (O8) {
                    typedef unsigned u32x2 __attribute__((ext_vector_type(2))); u32x2 w; w.x = pk4_fp8(h0.x, h0.y, h1.x, h1.y); w.y = pk4_fp8(h2.x, h2.y, h3.x, h3.y);
                    *(u32x2*)((unsigned char*)O + (size_t)(row0 + ai * HALF + m * 16) * ldo + col0) = w;
                    } else {
                    typedef __bf16 bf16x2_t __attribute__((ext_vector_type(2)));
                    u32x4 w; w.x = __builtin_bit_cast(unsigned, __builtin_convertvector(h0, bf16x2_t)); w.y = __builtin_bit_cast(unsigned, __builtin_convertvector(h1, bf16x2_t));
                    w.z = __builtin_bit_cast(unsigned, __builtin_convertvector(h2, bf16x2_t)); w.w = __builtin_bit_cast(unsigned, __builtin_convertvector(h3, bf16x2_t));
                    *(u32x4*)(O + (size_t)(row0 + ai * HALF + m * 16) * ldo + col0) = w;
                    }
                } else {
                const float r = rf[ai][m];
                const f32x4 g0 = acc[ai][0][m][0] * r, g1 = acc[ai][0][m][1] * r, u0 = acc[ai][1][m][0] * r, u1 = acc[ai][1][m][1] * r;
                u32x4 w;
                w.x = silu_mul2((f32x2){g0[0], g0[1]}, (f32x2){u0[0], u0[1]}); w.y = silu_mul2((f32x2){g0[2], g0[3]}, (f32x2){u0[2], u0[3]});
                w.z = silu_mul2((f32x2){g1[0], g1[1]}, (f32x2){u1[0], u1[1]}); w.w = silu_mul2((f32x2){g1[2], g1[3]}, (f32x2){u1[2], u1[3]});
                *(u32x4*)(O + (size_t)(row0 + ai * HALF + m * 16) * ldo + col0) = w;
                }
            }
    }
};
typedef EpiSwigluT<false> EpiSwiglu;
struct EpiResid {
    static constexpr bool PERM = false, AFTER_DRAIN = false;
    const float* base; float* out; int ldc; float alpha;
    bf16_t* XG; const float* gain; float* part;
    __device__ __forceinline__ void operator()(const f32x4 (&acc)[2][2][4][2], const Unit& u, int wr, int wc, int fr, int fq) const {
        const int row0 = u.pm * BM + wr * 64 + fr, col0 = u.pn * BM + wc * 32 + 4 * fq;
        f32x4 gg[2][2];
#pragma unroll
        for (int bj = 0; bj < 2; ++bj)
#pragma unroll
            for (int n = 0; n < 2; ++n) gg[bj][n] = XG ? *(const f32x4*)(gain + col0 + bj * HALF + 16 * n) : (f32x4){0.f, 0.f, 0.f, 0.f};
#pragma unroll
        for (int ai = 0; ai < 2; ++ai) {
            f32x4 b[4][2][2];
#pragma unroll
            for (int m = 0; m < 4; ++m)
#pragma unroll
                for (int bj = 0; bj < 2; ++bj)
#pragma unroll
                    for (int n = 0; n < 2; ++n) b[m][bj][n] = *(const f32x4*)(base + (size_t)(row0 + ai * HALF + m * 16) * ldc + col0 + bj * HALF + 16 * n);
#pragma unroll
            for (int m = 0; m < 4; ++m) { const int row = row0 + ai * HALF + m * 16; const size_t ro = (size_t)row * ldc + col0; float ssq = 0.f;
#pragma unroll
                for (int bj = 0; bj < 2; ++bj)
#pragma unroll
                    for (int n = 0; n < 2; ++n) { const size_t o = ro + bj * HALF + 16 * n; const f32x4 v = b[m][bj][n] + acc[ai][bj][m][n] * alpha; *(f32x4*)(out + o) = v;
                        if (XG) { const f32x4 g4 = gg[bj][n]; ssq += (v[0] * v[0] + v[1] * v[1]) + (v[2] * v[2] + v[3] * v[3]);
                            typedef unsigned u32x2 __attribute__((ext_vector_type(2))); u32x2 w; w.x = cvt_pk_bf16(v[0] * g4[0], v[1] * g4[1]); w.y = cvt_pk_bf16(v[2] * g4[2], v[3] * g4[3]); *(u32x2*)(XG + o) = w; } }
                if (XG) { ssq += __shfl_xor(ssq, 16); ssq += __shfl_xor(ssq, 32);
                    if (fq == 0) __hip_atomic_fetch_add((unsigned long long*)part + row, (unsigned long long)(ssq * 16777216.0f), __ATOMIC_RELAXED, __HIP_MEMORY_SCOPE_AGENT); } }
        }
    }
};
template <bool BB, bool OB>
struct EpiResidMix {
    static constexpr bool PERM = false, AFTER_DRAIN = false;
    const void* base; void* out; int ldc; float alpha;
    unsigned long long* rowsq;
    unsigned char* out8;
    __device__ __forceinline__ void operator()(const f32x4 (&acc)[2][2][4][2], const Unit& u, int wr, int wc, int fr, int fq) const {
        typedef unsigned u32x2 __attribute__((ext_vector_type(2)));
        const int row0 = u.pm * BM + wr * 64 + fr, col0 = u.pn * BM + wc * 32 + 4 * fq;
#pragma unroll
        for (int ai = 0; ai < 2; ++ai) {
            f32x4 b[4][2][2];
#pragma unroll
            for (int m = 0; m < 4; ++m)
#pragma unroll
                for (int bj = 0; bj < 2; ++bj)
#pragma unroll
                    for (int n = 0; n < 2; ++n) { const size_t o = (size_t)(row0 + ai * HALF + m * 16) * ldc + col0 + bj * HALF + 16 * n;
                        if (BB) { const u32x2 w = *(const u32x2*)((const bf16_t*)base + o);
                            b[m][bj][n] = (f32x4){__builtin_bit_cast(float, w.x << 16), __builtin_bit_cast(float, w.x & 0xffff0000u), __builtin_bit_cast(float, w.y << 16), __builtin_bit_cast(float, w.y & 0xffff0000u)}; }
                        else b[m][bj][n] = *(const f32x4*)((const float*)base + o); }
#pragma unroll
            for (int m = 0; m < 4; ++m) { float ssq = 0.f;
#pragma unroll
                for (int bj = 0; bj < 2; ++bj)
#pragma unroll
                    for (int n = 0; n < 2; ++n) { const size_t o = (size_t)(row0 + ai * HALF + m * 16) * ldc + col0 + bj * HALF + 16 * n; const f32x4 v = b[m][bj][n] + acc[ai][bj][m][n] * alpha;
                        ssq += (v[0] * v[0] + v[1] * v[1]) + (v[2] * v[2] + v[3] * v[3]);
                        if (OB) { u32x2 w; w.x = cvt_pk_bf16(v[0], v[1]); w.y = cvt_pk_bf16(v[2], v[3]); *(u32x2*)((bf16_t*)out + o) = w; }
                        else *(f32x4*)((float*)out + o) = v;
                        if (out8) *(unsigned*)(out8 + o) = pk4_fp8(v[0], v[1], v[2], v[3]); }
                if (rowsq) { ssq += __shfl_xor(ssq, 16); ssq += __shfl_xor(ssq, 32);
                    if (fq == 0) __hip_atomic_fetch_add(rowsq + (row0 + ai * HALF + m * 16), (unsigned long long)(ssq * 16777216.0f), __ATOMIC_RELAXED, __HIP_MEMORY_SCOPE_AGENT); } }
        }
    }
};
struct EpiStoreBf16 {
    static constexpr bool PERM = true, AFTER_DRAIN = false;
    bf16_t* O; int ldo; int sc_lo, sc_hi; float sc;
    const float* part; PG8_LAS float* rs;
    bf16_t* KVC; int kv_lo, kv_hi;
    __device__ __forceinline__ void operator()(const f32x4 (&acc)[2][2][4][2], const Unit& u, int wr, int wc, int fr, int fq) const {
        const int row0 = u.pm * BM + wr * 64 + fr, col0 = u.pn * BM + wc * 32 + 8 * fq;
        const float scl0 = (u.pn >= sc_lo && u.pn < sc_hi) ? sc : 1.0f;
        const bool kv = u.pn >= kv_lo && u.pn < kv_hi;
        const int which = (u.pn - kv_lo) >> 2, h0 = 2 * ((u.pn - kv_lo) & 3);
        float rf[2][4];
#pragma unroll
        for (int ai = 0; ai < 2; ++ai)
#pragma unroll
            for (int m = 0; m < 4; ++m) rf[ai][m] = part ? rs[u.ord * 256 + wr * 64 + fr + ai * HALF + m * 16] : 1.0f;
#pragma unroll
        for (int ai = 0; ai < 2; ++ai)
#pragma unroll
            for (int m = 0; m < 4; ++m) { const int row = row0 + ai * HALF + m * 16; bf16_t* rowp = O + (size_t)row * ldo + col0;
                const float scl = scl0 * rf[ai][m];
                bf16_t* kvp = KVC + ((size_t)((which * 4 + (row >> 12)) * 8 + h0) * 4096 + (row & 4095)) * 128 + wc * 32 + 8 * fq;
#pragma unroll
                for (int bj = 0; bj < 2; ++bj) { const f32x4 v0 = acc[ai][bj][m][0] * scl, v1 = acc[ai][bj][m][1] * scl;
                    u32x4 w; w.x = cvt_pk_bf16(v0[0], v0[1]); w.y = cvt_pk_bf16(v0[2], v0[3]); w.z = cvt_pk_bf16(v1[0], v1[1]); w.w = cvt_pk_bf16(v1[2], v1[3]);
                    if (kv) *(u32x4*)(kvp + (size_t)bj * 4096 * 128) = w; else *(u32x4*)(rowp + bj * HALF) = w; } }
    }
};
template <class Epi, class Sched, bool ALIGN_EPI = false, bool SP2 = false, bool FP8 = false, bool I8 = false>
__device__ __forceinline__ void gemm_phase(PG8_LAS unsigned char* lds, const Gemm g, const Sched& S, const Epi& E) {
    int tid_ = threadIdx.x; asm volatile("" : "+v"(tid_));
    const int tid = tid_, wid = __builtin_amdgcn_readfirstlane(tid >> 6), lane = tid & 63, wr = wid >> 2, wc = wid & 3, fr = lane & 15, fq = lane >> 4;
    const int K = g.K, nt = (K / BK) >> g.kshift;
    unsigned voffA[2], voffB[2];
#pragma unroll
    for (int i = 0; i < 2; ++i) { int R, C; stage_rc(tid * 16 + i * 8192, R, C); const int Rb = Epi::PERM ? ((R & ~31) + perm32(R & 31)) : R;
        voffA[i] = (unsigned)(R * K + C) * 2u; voffB[i] = (unsigned)(Rb * K + C) * 2u; }
    const size_t kstep = (size_t)(BK * 2);
    const size_t hstep = (size_t)HALF * K * 2;
    const size_t tstep = 2 * hstep;
    const unsigned ldsw = (unsigned)wid * 1024u;
    const int aoff = lds_byte(wr * 64 + fr, fq * 8), boff = lds_byte(wc * 32 + fr, fq * 8);
#define PG8_SA(b, h) (((b) * 2 + (h)) * HTB)
#define PG8_SB(b, h) ((4 + (b) * 2 + (h)) * HTB)
#define PG8_STAGE(bufoff, gbase, voff) do { _Pragma("unroll") for (int _i = 0; _i < 2; ++_i) \
        __builtin_amdgcn_global_load_lds((const unsigned*)((const char*)(gbase) + (voff)[_i]), (PG8_LAS unsigned*)(lds + (bufoff) + ldsw + _i * 8192), 16, 0, 0); } while (0)
#define PG8_LDA(dst, b, h) do { _Pragma("unroll") for (int m = 0; m < 4; ++m) _Pragma("unroll") for (int k = 0; k < 2; ++k) dst[m][k] = *(const PG8_LAS bf16x8*)(lds + PG8_SA(b, h) + aoff + m * 2048 + k * 1024); } while (0)
#define PG8_LDB(dst, b, h) do { _Pragma("unroll") for (int n = 0; n < 2; ++n) _Pragma("unroll") for (int k = 0; k < 2; ++k) dst[n][k] = *(const PG8_LAS bf16x8*)(lds + PG8_SB(b, h) + boff + n * 2048 + k * 1024); } while (0)
#define PG8_MMA(ai, bj, At, Bt) do { __builtin_amdgcn_s_setprio(1); _Pragma("unroll") for (int m = 0; m < 4; ++m) _Pragma("unroll") for (int n = 0; n < 2; ++n) _Pragma("unroll") for (int k = 0; k < 2; ++k) \
        acc[ai][bj][m][n] = __builtin_amdgcn_mfma_f32_16x16x32_bf16(Bt[n][k], At[m][k], acc[ai][bj][m][n], 0, 0, 0); __builtin_amdgcn_s_setprio(0); } while (0)
#define PG8_RD8(p) __builtin_shufflevector(*(const PG8_LAS v4i_t*)(p), *(const PG8_LAS v4i_t*)((p) + 1024), 0, 1, 2, 3, 4, 5, 6, 7)
#define PG8_LDA8(dst, b, h) do { _Pragma("unroll") for (int m = 0; m < 4; ++m) dst[m] = PG8_RD8(lds + PG8_SA(b, h) + aoff + m * 2048); } while (0)
#define PG8_LDB8(dst, b, h) do { _Pragma("unroll") for (int n = 0; n < 2; ++n) dst[n] = PG8_RD8(lds + PG8_SB(b, h) + boff + n * 2048); } while (0)
#define PG8_MQ(V, SW, b, a) V.SW = __builtin_amdgcn_mfma_scale_f32_16x16x128_f8f6f4(b, a, V.SW, 0, 0, 0, 0, 0, 0)
#define PG8_MMA8(ai, bj, At, Bt) do { __builtin_amdgcn_s_setprio(1); \
        PG8_MQ(accv[ai][bj][0], s0123, Bt[0], At[0]); PG8_MQ(accv[ai][bj][0], s4567, Bt[1], At[0]); PG8_MQ(accv[ai][bj][0], s89ab, Bt[0], At[1]); PG8_MQ(accv[ai][bj][0], scdef, Bt[1], At[1]); \
        PG8_MQ(accv[ai][bj][1], s0123, Bt[0], At[2]); PG8_MQ(accv[ai][bj][1], s4567, Bt[1], At[2]); PG8_MQ(accv[ai][bj][1], s89ab, Bt[0], At[3]); PG8_MQ(accv[ai][bj][1], scdef, Bt[1], At[3]); \
        __builtin_amdgcn_s_setprio(0); } while (0)
#define PG8_MMAI(ai, bj, At, Bt) do { __builtin_amdgcn_s_setprio(1); _Pragma("unroll") for (int m = 0; m < 4; ++m) _Pragma("unroll") for (int n = 0; n < 2; ++n) _Pragma("unroll") for (int k = 0; k < 2; ++k) \
        acc[ai][bj][m][n] = __builtin_bit_cast(f32x4, __builtin_amdgcn_mfma_i32_16x16x64_i8(__builtin_bit_cast(v4i_t, Bt[n][k]), __builtin_bit_cast(v4i_t, At[m][k]), __builtin_bit_cast(v4i_t, acc[ai][bj][m][n]), 0, 0, 0)); __builtin_amdgcn_s_setprio(0); } while (0)
#define PG8_MM(ai, bj, At, Bt) do { if constexpr (FP8) PG8_MMA8(ai, bj, At##8, Bt##8); else if constexpr (I8) PG8_MMAI(ai, bj, At, Bt); else PG8_MMA(ai, bj, At, Bt); } while (0)
#define PG8_LA(dst, b, h) do { if constexpr (FP8) PG8_LDA8(dst##8, b, h); else PG8_LDA(dst, b, h); } while (0)
#define PG8_LB(dst, b, h) do { if constexpr (FP8) PG8_LDB8(dst##8, b, h); else PG8_LDB(dst, b, h); } while (0)
#define PG8_WAIT_V(n) asm volatile("s_waitcnt vmcnt(" #n ")" ::: "memory")
#define PG8_WAIT_L(n) asm volatile("s_waitcnt lgkmcnt(" #n ")" ::: "memory")
#define PG8_BAR __builtin_amdgcn_s_barrier()
#define PG8_SCHED __builtin_amdgcn_sched_barrier(0)
    Unit cur, nxt; int ui = 0;
    if (!S.next(0, cur)) return;
    f32x4 acc[2][2][4][2];
    float zf = 0.f; asm volatile("" : "+v"(zf));
#pragma unroll
    for (int a = 0; a < 2; ++a)
#pragma unroll
        for (int b = 0; b < 2; ++b)
#pragma unroll
            for (int m = 0; m < 4; ++m)
#pragma unroll
                for (int n = 0; n < 2; ++n) acc[a][b][m][n] = (f32x4){zf, zf, zf, zf};
    bf16x8 At[4][2], B0[2][2], B1[2][2];
    typedef float f32x16_t __attribute__((ext_vector_type(16)));
    f32x16_t accv[2][2][2];
    if constexpr (FP8) {
#pragma unroll
        for (int a = 0; a < 2; ++a)
#pragma unroll
            for (int b = 0; b < 2; ++b)
#pragma unroll
                for (int h = 0; h < 2; ++h) accv[a][b][h] = (f32x16_t)(zf);
    }
    v8i_t At8[4], B08[2], B18[2];
    const char* cA = (const char*)g.A + (size_t)cur.pm * tstep; const char* cB = (const char*)g.Bt + (size_t)cur.pn * tstep;
    S.a_ready(cur);
    if constexpr (SP2) {
        PG8_STAGE(PG8_SB(0, 0), cB, voffB); PG8_STAGE(PG8_SB(0, 1), cB + hstep, voffB); PG8_STAGE(PG8_SA(0, 0), cA, voffA); PG8_STAGE(PG8_SA(0, 1), cA + hstep, voffA);
        if (wr == 1) PG8_BAR;
        PG8_WAIT_V(2); PG8_BAR;
        PG8_STAGE(PG8_SB(1, 0), cB + kstep, voffB); PG8_STAGE(PG8_SA(1, 0), cA + kstep, voffA); PG8_STAGE(PG8_SB(1, 1), cB + hstep + kstep, voffB);
        PG8_WAIT_V(6); PG8_BAR;
    } else {
        PG8_STAGE(PG8_SB(0, 0), cB, voffB); PG8_STAGE(PG8_SA(0, 0), cA, voffA); PG8_STAGE(PG8_SB(0, 1), cB + hstep, voffB); PG8_STAGE(PG8_SA(0, 1), cA + hstep, voffA);
        if (wr == 1) PG8_BAR;
        PG8_WAIT_V(4); PG8_BAR;
        PG8_STAGE(PG8_SB(1, 0), cB + kstep, voffB); PG8_STAGE(PG8_SA(1, 0), cA + kstep, voffA); PG8_STAGE(PG8_SB(1, 1), cB + hstep + kstep, voffB);
        PG8_WAIT_V(6); PG8_BAR;
    }
    for (;;) {
        const bool has_next = S.next(ui + 1, nxt);
        const char* nA = has_next ? (const char*)g.A + (size_t)nxt.pm * tstep : cA; const char* nB = has_next ? (const char*)g.Bt + (size_t)nxt.pn * tstep : cB;
        for (int t = 0; t < nt; t += 2) {
            const bool last = (t == nt - 2);
            const char* a1 = cA + (size_t)(t + 1) * kstep;
            const char* a2 = last ? nA : cA + (size_t)(t + 2) * kstep; const char* b2 = last ? nB : cB + (size_t)(t + 2) * kstep;
            const char* a3 = a2 + kstep; const char* b3 = b2 + kstep;
            if (last && has_next) S.a_ready(nxt);
            if constexpr (SP2) {
            PG8_LB(B0, 0, 0); PG8_LB(B1, 0, 1); PG8_SCHED; PG8_LA(At, 0, 0); PG8_STAGE(PG8_SA(1, 1), a1 + hstep, voffA);
            PG8_WAIT_V(8); PG8_WAIT_L(0); PG8_BAR; PG8_MM(0, 0, At, B0); PG8_MM(0, 1, At, B1); PG8_BAR; PG8_SCHED;
            PG8_LA(At, 0, 1); PG8_STAGE(PG8_SB(0, 0), b2, voffB); PG8_STAGE(PG8_SB(0, 1), b2 + hstep, voffB); PG8_STAGE(PG8_SA(0, 0), a2, voffA);
            PG8_WAIT_V(8); PG8_WAIT_L(0); PG8_BAR; PG8_MM(1, 0, At, B0); PG8_MM(1, 1, At, B1); PG8_BAR; PG8_SCHED;
            PG8_LB(B0, 1, 0); PG8_LB(B1, 1, 1); PG8_SCHED; PG8_LA(At, 1, 0); PG8_STAGE(PG8_SA(0, 1), a2 + hstep, voffA);
            PG8_WAIT_V(8); PG8_WAIT_L(0); PG8_BAR; PG8_MM(0, 0, At, B0); PG8_MM(0, 1, At, B1); PG8_BAR; PG8_SCHED;
            PG8_LA(At, 1, 1); PG8_STAGE(PG8_SB(1, 0), b3, voffB); PG8_STAGE(PG8_SB(1, 1), b3 + hstep, voffB); PG8_STAGE(PG8_SA(1, 0), a3, voffA);
            PG8_WAIT_V(8); PG8_WAIT_L(0); PG8_BAR; PG8_MM(1, 0, At, B0); PG8_MM(1, 1, At, B1); PG8_BAR; PG8_SCHED;
            } else {
            PG8_LB(B0, 0, 0); PG8_SCHED; PG8_LA(At, 0, 0); PG8_STAGE(PG8_SA(1, 1), a1 + hstep, voffA);
            PG8_WAIT_L(8); PG8_BAR; PG8_WAIT_L(0); PG8_MM(0, 0, At, B0); PG8_BAR; PG8_SCHED;
            PG8_LB(B1, 0, 1); PG8_STAGE(PG8_SB(0, 0), b2, voffB);
            PG8_BAR; PG8_WAIT_L(0); PG8_MM(0, 1, At, B1); PG8_BAR;
            PG8_LA(At, 0, 1); PG8_STAGE(PG8_SA(0, 0), a2, voffA);
            PG8_BAR; PG8_WAIT_L(0); PG8_MM(1, 0, At, B0); PG8_BAR; PG8_SCHED;
            PG8_STAGE(PG8_SB(0, 1), b2 + hstep, voffB);
            PG8_WAIT_V(6); PG8_BAR; PG8_MM(1, 1, At, B1); PG8_BAR;
            PG8_LB(B0, 1, 0); PG8_SCHED; PG8_LA(At, 1, 0); PG8_STAGE(PG8_SA(0, 1), a2 + hstep, voffA);
            PG8_WAIT_L(8); PG8_BAR; PG8_WAIT_L(0); PG8_MM(0, 0, At, B0); PG8_BAR; PG8_SCHED;
            PG8_LB(B1, 1, 1); PG8_STAGE(PG8_SB(1, 0), b3, voffB);
            PG8_BAR; PG8_WAIT_L(0); PG8_MM(0, 1, At, B1); PG8_BAR;
            PG8_LA(At, 1, 1); PG8_STAGE(PG8_SA(1, 0), a3, voffA);
            PG8_BAR; PG8_WAIT_L(0); PG8_MM(1, 0, At, B0); PG8_BAR; PG8_SCHED;
            PG8_STAGE(PG8_SB(1, 1), b3 + hstep, voffB);
            PG8_WAIT_V(6); PG8_BAR; PG8_MM(1, 1, At, B1); PG8_BAR;
            }
        }
        if constexpr (ALIGN_EPI) { if (wr == 0) PG8_BAR; }
        if constexpr (FP8) {
#pragma unroll
            for (int a = 0; a < 2; ++a)
#pragma unroll
                for (int b = 0; b < 2; ++b)
#pragma unroll
                    for (int h = 0; h < 2; ++h) { const f32x16_t v = accv[a][b][h]; acc[a][b][2 * h][0] = v.s0123; acc[a][b][2 * h][1] = v.s4567; acc[a][b][2 * h + 1][0] = v.s89ab; acc[a][b][2 * h + 1][1] = v.scdef; accv[a][b][h] = (f32x16_t)(zf); }
        }
        if constexpr (!Epi::AFTER_DRAIN) { E(acc, cur, wr, wc, fr, fq); S.done(cur); }
        if (!has_next) break;
#pragma unroll
        for (int a = 0; a < 2; ++a)
#pragma unroll
            for (int b = 0; b < 2; ++b)
#pragma unroll
                for (int m = 0; m < 4; ++m)
#pragma unroll
                    for (int n = 0; n < 2; ++n) acc[a][b][m][n] = (f32x4){zf, zf, zf, zf};
        cur = nxt; cA = nA; cB = nB; ++ui;
        if constexpr (ALIGN_EPI) { if (wr == 1) PG8_BAR; }
    }
    PG8_WAIT_V(0);
    if constexpr (!ALIGN_EPI) { if (wr == 0) PG8_BAR; }
    PG8_BAR;
    if constexpr (Epi::AFTER_DRAIN) { E.fused(acc, cur, wr, wc, fr, fq, lds, wid, lane); S.done(cur); }
#undef PG8_SA
#undef PG8_SB
#undef PG8_STAGE
#undef PG8_LDA
#undef PG8_LDB
#undef PG8_MMA
#undef PG8_MMA8
#undef PG8_MMAI
#undef PG8_MQ
#undef PG8_MM
#undef PG8_RD8
#undef PG8_LDA8
#undef PG8_LDB8
#undef PG8_LA
#undef PG8_LB
#undef PG8_WAIT_V
#undef PG8_WAIT_L
#undef PG8_BAR
#undef PG8_SCHED
}
}

struct Params {
    const float* x; const int* pos;
    const float *ffn1_norm, *ffn1_wg, *ffn1_wu, *ffn1_wd, *mix_norm, *w_in, *q_norm, *kc_norm, *ks_norm, *kw_norm;
    const float *ck_pos, *ck_w1, *ck_w2, *cv_pos, *cv_w1, *cv_w2, *nsa_on, *sb_on, *w_out, *ffn2_norm, *ffn2_wg, *ffn2_wu, *ffn2_wd;
    float* out; unsigned char* ws;
};


__device__ __forceinline__ void rmsnorm_rows(const float* X, const float* g, bf16* Y) {
    int tid = threadIdx.x; asm volatile("" : "+v"(tid));
    const int lane = tid & 63, gw = blockIdx.x * NWAVES + (tid >> 6), NGW = gridDim.x * NWAVES;
    f32x4 gg[8];
#pragma unroll
    for (int j = 0; j < 8; ++j) gg[j] = ((const f32x4*)g)[lane + 64 * j];
    for (int m0 = gw; m0 < M; m0 += 2 * NGW) {
        const int m1 = m0 + NGW; const bool ok1 = m1 < M;
        const f32x4* x0 = (const f32x4*)(X + (size_t)m0 * D) + lane; const f32x4* x1 = (const f32x4*)(X + (size_t)(ok1 ? m1 : m0) * D) + lane;
        f32x4 v0[8], v1[8]; float s0 = 0.f, s1 = 0.f;
#pragma unroll
        for (int j = 0; j < 8; ++j) { v0[j] = x0[64 * j]; v1[j] = x1[64 * j]; }
#pragma unroll
        for (int j = 0; j < 8; ++j) { s0 += (v0[j].x * v0[j].x + v0[j].y * v0[j].y) + (v0[j].z * v0[j].z + v0[j].w * v0[j].w); s1 += (v1[j].x * v1[j].x + v1[j].y * v1[j].y) + (v1[j].z * v1[j].z + v1[j].w * v1[j].w); }
        const float r0 = rsqrtf(wave_sum(s0) * (1.f / D) + EPS), r1 = rsqrtf(wave_sum(s1) * (1.f / D) + EPS);
        v2u* o0 = (v2u*)(Y + (size_t)m0 * D) + lane; v2u* o1 = (v2u*)(Y + (size_t)m1 * D) + lane;
#pragma unroll
        for (int j = 0; j < 8; ++j) { v2u w; w.x = pk2(v0[j].x * r0 * gg[j].x, v0[j].y * r0 * gg[j].y); w.y = pk2(v0[j].z * r0 * gg[j].z, v0[j].w * r0 * gg[j].w); o0[64 * j] = w; }
        if (ok1) {
#pragma unroll
            for (int j = 0; j < 8; ++j) { v2u w; w.x = pk2(v1[j].x * r1 * gg[j].x, v1[j].y * r1 * gg[j].y); w.y = pk2(v1[j].z * r1 * gg[j].z, v1[j].w * r1 * gg[j].w); o1[64 * j] = w; }
        }
    }
}

template <bool I8 = false>
__device__ __forceinline__ void cast_rows(const float* X, bf16* Y, unsigned long long* rowsq, unsigned char* Y8 = nullptr, float* rowscale = nullptr) {
    int tid = threadIdx.x; asm volatile("" : "+v"(tid));
    const int lane = tid & 63, gw = blockIdx.x * NWAVES + (tid >> 6), NGW = gridDim.x * NWAVES;
    for (int m0 = gw; m0 < M; m0 += 2 * NGW) {
        const int m1 = m0 + NGW; const bool ok1 = m1 < M;
        const f32x4* x0 = (const f32x4*)(X + (size_t)m0 * D) + lane; const f32x4* x1 = (const f32x4*)(X + (size_t)(ok1 ? m1 : m0) * D) + lane;
        f32x4 v0[8], v1[8]; float s0 = 0.f, s1 = 0.f;
#pragma unroll
        for (int j = 0; j < 8; ++j) { v0[j] = x0[64 * j]; v1[j] = x1[64 * j]; }
#pragma unroll
        for (int j = 0; j < 8; ++j) { s0 += (v0[j].x * v0[j].x + v0[j].y * v0[j].y) + (v0[j].z * v0[j].z + v0[j].w * v0[j].w); s1 += (v1[j].x * v1[j].x + v1[j].y * v1[j].y) + (v1[j].z * v1[j].z + v1[j].w * v1[j].w); }
        s0 = wave_sum(s0); s1 = wave_sum(s1);
        if (lane == 0) { rowsq[m0] = (unsigned long long)(s0 * 16777216.0f); if (ok1) rowsq[m1] = (unsigned long long)(s1 * 16777216.0f); }
        v2u* o0 = (v2u*)(Y + (size_t)m0 * D) + lane; v2u* o1 = (v2u*)(Y + (size_t)m1 * D) + lane;
#pragma unroll
        for (int j = 0; j < 8; ++j) { v2u w; w.x = pk2(v0[j].x, v0[j].y); w.y = pk2(v0[j].z, v0[j].w); o0[64 * j] = w; }
        float q0 = 0.f, q1 = 0.f;
        if constexpr (I8) {
            float a0 = 0.f, a1 = 0.f;
#pragma unroll
            for (int j = 0; j < 8; ++j) {
                a0 = fmaxf(a0, fabsf(v0[j][0])); a0 = fmaxf(a0, fabsf(v0[j][1])); a0 = fmaxf(a0, fabsf(v0[j][2])); a0 = fmaxf(a0, fabsf(v0[j][3]));
                a1 = fmaxf(a1, fabsf(v1[j][0])); a1 = fmaxf(a1, fabsf(v1[j][1])); a1 = fmaxf(a1, fabsf(v1[j][2])); a1 = fmaxf(a1, fabsf(v1[j][3])); }
            a0 = wave_max(a0); a1 = wave_max(a1);
            q0 = a0 > 0.f ? 127.0f / a0 : 0.f; q1 = a1 > 0.f ? 127.0f / a1 : 0.f;
            if (lane == 0) { rowscale[m0] = a0 * (1.0f / 127.0f); if (ok1) rowscale[m1] = a1 * (1.0f / 127.0f); }
        }
        if (Y8) {
#pragma unroll
            for (int j = 0; j < 8; ++j) ((unsigned*)(Y8 + (size_t)m0 * D))[lane + 64 * j] = I8 ? pg8::pk4_i8(v0[j].x, v0[j].y, v0[j].z, v0[j].w, q0) : pg8::pk4_fp8(v0[j].x, v0[j].y, v0[j].z, v0[j].w);
        }
        if (ok1) {
#pragma unroll
            for (int j = 0; j < 8; ++j) { v2u w; w.x = pk2(v1[j].x, v1[j].y); w.y = pk2(v1[j].z, v1[j].w); o1[64 * j] = w; }
            if (Y8) {
#pragma unroll
                for (int j = 0; j < 8; ++j) ((unsigned*)(Y8 + (size_t)m1 * D))[lane + 64 * j] = I8 ? pg8::pk4_i8(v1[j].x, v1[j].y, v1[j].z, v1[j].w, q1) : pg8::pk4_fp8(v1[j].x, v1[j].y, v1[j].z, v1[j].w);
            }
        }
    }
}
__device__ __forceinline__ void rmsnorm_rows_bf16(const bf16* X, const float* g, bf16* Y) {
    int tid = threadIdx.x; asm volatile("" : "+v"(tid));
    const int lane = tid & 63, gw = blockIdx.x * NWAVES + (tid >> 6), NGW = gridDim.x * NWAVES;
    f32x4 ga[4], gb[4];
#pragma unroll
    for (int j = 0; j < 4; ++j) { ga[j] = *(const f32x4*)(g + 8 * (lane + 64 * j)); gb[j] = *(const f32x4*)(g + 8 * (lane + 64 * j) + 4); }
    for (int m0 = gw; m0 < M; m0 += 2 * NGW) {
        const int m1 = m0 + NGW; const bool ok1 = m1 < M;
        const v4u* x0 = (const v4u*)(X + (size_t)m0 * D) + lane; const v4u* x1 = (const v4u*)(X + (size_t)(ok1 ? m1 : m0) * D) + lane;
        v4u r0[4], r1[4];
#pragma unroll
        for (int j = 0; j < 4; ++j) { r0[j] = x0[64 * j]; r1[j] = x1[64 * j]; }
        float s0 = 0.f, s1 = 0.f;
#pragma unroll
        for (int j = 0; j < 4; ++j) {
            s0 += (bflo(r0[j].x) * bflo(r0[j].x) + bfhi(r0[j].x) * bfhi(r0[j].x)) + (bflo(r0[j].y) * bflo(r0[j].y) + bfhi(r0[j].y) * bfhi(r0[j].y)) + (bflo(r0[j].z) * bflo(r0[j].z) + bfhi(r0[j].z) * bfhi(r0[j].z)) + (bflo(r0[j].w) * bflo(r0[j].w) + bfhi(r0[j].w) * bfhi(r0[j].w));
            s1 += (bflo(r1[j].x) * bflo(r1[j].x) + bfhi(r1[j].x) * bfhi(r1[j].x)) + (bflo(r1[j].y) * bflo(r1[j].y) + bfhi(r1[j].y) * bfhi(r1[j].y)) + (bflo(r1[j].z) * bflo(r1[j].z) + bfhi(r1[j].z) * bfhi(r1[j].z)) + (bflo(r1[j].w) * bflo(r1[j].w) + bfhi(r1[j].w) * bfhi(r1[j].w));
        }
        const float q0 = rsqrtf(wave_sum(s0) * (1.f / D) + EPS), q1 = rsqrtf(wave_sum(s1) * (1.f / D) + EPS);
        v4u* o0 = (v4u*)(Y + (size_t)m0 * D) + lane; v4u* o1 = (v4u*)(Y + (size_t)m1 * D) + lane;
#pragma unroll
        for (int j = 0; j < 4; ++j) { v4u w; w.x = pk2(bflo(r0[j].x) * q0 * ga[j].x, bfhi(r0[j].x) * q0 * ga[j].y); w.y = pk2(bflo(r0[j].y) * q0 * ga[j].z, bfhi(r0[j].y) * q0 * ga[j].w);
            w.z = pk2(bflo(r0[j].z) * q0 * gb[j].x, bfhi(r0[j].z) * q0 * gb[j].y); w.w = pk2(bflo(r0[j].w) * q0 * gb[j].z, bfhi(r0[j].w) * q0 * gb[j].w); o0[64 * j] = w; }
        if (ok1) {
#pragma unroll
            for (int j = 0; j < 4; ++j) { v4u w; w.x = pk2(bflo(r1[j].x) * q1 * ga[j].x, bfhi(r1[j].x) * q1 * ga[j].y); w.y = pk2(bflo(r1[j].y) * q1 * ga[j].z, bfhi(r1[j].y) * q1 * ga[j].w);
                w.z = pk2(bflo(r1[j].z) * q1 * gb[j].x, bfhi(r1[j].z) * q1 * gb[j].y); w.w = pk2(bflo(r1[j].w) * q1 * gb[j].z, bfhi(r1[j].w) * q1 * gb[j].w); o1[64 * j] = w; }
        }
    }
}

__device__ __forceinline__ void rope_tables(const int* pos, float* cs, float* sn) {
    int tid = threadIdx.x; asm volatile("" : "+v"(tid));
    const int gt = blockIdx.x * NTHREADS + tid, NGT = gridDim.x * NTHREADS;
    for (int i = gt; i < M * 64; i += NGT) {
        const int m = i >> 6, f = i & 63;
        const float inv = powf(10000.f, -(float)(2 * f) / 128.f);
        const float ang = (float)pos[m] * inv;
        cs[i] = cosf(ang); sn[i] = sinf(ang);
    }
}

__device__ __forceinline__ void postproj_naive(const Params& P, bf16* PROJ, const float* cs, const float* sn) {
    int tid = threadIdx.x; asm volatile("" : "+v"(tid));
    const int lane = tid & 63, sub = lane & 15, gw = blockIdx.x * NWAVES + (tid >> 6), NGW = gridDim.x * NWAVES;
    constexpr int NG = M * 12 / 4;
    for (int g0 = gw; g0 < NG; g0 += 2 * NGW) {
        v2u lo[2], hi[2]; f32x4 cv[2], sv[2]; bf16* pp[2]; const float* gp[2]; float qs[2]; bool ok[2];
#pragma unroll
        for (int u = 0; u < 2; ++u) {
            const int g = g0 + u * NGW; ok[u] = g < NG;
            const int task = ok[u] ? 4 * g + (lane >> 4) : 0, m = task / 12, sl = task % 12;
            int col;
            if (sl < 8) { col = C_QN + sl * 128; gp[u] = P.q_norm; } else if (sl < 10) { col = C_KS + (sl - 8) * 128; gp[u] = P.ks_norm; } else { col = C_KW + (sl - 10) * 128; gp[u] = P.kw_norm; }
            qs[u] = sl < 8 ? QSCALE : 1.0f;
            pp[u] = PROJ + (size_t)m * NP + col + 4 * sub;
            lo[u] = *(const v2u*)pp[u]; hi[u] = *(const v2u*)(pp[u] + 64);
            cv[u] = *(const f32x4*)(cs + m * 64 + 4 * sub); sv[u] = *(const f32x4*)(sn + m * 64 + 4 * sub);
        }
#pragma unroll
        for (int u = 0; u < 2; ++u) {
            float a[4], b[4];
            a[0] = bflo(lo[u].x); a[1] = bfhi(lo[u].x); a[2] = bflo(lo[u].y); a[3] = bfhi(lo[u].y);
            b[0] = bflo(hi[u].x); b[1] = bfhi(hi[u].x); b[2] = bflo(hi[u].y); b[3] = bfhi(hi[u].y);
            float ss = (a[0] * a[0] + a[1] * a[1]) + (a[2] * a[2] + a[3] * a[3]) + (b[0] * b[0] + b[1] * b[1]) + (b[2] * b[2] + b[3] * b[3]);
            ss += __shfl_xor(ss, 1); ss += __shfl_xor(ss, 2); ss += __shfl_xor(ss, 4); ss += __shfl_xor(ss, 8);
            const float r = rsqrtf(ss * (1.f / 128.f) + EPS) * qs[u];
            const f32x4 ga = *(const f32x4*)(gp[u] + 4 * sub), gb = *(const f32x4*)(gp[u] + 64 + 4 * sub);
            float oa[4], ob[4];
#pragma unroll
            for (int e = 0; e < 4; ++e) { const float x = a[e] * r * ga[e], y = b[e] * r * gb[e]; oa[e] = x * cv[u][e] - y * sv[u][e]; ob[e] = y * cv[u][e] + x * sv[u][e]; }
            if (ok[u]) { v2u wa, wb; wa.x = pk2(oa[0], oa[1]); wa.y = pk2(oa[2], oa[3]); wb.x = pk2(ob[0], ob[1]); wb.y = pk2(ob[2], ob[3]); *(v2u*)pp[u] = wa; *(v2u*)(pp[u] + 64) = wb; }
        }
    }
}

namespace att {
typedef short bf16x8 __attribute__((ext_vector_type(8)));
typedef short s16x4 __attribute__((ext_vector_type(4)));
constexpr float C1 = 0.08838834764831845f * 1.4426950408889634f;
typedef __bf16 bf16x2_t __attribute__((ext_vector_type(2)));
__device__ __forceinline__ unsigned cvt_pk_bf16(float lo, float hi) { const bf16x2_t v = __builtin_convertvector((f32x2){lo, hi}, bf16x2_t); return __builtin_bit_cast(unsigned, v); }
__device__ __forceinline__ int offK(int key, int dc) { return key * 256 + 16 * (dc ^ ((key & 3) | (((key >> 4) & 3) << 2))); }
__device__ __forceinline__ int offV(int key, int dc) { return key * 256 + 32 * ((dc >> 1) ^ ((key & 3) | (((key >> 4) & 1) << 2))) + 16 * (dc & 1); }
struct TileRegs { v4u k[2], v[2]; };
__device__ __forceinline__ void tile_load(TileRegs& r, const bf16* kp, const bf16* vp, int ld, int tid) {
#if NSA_OPAQUE
    asm volatile("" : "+v"(tid));
#endif
#pragma unroll
    for (int i = 0; i < 2; ++i) { const int id = tid + 512 * i, key = id >> 4, dc = id & 15; r.k[i] = *(const v4u*)(kp + (size_t)key * ld + dc * 8); r.v[i] = *(const v4u*)(vp + (size_t)key * ld + dc * 8); }
}
__device__ __forceinline__ void tile_store(const TileRegs& r, LAS unsigned char* kb, LAS unsigned char* vb, int tid) {
#if NSA_OPAQUE
    asm volatile("" : "+v"(tid));
#endif
#pragma unroll
    for (int i = 0; i < 2; ++i) { const int id = tid + 512 * i, key = id >> 4, dc = id & 15; *(LAS v4u*)(kb + offK(key, dc)) = r.k[i]; *(LAS v4u*)(vb + offV(key, dc)) = r.v[i]; }
}
__device__ __forceinline__ void tile_dma(const bf16* kp, const bf16* vp, int ld, LAS unsigned char* kb, LAS unsigned char* vb, int w, int lane) {
    asm volatile("" : "+v"(lane));
#pragma unroll
    for (int i = 0; i < 2; ++i) {
        const int p = 2 * w + i, key = 4 * p + (lane >> 4), sl = lane & 15;
        const int dck = sl ^ ((key & 3) | (((key >> 4) & 3) << 2));
        const int dcv = 2 * ((sl >> 1) ^ ((key & 3) | (((key >> 4) & 1) << 2))) + (sl & 1);
        __builtin_amdgcn_global_load_lds((const unsigned*)(kp + (size_t)key * ld + dck * 8), (LAS unsigned*)(kb + 1024 * p), 16, 0, 0);
        __builtin_amdgcn_global_load_lds((const unsigned*)(vp + (size_t)key * ld + dcv * 8), (LAS unsigned*)(vb + 1024 * p), 16, 0, 0);
    }
}
__device__ __forceinline__ void dma_k4(const bf16* kp, int ld, LAS unsigned char* kb, int w, int lane) {
    asm volatile("" : "+v"(lane));
#pragma unroll
    for (int i = 0; i < 4; ++i) {
        const int p = 4 * w + i, key = 4 * p + (lane >> 4), sl = lane & 15;
        const int dck = sl ^ ((key & 3) | (((key >> 4) & 3) << 2));
        __builtin_amdgcn_global_load_lds((const unsigned*)(kp + (size_t)key * ld + dck * 8), (LAS unsigned*)(kb + 1024 * p), 16, 0, 0);
    }
}
__device__ __forceinline__ void dma_v4(const bf16* vp, int ld, LAS unsigned char* vb, int w, int lane) {
    asm volatile("" : "+v"(lane));
#pragma unroll
    for (int i = 0; i < 4; ++i) {
        const int p = 4 * w + i, key = 4 * p + (lane >> 4), sl = lane & 15;
        const int dcv = 2 * ((sl >> 1) ^ ((key & 3) | (((key >> 4) & 1) << 2))) + (sl & 1);
        __builtin_amdgcn_global_load_lds((const unsigned*)(vp + (size_t)key * ld + dcv * 8), (LAS unsigned*)(vb + 1024 * p), 16, 0, 0);
    }
}
#define ATT_WAIT_V(n) asm volatile("s_waitcnt vmcnt(" #n ")" ::: "memory")
#define ATT_BAR() do { asm volatile("s_waitcnt lgkmcnt(0)" ::: "memory"); __builtin_amdgcn_s_barrier(); asm volatile("" ::: "memory"); } while (0)
template <bool OPAQUE = true>
__device__ __forceinline__ void qk_tile(f32x4 (&s)[2][4], const bf16x8 (&qf)[2][4], const LAS unsigned char* kb, int c, int q4) {
    if (OPAQUE) asm volatile("" : "+v"(c), "+v"(q4));
    const int rowoff = (16 * (c >> 2) + (c & 3)) * 256, lowp = 16 * (q4 ^ (c & 3));
#pragma unroll
    for (int kt = 0; kt < 4; ++kt) { s[0][kt] = (f32x4){0.f, 0.f, 0.f, 0.f}; s[1][kt] = (f32x4){0.f, 0.f, 0.f, 0.f}; }
#pragma unroll
    for (int ks = 0; ks < 4; ++ks) {
        const int a = rowoff + 64 * (ks ^ (c >> 2)) + lowp;
#pragma unroll
        for (int kt = 0; kt < 4; ++kt) {
            const bf16x8 kf = *(const LAS bf16x8*)(kb + a + kt * 1024);
            s[0][kt] = __builtin_amdgcn_mfma_f32_16x16x32_bf16(kf, qf[0][ks], s[0][kt], 0, 0, 0);
            s[1][kt] = __builtin_amdgcn_mfma_f32_16x16x32_bf16(kf, qf[1][ks], s[1][kt], 0, 0, 0);
        }
    }
}
__device__ __forceinline__ void qk_tile_lq(f32x4 (&s)[2][4], const LAS unsigned char* qb, const LAS unsigned char* kb, int c, int q4, int lane) {
#if NSA_OPAQUE
    asm volatile("" : "+v"(c), "+v"(q4), "+v"(lane));
#endif
    const int rowoff = (16 * (c >> 2) + (c & 3)) * 256, lowp = 16 * (q4 ^ (c & 3));
#pragma unroll
    for (int kt = 0; kt < 4; ++kt) { s[0][kt] = (f32x4){0.f, 0.f, 0.f, 0.f}; s[1][kt] = (f32x4){0.f, 0.f, 0.f, 0.f}; }
#pragma unroll
    for (int ks = 0; ks < 4; ++ks) {
        const int a = rowoff + 64 * (ks ^ (c >> 2)) + lowp;
        const bf16x8 q0 = *(const LAS bf16x8*)(qb + (ks * 64 + lane) * 16), q1 = *(const LAS bf16x8*)(qb + ((4 + ks) * 64 + lane) * 16);
#pragma unroll
        for (int kt = 0; kt < 4; ++kt) {
            const bf16x8 kf = *(const LAS bf16x8*)(kb + a + kt * 1024);
            s[0][kt] = __builtin_amdgcn_mfma_f32_16x16x32_bf16(kf, q0, s[0][kt], 0, 0, 0);
            s[1][kt] = __builtin_amdgcn_mfma_f32_16x16x32_bf16(kf, q1, s[1][kt], 0, 0, 0);
        }
    }
}
__device__ __forceinline__ void pv_tile(f32x4 (&o)[8][2], const bf16x8 (&pf)[2][2], const LAS unsigned char* vb, int c, int q4) {
#if NSA_OPAQUE
    asm volatile("" : "+v"(c), "+v"(q4));
#endif
    const int p = c & 3;
#pragma unroll
    for (int s2 = 0; s2 < 2; ++s2) {
        const int key0 = 16 * q4 + 8 * s2 + (c >> 2);
        const int g = (key0 & 3) | (((key0 >> 4) & 1) << 2);
        const int base = key0 * 256 + 16 * (p >> 1) + 8 * (p & 1);
#pragma unroll
        for (int dt = 0; dt < 8; ++dt) {
            const LAS unsigned char* a0 = vb + base + 32 * (dt ^ g);
            const s16x4 lo = __builtin_amdgcn_ds_read_tr16_b64_v4i16((LAS s16x4*)a0);
            const s16x4 hi = __builtin_amdgcn_ds_read_tr16_b64_v4i16((LAS s16x4*)(a0 + 1024));
            const bf16x8 vf = __builtin_shufflevector(lo, hi, 0, 1, 2, 3, 4, 5, 6, 7);
            o[dt][0] = __builtin_amdgcn_mfma_f32_16x16x32_bf16(vf, pf[0][s2], o[dt][0], 0, 0, 0);
            o[dt][1] = __builtin_amdgcn_mfma_f32_16x16x32_bf16(vf, pf[1][s2], o[dt][1], 0, 0, 0);
        }
    }
}
__device__ __forceinline__ s16x4 tr_read_asm(unsigned addr) { s16x4 r; asm volatile("ds_read_b64_tr_b16 %0, %1" : "=v"(r) : "v"(addr) : "memory"); return r; }
__device__ __forceinline__ s16x4 tr_read_asm_1k(unsigned addr) { s16x4 r; asm volatile("ds_read_b64_tr_b16 %0, %1 offset:1024" : "=v"(r) : "v"(addr) : "memory"); return r; }
template <bool OPAQUE = true>
__device__ __forceinline__ void pv_tile_asm(f32x4 (&o)[8][2], const bf16x8 (&pf)[2][2], const LAS unsigned char* vb, int c, int q4) {
    if (OPAQUE) asm volatile("" : "+v"(c), "+v"(q4));
    const int p = c & 3;
#pragma unroll
    for (int s2 = 0; s2 < 2; ++s2) {
        const int key0 = 16 * q4 + 8 * s2 + (c >> 2);
        const int g = (key0 & 3) | (((key0 >> 4) & 1) << 2);
        const unsigned base = (unsigned)(size_t)vb + key0 * 256 + 16 * (p >> 1) + 8 * (p & 1);
        s16x4 lo[8], hi[8];
#pragma unroll
        for (int dt = 0; dt < 8; ++dt) { const unsigned a0 = base + 32 * (dt ^ g); lo[dt] = tr_read_asm(a0); hi[dt] = tr_read_asm_1k(a0); }
        asm volatile("s_waitcnt lgkmcnt(0)" ::: "memory");
        __builtin_amdgcn_sched_barrier(0);
#pragma unroll
        for (int dt = 0; dt < 8; ++dt) {
            const bf16x8 vf = __builtin_shufflevector(lo[dt], hi[dt], 0, 1, 2, 3, 4, 5, 6, 7);
            o[dt][0] = __builtin_amdgcn_mfma_f32_16x16x32_bf16(vf, pf[0][s2], o[dt][0], 0, 0, 0);
            o[dt][1] = __builtin_amdgcn_mfma_f32_16x16x32_bf16(vf, pf[1][s2], o[dt][1], 0, 0, 0);
        }
    }
}
struct VGroup { s16x4 lo[4], hi[4]; };
template <int G>
__device__ __forceinline__ void pv_issue(VGroup& v, const LAS unsigned char* vb, int c, int q4) {
    constexpr int s2 = G >> 1, d0 = 4 * (G & 1);
    const int p = c & 3, key0 = 16 * q4 + 8 * s2 + (c >> 2), g = (key0 & 3) | (((key0 >> 4) & 1) << 2);
    const unsigned base = (unsigned)(size_t)vb + key0 * 256 + 16 * (p >> 1) + 8 * (p & 1);
#pragma unroll
    for (int i = 0; i < 4; ++i) { const unsigned a0 = base + 32 * ((d0 + i) ^ g); v.lo[i] = tr_read_asm(a0); v.hi[i] = tr_read_asm_1k(a0); }
}
template <int G>
__device__ __forceinline__ void pv_mma(f32x4 (&o)[8][2], const VGroup& v, const bf16x8 (&pf)[2][2]) {
    constexpr int s2 = G >> 1, d0 = 4 * (G & 1);
#pragma unroll
    for (int i = 0; i < 4; ++i) {
        const bf16x8 vf = __builtin_shufflevector(v.lo[i], v.hi[i], 0, 1, 2, 3, 4, 5, 6, 7);
        o[d0 + i][0] = __builtin_amdgcn_mfma_f32_16x16x32_bf16(vf, pf[0][s2], o[d0 + i][0], 0, 0, 0);
        o[d0 + i][1] = __builtin_amdgcn_mfma_f32_16x16x32_bf16(vf, pf[1][s2], o[d0 + i][1], 0, 0, 0);
    }
}
#define PV_WAIT() do { asm volatile("s_waitcnt lgkmcnt(0)" ::: "memory"); __builtin_amdgcn_sched_barrier(0); } while (0)
__device__ __forceinline__ void pv_tile_rest(f32x4 (&o)[8][2], VGroup& va, const bf16x8 (&pf)[2][2], const LAS unsigned char* vb, int c, int q4) {
    VGroup vb2;
    PV_WAIT(); pv_issue<1>(vb2, vb, c, q4); __builtin_amdgcn_sched_barrier(0); pv_mma<0>(o, va, pf);
    PV_WAIT(); pv_issue<2>(va, vb, c, q4);  __builtin_amdgcn_sched_barrier(0); pv_mma<1>(o, vb2, pf);
    PV_WAIT(); pv_issue<3>(vb2, vb, c, q4); __builtin_amdgcn_sched_barrier(0); pv_mma<2>(o, va, pf);
    PV_WAIT(); pv_mma<3>(o, vb2, pf);
}
__device__ __forceinline__ bf16x8 pack8(float a0, float a1, float a2, float a3, float a4, float a5, float a6, float a7) {
    v4u w; w.x = cvt_pk_bf16(a0, a1); w.y = cvt_pk_bf16(a2, a3); w.z = cvt_pk_bf16(a4, a5); w.w = cvt_pk_bf16(a6, a7);
    return __builtin_bit_cast(bf16x8, w);
}


template <bool MASK>
__device__ __forceinline__ void sb_elem(const f32x4 (&s)[4], float& R, bf16x8 (&pf)[2], const int kdiff, const int c, const int q4) {
    f32x2 a2[8]; f32x2 t2 = (f32x2){1.f, 1.f};
#pragma unroll
    for (int k = 0; k < 8; ++k) {
        f32x2 e;
        e.x = __builtin_amdgcn_exp2f(s[k >> 2][k & 3]); e.y = __builtin_amdgcn_exp2f(s[2 + (k >> 2)][k & 3]);
        if (MASK) { e.x = (k < kdiff) ? e.x : 0.f; e.y = (k + 8 < kdiff) ? e.y : 0.f; }
        a2[k] = e * t2; t2 = t2 * (e + 1.0f);
    }
    const float l0 = __builtin_amdgcn_logf(t2.x), l1 = __builtin_amdgcn_logf(t2.y), run = l0 + l1;
    const float u1 = __shfl_down(run, 16), u2 = __shfl_down(run, 32), u3 = __shfl_down(run, 48);
    const float X = (q4 < 3 ? u1 : 0.f) + (q4 < 2 ? u2 : 0.f) + (q4 < 1 ? u3 : 0.f);
    const float tot = __shfl(run + X, c);
    const float base = R + X + l1;
    f32x2 sc; sc.y = __builtin_amdgcn_exp2f(-base); sc.x = __builtin_amdgcn_exp2f(-(base + l0));
    R += tot;
#pragma unroll
    for (int k = 0; k < 8; ++k) a2[k] = a2[k] * sc;
    pf[0] = pack8(a2[0].x, a2[1].x, a2[2].x, a2[3].x, a2[4].x, a2[5].x, a2[6].x, a2[7].x);
    pf[1] = pack8(a2[0].y, a2[1].y, a2[2].y, a2[3].y, a2[4].y, a2[5].y, a2[6].y, a2[7].y);
}

template <int MODE = 31>
__device__ __forceinline__ void sb_unit(const Params& P, LAS unsigned char* lds, const bf16* PROJ, const bf16* KVC, bf16* Y, int b, int h, int tqq) {
    int tid = threadIdx.x; asm volatile("" : "+v"(tid));
    const int lane = tid & 63, w = __builtin_amdgcn_readfirstlane(tid >> 6), c = lane & 15, q4 = lane >> 4;
    const int qbase = 256 * tqq + 32 * w;
    bf16x8 qf[2][4];
#pragma unroll
    for (int qt = 0; qt < 2; ++qt)
#pragma unroll
        for (int ks = 0; ks < 4; ++ks) qf[qt][ks] = *(const bf16x8*)(PROJ + (size_t)(b * SEQ + qbase + 16 * qt + c) * NP + C_QS + h * 128 + 32 * ks + 8 * q4);
#pragma unroll
    for (int qt = 0; qt < 2; ++qt)
#pragma unroll
        for (int ks = 0; ks < 4; ++ks) asm volatile("" : "+v"(qf[qt][ks]));
    f32x4 o[8][2];
#pragma unroll
    for (int dt = 0; dt < 8; ++dt) { o[dt][0] = (f32x4){0.f, 0.f, 0.f, 0.f}; o[dt][1] = (f32x4){0.f, 0.f, 0.f, 0.f}; }
    float R[2] = {0.f, 0.f};
#if SB_COMPACT
    const bf16* kg = KVC + (size_t)((b * 8 + h) * 4096) * 128; const bf16* vg = KVC + (size_t)((32 + b * 8 + h) * 4096) * 128;
    constexpr int KLD = 128;
#else
    const bf16* kg = PROJ + (size_t)(b * SEQ) * NP + C_KSB + h * 128; const bf16* vg = PROJ + (size_t)(b * SEQ) * NP + C_VSB + h * 128;
    constexpr int KLD = NP;
#endif
    const int nkt = 4 * tqq + 4;
    const bool isA = w < 4;
    if (isA && (MODE & 8)) { dma_k4(kg + (size_t)(nkt - 1) * 64 * KLD, KLD, lds, w, lane); dma_v4(vg + (size_t)(nkt - 1) * 64 * KLD, KLD, lds + 32768, w, lane); ATT_WAIT_V(0); }
    ATT_BAR();
    if (!isA) ATT_BAR();
    for (int it = 0; it < nkt; ++it) {
        const int kt64 = nkt - 1 - it, kb0 = 64 * kt64, cur = it & 1;
        const bool has = it + 1 < nkt, active = kb0 <= qbase + 30, need_mask = (kb0 + 63 >= qbase);
        const LAS unsigned char* kb = lds + cur * 16384; const LAS unsigned char* vb = lds + 32768 + cur * 16384;
        f32x4 s[2][4]; bf16x8 pf[2][2];
        if (isA && has && (MODE & 8)) dma_k4(kg + (size_t)(kt64 - 1) * 64 * KLD, KLD, lds + (cur ^ 1) * 16384, w, lane);
        if (active) {
            if (MODE & 1) qk_tile<false>(s, qf, kb, c, q4);
            else {
#pragma unroll
                for (int kt = 0; kt < 4; ++kt) { s[0][kt] = (f32x4){0.1f, -0.2f, 0.3f, R[0]}; s[1][kt] = (f32x4){-0.1f, 0.2f, -0.3f, R[1]}; asm volatile("" : "+v"(s[0][kt]), "+v"(s[1][kt])); } }
            if (MODE & 2) { if (need_mask) sb_elem<true>(s[0], R[0], pf[0], qbase + c - kb0 - 16 * q4, c, q4); else sb_elem<false>(s[0], R[0], pf[0], 64, c, q4); }
            else { pf[0][0] = __builtin_bit_cast(bf16x8, s[0][0]); pf[0][1] = __builtin_bit_cast(bf16x8, s[0][1]); R[0] += s[0][2][0] + s[0][3][1]; }
        }
        if (isA) { if (has) ATT_WAIT_V(4); else ATT_WAIT_V(0); }
        if (MODE & 16) ATT_BAR();
        if (isA && has && (MODE & 8)) dma_v4(vg + (size_t)(kt64 - 1) * 64 * KLD, KLD, lds + 32768 + (cur ^ 1) * 16384, w, lane);
        if (active) {
            VGroup vg0;
            if (MODE & 4) { pv_issue<0>(vg0, vb, c, q4); __builtin_amdgcn_sched_barrier(0); }
            if (MODE & 2) { if (need_mask) sb_elem<true>(s[1], R[1], pf[1], qbase + 16 + c - kb0 - 16 * q4, c, q4); else sb_elem<false>(s[1], R[1], pf[1], 64, c, q4); }
            else { pf[1][0] = __builtin_bit_cast(bf16x8, s[1][0]); pf[1][1] = __builtin_bit_cast(bf16x8, s[1][1]); R[1] += s[1][2][0] + s[1][3][1]; }
            if (MODE & 4) pv_tile_rest(o, vg0, pf, vb, c, q4);
            else { o[0][0] = o[0][0] + __builtin_bit_cast(f32x4, pf[0][0]) + __builtin_bit_cast(f32x4, pf[0][1]); o[0][1] = o[0][1] + __builtin_bit_cast(f32x4, pf[1][0]) + __builtin_bit_cast(f32x4, pf[1][1]); }
        }
        if (isA) { if (has) ATT_WAIT_V(4); else ATT_WAIT_V(0); }
        if (MODE & 16) ATT_BAR();
    }
    if (isA) ATT_BAR();
    f32x4 gsb[8];
#pragma unroll
    for (int dt = 0; dt < 8; ++dt) gsb[dt] = *(const f32x4*)(P.sb_on + h * 128 + 4 * q4 + 16 * dt);
#pragma unroll
    for (int qt = 0; qt < 2; ++qt) {
        float ss = 0.f;
#pragma unroll
        for (int dt = 0; dt < 8; ++dt) { const f32x4 v = o[dt][qt]; ss += (v[0] * v[0] + v[1] * v[1]) + (v[2] * v[2] + v[3] * v[3]); }
        ss += __shfl_xor(ss, 16); ss += __shfl_xor(ss, 32);
        const float r = rsqrtf(ss * (1.f / 128.f) + EPS);
        bf16* yrow = Y + (size_t)(b * SEQ + qbase + 16 * qt + c) * D + 1024 + h * 128 + 4 * q4;
#pragma unroll
        for (int dt = 0; dt < 8; ++dt) { const f32x4 v = o[dt][qt]; const f32x4 gg = gsb[dt];
            v2u wv; wv.x = cvt_pk_bf16(v[0] * r * gg[0], v[1] * r * gg[1]); wv.y = cvt_pk_bf16(v[2] * r * gg[2], v[3] * r * gg[3]);
            *(v2u*)(yrow + 16 * dt) = wv; }
    }
}

__device__ __forceinline__ void osm_step(const f32x4 (&s)[4], const bool bsel, const bool masked, const int lo, const int hi, float& m, float& l, f32x4 (&o)[8][2], const int qt, bf16x8 (&pf)[2]) {
    float v[16];
#pragma unroll
    for (int idx = 0; idx < 16; ++idx) v[idx] = s[idx >> 2][idx & 3];
    if (masked) {
#pragma unroll
        for (int idx = 0; idx < 16; ++idx) v[idx] = (idx >= lo && idx <= hi) ? v[idx] : -1e30f;
    }
    float tm = fmaxf(fmaxf(fmaxf(v[0], v[1]), fmaxf(v[2], v[3])), fmaxf(fmaxf(v[4], v[5]), fmaxf(v[6], v[7])));
    tm = fmaxf(tm, fmaxf(fmaxf(fmaxf(v[8], v[9]), fmaxf(v[10], v[11])), fmaxf(fmaxf(v[12], v[13]), fmaxf(v[14], v[15]))));
    tm = fmaxf(tm, __shfl_xor(tm, 16)); tm = fmaxf(tm, __shfl_xor(tm, 32));
    tm = bsel ? tm : -1e30f;
    const bool grow = tm > m + 8.0f;
    if (__any(grow)) {
        const float mn = grow ? tm : m, alpha = __builtin_amdgcn_exp2f(m - mn);
        l *= alpha; m = mn;
#pragma unroll
        for (int dt = 0; dt < 8; ++dt) o[dt][qt] = o[dt][qt] * alpha;
    }
    const float sub = bsel ? m : 1e30f;
    float sum = 0.f;
#pragma unroll
    for (int idx = 0; idx < 16; ++idx) { v[idx] = __builtin_amdgcn_exp2f(v[idx] - sub); sum += v[idx]; }
    l += sum;
    pf[0] = pack8(v[0], v[1], v[2], v[3], v[4], v[5], v[6], v[7]);
    pf[1] = pack8(v[8], v[9], v[10], v[11], v[12], v[13], v[14], v[15]);
}
#define ATT_TILE_PROLOGUE(KP, VP, LD) do { tile_load(tr, (KP), (VP), (LD), tid); __syncthreads(); tile_store(tr, lds, lds + 32768, tid); __syncthreads(); } while (0)
#define ATT_TILE_NEXT(HAS, KP, VP, LD) do { if (HAS) tile_load(tr, (KP), (VP), (LD), tid); } while (0)
#define ATT_TILE_END(HAS, CUR) do { if (HAS) tile_store(tr, lds + ((CUR) ^ 1) * 16384, lds + 32768 + ((CUR) ^ 1) * 16384, tid); __syncthreads(); } while (0)

__device__ __forceinline__ void nsa_unit(const Params& P, LAS unsigned char* lds, const bf16* PROJ, const bf16* KC, const bf16* VC, bf16* Y, f32x4* scr, int b, int g, int tq) {
    int tid = threadIdx.x; asm volatile("" : "+v"(tid));
    const int lane = tid & 63, w = __builtin_amdgcn_readfirstlane(tid >> 6), c = lane & 15, q4 = lane >> 4;
    const int bg = b * 2 + g, t0 = 64 * tq, hg = g * 4 + (c & 3);
    LAS float* pslc = (LAS float*)(lds + 131072);
    LAS unsigned long long* selm = (LAS unsigned long long*)(lds + 147456);
    LAS unsigned char* qb = lds + 65536 + w * 8192;
    scr += (size_t)w * 32 * 64;
    int ql[2]; ql[0] = 8 * w + (c >> 2); ql[1] = ql[0] + 4;
#pragma unroll
    for (int i = 0; i < 8; ++i) pslc[(8 * w + i) * 64 + lane] = 0.f;
    bf16x8 qf[2][4];
#pragma unroll
    for (int qt = 0; qt < 2; ++qt) {
        const bf16* prow = PROJ + (size_t)(b * SEQ + t0 + ql[qt]) * NP;
#pragma unroll
        for (int ks = 0; ks < 4; ++ks) qf[qt][ks] = *(const bf16x8*)(prow + C_QN + hg * 128 + 32 * ks + 8 * q4);
    }
#pragma unroll
    for (int qt = 0; qt < 2; ++qt)
#pragma unroll
        for (int ks = 0; ks < 4; ++ks) asm volatile("" : "+v"(qf[qt][ks]));
    float gates[2][3];
    {
        bf16 graw[2][3];
#pragma unroll
        for (int qt = 0; qt < 2; ++qt)
#pragma unroll
            for (int br = 0; br < 3; ++br) graw[qt][br] = PROJ[(size_t)(b * SEQ + t0 + ql[qt]) * NP + C_GATE + hg * 3 + br];
#pragma unroll
        for (int qt = 0; qt < 2; ++qt)
#pragma unroll
            for (int br = 0; br < 3; ++br) gates[qt][br] = 1.f / (1.f + __expf(-bf2f(graw[qt][br])));
    }
    TileRegs tr;
    f32x4 o[8][2];
    float mx[2], ls[2];
    const bf16* kcg = KC + (size_t)bg * 256 * 128; const bf16* vcg = VC + (size_t)bg * 256 * 128;
    const int nvmax = min(NCMP, 4 * tq + 3), ntc = (nvmax + 63) >> 6;
    mx[0] = mx[1] = -1e20f; ls[0] = ls[1] = 0.f;
    ATT_TILE_PROLOGUE(kcg, vcg, 128);
    for (int it = 0; it < ntc; ++it) {
        const int cur = it & 1; const bool has = it + 1 < ntc;
        ATT_TILE_NEXT(has, kcg + (size_t)(it + 1) * 64 * 128, vcg + (size_t)(it + 1) * 64 * 128, 128);
        {
            f32x4 s[2][4];
            qk_tile<false>(s, qf, lds + cur * 16384, c, q4);
#pragma unroll
            for (int qt = 0; qt < 2; ++qt) {
                const int lim = t0 + ql[qt] - 31 - 16 * (64 * it + 16 * q4);
                float tm = -1e30f, v[16];
#pragma unroll
                for (int kt = 0; kt < 4; ++kt)
#pragma unroll
                    for (int i = 0; i < 4; ++i) { v[4 * kt + i] = (16 * (4 * kt + i) <= lim) ? s[qt][kt][i] : -1e30f; tm = fmaxf(tm, v[4 * kt + i]); }
                tm = fmaxf(tm, __shfl_xor(tm, 16)); tm = fmaxf(tm, __shfl_xor(tm, 32));
                const float mn = fmaxf(mx[qt], tm); float sum = 0.f;
#pragma unroll
                for (int i = 0; i < 16; ++i) sum += __builtin_amdgcn_exp2f(v[i] - mn);
                ls[qt] = ls[qt] * __builtin_amdgcn_exp2f(mx[qt] - mn) + sum; mx[qt] = mn;
            }
        }
        ATT_TILE_END(has, cur);
    }
    float inv[2];
#pragma unroll
    for (int qt = 0; qt < 2; ++qt) { float l = ls[qt]; l += __shfl_xor(l, 16); l += __shfl_xor(l, 32); inv[qt] = l > 0.f ? 1.f / l : 0.f; }
    float g0v[2]; g0v[0] = gates[0][0]; g0v[1] = gates[1][0];
#pragma unroll
    for (int dt = 0; dt < 8; ++dt) { o[dt][0] = (f32x4){0.f, 0.f, 0.f, 0.f}; o[dt][1] = (f32x4){0.f, 0.f, 0.f, 0.f}; }
    ATT_TILE_PROLOGUE(kcg, vcg, 128);
    for (int it = 0; it < ntc; ++it) {
        const int cur = it & 1; const bool has = it + 1 < ntc;
        ATT_TILE_NEXT(has, kcg + (size_t)(it + 1) * 64 * 128, vcg + (size_t)(it + 1) * 64 * 128, 128);
        {
            f32x4 s[2][4];
            qk_tile<false>(s, qf, lds + cur * 16384, c, q4);
            bf16x8 pf[2][2];
#pragma unroll
            for (int qt = 0; qt < 2; ++qt) {
                const int lim = t0 + ql[qt] - 31 - 16 * (64 * it + 16 * q4);
                float p[16];
#pragma unroll
                for (int kt = 0; kt < 4; ++kt)
#pragma unroll
                    for (int i = 0; i < 4; ++i) p[4 * kt + i] = (16 * (4 * kt + i) <= lim) ? __builtin_amdgcn_exp2f(s[qt][kt][i] - mx[qt]) * inv[qt] : 0.f;
                const int jb = 16 * it + 4 * q4;
#pragma unroll
                for (int kt = 0; kt < 4; ++kt) {
                    float gs = (p[4 * kt] + p[4 * kt + 1]) + (p[4 * kt + 2] + p[4 * kt + 3]), e3 = p[4 * kt + 3];
                    gs += __shfl_xor(gs, 1); gs += __shfl_xor(gs, 2); e3 += __shfl_xor(e3, 1); e3 += __shfl_xor(e3, 2);
                    if ((c & 3) == 0) {
                        LAS float* row = pslc + ql[qt] * 64;
                        __hip_atomic_fetch_add(row + jb + kt, gs, __ATOMIC_RELAXED, __HIP_MEMORY_SCOPE_WORKGROUP);
                        if (jb + kt + 1 < 64) __hip_atomic_fetch_add(row + jb + kt + 1, e3, __ATOMIC_RELAXED, __HIP_MEMORY_SCOPE_WORKGROUP);
                    }
                }
                const float g0 = g0v[qt];
                pf[qt][0] = pack8(p[0] * g0, p[1] * g0, p[2] * g0, p[3] * g0, p[4] * g0, p[5] * g0, p[6] * g0, p[7] * g0);
                pf[qt][1] = pack8(p[8] * g0, p[9] * g0, p[10] * g0, p[11] * g0, p[12] * g0, p[13] * g0, p[14] * g0, p[15] * g0);
            }
            pv_tile(o, pf, lds + 32768 + cur * 16384, c, q4);
        }
        ATT_TILE_END(has, cur);
    }
#pragma unroll
    for (int dt = 0; dt < 8; ++dt) { scr[lane * 32 + 2 * dt] = o[dt][0]; scr[lane * 32 + 2 * dt + 1] = o[dt][1]; }
    asm volatile("s_waitcnt lgkmcnt(0)" ::: "memory");
    {
        unsigned long long wor = 0ull;
        const int j = lane;
        const bool causal = j <= tq, forced = (j == 0) || (j == tq) || (j == tq - 1);
        const unsigned long long cmask = __ballot(causal);
        for (int i = 0; i < 8; ++i) {
            const float pv = pslc[(8 * w + i) * 64 + j];
            const unsigned key = causal ? (forced ? 0xFFFFFFFFu : __float_as_uint(pv) + 1u) : 0u;
            unsigned T = 0u;
#pragma unroll
            for (int bit = 31; bit >= 0; --bit) { const unsigned cand = T | (1u << bit); if (__popcll(__ballot(key >= cand)) >= 16) T = cand; }
            const unsigned long long gt = __ballot(key > T); unsigned long long eq = __ballot(key == T), take = 0ull;
            for (int need = 16 - __popcll(gt); need > 0 && eq != 0ull; --need) { const unsigned long long low = eq & (~eq + 1ull); take |= low; eq ^= low; }
            const unsigned long long mask = (gt | take) & cmask;
            if (lane == 0) selm[8 * w + i] = mask;
            wor |= mask;
        }
        if (lane == 0) selm[64 + w] = wor;
    }
    __syncthreads();
    unsigned long long uni = 0ull;
#pragma unroll
    for (int i = 0; i < 8; ++i) uni |= selm[64 + i];
    uni = ((unsigned long long)__builtin_amdgcn_readfirstlane((unsigned)(uni >> 32)) << 32) | (unsigned long long)__builtin_amdgcn_readfirstlane((unsigned)uni);
    {
#pragma unroll
        for (int dt = 0; dt < 8; ++dt) { o[dt][0] = (f32x4){0.f, 0.f, 0.f, 0.f}; o[dt][1] = (f32x4){0.f, 0.f, 0.f, 0.f}; }
        mx[0] = mx[1] = -1e20f; ls[0] = ls[1] = 0.f;
        const bf16* kg = PROJ + (size_t)(b * SEQ) * NP + C_KS + g * 128; const bf16* vg = PROJ + (size_t)(b * SEQ) * NP + C_VS + g * 128;
        unsigned long long rem = uni;
        int j = __builtin_ctzll(rem); rem &= rem - 1ull;
        ATT_TILE_PROLOGUE(kg + (size_t)j * 64 * NP, vg + (size_t)j * 64 * NP, NP);
        for (int it = 0;; ++it) {
            const int cur = it & 1; const bool has = rem != 0ull;
            const int jn = has ? __builtin_ctzll(rem) : 0; rem &= rem - 1ull;
            ATT_TILE_NEXT(has, kg + (size_t)jn * 64 * NP, vg + (size_t)jn * 64 * NP, NP);
            const bool b0 = (selm[ql[0]] >> j) & 1ull, b1 = (selm[ql[1]] >> j) & 1ull;
            if (__ballot(b0 || b1) != 0ull) {
                f32x4 s[2][4];
                qk_tile<false>(s, qf, lds + cur * 16384, c, q4);
                bf16x8 pf[2][2];
                osm_step(s[0], b0, j == tq, -64, ql[0] - 16 * q4, mx[0], ls[0], o, 0, pf[0]);
                osm_step(s[1], b1, j == tq, -64, ql[1] - 16 * q4, mx[1], ls[1], o, 1, pf[1]);
                pv_tile(o, pf, lds + 32768 + cur * 16384, c, q4);
            }
            ATT_TILE_END(has, cur);
            if (!has) break;
            j = jn;
        }
#pragma unroll
        for (int qt = 0; qt < 2; ++qt) {
            float l = ls[qt]; l += __shfl_xor(l, 16); l += __shfl_xor(l, 32);
            const float cb = gates[qt][1] / l;
#pragma unroll
            for (int dt = 0; dt < 8; ++dt) scr[lane * 32 + 16 + 2 * dt + qt] = o[dt][qt] * cb;
        }
    }
    {
#pragma unroll
        for (int dt = 0; dt < 8; ++dt) { o[dt][0] = (f32x4){0.f, 0.f, 0.f, 0.f}; o[dt][1] = (f32x4){0.f, 0.f, 0.f, 0.f}; }
        mx[0] = mx[1] = -1e20f; ls[0] = ls[1] = 0.f;
        const bf16* kg = PROJ + (size_t)(b * SEQ) * NP + C_KW + g * 128; const bf16* vg = PROJ + (size_t)(b * SEQ) * NP + C_VW + g * 128;
        const int k0 = max(0, tq - 8), nw = tq - k0 + 1;
        ATT_TILE_PROLOGUE(kg + (size_t)k0 * 64 * NP, vg + (size_t)k0 * 64 * NP, NP);
        for (int it = 0; it < nw; ++it) {
            const int cur = it & 1, kt64 = k0 + it; const bool has = it + 1 < nw;
            ATT_TILE_NEXT(has, kg + (size_t)(kt64 + 1) * 64 * NP, vg + (size_t)(kt64 + 1) * 64 * NP, NP);
            {
                f32x4 s[2][4];
                qk_tile<false>(s, qf, lds + cur * 16384, c, q4);
                bf16x8 pf[2][2];
                {
                    const int d0 = ql[0] - 16 * q4, d1 = ql[1] - 16 * q4;
                    const bool first = (kt64 == tq - 8), edge = first || (kt64 == tq);
                    osm_step(s[0], true, edge, first ? d0 + 1 : -64, first ? 64 : d0, mx[0], ls[0], o, 0, pf[0]);
                    osm_step(s[1], true, edge, first ? d1 + 1 : -64, first ? 64 : d1, mx[1], ls[1], o, 1, pf[1]);
                }
                pv_tile(o, pf, lds + 32768 + cur * 16384, c, q4);
            }
            ATT_TILE_END(has, cur);
        }
    }
    f32x4 gns[8];
#pragma unroll
    for (int dt = 0; dt < 8; ++dt) gns[dt] = *(const f32x4*)(P.nsa_on + hg * 128 + 4 * q4 + 16 * dt);
#pragma unroll
    for (int qt = 0; qt < 2; ++qt) {
        float l = ls[qt]; l += __shfl_xor(l, 16); l += __shfl_xor(l, 32);
        const float cb = gates[qt][2] / l;
        float ss = 0.f;
#pragma unroll
        for (int dt = 0; dt < 8; ++dt) { const f32x4 a = (scr[lane * 32 + 2 * dt + qt] + scr[lane * 32 + 16 + 2 * dt + qt]) + o[dt][qt] * cb; o[dt][qt] = a; ss += (a[0] * a[0] + a[1] * a[1]) + (a[2] * a[2] + a[3] * a[3]); if ((dt & 3) == 3) __builtin_amdgcn_sched_barrier(0); }
        ss += __shfl_xor(ss, 16); ss += __shfl_xor(ss, 32);
        const float r = rsqrtf(ss * (1.f / 128.f) + EPS);
        bf16* yrow = Y + (size_t)(b * SEQ + t0 + ql[qt]) * D + hg * 128 + 4 * q4;
#pragma unroll
        for (int dt = 0; dt < 8; ++dt) { const f32x4 v = o[dt][qt]; const f32x4 gg = gns[dt];
            v2u wv; wv.x = cvt_pk_bf16(v[0] * r * gg[0], v[1] * r * gg[1]); wv.y = cvt_pk_bf16(v[2] * r * gg[2], v[3] * r * gg[3]);
            *(v2u*)(yrow + 16 * dt) = wv; if (dt & 1) __builtin_amdgcn_sched_barrier(0); }
    }
    __syncthreads();
}
__device__ __forceinline__ void nsa_phase(const Params& P, LAS unsigned char* lds, const bf16* PROJ, const bf16* KC, const bf16* VC, bf16* Y, f32x4* scratch) {
    for (int i = blockIdx.x; i < 512; i += gridDim.x) {
        const int u = (i < 256) ? i : 767 - i;
        const int tq = 63 - (u >> 3), bg = u & 7;
        nsa_unit(P, lds, PROJ, KC, VC, Y, scratch + (size_t)blockIdx.x * 16384, bg >> 1, bg & 1, tq);
    }
}

__device__ __forceinline__ void compress_unit(const Params& P, LAS unsigned char* lds, const bf16* PROJ, const float* cs, const float* sn, bf16* KC, bf16* VC, int which, int bg, int n0) {
    int tid = threadIdx.x; asm volatile("" : "+v"(tid));
    const int lane = tid & 63, w = __builtin_amdgcn_readfirstlane(tid >> 6), c = lane & 15, q4 = lane >> 4;
    const int b = bg >> 1, g = bg & 1, col = (which ? C_VC : C_KC) + g * 128;
    constexpr int XS = 272;
    __syncthreads();
    for (int i = tid; i < 272 * 8; i += NTHREADS) {
        const int tk = i >> 3, ch = i & 7, s = 16 * n0 + tk;
        v4u lo = (v4u){0u, 0u, 0u, 0u}, hi = (v4u){0u, 0u, 0u, 0u};
        if (s < SEQ) {
            const int m = b * SEQ + s;
            lo = *(const v4u*)(PROJ + (size_t)m * NP + col + 8 * ch); hi = *(const v4u*)(PROJ + (size_t)m * NP + col + 64 + 8 * ch);
            if (!which) {
                const f32x4 c0 = *(const f32x4*)(cs + m * 64 + 8 * ch), c1 = *(const f32x4*)(cs + m * 64 + 8 * ch + 4), s0 = *(const f32x4*)(sn + m * 64 + 8 * ch), s1 = *(const f32x4*)(sn + m * 64 + 8 * ch + 4);
                float a[8], d[8];
                a[0] = bflo(lo.x); a[1] = bfhi(lo.x); a[2] = bflo(lo.y); a[3] = bfhi(lo.y); a[4] = bflo(lo.z); a[5] = bfhi(lo.z); a[6] = bflo(lo.w); a[7] = bfhi(lo.w);
                d[0] = bflo(hi.x); d[1] = bfhi(hi.x); d[2] = bflo(hi.y); d[3] = bfhi(hi.y); d[4] = bflo(hi.z); d[5] = bfhi(hi.z); d[6] = bflo(hi.w); d[7] = bfhi(hi.w);
                float ra[8], rd[8];
#pragma unroll
                for (int e = 0; e < 8; ++e) { const float cc = e < 4 ? c0[e] : c1[e - 4], ss = e < 4 ? s0[e] : s1[e - 4]; ra[e] = a[e] * cc - d[e] * ss; rd[e] = d[e] * cc + a[e] * ss; }
                lo.x = cvt_pk_bf16(ra[0], ra[1]); lo.y = cvt_pk_bf16(ra[2], ra[3]); lo.z = cvt_pk_bf16(ra[4], ra[5]); lo.w = cvt_pk_bf16(ra[6], ra[7]);
                hi.x = cvt_pk_bf16(rd[0], rd[1]); hi.y = cvt_pk_bf16(rd[2], rd[3]); hi.z = cvt_pk_bf16(rd[4], rd[5]); hi.w = cvt_pk_bf16(rd[6], rd[7]);
            }
        }
        *(LAS v4u*)(lds + tk * XS + 16 * ch) = lo; *(LAS v4u*)(lds + tk * XS + 128 + 16 * ch) = hi;
    }
    __syncthreads();
    const bf16* w1t = (const bf16*)(P.ws + (which ? WS_WC1V : WS_WC1K)) + (size_t)(32 * w + c) * 4096 + 8 * q4;
    f32x4 h0 = (f32x4){0.f, 0.f, 0.f, 0.f}, h1 = (f32x4){0.f, 0.f, 0.f, 0.f};
    const LAS unsigned char* xb = lds + (16 * c) * XS + 16 * q4;
#pragma unroll 16
    for (int ks = 0; ks < 128; ++ks) {
        const bf16x8 xf = *(const LAS bf16x8*)(xb + (ks >> 2) * XS + (ks & 3) * 64);
        const bf16x8 a0 = *(const bf16x8*)(w1t + 32 * ks), a1 = *(const bf16x8*)(w1t + 16 * 4096 + 32 * ks);
        h0 = __builtin_amdgcn_mfma_f32_16x16x32_bf16(a0, xf, h0, 0, 0, 0);
        h1 = __builtin_amdgcn_mfma_f32_16x16x32_bf16(a1, xf, h1, 0, 0, 0);
    }
    const float* pb = (const float*)(P.ws + WS_PBIAS + 65536) + which * 256 + 32 * w + 4 * q4;
    const f32x4 pb0 = *(const f32x4*)pb, pb1 = *(const f32x4*)(pb + 16);
    const bf16x8 hf = pack8(gelu_tanh(h0[0] + pb0[0]), gelu_tanh(h0[1] + pb0[1]), gelu_tanh(h0[2] + pb0[2]), gelu_tanh(h0[3] + pb0[3]),
                            gelu_tanh(h1[0] + pb1[0]), gelu_tanh(h1[1] + pb1[1]), gelu_tanh(h1[2] + pb1[2]), gelu_tanh(h1[3] + pb1[3]));
    const bf16* w2t = (const bf16*)(P.ws + (which ? WS_WC2V : WS_WC2K)) + (size_t)c * 256 + 32 * w + 4 * q4;
    __syncthreads();
    LAS float* part = (LAS float*)lds;
#pragma unroll
    for (int dt = 0; dt < 8; ++dt) {
        const v2u wa = *(const v2u*)(w2t + (size_t)(16 * dt) * 256), wb = *(const v2u*)(w2t + (size_t)(16 * dt) * 256 + 16);
        v4u wv; wv.x = wa.x; wv.y = wa.y; wv.z = wb.x; wv.w = wb.y;
        const f32x4 oa = __builtin_amdgcn_mfma_f32_16x16x32_bf16(__builtin_bit_cast(bf16x8, wv), hf, (f32x4){0.f, 0.f, 0.f, 0.f}, 0, 0, 0);
        *(LAS f32x4*)(part + (w * 16 + c) * 128 + 16 * dt + 4 * q4) = oa;
    }
    __syncthreads();
#pragma unroll
    for (int r = 0; r < 2; ++r) {
        const int n = 2 * w + r;
        float a = 0.f, d = 0.f;
#pragma unroll
        for (int ww = 0; ww < 8; ++ww) { a += part[(ww * 16 + n) * 128 + lane]; d += part[(ww * 16 + n) * 128 + 64 + lane]; }
        if (!which) { const float rr = rsqrtf(wave_sum(a * a + d * d) * (1.f / 128.f) + EPS); a = a * rr * P.kc_norm[lane]; d = d * rr * P.kc_norm[lane + 64]; }
        bf16* op = (which ? VC : KC) + ((size_t)bg * 256 + n0 + n) * 128;
        if (n0 + n < NCMP) { op[lane] = (bf16)f2bf(a); op[lane + 64] = (bf16)f2bf(d); } else { op[lane] = 0; op[lane + 64] = 0; }
    }
}
__device__ __forceinline__ void compress_phase(const Params& P, LAS unsigned char* lds, const bf16* PROJ, const float* cs, const float* sn, bf16* KC, bf16* VC) {
    for (int u = blockIdx.x; u < 256; u += gridDim.x) compress_unit(P, lds, PROJ, cs, sn, KC, VC, u >> 7, (u >> 4) & 7, (u & 15) * 16);
    __syncthreads();
}
template <int MODE = 31>
__device__ __forceinline__ void sb_phase(const Params& P, LAS unsigned char* lds, const bf16* PROJ, const bf16* KVC, bf16* Y) {
    for (int i = blockIdx.x; i < 512; i += gridDim.x) {
        const int u = (i < 256) ? i : 767 - i;
        const int tqq = 15 - (u >> 5), bh = u & 31;
        sb_unit<MODE>(P, lds, PROJ, KVC, Y, bh >> 3, bh & 7, tqq);
    }
}
}

template <int F8 = 0, class RowFn>
__device__ __forceinline__ void transpose_item(const float* W, int K, int N, bf16* WT, RowFn rowfn, LAS float* scr, int item, int lane, const float* kscale = nullptr, const unsigned* cmax = nullptr) {
    const int nblk = (N + 63) / 64, kb = item / nblk, nb = item % nblk, k0 = 64 * kb, n0 = 64 * nb;
    const int nn = n0 + 4 * (lane & 15), kr = lane >> 4;
    f32x4 v[16];
#pragma unroll
    for (int i = 0; i < 16; ++i) v[i] = nn < N ? __builtin_nontemporal_load((const f32x4*)(W + (size_t)(k0 + 4 * i + kr) * N + nn)) : (f32x4){0.f, 0.f, 0.f, 0.f};
#pragma unroll
    for (int i = 0; i < 16; ++i) { if (kscale) v[i] = v[i] * kscale[k0 + 4 * i + kr];
        if (F8 == 1) v[i] = v[i] * pg8::F8_WSCALE;
        LAS float* d = scr + (4 * i + kr) * 65 + 4 * (lane & 15); d[0] = v[i][0]; d[1] = v[i][1]; d[2] = v[i][2]; d[3] = v[i][3]; }
    asm volatile("s_waitcnt lgkmcnt(0)" ::: "memory");
    const int c = lane & 7;
#pragma unroll
    for (int jj = 0; jj < 8; ++jj) { const int n = (lane >> 3) + 8 * jj; const LAS float* s = scr + (8 * c) * 65 + n;
        if constexpr (F8 == 1) { v2u o; o.x = pg8::pk4_fp8(s[0 * 65], s[1 * 65], s[2 * 65], s[3 * 65]); o.y = pg8::pk4_fp8(s[4 * 65], s[5 * 65], s[6 * 65], s[7 * 65]);
            if (n0 + n < N) *(v2u*)((unsigned char*)WT + (size_t)rowfn(n0 + n) * K + k0 + 8 * c) = o; }
        else if constexpr (F8 == 2) { const float cm = n0 + n < N ? __builtin_bit_cast(float, cmax[n0 + n]) : 0.f, q = cm > 0.f ? 127.0f / cm : 0.f;
            v2u o; o.x = pg8::pk4_i8(s[0 * 65], s[1 * 65], s[2 * 65], s[3 * 65], q); o.y = pg8::pk4_i8(s[4 * 65], s[5 * 65], s[6 * 65], s[7 * 65], q);
            if (n0 + n < N) *(v2u*)((unsigned char*)WT + (size_t)rowfn(n0 + n) * K + k0 + 8 * c) = o; }
        else {
        v4u o; o.x = pk2(s[0 * 65], s[1 * 65]); o.y = pk2(s[2 * 65], s[3 * 65]); o.z = pk2(s[4 * 65], s[5 * 65]); o.w = pk2(s[6 * 65], s[7 * 65]);
        if (n0 + n < N) *(v4u*)(WT + (size_t)rowfn(n0 + n) * K + k0 + 8 * c) = o; } }
    asm volatile("s_waitcnt lgkmcnt(0)" ::: "memory");
}
__device__ __forceinline__ int row_gate(int n) { return (n >> 7) * 256 + (n & 127); }
__device__ __forceinline__ int row_up(int n) { return (n >> 7) * 256 + 128 + (n & 127); }
__device__ __forceinline__ int row_id(int n) { return n; }
__device__ __forceinline__ int row_win(int oc) { return oc < 2560 ? oc : (oc < 2584 ? oc - 2560 + C_GATE : oc - 24); }
__device__ __forceinline__ void colmax_item(const float* W, int N, const float* kscale, unsigned* cmax, int kb, int strip, int lane) {
    const int n = strip * 256 + 4 * lane, k0 = 64 * kb;
    if (n >= N) return;
    float m0 = 0.f, m1 = 0.f, m2 = 0.f, m3 = 0.f;
#pragma unroll 1
    for (int i0 = 0; i0 < 64; i0 += 16) {
        f32x4 v[16];
#pragma unroll
        for (int i = 0; i < 16; ++i) v[i] = *(const f32x4*)(W + (size_t)(k0 + i0 + i) * N + n);
#pragma unroll
        for (int i = 0; i < 16; ++i) { const float ks = kscale ? kscale[k0 + i0 + i] : 1.0f;
            m0 = fmaxf(m0, fabsf(v[i][0] * ks)); m1 = fmaxf(m1, fabsf(v[i][1] * ks)); m2 = fmaxf(m2, fabsf(v[i][2] * ks)); m3 = fmaxf(m3, fabsf(v[i][3] * ks)); }
    }
    atomicMax(cmax + n, __float_as_uint(m0)); atomicMax(cmax + n + 1, __float_as_uint(m1)); atomicMax(cmax + n + 2, __float_as_uint(m2)); atomicMax(cmax + n + 3, __float_as_uint(m3));
}
__device__ __forceinline__ void colmax_phase(const Params& P) {
    int tid = threadIdx.x; asm volatile("" : "+v"(tid));
    const int lane = tid & 63, gw = blockIdx.x * NWAVES + (tid >> 6), NGW = gridDim.x * NWAVES;
    unsigned* cm = (unsigned*)(P.ws + WS_CMAX);
    constexpr int S_GU = FF / 256, I_GU = (D / 64) * S_GU;
    for (int it = gw; it < 2 * I_GU; it += NGW) {
        const int mat = it / I_GU, r = it % I_GU;
        colmax_item(mat ? P.ffn1_wu : P.ffn1_wg, FF, FOLD_GAINS ? P.ffn1_norm : nullptr, cm + mat * FF, r / S_GU, r % S_GU, lane);
    }
}
constexpr int CW_I_GU = (D / 64) * (FF / 64), CW_I_IN = (D / 64) * ((IN_COLS + 63) / 64), CW_I_OUT = (D / 64) * (D / 64), CW_I_C1 = (4096 / 64) * (256 / 64), CW_I_C2 = (256 / 64) * (128 / 64);
constexpr int CW_EARLY = 3 * CW_I_GU + CW_I_IN + CW_I_OUT + 2 * CW_I_C1 + 2 * CW_I_C2, CW_ITEMS = CW_EARLY + 3 * CW_I_GU;
__device__ __forceinline__ void convert_items(const Params& P, LAS unsigned char* lds, int lo, int hi, int gw, int NGW) {
    unsigned char* ws = P.ws;
    int tid = threadIdx.x; asm volatile("" : "+v"(tid));
    const int lane = tid & 63, wave = tid >> 6;
    LAS float* scr = (LAS float*)(lds + wave * 16640);
    constexpr int I_GU = CW_I_GU, I_DN = CW_I_GU, I_IN = CW_I_IN, I_OUT = CW_I_OUT, I_C1 = CW_I_C1, I_C2 = CW_I_C2;
    for (int it = lo + gw; it < hi; it += NGW) {
        int r = it;
        if (r < I_GU) { transpose_item<FFN1_I8 ? 2 : (FFN1_FP8 != 0)>(P.ffn1_wg, D, FF, (bf16*)(ws + WS_W1GU), row_gate, scr, r, lane, FOLD_GAINS ? P.ffn1_norm : nullptr, (const unsigned*)(ws + WS_CMAX)); continue; } r -= I_GU;
        if (r < I_GU) { transpose_item<FFN1_I8 ? 2 : (FFN1_FP8 != 0)>(P.ffn1_wu, D, FF, (bf16*)(ws + WS_W1GU), row_up, scr, r, lane, FOLD_GAINS ? P.ffn1_norm : nullptr, (const unsigned*)(ws + WS_CMAX) + FF); continue; } r -= I_GU;
        if (r < I_DN) { transpose_item<(FFN1_FP8 == 2) ? 1 : 0>(P.ffn1_wd, FF, D, (bf16*)(ws + WS_W1D), row_id, scr, r, lane); continue; } r -= I_DN;
        if (r < I_IN) { transpose_item(P.w_in, D, IN_COLS, (bf16*)(ws + WS_WIN), row_win, scr, r, lane, FOLD_GAINS ? P.mix_norm : nullptr); continue; } r -= I_IN;
        if (r < I_OUT) { transpose_item(P.w_out, D, D, (bf16*)(ws + WS_WOUT), row_id, scr, r, lane); continue; } r -= I_OUT;
        if (r < I_C1) { transpose_item(P.ck_w1, 4096, 256, (bf16*)(ws + WS_WC1K), row_id, scr, r, lane); continue; } r -= I_C1;
        if (r < I_C1) { transpose_item(P.cv_w1, 4096, 256, (bf16*)(ws + WS_WC1V), row_id, scr, r, lane); continue; } r -= I_C1;
        if (r < I_C2) { transpose_item(P.ck_w2, 256, 128, (bf16*)(ws + WS_WC2K), row_id, scr, r, lane); continue; } r -= I_C2;
        if (r < I_C2) { transpose_item(P.cv_w2, 256, 128, (bf16*)(ws + WS_WC2V), row_id, scr, r, lane); continue; } r -= I_C2;
        if (r < I_GU) { transpose_item<(FFN2_FP8 != 0) ? 1 : 0>(P.ffn2_wg, D, FF, (bf16*)(ws + WS_W2GU), row_gate, scr, r, lane, FOLD_GAINS ? P.ffn2_norm : nullptr); continue; } r -= I_GU;
        if (r < I_GU) { transpose_item<(FFN2_FP8 != 0) ? 1 : 0>(P.ffn2_wu, D, FF, (bf16*)(ws + WS_W2GU), row_up, scr, r, lane, FOLD_GAINS ? P.ffn2_norm : nullptr); continue; } r -= I_GU;
        transpose_item<(FFN2_FP8 != 0) ? 1 : 0>(P.ffn2_wd, FF, D, (bf16*)(ws + WS_W2D), row_id, scr, r, lane);
    }
}
__device__ __forceinline__ void convert_weights(const Params& P, LAS unsigned char* lds) {
    unsigned char* ws = P.ws;
    convert_items(P, lds, 0, TAIL_CONVERT ? CW_EARLY : CW_ITEMS, blockIdx.x * NWAVES + (threadIdx.x >> 6), gridDim.x * NWAVES);
    if (blockIdx.x < 32) {
        const int which = blockIdx.x >> 4, part = (blockIdx.x & 15) * 2 + (threadIdx.x >> 8), j = threadIdx.x & 255;
        const float* pos = which ? P.cv_pos : P.ck_pos; const float* w1 = which ? P.cv_w1 : P.ck_w1;
        float a = 0.f;
#pragma unroll 32
        for (int k = 128 * part; k < 128 * part + 128; ++k) a += pos[k] * w1[(size_t)k * 256 + j];
        ((float*)(ws + WS_PBIAS))[(which * 32 + part) * 256 + j] = a;
    }
    { v4u* z = (v4u*)((bf16*)(ws + WS_WIN) + (size_t)IN_COLS * D); const int n16 = (NP - IN_COLS) * D / 8;
      for (int i = blockIdx.x * NTHREADS + threadIdx.x; i < n16; i += gridDim.x * NTHREADS) z[i] = (v4u){0u, 0u, 0u, 0u}; }
}

__global__ void __launch_bounds__(NTHREADS, 2) fwd_kernel(Params P) {
    extern __shared__ __attribute__((aligned(16))) unsigned char lds_raw[];
    LAS unsigned char* lds = (LAS unsigned char*)lds_raw;
    const int tid = threadIdx.x;
    for (int u = tid; u < (LDS_BYTES - LDSCTL_OFF) / 4; u += NTHREADS) ((LAS unsigned*)(lds + LDSCTL_OFF))[u] = 0u;
    __syncthreads();
    unsigned char* ws = P.ws;
    XcdBarrier bar = xcd_barrier_post((unsigned*)(ws + WS_CTL) + CW_BAR, (volatile LAS unsigned*)(lds + LDSCTL_OFF + 64));
    bf16* HB = (bf16*)(ws + WS_HB); bf16* BIG = (bf16*)(ws + WS_BIG);
    float* cs = (float*)(ws + WS_COS); float* sn = (float*)(ws + WS_SIN);
    bf16* KC = (bf16*)(ws + WS_KC); bf16* VC = (bf16*)(ws + WS_VC);
    float* XR = P.out;
    bf16* X1B = (bf16*)P.out;
    bf16* X2B = (bf16*)(ws + WS_W1GU);
    unsigned char* X0F8 = ws + WS_SCR + ((size_t)32 << 20);
    unsigned char* X2F8 = ws + WS_SCR;
    float* PART = (float*)(ws + WS_PART);
    float* PART2 = (float*)(ws + WS_PART + (size_t)M * 8);
    float* PART0 = (float*)(ws + WS_PART + (size_t)M * 16);
    float* XS0 = (float*)(ws + WS_PART + (size_t)M * 24);
    PG8_LAS float* RS = (PG8_LAS float*)(lds + 131072);

#define REP(n) _Pragma("unroll") for (int rep_ = 0; rep_ < (n); ++rep_)
#if FOLD_GAINS
#if FFN1_I8
    rope_tables(P.pos, cs, sn); cast_rows<true>(P.x, HB, (unsigned long long*)PART0, X0F8, XS0); colmax_phase(P);
    xcd_barrier(bar);
    convert_weights(P, lds);
#else
    REP(REP_P0) { rope_tables(P.pos, cs, sn); cast_rows(P.x, HB, (unsigned long long*)PART0, FFN1_FP8 ? X0F8 : nullptr); convert_weights(P, lds); }
#endif
#else
    REP(REP_P0) { rope_tables(P.pos, cs, sn); rmsnorm_rows(P.x, P.ffn1_norm, HB); convert_weights(P, lds); }
#endif
#if FUSE_NORMS || FOLD_GAINS
    for (int i = blockIdx.x * NTHREADS + tid; i < 2 * M; i += gridDim.x * NTHREADS) ((unsigned long long*)PART)[i] = 0ull;
#endif
    xcd_barrier(bar);
#if PROBE_P1K
    for (int pass = 0; pass < 2; ++pass) {
        pg8::Gemm g{HB, (const bf16*)(ws + WS_W1GU), M, 2 * FF, D, pass == 0 ? (PROBE_P1K >= 4 ? PROBE_P1K - 4 : PROBE_P1K - 1) : 0}; pg8::StaticOrder S; S.init(M, 2 * FF, gridDim.x, (int)blockIdx.x); S.zero = (pass == 0 && PROBE_P1K >= 4);
        if (FOLD_GAINS) pg8::row_factor_table(RS, PART0, S);
        pg8::EpiSwiglu E{BIG, FF, FOLD_GAINS ? PART0 : nullptr, RS};
        pg8::gemm_phase<pg8::EpiSwiglu, pg8::StaticOrder, true, true>(lds, g, S, E);
        if (pass == 0) xcd_barrier(bar);
    }
#else
    REP(REP_P1) {
#if FFN1_FP8
        pg8::Gemm g{(const bf16*)X0F8, (const bf16*)(ws + WS_W1GU), M, 2 * FF, D / 2}; pg8::StaticOrder S; S.init(M, 2 * FF, gridDim.x, (int)blockIdx.x);
#if FFN1_I8
        pg8::row_factor_table(RS, PART0, S, XS0);
        pg8::EpiSwigluT<true, FFN1_FP8 == 2, true> E{BIG, FF, PART0, RS, (const float*)(ws + WS_CMAX)};
        pg8::gemm_phase<pg8::EpiSwigluT<true, FFN1_FP8 == 2, true>, pg8::StaticOrder, true, true, false, true>(lds, g, S, E);
#else
        pg8::row_factor_table(RS, PART0, S);
        pg8::EpiSwigluT<true, FFN1_FP8 == 2> E{BIG, FF, PART0, RS};
        pg8::gemm_phase<pg8::EpiSwigluT<true, FFN1_FP8 == 2>, pg8::StaticOrder, true, true, true>(lds, g, S, E);
#endif
#else
        pg8::Gemm g{HB, (const bf16*)(ws + WS_W1GU), M, 2 * FF, D}; pg8::StaticOrder S; S.init(M, 2 * FF, gridDim.x, (int)blockIdx.x);
        if (FOLD_GAINS) pg8::row_factor_table(RS, PART0, S);
        pg8::EpiSwiglu E{BIG, FF, FOLD_GAINS ? PART0 : nullptr, RS};
        pg8::gemm_phase<pg8::EpiSwiglu, pg8::StaticOrder, true, true>(lds, g, S, E);
#endif
    }
#endif
    xcd_barrier(bar);
    REP(REP_P2) {
        pg8::Gemm g{BIG, (const bf16*)(ws + WS_W1D), M, D, FFN1_FP8 == 2 ? FF / 2 : FF}; pg8::StaticOrder S; S.init(M, D, gridDim.x, (int)blockIdx.x);
#if FUSE_NORMS
        pg8::EpiResid E{P.x, XR, D, 0.5f, HB, P.mix_norm, PART};
#else
        pg8::EpiResidMix<FOLD_GAINS != 0, true> E{FOLD_GAINS ? (const void*)HB : (const void*)P.x, X1B, D, FFN1_FP8 == 2 ? 0.5f / (pg8::F8_WSCALE * pg8::F8_HSCALE) : 0.5f, FOLD_GAINS ? (unsigned long long*)PART : nullptr};
#endif
        pg8::gemm_phase<pg8::EpiResidMix<FOLD_GAINS != 0, true>, pg8::StaticOrder, true, true, FFN1_FP8 == 2>(lds, g, S, E);
    }
    xcd_barrier(bar);
    if (blockIdx.x == gridDim.x - 1) { const float* pp = (const float*)(ws + WS_PBIAS); const int which = tid >> 8, j = tid & 255; float t[32];
#pragma unroll
        for (int part = 0; part < 32; ++part) t[part] = pp[(which * 32 + part) * 256 + j];
        float a = 0.f;
#pragma unroll
        for (int part = 0; part < 32; ++part) a += t[part];
        ((float*)(ws + WS_PBIAS + 65536))[tid] = a; }
#if !FUSE_NORMS && !FOLD_GAINS
    rmsnorm_rows_bf16(X1B, P.mix_norm, HB);
    xcd_barrier(bar);
#endif
    REP(REP_P4) {
        pg8::Gemm g{FOLD_GAINS ? (const bf16*)X1B : (const bf16*)HB, (const bf16*)(ws + WS_WIN), M, NP, D}; pg8::StaticOrder S; S.init(M, NP, gridDim.x, (int)blockIdx.x);
        if (FUSE_NORMS || FOLD_GAINS) pg8::row_factor_table(RS, PART, S);
        pg8::EpiStoreBf16 E{BIG, NP, C_QS / 256, (C_QS + 1024) / 256, att::C1, (FUSE_NORMS || FOLD_GAINS) ? PART : nullptr, RS, (bf16*)(ws + WS_W1GU), SB_COMPACT ? C_KSB / 256 : 0, SB_COMPACT ? (C_VSB + 1024) / 256 : 0};
        pg8::gemm_phase<pg8::EpiStoreBf16, pg8::StaticOrder, true, true>(lds, g, S, E);
#if TAIL_CONVERT
        {
            const int G = (int)gridDim.x, rem = S.nwg % G;
            if (rem == 0) convert_items(P, lds, CW_EARLY, CW_ITEMS, (int)blockIdx.x * NWAVES + (tid >> 6), G * NWAVES);
            else if ((int)blockIdx.x >= rem) convert_items(P, lds, CW_EARLY, CW_ITEMS, ((int)blockIdx.x - rem) * NWAVES + (tid >> 6), (G - rem) * NWAVES);
        }
#endif
    }
    xcd_barrier(bar);
    postproj_naive(P, BIG, cs, sn);
    REP(REP_CMP) att::compress_phase(P, lds, BIG, cs, sn, KC, VC);
    xcd_barrier(bar);
    REP(REP_NSA) att::nsa_phase(P, lds, BIG, KC, VC, HB, (f32x4*)(ws + WS_SCR));
    REP(REP_SB) att::sb_phase(P, lds, BIG, (const bf16*)(ws + WS_W1GU), HB);
    xcd_barrier(bar);
    {
        pg8::Gemm g{HB, (const bf16*)(ws + WS_WOUT), M, D, D}; pg8::StaticOrder S; S.init(M, D, gridDim.x, (int)blockIdx.x);
#if FUSE_NORMS
        pg8::EpiResid E{XR, XR, D, 1.0f, (bf16*)(ws + WS_W1GU), P.ffn2_norm, PART2};
#else
        pg8::EpiResidMix<true, true> E{X1B, X2B, D, 1.0f, FOLD_GAINS ? (unsigned long long*)PART2 : nullptr, FFN2_FP8 ? X2F8 : nullptr};
#endif
        pg8::gemm_phase<pg8::EpiResidMix<true, true>, pg8::StaticOrder, true, true>(lds, g, S, E);
    }
    xcd_barrier(bar);
#if !FUSE_NORMS && !FOLD_GAINS
    rmsnorm_rows_bf16(X2B, P.ffn2_norm, HB);
    xcd_barrier(bar);
#endif
    REP(REP_P9) {
#if FFN2_FP8
        pg8::Gemm g{(const bf16*)X2F8, (const bf16*)(ws + WS_W2GU), M, 2 * FF, D / 2}; pg8::StaticOrder S; S.init(M, 2 * FF, gridDim.x, (int)blockIdx.x);
        pg8::row_factor_table(RS, PART2, S);
        pg8::EpiSwigluT<true> E{BIG, FF, PART2, RS};
        pg8::gemm_phase<pg8::EpiSwigluT<true>, pg8::StaticOrder, true, true, true>(lds, g, S, E);
#else
        pg8::Gemm g{(FUSE_NORMS || FOLD_GAINS) ? (const bf16*)(ws + WS_W1GU) : (const bf16*)HB, (const bf16*)(ws + WS_W2GU), M, 2 * FF, D}; pg8::StaticOrder S; S.init(M, 2 * FF, gridDim.x, (int)blockIdx.x);
        if (FUSE_NORMS || FOLD_GAINS) pg8::row_factor_table(RS, PART2, S);
        pg8::EpiSwiglu E{BIG, FF, (FUSE_NORMS || FOLD_GAINS) ? PART2 : nullptr, RS};
        pg8::gemm_phase<pg8::EpiSwiglu, pg8::StaticOrder, true, true>(lds, g, S, E);
#endif
    }
    xcd_barrier(bar);
    REP(REP_P10) {
#if FFN2_FP8
        pg8::Gemm g{BIG, (const bf16*)(ws + WS_W2D), M, D, FF / 2}; pg8::StaticOrder S; S.init(M, D, gridDim.x, (int)blockIdx.x);
        pg8::EpiResidMix<true, false> E{X2B, XR, D, 0.5f / (pg8::F8_WSCALE * pg8::F8_HSCALE), nullptr};
        pg8::gemm_phase<pg8::EpiResidMix<true, false>, pg8::StaticOrder, true, true, true>(lds, g, S, E);
#else
        pg8::Gemm g{BIG, (const bf16*)(ws + WS_W2D), M, D, FF}; pg8::StaticOrder S; S.init(M, D, gridDim.x, (int)blockIdx.x);
        pg8::EpiResidMix<true, false> E{X2B, XR, D, 0.5f, nullptr};
        pg8::gemm_phase<pg8::EpiResidMix<true, false>, pg8::StaticOrder, true, true>(lds, g, S, E);
#endif
    }
#if PROBE_PP
    xcd_barrier(bar);
    postproj_naive(P, BIG, cs, sn);
#endif
#if PROBE_SB_MODE
    __syncthreads();
    att::sb_phase<PROBE_SB_MODE>(P, lds, BIG, (const bf16*)(ws + WS_SB_DUMMY_KV), (bf16*)(ws + WS_HB));
#endif
}

extern "C" void kernel_launch(void* const* d_in, const int* in_sizes, int n_in, void* d_out, int out_size, void* d_ws, size_t ws_size, hipStream_t stream) {
    static int grid = 0;
    if (grid == 0) {
        if (n_in != 25 || out_size != M * D || ws_size < WS_END) { fprintf(stderr, "kernel_launch: unexpected shapes: n_in %d out %d ws %zu\n", n_in, out_size, ws_size); grid = -1; return; }
        int dev = 0, cus = 0, per_cu = 0;
        hipGetDevice(&dev); hipDeviceGetAttribute(&cus, hipDeviceAttributeMultiprocessorCount, dev);
        if (hipFuncSetAttribute((const void*)fwd_kernel, hipFuncAttributeMaxDynamicSharedMemorySize, LDS_BYTES) != hipSuccess) { fprintf(stderr, "kernel_launch: hipFuncSetAttribute failed\n"); grid = -1; return; }
        hipOccupancyMaxActiveBlocksPerMultiprocessor(&per_cu, (const void*)fwd_kernel, NTHREADS, LDS_BYTES);
        (void)hipGetLastError();
        if (per_cu < 1) fprintf(stderr, "kernel_launch: occupancy query says %d\n", per_cu);
        grid = cus;
    }
    if (grid < 0) return;
    hipMemsetAsync((char*)d_ws + WS_CTL, 0, CTL_ZERO_BYTES, stream);
    Params p{};
    p.x = (const float*)d_in[0]; p.pos = (const int*)d_in[1];
    p.ffn1_norm = (const float*)d_in[2]; p.ffn1_wg = (const float*)d_in[3]; p.ffn1_wu = (const float*)d_in[4]; p.ffn1_wd = (const float*)d_in[5];
    p.mix_norm = (const float*)d_in[6]; p.w_in = (const float*)d_in[7]; p.q_norm = (const float*)d_in[8]; p.kc_norm = (const float*)d_in[9];
    p.ks_norm = (const float*)d_in[10]; p.kw_norm = (const float*)d_in[11]; p.ck_pos = (const float*)d_in[12]; p.ck_w1 = (const float*)d_in[13];
    p.ck_w2 = (const float*)d_in[14]; p.cv_pos = (const float*)d_in[15]; p.cv_w1 = (const float*)d_in[16]; p.cv_w2 = (const float*)d_in[17];
    p.nsa_on = (const float*)d_in[18]; p.sb_on = (const float*)d_in[19]; p.w_out = (const float*)d_in[20]; p.ffn2_norm = (const float*)d_in[21];
    p.ffn2_wg = (const float*)d_in[22]; p.ffn2_wu = (const float*)d_in[23]; p.ffn2_wd = (const float*)d_in[24];
    p.out = (float*)d_out; p.ws = (unsigned char*)d_ws;
    hipLaunchKernelGGL(fwd_kernel, dim3(grid), dim3(NTHREADS), LDS_BYTES, stream, p);
}
```

```cpp
#include <hip/hip_runtime.h>
#include <cstdio>
#include <cstdint>

#define SB_COMPACT 0
#define FOLD_GAINS 1
#define FUSE_NORMS 0
#define NSA_OPAQUE 1
#define REP_P0 1
#define REP_P1 1
#define REP_P2 1
#define REP_P4 1
#define REP_P9 1
#define REP_P10 1
#define REP_CMP 1
#define REP_NSA 1
#define REP_SB 1
#define PROBE_SB_MODE 0
#define TAIL_CONVERT 1
#define FFN2_FP8 1
#define FFN1_FP8 2
#define FFN1_I8 1
#define WIN_I8 1
#define FFN2_I8 1
#define PROBE_P1K 0
#define PROBE_PP 0

#define GAS __attribute__((address_space(1)))
#define LAS __attribute__((address_space(3)))
typedef unsigned short bf16;
typedef unsigned v4u __attribute__((ext_vector_type(4)));
typedef unsigned v2u __attribute__((ext_vector_type(2)));
typedef float f32x4 __attribute__((ext_vector_type(4)));
typedef float f32x2 __attribute__((ext_vector_type(2)));

constexpr int NBATCH = 4, SEQ = 4096, M = NBATCH * SEQ, D = 2048, FF = 5632, HD = 128;
constexpr int NCMP = 255;
constexpr int IN_COLS = 5656;
constexpr int NP = 5888;
constexpr int C_QN = 0, C_KC = 1024, C_VC = 1280, C_KS = 1536, C_VS = 1792, C_KW = 2048, C_VW = 2304, C_QS = 2560, C_KSB = 3584, C_VSB = 4608, C_GATE = 5632;
constexpr float EPS = 1e-6f;
constexpr float SCALE = 0.08838834764831845f;
constexpr float NEG_INF = -1e30f;
constexpr float QSCALE = 0.08838834764831845f * 1.4426950408889634f;

constexpr size_t MiB = 1u << 20;
constexpr size_t WS_CTL = 0, CTL_ZERO_BYTES = 1 * MiB;
constexpr size_t WS_RMAX = 256 * 1024;
constexpr size_t WS_CMAX = 512 * 1024;
constexpr size_t WS_W1GU = 2 * MiB, WS_W1D = 46 * MiB, WS_W2GU = 68 * MiB, WS_W2D = 112 * MiB, WS_WIN = 134 * MiB, WS_WOUT = 157 * MiB;
constexpr size_t WS_WC1K = 165 * MiB, WS_WC1V = 167 * MiB, WS_WC2K = 169 * MiB, WS_WC2V = 169 * MiB + 65536, WS_PBIAS = 169 * MiB + 131072;
constexpr size_t WS_COS = 170 * MiB, WS_SIN = 174 * MiB, WS_KC = 178 * MiB, WS_VC = 178 * MiB + 524288;
constexpr size_t WS_HB = 180 * MiB, WS_BIG = 244 * MiB, WS_SCR = 428 * MiB, WS_PART = 492 * MiB, WS_END = 494 * MiB;
constexpr size_t WS_SB_DUMMY_KV = WS_W2GU;
constexpr int CW_BAR = 4096;

constexpr int NWAVES = 8, NTHREADS = 512;
constexpr int LDS_BYTES = 163840;
constexpr int LDSCTL_OFF = 163840 - 1024;

__device__ __forceinline__ unsigned f2bf(float f) { unsigned u = __builtin_bit_cast(unsigned, f); return (u + 0x7fffu + ((u >> 16) & 1u)) >> 16; }
__device__ __forceinline__ unsigned pk2(float lo, float hi) { return f2bf(lo) | (f2bf(hi) << 16); }
__device__ __forceinline__ float bf2f(unsigned h) { return __builtin_bit_cast(float, h << 16); }
__device__ __forceinline__ float bflo(unsigned w) { return __builtin_bit_cast(float, w << 16); }
__device__ __forceinline__ float bfhi(unsigned w) { return __builtin_bit_cast(float, w & 0xffff0000u); }
__device__ __forceinline__ float wave_sum(float v) {
#pragma unroll
    for (int o = 1; o < 64; o <<= 1) v += __shfl_xor(v, o);
    return v;
}
__device__ __forceinline__ float wave_max(float v) {
#pragma unroll
    for (int o = 1; o < 64; o <<= 1) v = fmaxf(v, __shfl_xor(v, o));
    return v;
}
__device__ __forceinline__ float softplusf(float z) { return fmaxf(z, 0.f) + log1pf(expf(-fabsf(z))); }
__device__ __forceinline__ float sigmoidf(float z) { return 1.f / (1.f + expf(-z)); }
__device__ __forceinline__ float gelu_tanh(float x) { const float u = 0.7978845608028654f * (x + 0.044715f * x * x * x); return 0.5f * x * (1.f + tanhf(u)); }

#define XB_TMO      128
#define XB_XCNT(j)  (256  + 64 * (j))
#define XB_XSUB(j)  (1280 + 64 * (j))
#define XB_XGEN(j)  (2304 + 64 * (j))
#define XB_TOP      3328
#define XB_TOPGEN   3392
#define XCD_BAR_WORDS 3456
#define XB_SPIN_CAP (1u << 22)

__device__ __forceinline__ unsigned xb_ld(unsigned* p)              { return __hip_atomic_load(p, __ATOMIC_RELAXED, __HIP_MEMORY_SCOPE_AGENT); }
__device__ __forceinline__ unsigned xb_add(unsigned* p, unsigned v) { return __hip_atomic_fetch_add(p, v, __ATOMIC_RELAXED, __HIP_MEMORY_SCOPE_AGENT); }
__device__ __forceinline__ unsigned xb_xcc_id() { return (unsigned)__builtin_amdgcn_s_getreg((3 << 11) | 20) & 0xFu; }
#define XB_SPIN(cond, bar) do { unsigned _sp = 0; while (cond) { __builtin_amdgcn_s_sleep(1); \
    if ((++_sp & 255u) == 0u) { if (xb_ld(&(bar)[XB_TMO])) break; if (_sp > XB_SPIN_CAP) { atomicAdd(&(bar)[XB_TMO], 1u); break; } } } } while (0)

struct XcdBarrier { unsigned* bar; unsigned x; volatile LAS unsigned* st; };

__device__ __forceinline__ XcdBarrier xcd_barrier_post(unsigned* bar, volatile LAS unsigned* st) {
    XcdBarrier b; b.bar = bar; b.x = xb_xcc_id(); b.st = st;
    if (threadIdx.x == 0) (void)xb_add(&bar[XB_XCNT(b.x)], 1u);
    return b;
}
__device__ __forceinline__ void xcd_barrier_complete(unsigned* bar, unsigned x, unsigned& nloc, unsigned& nx) {
    const unsigned G = gridDim.x * gridDim.y * gridDim.z;
    unsigned sum, cnt, mine, sp = 0u;
    for (;;) {
        sum = 0u; cnt = 0u; mine = 0u;
#pragma unroll
        for (unsigned j = 0; j < 16; ++j) { const unsigned c = xb_ld(&bar[XB_XCNT(j)]); sum += c; cnt += (c > 0u) ? 1u : 0u; mine = (j == x) ? c : mine; }
        if (sum == G) break;
        __builtin_amdgcn_s_sleep(1);
        if ((++sp & 255u) == 0u) { if (xb_ld(&bar[XB_TMO])) break; if (sp > XB_SPIN_CAP) { atomicAdd(&bar[XB_TMO], 1u); break; } }
    }
    nloc = mine > 0u ? mine : 1u; nx = cnt > 0u ? cnt : 1u;
}
__device__ __forceinline__ void xcd_barrier(const XcdBarrier& b) {
    asm volatile("s_waitcnt vmcnt(0)" ::: "memory");
    __syncthreads();
    if (threadIdx.x == 0) {
        unsigned* bar = b.bar;
        __builtin_amdgcn_s_waitcnt(0);
        unsigned nloc = b.st[0], nx = b.st[1];
        if (nloc == 0u) { xcd_barrier_complete(bar, b.x, nloc, nx); b.st[0] = nloc; b.st[1] = nx; }
        const unsigned old = xb_add(&bar[XB_XSUB(b.x)], 1u);
        const unsigned gen = old / nloc;
        if (old + 1u == (gen + 1u) * nloc) {
            __builtin_amdgcn_fence(__ATOMIC_RELEASE, "agent");
            asm volatile("s_waitcnt vmcnt(0)" ::: "memory");
            const unsigned og = xb_add(&bar[XB_TOP], 1u);
            const unsigned tg = og / nx;
            if (og + 1u == (tg + 1u) * nx) xb_add(&bar[XB_TOPGEN], 1u);
            else XB_SPIN(xb_ld(&bar[XB_TOPGEN]) == tg, bar);
            __builtin_amdgcn_fence(__ATOMIC_ACQUIRE, "agent");
            xb_add(&bar[XB_XGEN(b.x)], 1u);
            asm volatile("s_waitcnt vmcnt(0)" ::: "memory");
        } else {
            XB_SPIN(xb_ld(&bar[XB_XGEN(b.x)]) == gen, bar);
            __builtin_amdgcn_fence(__ATOMIC_ACQUIRE, "agent");
            asm volatile("s_waitcnt vmcnt(0)" ::: "memory");
        }
    }
    __syncthreads();
}

namespace pg8 {
#define PG8_LAS __attribute__((address_space(3)))
typedef unsigned short bf16_t;
typedef short bf16x8 __attribute__((ext_vector_type(8)));
typedef float f32x4 __attribute__((ext_vector_type(4)));
typedef unsigned u32x4 __attribute__((ext_vector_type(4)));
constexpr int BM = 256, BK = 64, HALF = 128, HTB = HALF * BK * 2  , STAGE_BYTES = 8 * HTB, NXCD = 8, WGM = 8;

__host__ __device__ __forceinline__ int lds_byte(int r, int c) { const int st = (r >> 4) * 2 + (c >> 5), rr = r & 15, cc = c & 31, ob = rr * 64 + cc * 2; return st * 1024 + (ob ^ (((ob >> 9) & 1) << 5)); }
__host__ __device__ __forceinline__ void stage_rc(int b, int& R, int& C) { const int st = b / 1024, sb = b % 1024, swz = sb ^ (((sb >> 9) & 1) << 5); R = (st >> 1) * 16 + swz / 64; C = (st & 1) * 32 + (swz % 64) / 2; }
__host__ __device__ __forceinline__ int perm32(int rho) { const int n = rho >> 4, i = rho & 15; return 8 * (i >> 2) + 4 * n + (i & 3); }

typedef int v4i_t __attribute__((ext_vector_type(4)));
typedef int v8i_t __attribute__((ext_vector_type(8)));
__device__ __forceinline__ unsigned pk4_fp8(float a, float b, float c, float d) {
    a = __builtin_amdgcn_fmed3f(a, -448.f, 448.f); b = __builtin_amdgcn_fmed3f(b, -448.f, 448.f); c = __builtin_amdgcn_fmed3f(c, -448.f, 448.f); d = __builtin_amdgcn_fmed3f(d, -448.f, 448.f);
    int w = 0; w = __builtin_amdgcn_cvt_pk_fp8_f32(a, b, w, false); w = __builtin_amdgcn_cvt_pk_fp8_f32(c, d, w, true); return (unsigned)w;
}
__device__ __forceinline__ unsigned pk4_i8(float a, float b, float c, float d, float s) {
    const unsigned u0 = __builtin_bit_cast(unsigned, __builtin_fmaf(a, s, 12582912.0f)), u1 = __builtin_bit_cast(unsigned, __builtin_fmaf(b, s, 12582912.0f));
    const unsigned u2 = __builtin_bit_cast(unsigned, __builtin_fmaf(c, s, 12582912.0f)), u3 = __builtin_bit_cast(unsigned, __builtin_fmaf(d, s, 12582912.0f));
    return (u0 & 255u) | ((u1 & 255u) << 8) | ((u2 & 255u) << 16) | (u3 << 24);
}
constexpr float F8_WSCALE = 256.0f, F8_HSCALE = 16.0f;
struct Unit { int pm, pn, ord; };
struct Gemm { const bf16_t* A; const bf16_t* Bt; int M, N, K; int kshift = 0; };

struct StaticOrder {
    int nM, nN, nwg, G, c; int zero = 0;
    __host__ __device__ void init(int M, int N, int G_, int c_) { nM = M / BM; nN = N / BM; nwg = nM * nN; G = G_; c = c_; }
    __host__ __device__ bool next(int i, Unit& u) const {
        const long L = (long)i * G + c; if (L >= nwg) return false;
        int wgid = (int)L; { const int q = nwg / NXCD, r = nwg % NXCD, xcd = wgid % NXCD, off = wgid / NXCD; wgid = (xcd < r ? xcd * (q + 1) : r * (q + 1) + (xcd - r) * q) + off; }
        const int nig = WGM * nN, gid = wgid / nig, fm = gid * WGM, gsz = (nM - fm) < WGM ? (nM - fm) : WGM;
        u.pm = fm + ((wgid % nig) % gsz); u.pn = (wgid % nig) / gsz; u.ord = i;
        if (zero) { u.pm = 0; u.pn = 0; }
        return true;
    }
    __device__ __forceinline__ void a_ready(const Unit&) const {}
    __device__ __forceinline__ void done(const Unit&) const {}
};


__device__ __forceinline__ unsigned cvt_pk_bf16(float lo, float hi) { unsigned r; asm volatile("v_cvt_pk_bf16_f32 %0, %1, %2" : "=v"(r) : "v"(lo), "v"(hi)); return r; }
__device__ __forceinline__ float silu_mul(float g, float u) { return g * u * __builtin_amdgcn_rcpf(1.0f + __builtin_amdgcn_exp2f(-1.4426950408889634f * g)); }
__device__ __forceinline__ void row_scale_table(PG8_LAS float* rs, const float* part, const Unit& u, float inv_n, float eps) {
    asm volatile("s_waitcnt lgkmcnt(0)" ::: "memory"); __builtin_amdgcn_s_barrier(); asm volatile("" ::: "memory");
    const int t = threadIdx.x;
    if (t < 256) { const f32x4* p = (const f32x4*)(part + (size_t)(u.pm * BM + t) * 32); f32x4 a = p[0];
#pragma unroll
        for (int i = 1; i < 8; ++i) a = a + p[i];
        rs[t] = rsqrtf(((a[0] + a[1]) + (a[2] + a[3])) * inv_n + eps); }
    asm volatile("s_waitcnt lgkmcnt(0)" ::: "memory"); __builtin_amdgcn_s_barrier(); asm volatile("" ::: "memory");
}
__device__ __forceinline__ float row_factor(const float* part, int row) {
    const unsigned long long q = ((const unsigned long long*)part)[row];
    return rsqrtf((float)q * (1.0f / 16777216.0f) * (1.0f / 2048.0f) + 1e-6f);
}
template <class Sched>
__device__ __forceinline__ void row_factor_table(PG8_LAS float* rs, const float* part, const Sched& S, const float* rowmul = nullptr) {
    int t = threadIdx.x; asm volatile("" : "+v"(t));
    Unit u;
    for (int i = 0; S.next(i, u); ++i) if (t < 256) rs[i * 256 + t] = row_factor(part, u.pm * BM + t) * (rowmul ? rowmul[u.pm * BM + t] : 1.0f);
    asm volatile("s_waitcnt vmcnt(0) lgkmcnt(0)" ::: "memory"); __builtin_amdgcn_s_barrier(); asm volatile("" ::: "memory");
}
template <bool F8 = false, bool O8 = F8, bool I8 = false>
struct EpiSwigluT {
    static constexpr bool PERM = true, AFTER_DRAIN = false;
    bf16_t* O; int ldo;
    const float* part; PG8_LAS float* rs;
    const float* colmax;
    static __device__ __forceinline__ unsigned silu_mul2(f32x2 g, f32x2 u) {
        const f32x2 t = g * (-1.4426950408889634f);
        f32x2 e; e.x = __builtin_amdgcn_exp2f(t.x); e.y = __builtin_amdgcn_exp2f(t.y);
        const f32x2 d = e + 1.0f;
        f32x2 rc; rc.x = __builtin_amdgcn_rcpf(d.x); rc.y = __builtin_amdgcn_rcpf(d.y);
        const f32x2 r = (g * u) * rc;
        typedef __bf16 bf16x2_t __attribute__((ext_vector_type(2)));
        return __builtin_bit_cast(unsigned, __builtin_convertvector(r, bf16x2_t));
    }
    static __device__ __forceinline__ f32x2 silu_mul2f(f32x2 g, f32x2 u) {
        const f32x2 t = g * (-1.4426950408889634f);
        f32x2 e; e.x = __builtin_amdgcn_exp2f(t.x); e.y = __builtin_amdgcn_exp2f(t.y);
        const f32x2 d = e + 1.0f;
        f32x2 rc; rc.x = __builtin_amdgcn_rcpf(d.x); rc.y = __builtin_amdgcn_rcpf(d.y);
        return (g * u) * rc;
    }
    __device__ __forceinline__ void operator()(const f32x4 (&acc)[2][2][4][2], const Unit& u, int wr, int wc, int fr, int fq) const {
        const int row0 = u.pm * BM + wr * 64 + fr, col0 = u.pn * HALF + wc * 32 + 8 * fq;
        float rf[2][4];
#pragma unroll
        for (int ai = 0; ai < 2; ++ai)
#pragma unroll
            for (int m = 0; m < 4; ++m) rf[ai][m] = part ? rs[u.ord * 256 + wr * 64 + fr + ai * HALF + m * 16] : 1.0f;
        f32x4 cg0, cg1, cu0, cu1;
        if constexpr (I8) { cg0 = *(const f32x4*)(colmax + col0); cg1 = *(const f32x4*)(colmax + col0 + 4); cu0 = *(const f32x4*)(colmax + ldo + col0); cu1 = *(const f32x4*)(colmax + ldo + col0 + 4); }
#pragma unroll
        for (int ai = 0; ai < 2; ++ai)
#pragma unroll
            for (int m = 0; m < 4; ++m) {
                if constexpr (F8) {
                    f32x4 g0, g1, u0, u1;
                    if constexpr (I8) {
                        const float rg = rf[ai][m] * (1.0f / 127.0f), ru = O8 ? rg * F8_HSCALE : rg;
                        g0 = __builtin_convertvector(__builtin_bit_cast(v4i_t, acc[ai][0][m][0]), f32x4) * (cg0 * rg); g1 = __builtin_convertvector(__builtin_bit_cast(v4i_t, acc[ai][0][m][1]), f32x4) * (cg1 * rg);
                        u0 = __builtin_convertvector(__builtin_bit_cast(v4i_t, acc[ai][1][m][0]), f32x4) * (cu0 * ru); u1 = __builtin_convertvector(__builtin_bit_cast(v4i_t, acc[ai][1][m][1]), f32x4) * (cu1 * ru);
                    } else {
                    const float rg = rf[ai][m] * (1.0f / F8_WSCALE), ru = O8 ? rg * F8_HSCALE : rg;
                    g0 = acc[ai][0][m][0] * rg; g1 = acc[ai][0][m][1] * rg; u0 = acc[ai][1][m][0] * ru; u1 = acc[ai][1][m][1] * ru;
                    }
                    const f32x2 h0 = silu_mul2f((f32x2){g0[0], g0[1]}, (f32x2){u0[0], u0[1]}), h1 = silu_mul2f((f32x2){g0[2], g0[3]}, (f32x2){u0[2], u0[3]});
                    const f32x2 h2 = silu_mul2f((f32x2){g1[0], g1[1]}, (f32x2){u1[0], u1[1]}), h3 = silu_mul2f((f32x2){g1[2], g1[3]}, (f32x2){u1[2], u1[3]});
                    if constexpr (O8) {
                    typedef unsigned u32x2 __attribute__((ext_vector_type(2))); u32x2 w; w.x = pk4_fp8(h0.x, h0.y, h1.x, h1.y); w.y = pk4_fp8(h2.x, h2.y, h3.x, h3.y);
                    *(u32x2*)((unsigned char*)O + (size_t)(row0 + ai * HALF + m * 16) * ldo + col0) = w;
                    } else {
                    typedef __bf16 bf16x2_t __attribute__((ext_vector_type(2)));
                    u32x4 w; w.x = __builtin_bit_cast(unsigned, __builtin_convertvector(h0, bf16x2_t)); w.y = __builtin_bit_cast(unsigned, __builtin_convertvector(h1, bf16x2_t));
                    w.z = __builtin_bit_cast(unsigned, __builtin_convertvector(h2, bf16x2_t)); w.w = __builtin_bit_cast(unsigned, __builtin_convertvector(h3, bf16x2_t));
                    *(u32x4*)(O + (size_t)(row0 + ai * HALF + m * 16) * ldo + col0) = w;
                    }
                } else {
                const float r = rf[ai][m];
                const f32x4 g0 = acc[ai][0][m][0] * r, g1 = acc[ai][0][m][1] * r, u0 = acc[ai][1][m][0] * r, u1 = acc[ai][1][m][1] * r;
                u32x4 w;
                w.x = silu_mul2((f32x2){g0[0], g0[1]}, (f32x2){u0[0], u0[1]}); w.y = silu_mul2((f32x2){g0[2], g0[3]}, (f32x2){u0[2], u0[3]});
                w.z = silu_mul2((f32x2){g1[0], g1[1]}, (f32x2){u1[0], u1[1]}); w.w = silu_mul2((f32x2){g1[2], g1[3]}, (f32x2){u1[2], u1[3]});
                *(u32x4*)(O + (size_t)(row0 + ai * HALF + m * 16) * ldo + col0) = w;
                }
            }
    }
};
typedef EpiSwigluT<false> EpiSwiglu;
struct EpiResid {
    static constexpr bool PERM = false, AFTER_DRAIN = false;
    const float* base; float* out; int ldc; float alpha;
    bf16_t* XG; const float* gain; float* part;
    __device__ __forceinline__ void operator()(const f32x4 (&acc)[2][2][4][2], const Unit& u, int wr, int wc, int fr, int fq) const {
        const int row0 = u.pm * BM + wr * 64 + fr, col0 = u.pn * BM + wc * 32 + 4 * fq;
        f32x4 gg[2][2];
#pragma unroll
        for (int bj = 0; bj < 2; ++bj)
#pragma unroll
            for (int n = 0; n < 2; ++n) gg[bj][n] = XG ? *(const f32x4*)(gain + col0 + bj * HALF + 16 * n) : (f32x4){0.f, 0.f, 0.f, 0.f};
#pragma unroll
        for (int ai = 0; ai < 2; ++ai) {
            f32x4 b[4][2][2];
#pragma unroll
            for (int m = 0; m < 4; ++m)
#pragma unroll
                for (int bj = 0; bj < 2; ++bj)
#pragma unroll
                    for (int n = 0; n < 2; ++n) b[m][bj][n] = *(const f32x4*)(base + (size_t)(row0 + ai * HALF + m * 16) * ldc + col0 + bj * HALF + 16 * n);
#pragma unroll
            for (int m = 0; m < 4; ++m) { const int row = row0 + ai * HALF + m * 16; const size_t ro = (size_t)row * ldc + col0; float ssq = 0.f;
#pragma unroll
                for (int bj = 0; bj < 2; ++bj)
#pragma unroll
                    for (int n = 0; n < 2; ++n) { const size_t o = ro + bj * HALF + 16 * n; const f32x4 v = b[m][bj][n] + acc[ai][bj][m][n] * alpha; *(f32x4*)(out + o) = v;
                        if (XG) { const f32x4 g4 = gg[bj][n]; ssq += (v[0] * v[0] + v[1] * v[1]) + (v[2] * v[2] + v[3] * v[3]);
                            typedef unsigned u32x2 __attribute__((ext_vector_type(2))); u32x2 w; w.x = cvt_pk_bf16(v[0] * g4[0], v[1] * g4[1]); w.y = cvt_pk_bf16(v[2] * g4[2], v[3] * g4[3]); *(u32x2*)(XG + o) = w; } }
                if (XG) { ssq += __shfl_xor(ssq, 16); ssq += __shfl_xor(ssq, 32);
                    if (fq == 0) __hip_atomic_fetch_add((unsigned long long*)part + row, (unsigned long long)(ssq * 16777216.0f), __ATOMIC_RELAXED, __HIP_MEMORY_SCOPE_AGENT); } }
        }
    }
};
template <bool BB, bool OB>
struct EpiResidMix {
    static constexpr bool PERM = false, AFTER_DRAIN = false;
    const void* base; void* out; int ldc; float alpha;
    unsigned long long* rowsq;
    unsigned char* out8;
    unsigned* rowmax;
    __device__ __forceinline__ void operator()(const f32x4 (&acc)[2][2][4][2], const Unit& u, int wr, int wc, int fr, int fq) const {
        typedef unsigned u32x2 __attribute__((ext_vector_type(2)));
        const int row0 = u.pm * BM + wr * 64 + fr, col0 = u.pn * BM + wc * 32 + 4 * fq;
#pragma unroll
        for (int ai = 0; ai < 2; ++ai) {
            f32x4 b[4][2][2];
#pragma unroll
            for (int m = 0; m < 4; ++m)
#pragma unroll
                for (int bj = 0; bj < 2; ++bj)
#pragma unroll
                    for (int n = 0; n < 2; ++n) { const size_t o = (size_t)(row0 + ai * HALF + m * 16) * ldc + col0 + bj * HALF + 16 * n;
                        if (BB) { const u32x2 w = *(const u32x2*)((const bf16_t*)base + o);
                            b[m][bj][n] = (f32x4){__builtin_bit_cast(float, w.x << 16), __builtin_bit_cast(float, w.x & 0xffff0000u), __builtin_bit_cast(float, w.y << 16), __builtin_bit_cast(float, w.y & 0xffff0000u)}; }
                        else b[m][bj][n] = *(const f32x4*)((const float*)base + o); }
#pragma unroll
            for (int m = 0; m < 4; ++m) { float ssq = 0.f, amx = 0.f;
#pragma unroll
                for (int bj = 0; bj < 2; ++bj)
#pragma unroll
                    for (int n = 0; n < 2; ++n) { const size_t o = (size_t)(row0 + ai * HALF + m * 16) * ldc + col0 + bj * HALF + 16 * n; const f32x4 v = b[m][bj][n] + acc[ai][bj][m][n] * alpha;
                        ssq += (v[0] * v[0] + v[1] * v[1]) + (v[2] * v[2] + v[3] * v[3]);
                        if (rowmax) { amx = __builtin_fmaxf(__builtin_fmaxf(amx, __builtin_fabsf(v[0])), __builtin_fabsf(v[1])); amx = __builtin_fmaxf(__builtin_fmaxf(amx, __builtin_fabsf(v[2])), __builtin_fabsf(v[3])); }
                        if (OB) { u32x2 w; w.x = cvt_pk_bf16(v[0], v[1]); w.y = cvt_pk_bf16(v[2], v[3]); *(u32x2*)((bf16_t*)out + o) = w; }
                        else *(f32x4*)((float*)out + o) = v;
                        if (out8) *(unsigned*)(out8 + o) = pk4_fp8(v[0], v[1], v[2], v[3]); }
                if (rowsq) { ssq += __shfl_xor(ssq, 16); ssq += __shfl_xor(ssq, 32);
                    if (fq == 0) __hip_atomic_fetch_add(rowsq + (row0 + ai * HALF + m * 16), (unsigned long long)(ssq * 16777216.0f), __ATOMIC_RELAXED, __HIP_MEMORY_SCOPE_AGENT); }
                if (rowmax) { amx = __builtin_fmaxf(amx, __shfl_xor(amx, 16)); amx = __builtin_fmaxf(amx, __shfl_xor(amx, 32));
                    if (fq == 0) __hip_atomic_fetch_max(rowmax + (row0 + ai * HALF + m * 16), __builtin_bit_cast(unsigned, amx), __ATOMIC_RELAXED, __HIP_MEMORY_SCOPE_AGENT); } }
        }
    }
};
template <bool I8 = false>
struct EpiStoreBf16T {
    static constexpr bool PERM = true, AFTER_DRAIN = false;
    bf16_t* O; int ldo; int sc_lo, sc_hi; float sc;
    const float* part; PG8_LAS float* rs;
    bf16_t* KVC; int kv_lo, kv_hi;
    const float* colmax;
    __device__ __forceinline__ void operator()(const f32x4 (&acc)[2][2][4][2], const Unit& u, int wr, int wc, int fr, int fq) const {
        const int row0 = u.pm * BM + wr * 64 + fr, col0 = u.pn * BM + wc * 32 + 8 * fq;
        const float scl0 = (u.pn >= sc_lo && u.pn < sc_hi) ? sc : 1.0f;
        const bool kv = u.pn >= kv_lo && u.pn < kv_hi;
        const int which = (u.pn - kv_lo) >> 2, h0 = 2 * ((u.pn - kv_lo) & 3);
        float rf[2][4];
#pragma unroll
        for (int ai = 0; ai < 2; ++ai)
#pragma unroll
            for (int m = 0; m < 4; ++m) rf[ai][m] = part ? rs[u.ord * 256 + wr * 64 + fr + ai * HALF + m * 16] : 1.0f;
        f32x4 cm[2][2];
        if constexpr (I8) {
#pragma unroll
            for (int bj = 0; bj < 2; ++bj) { cm[bj][0] = *(const f32x4*)(colmax + col0 + bj * HALF); cm[bj][1] = *(const f32x4*)(colmax + col0 + bj * HALF + 4); } }
#pragma unroll
        for (int ai = 0; ai < 2; ++ai)
#pragma unroll
            for (int m = 0; m < 4; ++m) { const int row = row0 + ai * HALF + m * 16; bf16_t* rowp = O + (size_t)row * ldo + col0;
                const float scl = I8 ? scl0 * rf[ai][m] * (1.0f / 127.0f) : scl0 * rf[ai][m];
                bf16_t* kvp = KVC + ((size_t)((which * 4 + (row >> 12)) * 8 + h0) * 4096 + (row & 4095)) * 128 + wc * 32 + 8 * fq;
#pragma unroll
                for (int bj = 0; bj < 2; ++bj) { f32x4 v0, v1;
                    if constexpr (I8) { v0 = __builtin_convertvector(__builtin_bit_cast(v4i_t, acc[ai][bj][m][0]), f32x4) * (cm[bj][0] * scl); v1 = __builtin_convertvector(__builtin_bit_cast(v4i_t, acc[ai][bj][m][1]), f32x4) * (cm[bj][1] * scl); }
                    else { v0 = acc[ai][bj][m][0] * scl; v1 = acc[ai][bj][m][1] * scl; }
                    u32x4 w; w.x = cvt_pk_bf16(v0[0], v0[1]); w.y = cvt_pk_bf16(v0[2], v0[3]); w.z = cvt_pk_bf16(v1[0], v1[1]); w.w = cvt_pk_bf16(v1[2], v1[3]);
                    if (kv) *(u32x4*)(kvp + (size_t)bj * 4096 * 128) = w; else *(u32x4*)(rowp + bj * HALF) = w; } }
    }
};
typedef EpiStoreBf16T<false> EpiStoreBf16;
template <class Epi, class Sched, bool ALIGN_EPI = false, bool SP2 = false, bool FP8 = false, bool I8 = false>
__device__ __forceinline__ void gemm_phase(PG8_LAS unsigned char* lds, const Gemm g, const Sched& S, const Epi& E) {
    int tid_ = threadIdx.x; asm volatile("" : "+v"(tid_));
    const int tid = tid_, wid = __builtin_amdgcn_readfirstlane(tid >> 6), lane = tid & 63, wr = wid >> 2, wc = wid & 3, fr = lane & 15, fq = lane >> 4;
    const int K = g.K, nt = (K / BK) >> g.kshift;
    unsigned voffA[2], voffB[2];
#pragma unroll
    for (int i = 0; i < 2; ++i) { int R, C; stage_rc(tid * 16 + i * 8192, R, C); const int Rb = Epi::PERM ? ((R & ~31) + perm32(R & 31)) : R;
        voffA[i] = (unsigned)(R * K + C) * 2u; voffB[i] = (unsigned)(Rb * K + C) * 2u; }
    const size_t kstep = (size_t)(BK * 2);
    const size_t hstep = (size_t)HALF * K * 2;
    const size_t tstep = 2 * hstep;
    const unsigned ldsw = (unsigned)wid * 1024u;
    const int aoff = lds_byte(wr * 64 + fr, fq * 8), boff = lds_byte(wc * 32 + fr, fq * 8);
#define PG8_SA(b, h) (((b) * 2 + (h)) * HTB)
#define PG8_SB(b, h) ((4 + (b) * 2 + (h)) * HTB)
#define PG8_STAGE(bufoff, gbase, voff) do { _Pragma("unroll") for (int _i = 0; _i < 2; ++_i) \
        __builtin_amdgcn_global_load_lds((const unsigned*)((const char*)(gbase) + (voff)[_i]), (PG8_LAS unsigned*)(lds + (bufoff) + ldsw + _i * 8192), 16, 0, 0); } while (0)
#define PG8_LDA(dst, b, h) do { _Pragma("unroll") for (int m = 0; m < 4; ++m) _Pragma("unroll") for (int k = 0; k < 2; ++k) dst[m][k] = *(const PG8_LAS bf16x8*)(lds + PG8_SA(b, h) + aoff + m * 2048 + k * 1024); } while (0)
#define PG8_LDB(dst, b, h) do { _Pragma("unroll") for (int n = 0; n < 2; ++n) _Pragma("unroll") for (int k = 0; k < 2; ++k) dst[n][k] = *(const PG8_LAS bf16x8*)(lds + PG8_SB(b, h) + boff + n * 2048 + k * 1024); } while (0)
#define PG8_MMA(ai, bj, At, Bt) do { __builtin_amdgcn_s_setprio(1); _Pragma("unroll") for (int m = 0; m < 4; ++m) _Pragma("unroll") for (int n = 0; n < 2; ++n) _Pragma("unroll") for (int k = 0; k < 2; ++k) \
        acc[ai][bj][m][n] = __builtin_amdgcn_mfma_f32_16x16x32_bf16(Bt[n][k], At[m][k], acc[ai][bj][m][n], 0, 0, 0); __builtin_amdgcn_s_setprio(0); } while (0)
#define PG8_RD8(p) __builtin_shufflevector(*(const PG8_LAS v4i_t*)(p), *(const PG8_LAS v4i_t*)((p) + 1024), 0, 1, 2, 3, 4, 5, 6, 7)
#define PG8_LDA8(dst, b, h) do { _Pragma("unroll") for (int m = 0; m < 4; ++m) dst[m] = PG8_RD8(lds + PG8_SA(b, h) + aoff + m * 2048); } while (0)
#define PG8_LDB8(dst, b, h) do { _Pragma("unroll") for (int n = 0; n < 2; ++n) dst[n] = PG8_RD8(lds + PG8_SB(b, h) + boff + n * 2048); } while (0)
#define PG8_MQ(V, SW, b, a) V.SW = __builtin_amdgcn_mfma_scale_f32_16x16x128_f8f6f4(b, a, V.SW, 0, 0, 0, 0, 0, 0)
#define PG8_MMA8(ai, bj, At, Bt) do { __builtin_amdgcn_s_setprio(1); \
        PG8_MQ(accv[ai][bj][0], s0123, Bt[0], At[0]); PG8_MQ(accv[ai][bj][0], s4567, Bt[1], At[0]); PG8_MQ(accv[ai][bj][0], s89ab, Bt[0], At[1]); PG8_MQ(accv[ai][bj][0], scdef, Bt[1], At[1]); \
        PG8_MQ(accv[ai][bj][1], s0123, Bt[0], At[2]); PG8_MQ(accv[ai][bj][1], s4567, Bt[1], At[2]); PG8_MQ(accv[ai][bj][1], s89ab, Bt[0], At[3]); PG8_MQ(accv[ai][bj][1], scdef, Bt[1], At[3]); \
        __builtin_amdgcn_s_setprio(0); } while (0)
#define PG8_MMAI(ai, bj, At, Bt) do { __builtin_amdgcn_s_setprio(1); _Pragma("unroll") for (int m = 0; m < 4; ++m) _Pragma("unroll") for (int n = 0; n < 2; ++n) _Pragma("unroll") for (int k = 0; k < 2; ++k) \
        acc[ai][bj][m][n] = __builtin_bit_cast(f32x4, __builtin_amdgcn_mfma_i32_16x16x64_i8(__builtin_bit_cast(v4i_t, Bt[n][k]), __builtin_bit_cast(v4i_t, At[m][k]), __builtin_bit_cast(v4i_t, acc[ai][bj][m][n]), 0, 0, 0)); __builtin_amdgcn_s_setprio(0); } while (0)
#define PG8_MM(ai, bj, At, Bt) do { if constexpr (FP8) PG8_MMA8(ai, bj, At##8, Bt##8); else if constexpr (I8) PG8_MMAI(ai, bj, At, Bt); else PG8_MMA(ai, bj, At, Bt); } while (0)
#define PG8_LA(dst, b, h) do { if constexpr (FP8) PG8_LDA8(dst##8, b, h); else PG8_LDA(dst, b, h); } while (0)
#define PG8_LB(dst, b, h) do { if constexpr (FP8) PG8_LDB8(dst##8, b, h); else PG8_LDB(dst, b, h); } while (0)
#define PG8_WAIT_V(n) asm volatile("s_waitcnt vmcnt(" #n ")" ::: "memory")
#define PG8_WAIT_L(n) asm volatile("s_waitcnt lgkmcnt(" #n ")" ::: "memory")
#define PG8_BAR __builtin_amdgcn_s_barrier()
#define PG8_SCHED __builtin_amdgcn_sched_barrier(0)
    Unit cur, nxt; int ui = 0;
    if (!S.next(0, cur)) return;
    f32x4 acc[2][2][4][2];
    float zf = 0.f; asm volatile("" : "+v"(zf));
#pragma unroll
    for (int a = 0; a < 2; ++a)
#pragma unroll
        for (int b = 0; b < 2; ++b)
#pragma unroll
            for (int m = 0; m < 4; ++m)
#pragma unroll
                for (int n = 0; n < 2; ++n) acc[a][b][m][n] = (f32x4){zf, zf, zf, zf};
    bf16x8 At[4][2], B0[2][2], B1[2][2];
    typedef float f32x16_t __attribute__((ext_vector_type(16)));
    f32x16_t accv[2][2][2];
    if constexpr (FP8) {
#pragma unroll
        for (int a = 0; a < 2; ++a)
#pragma unroll
            for (int b = 0; b < 2; ++b)
#pragma unroll
                for (int h = 0; h < 2; ++h) accv[a][b][h] = (f32x16_t)(zf);
    }
    v8i_t At8[4], B08[2], B18[2];
    const char* cA = (const char*)g.A + (size_t)cur.pm * tstep; const char* cB = (const char*)g.Bt + (size_t)cur.pn * tstep;
    S.a_ready(cur);
    if constexpr (SP2) {
        PG8_STAGE(PG8_SB(0, 0), cB, voffB); PG8_STAGE(PG8_SB(0, 1), cB + hstep, voffB); PG8_STAGE(PG8_SA(0, 0), cA, voffA); PG8_STAGE(PG8_SA(0, 1), cA + hstep, voffA);
        if (wr == 1) PG8_BAR;
        PG8_WAIT_V(2); PG8_BAR;
        PG8_STAGE(PG8_SB(1, 0), cB + kstep, voffB); PG8_STAGE(PG8_SA(1, 0), cA + kstep, voffA); PG8_STAGE(PG8_SB(1, 1), cB + hstep + kstep, voffB);
        PG8_WAIT_V(6); PG8_BAR;
    } else {
        PG8_STAGE(PG8_SB(0, 0), cB, voffB); PG8_STAGE(PG8_SA(0, 0), cA, voffA); PG8_STAGE(PG8_SB(0, 1), cB + hstep, voffB); PG8_STAGE(PG8_SA(0, 1), cA + hstep, voffA);
        if (wr == 1) PG8_BAR;
        PG8_WAIT_V(4); PG8_BAR;
        PG8_STAGE(PG8_SB(1, 0), cB + kstep, voffB); PG8_STAGE(PG8_SA(1, 0), cA + kstep, voffA); PG8_STAGE(PG8_SB(1, 1), cB + hstep + kstep, voffB);
        PG8_WAIT_V(6); PG8_BAR;
    }
    for (;;) {
        const bool has_next = S.next(ui + 1, nxt);
        const char* nA = has_next ? (const char*)g.A + (size_t)nxt.pm * tstep : cA; const char* nB = has_next ? (const char*)g.Bt + (size_t)nxt.pn * tstep : cB;
        for (int t = 0; t < nt; t += 2) {
            const bool last = (t == nt - 2);
            const char* a1 = cA + (size_t)(t + 1) * kstep;
            const char* a2 = last ? nA : cA + (size_t)(t + 2) * kstep; const char* b2 = last ? nB : cB + (size_t)(t + 2) * kstep;
            const char* a3 = a2 + kstep; const char* b3 = b2 + kstep;
            if (last && has_next) S.a_ready(nxt);
            if constexpr (SP2) {
            PG8_LB(B0, 0, 0); PG8_LB(B1, 0, 1); PG8_SCHED; PG8_LA(At, 0, 0); PG8_STAGE(PG8_SA(1, 1), a1 + hstep, voffA);
            PG8_WAIT_V(8); PG8_WAIT_L(0); PG8_BAR; PG8_MM(0, 0, At, B0); PG8_MM(0, 1, At, B1); PG8_BAR; PG8_SCHED;
            PG8_LA(At, 0, 1); PG8_STAGE(PG8_SB(0, 0), b2, voffB); PG8_STAGE(PG8_SB(0, 1), b2 + hstep, voffB); PG8_STAGE(PG8_SA(0, 0), a2, voffA);
            PG8_WAIT_V(8); PG8_WAIT_L(0); PG8_BAR; PG8_MM(1, 0, At, B0); PG8_MM(1, 1, At, B1); PG8_BAR; PG8_SCHED;
            PG8_LB(B0, 1, 0); PG8_LB(B1, 1, 1); PG8_SCHED; PG8_LA(At, 1, 0); PG8_STAGE(PG8_SA(0, 1), a2 + hstep, voffA);
            PG8_WAIT_V(8); PG8_WAIT_L(0); PG8_BAR; PG8_MM(0, 0, At, B0); PG8_MM(0, 1, At, B1); PG8_BAR; PG8_SCHED;
            PG8_LA(At, 1, 1); PG8_STAGE(PG8_SB(1, 0), b3, voffB); PG8_STAGE(PG8_SB(1, 1), b3 + hstep, voffB); PG8_STAGE(PG8_SA(1, 0), a3, voffA);
            PG8_WAIT_V(8); PG8_WAIT_L(0); PG8_BAR; PG8_MM(1, 0, At, B0); PG8_MM(1, 1, At, B1); PG8_BAR; PG8_SCHED;
            } else {
            PG8_LB(B0, 0, 0); PG8_SCHED; PG8_LA(At, 0, 0); PG8_STAGE(PG8_SA(1, 1), a1 + hstep, voffA);
            PG8_WAIT_L(8); PG8_BAR; PG8_WAIT_L(0); PG8_MM(0, 0, At, B0); PG8_BAR; PG8_SCHED;
            PG8_LB(B1, 0, 1); PG8_STAGE(PG8_SB(0, 0), b2, voffB);
            PG8_BAR; PG8_WAIT_L(0); PG8_MM(0, 1, At, B1); PG8_BAR;
            PG8_LA(At, 0, 1); PG8_STAGE(PG8_SA(0, 0), a2, voffA);
            PG8_BAR; PG8_WAIT_L(0); PG8_MM(1, 0, At, B0); PG8_BAR; PG8_SCHED;
            PG8_STAGE(PG8_SB(0, 1), b2 + hstep, voffB);
            PG8_WAIT_V(6); PG8_BAR; PG8_MM(1, 1, At, B1); PG8_BAR;
            PG8_LB(B0, 1, 0); PG8_SCHED; PG8_LA(At, 1, 0); PG8_STAGE(PG8_SA(0, 1), a2 + hstep, voffA);
            PG8_WAIT_L(8); PG8_BAR; PG8_WAIT_L(0); PG8_MM(0, 0, At, B0); PG8_BAR; PG8_SCHED;
            PG8_LB(B1, 1, 1); PG8_STAGE(PG8_SB(1, 0), b3, voffB);
            PG8_BAR; PG8_WAIT_L(0); PG8_MM(0, 1, At, B1); PG8_BAR;
            PG8_LA(At, 1, 1); PG8_STAGE(PG8_SA(1, 0), a3, voffA);
            PG8_BAR; PG8_WAIT_L(0); PG8_MM(1, 0, At, B0); PG8_BAR; PG8_SCHED;
            PG8_STAGE(PG8_SB(1, 1), b3 + hstep, voffB);
            PG8_WAIT_V(6); PG8_BAR; PG8_MM(1, 1, At, B1); PG8_BAR;
            }
        }
        if constexpr (ALIGN_EPI) { if (wr == 0) PG8_BAR; }
        if constexpr (FP8) {
#pragma unroll
            for (int a = 0; a < 2; ++a)
#pragma unroll
                for (int b = 0; b < 2; ++b)
#pragma unroll
                    for (int h = 0; h < 2; ++h) { const f32x16_t v = accv[a][b][h]; acc[a][b][2 * h][0] = v.s0123; acc[a][b][2 * h][1] = v.s4567; acc[a][b][2 * h + 1][0] = v.s89ab; acc[a][b][2 * h + 1][1] = v.scdef; accv[a][b][h] = (f32x16_t)(zf); }
        }
        if constexpr (!Epi::AFTER_DRAIN) { E(acc, cur, wr, wc, fr, fq); S.done(cur); }
        if (!has_next) break;
#pragma unroll
        for (int a = 0; a < 2; ++a)
#pragma unroll
            for (int b = 0; b < 2; ++b)
#pragma unroll
                for (int m = 0; m < 4; ++m)
#pragma unroll
                    for (int n = 0; n < 2; ++n) acc[a][b][m][n] = (f32x4){zf, zf, zf, zf};
        cur = nxt; cA = nA; cB = nB; ++ui;
        if constexpr (ALIGN_EPI) { if (wr == 1) PG8_BAR; }
    }
    PG8_WAIT_V(0);
    if constexpr (!ALIGN_EPI) { if (wr == 0) PG8_BAR; }
    PG8_BAR;
    if constexpr (Epi::AFTER_DRAIN) { E.fused(acc, cur, wr, wc, fr, fq, lds, wid, lane); S.done(cur); }
#undef PG8_SA
#undef PG8_SB
#undef PG8_STAGE
#undef PG8_LDA
#undef PG8_LDB
#undef PG8_MMA
#undef PG8_MMA8
#undef PG8_MMAI
#undef PG8_MQ
#undef PG8_MM
#undef PG8_RD8
#undef PG8_LDA8
#undef PG8_LDB8
#undef PG8_LA
#undef PG8_LB
#undef PG8_WAIT_V
#undef PG8_WAIT_L
#undef PG8_BAR
#undef PG8_SCHED
}
}

struct Params {
    const float* x; const int* pos;
    const float *ffn1_norm, *ffn1_wg, *ffn1_wu, *ffn1_wd, *mix_norm, *w_in, *q_norm, *kc_norm, *ks_norm, *kw_norm;
    const float *ck_pos, *ck_w1, *ck_w2, *cv_pos, *cv_w1, *cv_w2, *nsa_on, *sb_on, *w_out, *ffn2_norm, *ffn2_wg, *ffn2_wu, *ffn2_wd;
    float* out; unsigned char* ws;
};


__device__ __forceinline__ void rmsnorm_rows(const float* X, const float* g, bf16* Y) {
    int tid = threadIdx.x; asm volatile("" : "+v"(tid));
    const int lane = tid & 63, gw = blockIdx.x * NWAVES + (tid >> 6), NGW = gridDim.x * NWAVES;
    f32x4 gg[8];
#pragma unroll
    for (int j = 0; j < 8; ++j) gg[j] = ((const f32x4*)g)[lane + 64 * j];
    for (int m0 = gw; m0 < M; m0 += 2 * NGW) {
        const int m1 = m0 + NGW; const bool ok1 = m1 < M;
        const f32x4* x0 = (const f32x4*)(X + (size_t)m0 * D) + lane; const f32x4* x1 = (const f32x4*)(X + (size_t)(ok1 ? m1 : m0) * D) + lane;
        f32x4 v0[8], v1[8]; float s0 = 0.f, s1 = 0.f;
#pragma unroll
        for (int j = 0; j < 8; ++j) { v0[j] = x0[64 * j]; v1[j] = x1[64 * j]; }
#pragma unroll
        for (int j = 0; j < 8; ++j) { s0 += (v0[j].x * v0[j].x + v0[j].y * v0[j].y) + (v0[j].z * v0[j].z + v0[j].w * v0[j].w); s1 += (v1[j].x * v1[j].x + v1[j].y * v1[j].y) + (v1[j].z * v1[j].z + v1[j].w * v1[j].w); }
        const float r0 = rsqrtf(wave_sum(s0) * (1.f / D) + EPS), r1 = rsqrtf(wave_sum(s1) * (1.f / D) + EPS);
        v2u* o0 = (v2u*)(Y + (size_t)m0 * D) + lane; v2u* o1 = (v2u*)(Y + (size_t)m1 * D) + lane;
#pragma unroll
        for (int j = 0; j < 8; ++j) { v2u w; w.x = pk2(v0[j].x * r0 * gg[j].x, v0[j].y * r0 * gg[j].y); w.y = pk2(v0[j].z * r0 * gg[j].z, v0[j].w * r0 * gg[j].w); o0[64 * j] = w; }
        if (ok1) {
#pragma unroll
            for (int j = 0; j < 8; ++j) { v2u w; w.x = pk2(v1[j].x * r1 * gg[j].x, v1[j].y * r1 * gg[j].y); w.y = pk2(v1[j].z * r1 * gg[j].z, v1[j].w * r1 * gg[j].w); o1[64 * j] = w; }
        }
    }
}

template <bool I8 = false>
__device__ __forceinline__ void cast_rows(const float* X, bf16* Y, unsigned long long* rowsq, unsigned char* Y8 = nullptr, float* rowscale = nullptr) {
    int tid = threadIdx.x; asm volatile("" : "+v"(tid));
    const int lane = tid & 63, gw = blockIdx.x * NWAVES + (tid >> 6), NGW = gridDim.x * NWAVES;
    for (int m0 = gw; m0 < M; m0 += 2 * NGW) {
        const int m1 = m0 + NGW; const bool ok1 = m1 < M;
        const f32x4* x0 = (const f32x4*)(X + (size_t)m0 * D) + lane; const f32x4* x1 = (const f32x4*)(X + (size_t)(ok1 ? m1 : m0) * D) + lane;
        f32x4 v0[8], v1[8]; float s0 = 0.f, s1 = 0.f;
#pragma unroll
        for (int j = 0; j < 8; ++j) { v0[j] = x0[64 * j]; v1[j] = x1[64 * j]; }
#pragma unroll
        for (int j = 0; j < 8; ++j) { s0 += (v0[j].x * v0[j].x + v0[j].y * v0[j].y) + (v0[j].z * v0[j].z + v0[j].w * v0[j].w); s1 += (v1[j].x * v1[j].x + v1[j].y * v1[j].y) + (v1[j].z * v1[j].z + v1[j].w * v1[j].w); }
        s0 = wave_sum(s0); s1 = wave_sum(s1);
        if (lane == 0) { rowsq[m0] = (unsigned long long)(s0 * 16777216.0f); if (ok1) rowsq[m1] = (unsigned long long)(s1 * 16777216.0f); }
        v2u* o0 = (v2u*)(Y + (size_t)m0 * D) + lane; v2u* o1 = (v2u*)(Y + (size_t)m1 * D) + lane;
#pragma unroll
        for (int j = 0; j < 8; ++j) { v2u w; w.x = pk2(v0[j].x, v0[j].y); w.y = pk2(v0[j].z, v0[j].w); o0[64 * j] = w; }
        float q0 = 0.f, q1 = 0.f;
        if constexpr (I8) {
            float a0 = 0.f, a1 = 0.f;
#pragma unroll
            for (int j = 0; j < 8; ++j) {
                a0 = fmaxf(a0, fabsf(v0[j][0])); a0 = fmaxf(a0, fabsf(v0[j][1])); a0 = fmaxf(a0, fabsf(v0[j][2])); a0 = fmaxf(a0, fabsf(v0[j][3]));
                a1 = fmaxf(a1, fabsf(v1[j][0])); a1 = fmaxf(a1, fabsf(v1[j][1])); a1 = fmaxf(a1, fabsf(v1[j][2])); a1 = fmaxf(a1, fabsf(v1[j][3])); }
            a0 = wave_max(a0); a1 = wave_max(a1);
            q0 = a0 > 0.f ? 127.0f / a0 : 0.f; q1 = a1 > 0.f ? 127.0f / a1 : 0.f;
            if (lane == 0) { rowscale[m0] = a0 * (1.0f / 127.0f); if (ok1) rowscale[m1] = a1 * (1.0f / 127.0f); }
        }
        if (Y8) {
#pragma unroll
            for (int j = 0; j < 8; ++j) ((unsigned*)(Y8 + (size_t)m0 * D))[lane + 64 * j] = I8 ? pg8::pk4_i8(v0[j].x, v0[j].y, v0[j].z, v0[j].w, q0) : pg8::pk4_fp8(v0[j].x, v0[j].y, v0[j].z, v0[j].w);
        }
        if (ok1) {
#pragma unroll
            for (int j = 0; j < 8; ++j) { v2u w; w.x = pk2(v1[j].x, v1[j].y); w.y = pk2(v1[j].z, v1[j].w); o1[64 * j] = w; }
            if (Y8) {
#pragma unroll
                for (int j = 0; j < 8; ++j) ((unsigned*)(Y8 + (size_t)m1 * D))[lane + 64 * j] = I8 ? pg8::pk4_i8(v1[j].x, v1[j].y, v1[j].z, v1[j].w, q1) : pg8::pk4_fp8(v1[j].x, v1[j].y, v1[j].z, v1[j].w);
            }
        }
    }
}
__device__ __forceinline__ void quant_rows_i8(const bf16* X, const unsigned* rowmax, unsigned char* Y8, float* rowscale) {
    int tid = threadIdx.x; asm volatile("" : "+v"(tid));
    const int lane = tid & 63, gw = blockIdx.x * NWAVES + (tid >> 6), NGW = gridDim.x * NWAVES;
    for (int m0 = gw; m0 < M; m0 += 2 * NGW) {
        const int m1 = m0 + NGW; const bool ok1 = m1 < M; const int mm1 = ok1 ? m1 : m0;
        const v4u* x0 = (const v4u*)(X + (size_t)m0 * D) + 4 * lane; const v4u* x1 = (const v4u*)(X + (size_t)mm1 * D) + 4 * lane;
        v4u a[4], b[4];
#pragma unroll
        for (int j = 0; j < 4; ++j) { a[j] = x0[j]; b[j] = x1[j]; }
        const float am0 = __builtin_bit_cast(float, rowmax[m0]), am1 = __builtin_bit_cast(float, rowmax[mm1]);
        const float q0 = am0 > 0.f ? 127.0f / am0 : 0.f, q1 = am1 > 0.f ? 127.0f / am1 : 0.f;
        if (lane == 0) { rowscale[m0] = am0 * (1.0f / 127.0f); if (ok1) rowscale[m1] = am1 * (1.0f / 127.0f); }
        v4u o0[2], o1[2];
#pragma unroll
        for (int j = 0; j < 4; ++j) {
            const unsigned w0 = pg8::pk4_i8(__builtin_amdgcn_fmed3f(bflo(a[j].x) * q0, -127.f, 127.f), __builtin_amdgcn_fmed3f(bfhi(a[j].x) * q0, -127.f, 127.f), __builtin_amdgcn_fmed3f(bflo(a[j].y) * q0, -127.f, 127.f), __builtin_amdgcn_fmed3f(bfhi(a[j].y) * q0, -127.f, 127.f), 1.0f);
            const unsigned w1 = pg8::pk4_i8(__builtin_amdgcn_fmed3f(bflo(a[j].z) * q0, -127.f, 127.f), __builtin_amdgcn_fmed3f(bfhi(a[j].z) * q0, -127.f, 127.f), __builtin_amdgcn_fmed3f(bflo(a[j].w) * q0, -127.f, 127.f), __builtin_amdgcn_fmed3f(bfhi(a[j].w) * q0, -127.f, 127.f), 1.0f);
            const unsigned w2 = pg8::pk4_i8(__builtin_amdgcn_fmed3f(bflo(b[j].x) * q1, -127.f, 127.f), __builtin_amdgcn_fmed3f(bfhi(b[j].x) * q1, -127.f, 127.f), __builtin_amdgcn_fmed3f(bflo(b[j].y) * q1, -127.f, 127.f), __builtin_amdgcn_fmed3f(bfhi(b[j].y) * q1, -127.f, 127.f), 1.0f);
            const unsigned w3 = pg8::pk4_i8(__builtin_amdgcn_fmed3f(bflo(b[j].z) * q1, -127.f, 127.f), __builtin_amdgcn_fmed3f(bfhi(b[j].z) * q1, -127.f, 127.f), __builtin_amdgcn_fmed3f(bflo(b[j].w) * q1, -127.f, 127.f), __builtin_amdgcn_fmed3f(bfhi(b[j].w) * q1, -127.f, 127.f), 1.0f);
            if (j & 1) { o0[j >> 1].z = w0; o0[j >> 1].w = w1; o1[j >> 1].z = w2; o1[j >> 1].w = w3; } else { o0[j >> 1].x = w0; o0[j >> 1].y = w1; o1[j >> 1].x = w2; o1[j >> 1].y = w3; }
        }
        v4u* y0 = (v4u*)(Y8 + (size_t)m0 * D) + 2 * lane; y0[0] = o0[0]; y0[1] = o0[1];
        if (ok1) { v4u* y1 = (v4u*)(Y8 + (size_t)m1 * D) + 2 * lane; y1[0] = o1[0]; y1[1] = o1[1]; }
    }
}
__device__ __forceinline__ void rmsnorm_rows_bf16(const bf16* X, const float* g, bf16* Y) {
    int tid = threadIdx.x; asm volatile("" : "+v"(tid));
    const int lane = tid & 63, gw = blockIdx.x * NWAVES + (tid >> 6), NGW = gridDim.x * NWAVES;
    f32x4 ga[4], gb[4];
#pragma unroll
    for (int j = 0; j < 4; ++j) { ga[j] = *(const f32x4*)(g + 8 * (lane + 64 * j)); gb[j] = *(const f32x4*)(g + 8 * (lane + 64 * j) + 4); }
    for (int m0 = gw; m0 < M; m0 += 2 * NGW) {
        const int m1 = m0 + NGW; const bool ok1 = m1 < M;
        const v4u* x0 = (const v4u*)(X + (size_t)m0 * D) + lane; const v4u* x1 = (const v4u*)(X + (size_t)(ok1 ? m1 : m0) * D) + lane;
        v4u r0[4], r1[4];
#pragma unroll
        for (int j = 0; j < 4; ++j) { r0[j] = x0[64 * j]; r1[j] = x1[64 * j]; }
        float s0 = 0.f, s1 = 0.f;
#pragma unroll
        for (int j = 0; j < 4; ++j) {
            s0 += (bflo(r0[j].x) * bflo(r0[j].x) + bfhi(r0[j].x) * bfhi(r0[j].x)) + (bflo(r0[j].y) * bflo(r0[j].y) + bfhi(r0[j].y) * bfhi(r0[j].y)) + (bflo(r0[j].z) * bflo(r0[j].z) + bfhi(r0[j].z) * bfhi(r0[j].z)) + (bflo(r0[j].w) * bflo(r0[j].w) + bfhi(r0[j].w) * bfhi(r0[j].w));
            s1 += (bflo(r1[j].x) * bflo(r1[j].x) + bfhi(r1[j].x) * bfhi(r1[j].x)) + (bflo(r1[j].y) * bflo(r1[j].y) + bfhi(r1[j].y) * bfhi(r1[j].y)) + (bflo(r1[j].z) * bflo(r1[j].z) + bfhi(r1[j].z) * bfhi(r1[j].z)) + (bflo(r1[j].w) * bflo(r1[j].w) + bfhi(r1[j].w) * bfhi(r1[j].w));
        }
        const float q0 = rsqrtf(wave_sum(s0) * (1.f / D) + EPS), q1 = rsqrtf(wave_sum(s1) * (1.f / D) + EPS);
        v4u* o0 = (v4u*)(Y + (size_t)m0 * D) + lane; v4u* o1 = (v4u*)(Y + (size_t)m1 * D) + lane;
#pragma unroll
        for (int j = 0; j < 4; ++j) { v4u w; w.x = pk2(bflo(r0[j].x) * q0 * ga[j].x, bfhi(r0[j].x) * q0 * ga[j].y); w.y = pk2(bflo(r0[j].y) * q0 * ga[j].z, bfhi(r0[j].y) * q0 * ga[j].w);
            w.z = pk2(bflo(r0[j].z) * q0 * gb[j].x, bfhi(r0[j].z) * q0 * gb[j].y); w.w = pk2(bflo(r0[j].w) * q0 * gb[j].z, bfhi(r0[j].w) * q0 * gb[j].w); o0[64 * j] = w; }
        if (ok1) {
#pragma unroll
            for (int j = 0; j < 4; ++j) { v4u w; w.x = pk2(bflo(r1[j].x) * q1 * ga[j].x, bfhi(r1[j].x) * q1 * ga[j].y); w.y = pk2(bflo(r1[j].y) * q1 * ga[j].z, bfhi(r1[j].y) * q1 * ga[j].w);
                w.z = pk2(bflo(r1[j].z) * q1 * gb[j].x, bfhi(r1[j].z) * q1 * gb[j].y); w.w = pk2(bflo(r1[j].w) * q1 * gb[j].z, bfhi(r1[j].w) * q1 * gb[j].w); o1[64 * j] = w; }
        }
    }
}

__device__ __forceinline__ void rope_tables(const int* pos, float* cs, float* sn) {
    int tid = threadIdx.x; asm volatile("" : "+v"(tid));
    const int gt = blockIdx.x * NTHREADS + tid, NGT = gridDim.x * NTHREADS;
    for (int i = gt; i < M * 64; i += NGT) {
        const int m = i >> 6, f = i & 63;
        const float inv = powf(10000.f, -(float)(2 * f) / 128.f);
        const float ang = (float)pos[m] * inv;
        cs[i] = cosf(ang); sn[i] = sinf(ang);
    }
}

__device__ __forceinline__ void postproj_naive(const Params& P, bf16* PROJ, const float* cs, const float* sn) {
    int tid = threadIdx.x; asm volatile("" : "+v"(tid));
    const int lane = tid & 63, sub = lane & 15, gw = blockIdx.x * NWAVES + (tid >> 6), NGW = gridDim.x * NWAVES;
    constexpr int NG = M * 12 / 4;
    for (int g0 = gw; g0 < NG; g0 += 2 * NGW) {
        v2u lo[2], hi[2]; f32x4 cv[2], sv[2]; bf16* pp[2]; const float* gp[2]; float qs[2]; bool ok[2];
#pragma unroll
        for (int u = 0; u < 2; ++u) {
            const int g = g0 + u * NGW; ok[u] = g < NG;
            const int task = ok[u] ? 4 * g + (lane >> 4) : 0, m = task / 12, sl = task % 12;
            int col;
            if (sl < 8) { col = C_QN + sl * 128; gp[u] = P.q_norm; } else if (sl < 10) { col = C_KS + (sl - 8) * 128; gp[u] = P.ks_norm; } else { col = C_KW + (sl - 10) * 128; gp[u] = P.kw_norm; }
            qs[u] = sl < 8 ? QSCALE : 1.0f;
            pp[u] = PROJ + (size_t)m * NP + col + 4 * sub;
            lo[u] = *(const v2u*)pp[u]; hi[u] = *(const v2u*)(pp[u] + 64);
            cv[u] = *(const f32x4*)(cs + m * 64 + 4 * sub); sv[u] = *(const f32x4*)(sn + m * 64 + 4 * sub);
        }
#pragma unroll
        for (int u = 0; u < 2; ++u) {
            float a[4], b[4];
            a[0] = bflo(lo[u].x); a[1] = bfhi(lo[u].x); a[2] = bflo(lo[u].y); a[3] = bfhi(lo[u].y);
            b[0] = bflo(hi[u].x); b[1] = bfhi(hi[u].x); b[2] = bflo(hi[u].y); b[3] = bfhi(hi[u].y);
            float ss = (a[0] * a[0] + a[1] * a[1]) + (a[2] * a[2] + a[3] * a[3]) + (b[0] * b[0] + b[1] * b[1]) + (b[2] * b[2] + b[3] * b[3]);
            ss += __shfl_xor(ss, 1); ss += __shfl_xor(ss, 2); ss += __shfl_xor(ss, 4); ss += __shfl_xor(ss, 8);
            const float r = rsqrtf(ss * (1.f / 128.f) + EPS) * qs[u];
            const f32x4 ga = *(const f32x4*)(gp[u] + 4 * sub), gb = *(const f32x4*)(gp[u] + 64 + 4 * sub);
            float oa[4], ob[4];
#pragma unroll
            for (int e = 0; e < 4; ++e) { const float x = a[e] * r * ga[e], y = b[e] * r * gb[e]; oa[e] = x * cv[u][e] - y * sv[u][e]; ob[e] = y * cv[u][e] + x * sv[u][e]; }
            if (ok[u]) { v2u wa, wb; wa.x = pk2(oa[0], oa[1]); wa.y = pk2(oa[2], oa[3]); wb.x = pk2(ob[0], ob[1]); wb.y = pk2(ob[2], ob[3]); *(v2u*)pp[u] = wa; *(v2u*)(pp[u] + 64) = wb; }
        }
    }
}

namespace att {
typedef short bf16x8 __attribute__((ext_vector_type(8)));
typedef short s16x4 __attribute__((ext_vector_type(4)));
constexpr float C1 = 0.08838834764831845f * 1.4426950408889634f;
typedef __bf16 bf16x2_t __attribute__((ext_vector_type(2)));
__device__ __forceinline__ unsigned cvt_pk_bf16(float lo, float hi) { const bf16x2_t v = __builtin_convertvector((f32x2){lo, hi}, bf16x2_t); return __builtin_bit_cast(unsigned, v); }
__device__ __forceinline__ int offK(int key, int dc) { return key * 256 + 16 * (dc ^ ((key & 3) | (((key >> 4) & 3) << 2))); }
__device__ __forceinline__ int offV(int key, int dc) { return key * 256 + 32 * ((dc >> 1) ^ ((key & 3) | (((key >> 4) & 1) << 2))) + 16 * (dc & 1); }
struct TileRegs { v4u k[2], v[2]; };
__device__ __forceinline__ void tile_load(TileRegs& r, const bf16* kp, const bf16* vp, int ld, int tid) {
#if NSA_OPAQUE
    asm volatile("" : "+v"(tid));
#endif
#pragma unroll
    for (int i = 0; i < 2; ++i) { const int id = tid + 512 * i, key = id >> 4, dc = id & 15; r.k[i] = *(const v4u*)(kp + (size_t)key * ld + dc * 8); r.v[i] = *(const v4u*)(vp + (size_t)key * ld + dc * 8); }
}
__device__ __forceinline__ void tile_store(const TileRegs& r, LAS unsigned char* kb, LAS unsigned char* vb, int tid) {
#if NSA_OPAQUE
    asm volatile("" : "+v"(tid));
#endif
#pragma unroll
    for (int i = 0; i < 2; ++i) { const int id = tid + 512 * i, key = id >> 4, dc = id & 15; *(LAS v4u*)(kb + offK(key, dc)) = r.k[i]; *(LAS v4u*)(vb + offV(key, dc)) = r.v[i]; }
}
__device__ __forceinline__ void tile_dma(const bf16* kp, const bf16* vp, int ld, LAS unsigned char* kb, LAS unsigned char* vb, int w, int lane) {
    asm volatile("" : "+v"(lane));
#pragma unroll
    for (int i = 0; i < 2; ++i) {
        const int p = 2 * w + i, key = 4 * p + (lane >> 4), sl = lane & 15;
        const int dck = sl ^ ((key & 3) | (((key >> 4) & 3) << 2));
        const int dcv = 2 * ((sl >> 1) ^ ((key & 3) | (((key >> 4) & 1) << 2))) + (sl & 1);
        __builtin_amdgcn_global_load_lds((const unsigned*)(kp + (size_t)key * ld + dck * 8), (LAS unsigned*)(kb + 1024 * p), 16, 0, 0);
        __builtin_amdgcn_global_load_lds((const unsigned*)(vp + (size_t)key * ld + dcv * 8), (LAS unsigned*)(vb + 1024 * p), 16, 0, 0);
    }
}
__device__ __forceinline__ void dma_k4(const bf16* kp, int ld, LAS unsigned char* kb, int w, int lane) {
    asm volatile("" : "+v"(lane));
#pragma unroll
    for (int i = 0; i < 4; ++i) {
        const int p = 4 * w + i, key = 4 * p + (lane >> 4), sl = lane & 15;
        const int dck = sl ^ ((key & 3) | (((key >> 4) & 3) << 2));
        __builtin_amdgcn_global_load_lds((const unsigned*)(kp + (size_t)key * ld + dck * 8), (LAS unsigned*)(kb + 1024 * p), 16, 0, 0);
    }
}
__device__ __forceinline__ void dma_v4(const bf16* vp, int ld, LAS unsigned char* vb, int w, int lane) {
    asm volatile("" : "+v"(lane));
#pragma unroll
    for (int i = 0; i < 4; ++i) {
        const int p = 4 * w + i, key = 4 * p + (lane >> 4), sl = lane & 15;
        const int dcv = 2 * ((sl >> 1) ^ ((key & 3) | (((key >> 4) & 1) << 2))) + (sl & 1);
        __builtin_amdgcn_global_load_lds((const unsigned*)(vp + (size_t)key * ld + dcv * 8), (LAS unsigned*)(vb + 1024 * p), 16, 0, 0);
    }
}
#define ATT_WAIT_V(n) asm volatile("s_waitcnt vmcnt(" #n ")" ::: "memory")
#define ATT_BAR() do { asm volatile("s_waitcnt lgkmcnt(0)" ::: "memory"); __builtin_amdgcn_s_barrier(); asm volatile("" ::: "memory"); } while (0)
template <bool OPAQUE = true>
__device__ __forceinline__ void qk_tile(f32x4 (&s)[2][4], const bf16x8 (&qf)[2][4], const LAS unsigned char* kb, int c, int q4) {
    if (OPAQUE) asm volatile("" : "+v"(c), "+v"(q4));
    const int rowoff = (16 * (c >> 2) + (c & 3)) * 256, lowp = 16 * (q4 ^ (c & 3));
#pragma unroll
    for (int kt = 0; kt < 4; ++kt) { s[0][kt] = (f32x4){0.f, 0.f, 0.f, 0.f}; s[1][kt] = (f32x4){0.f, 0.f, 0.f, 0.f}; }
#pragma unroll
    for (int ks = 0; ks < 4; ++ks) {
        const int a = rowoff + 64 * (ks ^ (c >> 2)) + lowp;
#pragma unroll
        for (int kt = 0; kt < 4; ++kt) {
            const bf16x8 kf = *(const LAS bf16x8*)(kb + a + kt * 1024);
            s[0][kt] = __builtin_amdgcn_mfma_f32_16x16x32_bf16(kf, qf[0][ks], s[0][kt], 0, 0, 0);
            s[1][kt] = __builtin_amdgcn_mfma_f32_16x16x32_bf16(kf, qf[1][ks], s[1][kt], 0, 0, 0);
        }
    }
}
__device__ __forceinline__ void qk_tile_lq(f32x4 (&s)[2][4], const LAS unsigned char* qb, const LAS unsigned char* kb, int c, int q4, int lane) {
#if NSA_OPAQUE
    asm volatile("" : "+v"(c), "+v"(q4), "+v"(lane));
#endif
    const int rowoff = (16 * (c >> 2) + (c & 3)) * 256, lowp = 16 * (q4 ^ (c & 3));
#pragma unroll
    for (int kt = 0; kt < 4; ++kt) { s[0][kt] = (f32x4){0.f, 0.f, 0.f, 0.f}; s[1][kt] = (f32x4){0.f, 0.f, 0.f, 0.f}; }
#pragma unroll
    for (int ks = 0; ks < 4; ++ks) {
        const int a = rowoff + 64 * (ks ^ (c >> 2)) + lowp;
        const bf16x8 q0 = *(const LAS bf16x8*)(qb + (ks * 64 + lane) * 16), q1 = *(const LAS bf16x8*)(qb + ((4 + ks) * 64 + lane) * 16);
#pragma unroll
        for (int kt = 0; kt < 4; ++kt) {
            const bf16x8 kf = *(const LAS bf16x8*)(kb + a + kt * 1024);
            s[0][kt] = __builtin_amdgcn_mfma_f32_16x16x32_bf16(kf, q0, s[0][kt], 0, 0, 0);
            s[1][kt] = __builtin_amdgcn_mfma_f32_16x16x32_bf16(kf, q1, s[1][kt], 0, 0, 0);
        }
    }
}
__device__ __forceinline__ void pv_tile(f32x4 (&o)[8][2], const bf16x8 (&pf)[2][2], const LAS unsigned char* vb, int c, int q4) {
#if NSA_OPAQUE
    asm volatile("" : "+v"(c), "+v"(q4));
#endif
    const int p = c & 3;
#pragma unroll
    for (int s2 = 0; s2 < 2; ++s2) {
        const int key0 = 16 * q4 + 8 * s2 + (c >> 2);
        const int g = (key0 & 3) | (((key0 >> 4) & 1) << 2);
        const int base = key0 * 256 + 16 * (p >> 1) + 8 * (p & 1);
#pragma unroll
        for (int dt = 0; dt < 8; ++dt) {
            const LAS unsigned char* a0 = vb + base + 32 * (dt ^ g);
            const s16x4 lo = __builtin_amdgcn_ds_read_tr16_b64_v4i16((LAS s16x4*)a0);
            const s16x4 hi = __builtin_amdgcn_ds_read_tr16_b64_v4i16((LAS s16x4*)(a0 + 1024));
            const bf16x8 vf = __builtin_shufflevector(lo, hi, 0, 1, 2, 3, 4, 5, 6, 7);
            o[dt][0] = __builtin_amdgcn_mfma_f32_16x16x32_bf16(vf, pf[0][s2], o[dt][0], 0, 0, 0);
            o[dt][1] = __builtin_amdgcn_mfma_f32_16x16x32_bf16(vf, pf[1][s2], o[dt][1], 0, 0, 0);
        }
    }
}
__device__ __forceinline__ s16x4 tr_read_asm(unsigned addr) { s16x4 r; asm volatile("ds_read_b64_tr_b16 %0, %1" : "=v"(r) : "v"(addr) : "memory"); return r; }
__device__ __forceinline__ s16x4 tr_read_asm_1k(unsigned addr) { s16x4 r; asm volatile("ds_read_b64_tr_b16 %0, %1 offset:1024" : "=v"(r) : "v"(addr) : "memory"); return r; }
template <bool OPAQUE = true>
__device__ __forceinline__ void pv_tile_asm(f32x4 (&o)[8][2], const bf16x8 (&pf)[2][2], const LAS unsigned char* vb, int c, int q4) {
    if (OPAQUE) asm volatile("" : "+v"(c), "+v"(q4));
    const int p = c & 3;
#pragma unroll
    for (int s2 = 0; s2 < 2; ++s2) {
        const int key0 = 16 * q4 + 8 * s2 + (c >> 2);
        const int g = (key0 & 3) | (((key0 >> 4) & 1) << 2);
        const unsigned base = (unsigned)(size_t)vb + key0 * 256 + 16 * (p >> 1) + 8 * (p & 1);
        s16x4 lo[8], hi[8];
#pragma unroll
        for (int dt = 0; dt < 8; ++dt) { const unsigned a0 = base + 32 * (dt ^ g); lo[dt] = tr_read_asm(a0); hi[dt] = tr_read_asm_1k(a0); }
        asm volatile("s_waitcnt lgkmcnt(0)" ::: "memory");
        __builtin_amdgcn_sched_barrier(0);
#pragma unroll
        for (int dt = 0; dt < 8; ++dt) {
            const bf16x8 vf = __builtin_shufflevector(lo[dt], hi[dt], 0, 1, 2, 3, 4, 5, 6, 7);
            o[dt][0] = __builtin_amdgcn_mfma_f32_16x16x32_bf16(vf, pf[0][s2], o[dt][0], 0, 0, 0);
            o[dt][1] = __builtin_amdgcn_mfma_f32_16x16x32_bf16(vf, pf[1][s2], o[dt][1], 0, 0, 0);
        }
    }
}
struct VGroup { s16x4 lo[4], hi[4]; };
template <int G>
__device__ __forceinline__ void pv_issue(VGroup& v, const LAS unsigned char* vb, int c, int q4) {
    constexpr int s2 = G >> 1, d0 = 4 * (G & 1);
    const int p = c & 3, key0 = 16 * q4 + 8 * s2 + (c >> 2), g = (key0 & 3) | (((key0 >> 4) & 1) << 2);
    const unsigned base = (unsigned)(size_t)vb + key0 * 256 + 16 * (p >> 1) + 8 * (p & 1);
#pragma unroll
    for (int i = 0; i < 4; ++i) { const unsigned a0 = base + 32 * ((d0 + i) ^ g); v.lo[i] = tr_read_asm(a0); v.hi[i] = tr_read_asm_1k(a0); }
}
template <int G>
__device__ __forceinline__ void pv_mma(f32x4 (&o)[8][2], const VGroup& v, const bf16x8 (&pf)[2][2]) {
    constexpr int s2 = G >> 1, d0 = 4 * (G & 1);
#pragma unroll
    for (int i = 0; i < 4; ++i) {
        const bf16x8 vf = __builtin_shufflevector(v.lo[i], v.hi[i], 0, 1, 2, 3, 4, 5, 6, 7);
        o[d0 + i][0] = __builtin_amdgcn_mfma_f32_16x16x32_bf16(vf, pf[0][s2], o[d0 + i][0], 0, 0, 0);
        o[d0 + i][1] = __builtin_amdgcn_mfma_f32_16x16x32_bf16(vf, pf[1][s2], o[d0 + i][1], 0, 0, 0);
    }
}
#define PV_WAIT() do { asm volatile("s_waitcnt lgkmcnt(0)" ::: "memory"); __builtin_amdgcn_sched_barrier(0); } while (0)
__device__ __forceinline__ void pv_tile_rest(f32x4 (&o)[8][2], VGroup& va, const bf16x8 (&pf)[2][2], const LAS unsigned char* vb, int c, int q4) {
    VGroup vb2;
    PV_WAIT(); pv_issue<1>(vb2, vb, c, q4); __builtin_amdgcn_sched_barrier(0); pv_mma<0>(o, va, pf);
    PV_WAIT(); pv_issue<2>(va, vb, c, q4);  __builtin_amdgcn_sched_barrier(0); pv_mma<1>(o, vb2, pf);
    PV_WAIT(); pv_issue<3>(vb2, vb, c, q4); __builtin_amdgcn_sched_barrier(0); pv_mma<2>(o, va, pf);
    PV_WAIT(); pv_mma<3>(o, vb2, pf);
}
__device__ __forceinline__ bf16x8 pack8(float a0, float a1, float a2, float a3, float a4, float a5, float a6, float a7) {
    v4u w; w.x = cvt_pk_bf16(a0, a1); w.y = cvt_pk_bf16(a2, a3); w.z = cvt_pk_bf16(a4, a5); w.w = cvt_pk_bf16(a6, a7);
    return __builtin_bit_cast(bf16x8, w);
}


template <bool MASK>
__device__ __forceinline__ void sb_elem(const f32x4 (&s)[4], float& R, bf16x8 (&pf)[2], const int kdiff, const int c, const int q4) {
    f32x2 a2[8]; f32x2 t2 = (f32x2){1.f, 1.f};
#pragma unroll
    for (int k = 0; k < 8; ++k) {
        f32x2 e;
        e.x = __builtin_amdgcn_exp2f(s[k >> 2][k & 3]); e.y = __builtin_amdgcn_exp2f(s[2 + (k >> 2)][k & 3]);
        if (MASK) { e.x = (k < kdiff) ? e.x : 0.f; e.y = (k + 8 < kdiff) ? e.y : 0.f; }
        a2[k] = e * t2; t2 = t2 * (e + 1.0f);
    }
    const float l0 = __builtin_amdgcn_logf(t2.x), l1 = __builtin_amdgcn_logf(t2.y), run = l0 + l1;
    const float u1 = __shfl_down(run, 16), u2 = __shfl_down(run, 32), u3 = __shfl_down(run, 48);
    const float X = (q4 < 3 ? u1 : 0.f) + (q4 < 2 ? u2 : 0.f) + (q4 < 1 ? u3 : 0.f);
    const float tot = __shfl(run + X, c);
    const float base = R + X + l1;
    f32x2 sc; sc.y = __builtin_amdgcn_exp2f(-base); sc.x = __builtin_amdgcn_exp2f(-(base + l0));
    R += tot;
#pragma unroll
    for (int k = 0; k < 8; ++k) a2[k] = a2[k] * sc;
    pf[0] = pack8(a2[0].x, a2[1].x, a2[2].x, a2[3].x, a2[4].x, a2[5].x, a2[6].x, a2[7].x);
    pf[1] = pack8(a2[0].y, a2[1].y, a2[2].y, a2[3].y, a2[4].y, a2[5].y, a2[6].y, a2[7].y);
}

template <int MODE = 31>
__device__ __forceinline__ void sb_unit(const Params& P, LAS unsigned char* lds, const bf16* PROJ, const bf16* KVC, bf16* Y, int b, int h, int tqq) {
    int tid = threadIdx.x; asm volatile("" : "+v"(tid));
    const int lane = tid & 63, w = __builtin_amdgcn_readfirstlane(tid >> 6), c = lane & 15, q4 = lane >> 4;
    const int qbase = 256 * tqq + 32 * w;
    bf16x8 qf[2][4];
#pragma unroll
    for (int qt = 0; qt < 2; ++qt)
#pragma unroll
        for (int ks = 0; ks < 4; ++ks) qf[qt][ks] = *(const bf16x8*)(PROJ + (size_t)(b * SEQ + qbase + 16 * qt + c) * NP + C_QS + h * 128 + 32 * ks + 8 * q4);
#pragma unroll
    for (int qt = 0; qt < 2; ++qt)
#pragma unroll
        for (int ks = 0; ks < 4; ++ks) asm volatile("" : "+v"(qf[qt][ks]));
    f32x4 o[8][2];
#pragma unroll
    for (int dt = 0; dt < 8; ++dt) { o[dt][0] = (f32x4){0.f, 0.f, 0.f, 0.f}; o[dt][1] = (f32x4){0.f, 0.f, 0.f, 0.f}; }
    float R[2] = {0.f, 0.f};
#if SB_COMPACT
    const bf16* kg = KVC + (size_t)((b * 8 + h) * 4096) * 128; const bf16* vg = KVC + (size_t)((32 + b * 8 + h) * 4096) * 128;
    constexpr int KLD = 128;
#else
    const bf16* kg = PROJ + (size_t)(b * SEQ) * NP + C_KSB + h * 128; const bf16* vg = PROJ + (size_t)(b * SEQ) * NP + C_VSB + h * 128;
    constexpr int KLD = NP;
#endif
    const int nkt = 4 * tqq + 4;
    const bool isA = w < 4;
    if (isA && (MODE & 8)) { dma_k4(kg + (size_t)(nkt - 1) * 64 * KLD, KLD, lds, w, lane); dma_v4(vg + (size_t)(nkt - 1) * 64 * KLD, KLD, lds + 32768, w, lane); ATT_WAIT_V(0); }
    ATT_BAR();
    if (!isA) ATT_BAR();
    for (int it = 0; it < nkt; ++it) {
        const int kt64 = nkt - 1 - it, kb0 = 64 * kt64, cur = it & 1;
        const bool has = it + 1 < nkt, active = kb0 <= qbase + 30, need_mask = (kb0 + 63 >= qbase);
        const LAS unsigned char* kb = lds + cur * 16384; const LAS unsigned char* vb = lds + 32768 + cur * 16384;
        f32x4 s[2][4]; bf16x8 pf[2][2];
        if (isA && has && (MODE & 8)) dma_k4(kg + (size_t)(kt64 - 1) * 64 * KLD, KLD, lds + (cur ^ 1) * 16384, w, lane);
        if (active) {
            if (MODE & 1) qk_tile<false>(s, qf, kb, c, q4);
            else {
#pragma unroll
                for (int kt = 0; kt < 4; ++kt) { s[0][kt] = (f32x4){0.1f, -0.2f, 0.3f, R[0]}; s[1][kt] = (f32x4){-0.1f, 0.2f, -0.3f, R[1]}; asm volatile("" : "+v"(s[0][kt]), "+v"(s[1][kt])); } }
            if (MODE & 2) { if (need_mask) sb_elem<true>(s[0], R[0], pf[0], qbase + c - kb0 - 16 * q4, c, q4); else sb_elem<false>(s[0], R[0], pf[0], 64, c, q4); }
            else { pf[0][0] = __builtin_bit_cast(bf16x8, s[0][0]); pf[0][1] = __builtin_bit_cast(bf16x8, s[0][1]); R[0] += s[0][2][0] + s[0][3][1]; }
        }
        if (isA) { if (has) ATT_WAIT_V(4); else ATT_WAIT_V(0); }
        if (MODE & 16) ATT_BAR();
        if (isA && has && (MODE & 8)) dma_v4(vg + (size_t)(kt64 - 1) * 64 * KLD, KLD, lds + 32768 + (cur ^ 1) * 16384, w, lane);
        if (active) {
            VGroup vg0;
            if (MODE & 4) { pv_issue<0>(vg0, vb, c, q4); __builtin_amdgcn_sched_barrier(0); }
            if (MODE & 2) { if (need_mask) sb_elem<true>(s[1], R[1], pf[1], qbase + 16 + c - kb0 - 16 * q4, c, q4); else sb_elem<false>(s[1], R[1], pf[1], 64, c, q4); }
            else { pf[1][0] = __builtin_bit_cast(bf16x8, s[1][0]); pf[1][1] = __builtin_bit_cast(bf16x8, s[1][1]); R[1] += s[1][2][0] + s[1][3][1]; }
            if (MODE & 4) pv_tile_rest(o, vg0, pf, vb, c, q4);
            else { o[0][0] = o[0][0] + __builtin_bit_cast(f32x4, pf[0][0]) + __builtin_bit_cast(f32x4, pf[0][1]); o[0][1] = o[0][1] + __builtin_bit_cast(f32x4, pf[1][0]) + __builtin_bit_cast(f32x4, pf[1][1]); }
        }
        if (isA) { if (has) ATT_WAIT_V(4); else ATT_WAIT_V(0); }
        if (MODE & 16) ATT_BAR();
    }
    if (isA) ATT_BAR();
    f32x4 gsb[8];
#pragma unroll
    for (int dt = 0; dt < 8; ++dt) gsb[dt] = *(const f32x4*)(P.sb_on + h * 128 + 4 * q4 + 16 * dt);
#pragma unroll
    for (int qt = 0; qt < 2; ++qt) {
        float ss = 0.f;
#pragma unroll
        for (int dt = 0; dt < 8; ++dt) { const f32x4 v = o[dt][qt]; ss += (v[0] * v[0] + v[1] * v[1]) + (v[2] * v[2] + v[3] * v[3]); }
        ss += __shfl_xor(ss, 16); ss += __shfl_xor(ss, 32);
        const float r = rsqrtf(ss * (1.f / 128.f) + EPS);
        bf16* yrow = Y + (size_t)(b * SEQ + qbase + 16 * qt + c) * D + 1024 + h * 128 + 4 * q4;
#pragma unroll
        for (int dt = 0; dt < 8; ++dt) { const f32x4 v = o[dt][qt]; const f32x4 gg = gsb[dt];
            v2u wv; wv.x = cvt_pk_bf16(v[0] * r * gg[0], v[1] * r * gg[1]); wv.y = cvt_pk_bf16(v[2] * r * gg[2], v[3] * r * gg[3]);
            *(v2u*)(yrow + 16 * dt) = wv; }
    }
}

__device__ __forceinline__ void osm_step(const f32x4 (&s)[4], const bool bsel, const bool masked, const int lo, const int hi, float& m, float& l, f32x4 (&o)[8][2], const int qt, bf16x8 (&pf)[2]) {
    float v[16];
#pragma unroll
    for (int idx = 0; idx < 16; ++idx) v[idx] = s[idx >> 2][idx & 3];
    if (masked) {
#pragma unroll
        for (int idx = 0; idx < 16; ++idx) v[idx] = (idx >= lo && idx <= hi) ? v[idx] : -1e30f;
    }
    float tm = fmaxf(fmaxf(fmaxf(v[0], v[1]), fmaxf(v[2], v[3])), fmaxf(fmaxf(v[4], v[5]), fmaxf(v[6], v[7])));
    tm = fmaxf(tm, fmaxf(fmaxf(fmaxf(v[8], v[9]), fmaxf(v[10], v[11])), fmaxf(fmaxf(v[12], v[13]), fmaxf(v[14], v[15]))));
    tm = fmaxf(tm, __shfl_xor(tm, 16)); tm = fmaxf(tm, __shfl_xor(tm, 32));
    tm = bsel ? tm : -1e30f;
    const bool grow = tm > m + 8.0f;
    if (__any(grow)) {
        const float mn = grow ? tm : m, alpha = __builtin_amdgcn_exp2f(m - mn);
        l *= alpha; m = mn;
#pragma unroll
        for (int dt = 0; dt < 8; ++dt) o[dt][qt] = o[dt][qt] * alpha;
    }
    const float sub = bsel ? m : 1e30f;
    float sum = 0.f;
#pragma unroll
    for (int idx = 0; idx < 16; ++idx) { v[idx] = __builtin_amdgcn_exp2f(v[idx] - sub); sum += v[idx]; }
    l += sum;
    pf[0] = pack8(v[0], v[1], v[2], v[3], v[4], v[5], v[6], v[7]);
    pf[1] = pack8(v[8], v[9], v[10], v[11], v[12], v[13], v[14], v[15]);
}
#define ATT_TILE_PROLOGUE(KP, VP, LD) do { tile_load(tr, (KP), (VP), (LD), tid); __syncthreads(); tile_store(tr, lds, lds + 32768, tid); __syncthreads(); } while (0)
#define ATT_TILE_NEXT(HAS, KP, VP, LD) do { if (HAS) tile_load(tr, (KP), (VP), (LD), tid); } while (0)
#define ATT_TILE_END(HAS, CUR) do { if (HAS) tile_store(tr, lds + ((CUR) ^ 1) * 16384, lds + 32768 + ((CUR) ^ 1) * 16384, tid); __syncthreads(); } while (0)

__device__ __forceinline__ void nsa_unit(const Params& P, LAS unsigned char* lds, const bf16* PROJ, const bf16* KC, const bf16* VC, bf16* Y, f32x4* scr, int b, int g, int tq) {
    int tid = threadIdx.x; asm volatile("" : "+v"(tid));
    const int lane = tid & 63, w = __builtin_amdgcn_readfirstlane(tid >> 6), c = lane & 15, q4 = lane >> 4;
    const int bg = b * 2 + g, t0 = 64 * tq, hg = g * 4 + (c & 3);
    LAS float* pslc = (LAS float*)(lds + 131072);
    LAS unsigned long long* selm = (LAS unsigned long long*)(lds + 147456);
    LAS unsigned char* qb = lds + 65536 + w * 8192;
    scr += (size_t)w * 32 * 64;
    int ql[2]; ql[0] = 8 * w + (c >> 2); ql[1] = ql[0] + 4;
#pragma unroll
    for (int i = 0; i < 8; ++i) pslc[(8 * w + i) * 64 + lane] = 0.f;
    bf16x8 qf[2][4];
#pragma unroll
    for (int qt = 0; qt < 2; ++qt) {
        const bf16* prow = PROJ + (size_t)(b * SEQ + t0 + ql[qt]) * NP;
#pragma unroll
        for (int ks = 0; ks < 4; ++ks) qf[qt][ks] = *(const bf16x8*)(prow + C_QN + hg * 128 + 32 * ks + 8 * q4);
    }
#pragma unroll
    for (int qt = 0; qt < 2; ++qt)
#pragma unroll
        for (int ks = 0; ks < 4; ++ks) asm volatile("" : "+v"(qf[qt][ks]));
    float gates[2][3];
    {
        bf16 graw[2][3];
#pragma unroll
        for (int qt = 0; qt < 2; ++qt)
#pragma unroll
            for (int br = 0; br < 3; ++br) graw[qt][br] = PROJ[(size_t)(b * SEQ + t0 + ql[qt]) * NP + C_GATE + hg * 3 + br];
#pragma unroll
        for (int qt = 0; qt < 2; ++qt)
#pragma unroll
            for (int br = 0; br < 3; ++br) gates[qt][br] = 1.f / (1.f + __expf(-bf2f(graw[qt][br])));
    }
    TileRegs tr;
    f32x4 o[8][2];
    float mx[2], ls[2];
    const bf16* kcg = KC + (size_t)bg * 256 * 128; const bf16* vcg = VC + (size_t)bg * 256 * 128;
    const int nvmax = min(NCMP, 4 * tq + 3), ntc = (nvmax + 63) >> 6;
    mx[0] = mx[1] = -1e20f; ls[0] = ls[1] = 0.f;
    ATT_TILE_PROLOGUE(kcg, vcg, 128);
    for (int it = 0; it < ntc; ++it) {
        const int cur = it & 1; const bool has = it + 1 < ntc;
        ATT_TILE_NEXT(has, kcg + (size_t)(it + 1) * 64 * 128, vcg + (size_t)(it + 1) * 64 * 128, 128);
        {
            f32x4 s[2][4];
            qk_tile<false>(s, qf, lds + cur * 16384, c, q4);
#pragma unroll
            for (int qt = 0; qt < 2; ++qt) {
                const int lim = t0 + ql[qt] - 31 - 16 * (64 * it + 16 * q4);
                float tm = -1e30f, v[16];
#pragma unroll
                for (int kt = 0; kt < 4; ++kt)
#pragma unroll
                    for (int i = 0; i < 4; ++i) { v[4 * kt + i] = (16 * (4 * kt + i) <= lim) ? s[qt][kt][i] : -1e30f; tm = fmaxf(tm, v[4 * kt + i]); }
                tm = fmaxf(tm, __shfl_xor(tm, 16)); tm = fmaxf(tm, __shfl_xor(tm, 32));
                const float mn = fmaxf(mx[qt], tm); float sum = 0.f;
#pragma unroll
                for (int i = 0; i < 16; ++i) sum += __builtin_amdgcn_exp2f(v[i] - mn);
                ls[qt] = ls[qt] * __builtin_amdgcn_exp2f(mx[qt] - mn) + sum; mx[qt] = mn;
            }
        }
        ATT_TILE_END(has, cur);
    }
    float inv[2];
#pragma unroll
    for (int qt = 0; qt < 2; ++qt) { float l = ls[qt]; l += __shfl_xor(l, 16); l += __shfl_xor(l, 32); inv[qt] = l > 0.f ? 1.f / l : 0.f; }
    float g0v[2]; g0v[0] = gates[0][0]; g0v[1] = gates[1][0];
#pragma unroll
    for (int dt = 0; dt < 8; ++dt) { o[dt][0] = (f32x4){0.f, 0.f, 0.f, 0.f}; o[dt][1] = (f32x4){0.f, 0.f, 0.f, 0.f}; }
    ATT_TILE_PROLOGUE(kcg, vcg, 128);
    for (int it = 0; it < ntc; ++it) {
        const int cur = it & 1; const bool has = it + 1 < ntc;
        ATT_TILE_NEXT(has, kcg + (size_t)(it + 1) * 64 * 128, vcg + (size_t)(it + 1) * 64 * 128, 128);
        {
            f32x4 s[2][4];
            qk_tile<false>(s, qf, lds + cur * 16384, c, q4);
            bf16x8 pf[2][2];
#pragma unroll
            for (int qt = 0; qt < 2; ++qt) {
                const int lim = t0 + ql[qt] - 31 - 16 * (64 * it + 16 * q4);
                float p[16];
#pragma unroll
                for (int kt = 0; kt < 4; ++kt)
#pragma unroll
                    for (int i = 0; i < 4; ++i) p[4 * kt + i] = (16 * (4 * kt + i) <= lim) ? __builtin_amdgcn_exp2f(s[qt][kt][i] - mx[qt]) * inv[qt] : 0.f;
                const int jb = 16 * it + 4 * q4;
#pragma unroll
                for (int kt = 0; kt < 4; ++kt) {
                    float gs = (p[4 * kt] + p[4 * kt + 1]) + (p[4 * kt + 2] + p[4 * kt + 3]), e3 = p[4 * kt + 3];
                    gs += __shfl_xor(gs, 1); gs += __shfl_xor(gs, 2); e3 += __shfl_xor(e3, 1); e3 += __shfl_xor(e3, 2);
                    if ((c & 3) == 0) {
                        LAS float* row = pslc + ql[qt] * 64;
                        __hip_atomic_fetch_add(row + jb + kt, gs, __ATOMIC_RELAXED, __HIP_MEMORY_SCOPE_WORKGROUP);
                        if (jb + kt + 1 < 64) __hip_atomic_fetch_add(row + jb + kt + 1, e3, __ATOMIC_RELAXED, __HIP_MEMORY_SCOPE_WORKGROUP);
                    }
                }
                const float g0 = g0v[qt];
                pf[qt][0] = pack8(p[0] * g0, p[1] * g0, p[2] * g0, p[3] * g0, p[4] * g0, p[5] * g0, p[6] * g0, p[7] * g0);
                pf[qt][1] = pack8(p[8] * g0, p[9] * g0, p[10] * g0, p[11] * g0, p[12] * g0, p[13] * g0, p[14] * g0, p[15] * g0);
            }
            pv_tile(o, pf, lds + 32768 + cur * 16384, c, q4);
        }
        ATT_TILE_END(has, cur);
    }
#pragma unroll
    for (int dt = 0; dt < 8; ++dt) { scr[lane * 32 + 2 * dt] = o[dt][0]; scr[lane * 32 + 2 * dt + 1] = o[dt][1]; }
    asm volatile("s_waitcnt lgkmcnt(0)" ::: "memory");
    {
        unsigned long long wor = 0ull;
        const int j = lane;
        const bool causal = j <= tq, forced = (j == 0) || (j == tq) || (j == tq - 1);
        const unsigned long long cmask = __ballot(causal);
        for (int i = 0; i < 8; ++i) {
            const float pv = pslc[(8 * w + i) * 64 + j];
            const unsigned key = causal ? (forced ? 0xFFFFFFFFu : __float_as_uint(pv) + 1u) : 0u;
            unsigned T = 0u;
#pragma unroll
            for (int bit = 31; bit >= 0; --bit) { const unsigned cand = T | (1u << bit); if (__popcll(__ballot(key >= cand)) >= 16) T = cand; }
            const unsigned long long gt = __ballot(key > T); unsigned long long eq = __ballot(key == T), take = 0ull;
            for (int need = 16 - __popcll(gt); need > 0 && eq != 0ull; --need) { const unsigned long long low = eq & (~eq + 1ull); take |= low; eq ^= low; }
            const unsigned long long mask = (gt | take) & cmask;
            if (lane == 0) selm[8 * w + i] = mask;
            wor |= mask;
        }
        if (lane == 0) selm[64 + w] = wor;
    }
    __syncthreads();
    unsigned long long uni = 0ull;
#pragma unroll
    for (int i = 0; i < 8; ++i) uni |= selm[64 + i];
    uni = ((unsigned long long)__builtin_amdgcn_readfirstlane((unsigned)(uni >> 32)) << 32) | (unsigned long long)__builtin_amdgcn_readfirstlane((unsigned)uni);
    {
#pragma unroll
        for (int dt = 0; dt < 8; ++dt) { o[dt][0] = (f32x4){0.f, 0.f, 0.f, 0.f}; o[dt][1] = (f32x4){0.f, 0.f, 0.f, 0.f}; }
        mx[0] = mx[1] = -1e20f; ls[0] = ls[1] = 0.f;
        const bf16* kg = PROJ + (size_t)(b * SEQ) * NP + C_KS + g * 128; const bf16* vg = PROJ + (size_t)(b * SEQ) * NP + C_VS + g * 128;
        unsigned long long rem = uni;
        int j = __builtin_ctzll(rem); rem &= rem - 1ull;
        ATT_TILE_PROLOGUE(kg + (size_t)j * 64 * NP, vg + (size_t)j * 64 * NP, NP);
        for (int it = 0;; ++it) {
            const int cur = it & 1; const bool has = rem != 0ull;
            const int jn = has ? __builtin_ctzll(rem) : 0; rem &= rem - 1ull;
            ATT_TILE_NEXT(has, kg + (size_t)jn * 64 * NP, vg + (size_t)jn * 64 * NP, NP);
            const bool b0 = (selm[ql[0]] >> j) & 1ull, b1 = (selm[ql[1]] >> j) & 1ull;
            if (__ballot(b0 || b1) != 0ull) {
                f32x4 s[2][4];
                qk_tile<false>(s, qf, lds + cur * 16384, c, q4);
                bf16x8 pf[2][2];
                osm_step(s[0], b0, j == tq, -64, ql[0] - 16 * q4, mx[0], ls[0], o, 0, pf[0]);
                osm_step(s[1], b1, j == tq, -64, ql[1] - 16 * q4, mx[1], ls[1], o, 1, pf[1]);
                pv_tile(o, pf, lds + 32768 + cur * 16384, c, q4);
            }
            ATT_TILE_END(has, cur);
            if (!has) break;
            j = jn;
        }
#pragma unroll
        for (int qt = 0; qt < 2; ++qt) {
            float l = ls[qt]; l += __shfl_xor(l, 16); l += __shfl_xor(l, 32);
            const float cb = gates[qt][1] / l;
#pragma unroll
            for (int dt = 0; dt < 8; ++dt) scr[lane * 32 + 16 + 2 * dt + qt] = o[dt][qt] * cb;
        }
    }
    {
#pragma unroll
        for (int dt = 0; dt < 8; ++dt) { o[dt][0] = (f32x4){0.f, 0.f, 0.f, 0.f}; o[dt][1] = (f32x4){0.f, 0.f, 0.f, 0.f}; }
        mx[0] = mx[1] = -1e20f; ls[0] = ls[1] = 0.f;
        const bf16* kg = PROJ + (size_t)(b * SEQ) * NP + C_KW + g * 128; const bf16* vg = PROJ + (size_t)(b * SEQ) * NP + C_VW + g * 128;
        const int k0 = max(0, tq - 8), nw = tq - k0 + 1;
        ATT_TILE_PROLOGUE(kg + (size_t)k0 * 64 * NP, vg + (size_t)k0 * 64 * NP, NP);
        for (int it = 0; it < nw; ++it) {
            const int cur = it & 1, kt64 = k0 + it; const bool has = it + 1 < nw;
            ATT_TILE_NEXT(has, kg + (size_t)(kt64 + 1) * 64 * NP, vg + (size_t)(kt64 + 1) * 64 * NP, NP);
            {
                f32x4 s[2][4];
                qk_tile<false>(s, qf, lds + cur * 16384, c, q4);
                bf16x8 pf[2][2];
                {
                    const int d0 = ql[0] - 16 * q4, d1 = ql[1] - 16 * q4;
                    const bool first = (kt64 == tq - 8), edge = first || (kt64 == tq);
                    osm_step(s[0], true, edge, first ? d0 + 1 : -64, first ? 64 : d0, mx[0], ls[0], o, 0, pf[0]);
                    osm_step(s[1], true, edge, first ? d1 + 1 : -64, first ? 64 : d1, mx[1], ls[1], o, 1, pf[1]);
                }
                pv_tile(o, pf, lds + 32768 + cur * 16384, c, q4);
            }
            ATT_TILE_END(has, cur);
        }
    }
    f32x4 gns[8];
#pragma unroll
    for (int dt = 0; dt < 8; ++dt) gns[dt] = *(const f32x4*)(P.nsa_on + hg * 128 + 4 * q4 + 16 * dt);
#pragma unroll
    for (int qt = 0; qt < 2; ++qt) {
        float l = ls[qt]; l += __shfl_xor(l, 16); l += __shfl_xor(l, 32);
        const float cb = gates[qt][2] / l;
        float ss = 0.f;
#pragma unroll
        for (int dt = 0; dt < 8; ++dt) { const f32x4 a = (scr[lane * 32 + 2 * dt + qt] + scr[lane * 32 + 16 + 2 * dt + qt]) + o[dt][qt] * cb; o[dt][qt] = a; ss += (a[0] * a[0] + a[1] * a[1]) + (a[2] * a[2] + a[3] * a[3]); if ((dt & 3) == 3) __builtin_amdgcn_sched_barrier(0); }
        ss += __shfl_xor(ss, 16); ss += __shfl_xor(ss, 32);
        const float r = rsqrtf(ss * (1.f / 128.f) + EPS);
        bf16* yrow = Y + (size_t)(b * SEQ + t0 + ql[qt]) * D + hg * 128 + 4 * q4;
#pragma unroll
        for (int dt = 0; dt < 8; ++dt) { const f32x4 v = o[dt][qt]; const f32x4 gg = gns[dt];
            v2u wv; wv.x = cvt_pk_bf16(v[0] * r * gg[0], v[1] * r * gg[1]); wv.y = cvt_pk_bf16(v[2] * r * gg[2], v[3] * r * gg[3]);
            *(v2u*)(yrow + 16 * dt) = wv; if (dt & 1) __builtin_amdgcn_sched_barrier(0); }
    }
    __syncthreads();
}
__device__ __forceinline__ void nsa_phase(const Params& P, LAS unsigned char* lds, const bf16* PROJ, const bf16* KC, const bf16* VC, bf16* Y, f32x4* scratch) {
    for (int i = blockIdx.x; i < 512; i += gridDim.x) {
        const int u = (i < 256) ? i : 767 - i;
        const int tq = 63 - (u >> 3), bg = u & 7;
        nsa_unit(P, lds, PROJ, KC, VC, Y, scratch + (size_t)blockIdx.x * 16384, bg >> 1, bg & 1, tq);
    }
}

__device__ __forceinline__ void compress_unit(const Params& P, LAS unsigned char* lds, const bf16* PROJ, const float* cs, const float* sn, bf16* KC, bf16* VC, int which, int bg, int n0) {
    int tid = threadIdx.x; asm volatile("" : "+v"(tid));
    const int lane = tid & 63, w = __builtin_amdgcn_readfirstlane(tid >> 6), c = lane & 15, q4 = lane >> 4;
    const int b = bg >> 1, g = bg & 1, col = (which ? C_VC : C_KC) + g * 128;
    constexpr int XS = 272;
    __syncthreads();
    for (int i = tid; i < 272 * 8; i += NTHREADS) {
        const int tk = i >> 3, ch = i & 7, s = 16 * n0 + tk;
        v4u lo = (v4u){0u, 0u, 0u, 0u}, hi = (v4u){0u, 0u, 0u, 0u};
        if (s < SEQ) {
            const int m = b * SEQ + s;
            lo = *(const v4u*)(PROJ + (size_t)m * NP + col + 8 * ch); hi = *(const v4u*)(PROJ + (size_t)m * NP + col + 64 + 8 * ch);
            if (!which) {
                const f32x4 c0 = *(const f32x4*)(cs + m * 64 + 8 * ch), c1 = *(const f32x4*)(cs + m * 64 + 8 * ch + 4), s0 = *(const f32x4*)(sn + m * 64 + 8 * ch), s1 = *(const f32x4*)(sn + m * 64 + 8 * ch + 4);
                float a[8], d[8];
                a[0] = bflo(lo.x); a[1] = bfhi(lo.x); a[2] = bflo(lo.y); a[3] = bfhi(lo.y); a[4] = bflo(lo.z); a[5] = bfhi(lo.z); a[6] = bflo(lo.w); a[7] = bfhi(lo.w);
                d[0] = bflo(hi.x); d[1] = bfhi(hi.x); d[2] = bflo(hi.y); d[3] = bfhi(hi.y); d[4] = bflo(hi.z); d[5] = bfhi(hi.z); d[6] = bflo(hi.w); d[7] = bfhi(hi.w);
                float ra[8], rd[8];
#pragma unroll
                for (int e = 0; e < 8; ++e) { const float cc = e < 4 ? c0[e] : c1[e - 4], ss = e < 4 ? s0[e] : s1[e - 4]; ra[e] = a[e] * cc - d[e] * ss; rd[e] = d[e] * cc + a[e] * ss; }
                lo.x = cvt_pk_bf16(ra[0], ra[1]); lo.y = cvt_pk_bf16(ra[2], ra[3]); lo.z = cvt_pk_bf16(ra[4], ra[5]); lo.w = cvt_pk_bf16(ra[6], ra[7]);
                hi.x = cvt_pk_bf16(rd[0], rd[1]); hi.y = cvt_pk_bf16(rd[2], rd[3]); hi.z = cvt_pk_bf16(rd[4], rd[5]); hi.w = cvt_pk_bf16(rd[6], rd[7]);
            }
        }
        *(LAS v4u*)(lds + tk * XS + 16 * ch) = lo; *(LAS v4u*)(lds + tk * XS + 128 + 16 * ch) = hi;
    }
    __syncthreads();
    const bf16* w1t = (const bf16*)(P.ws + (which ? WS_WC1V : WS_WC1K)) + (size_t)(32 * w + c) * 4096 + 8 * q4;
    f32x4 h0 = (f32x4){0.f, 0.f, 0.f, 0.f}, h1 = (f32x4){0.f, 0.f, 0.f, 0.f};
    const LAS unsigned char* xb = lds + (16 * c) * XS + 16 * q4;
#pragma unroll 16
    for (int ks = 0; ks < 128; ++ks) {
        const bf16x8 xf = *(const LAS bf16x8*)(xb + (ks >> 2) * XS + (ks & 3) * 64);
        const bf16x8 a0 = *(const bf16x8*)(w1t + 32 * ks), a1 = *(const bf16x8*)(w1t + 16 * 4096 + 32 * ks);
        h0 = __builtin_amdgcn_mfma_f32_16x16x32_bf16(a0, xf, h0, 0, 0, 0);
        h1 = __builtin_amdgcn_mfma_f32_16x16x32_bf16(a1, xf, h1, 0, 0, 0);
    }
    const float* pb = (const float*)(P.ws + WS_PBIAS + 65536) + which * 256 + 32 * w + 4 * q4;
    const f32x4 pb0 = *(const f32x4*)pb, pb1 = *(const f32x4*)(pb + 16);
    const bf16x8 hf = pack8(gelu_tanh(h0[0] + pb0[0]), gelu_tanh(h0[1] + pb0[1]), gelu_tanh(h0[2] + pb0[2]), gelu_tanh(h0[3] + pb0[3]),
                            gelu_tanh(h1[0] + pb1[0]), gelu_tanh(h1[1] + pb1[1]), gelu_tanh(h1[2] + pb1[2]), gelu_tanh(h1[3] + pb1[3]));
    const bf16* w2t = (const bf16*)(P.ws + (which ? WS_WC2V : WS_WC2K)) + (size_t)c * 256 + 32 * w + 4 * q4;
    __syncthreads();
    LAS float* part = (LAS float*)lds;
#pragma unroll
    for (int dt = 0; dt < 8; ++dt) {
        const v2u wa = *(const v2u*)(w2t + (size_t)(16 * dt) * 256), wb = *(const v2u*)(w2t + (size_t)(16 * dt) * 256 + 16);
        v4u wv; wv.x = wa.x; wv.y = wa.y; wv.z = wb.x; wv.w = wb.y;
        const f32x4 oa = __builtin_amdgcn_mfma_f32_16x16x32_bf16(__builtin_bit_cast(bf16x8, wv), hf, (f32x4){0.f, 0.f, 0.f, 0.f}, 0, 0, 0);
        *(LAS f32x4*)(part + (w * 16 + c) * 128 + 16 * dt + 4 * q4) = oa;
    }
    __syncthreads();
#pragma unroll
    for (int r = 0; r < 2; ++r) {
        const int n = 2 * w + r;
        float a = 0.f, d = 0.f;
#pragma unroll
        for (int ww = 0; ww < 8; ++ww) { a += part[(ww * 16 + n) * 128 + lane]; d += part[(ww * 16 + n) * 128 + 64 + lane]; }
        if (!which) { const float rr = rsqrtf(wave_sum(a * a + d * d) * (1.f / 128.f) + EPS); a = a * rr * P.kc_norm[lane]; d = d * rr * P.kc_norm[lane + 64]; }
        bf16* op = (which ? VC : KC) + ((size_t)bg * 256 + n0 + n) * 128;
        if (n0 + n < NCMP) { op[lane] = (bf16)f2bf(a); op[lane + 64] = (bf16)f2bf(d); } else { op[lane] = 0; op[lane + 64] = 0; }
    }
}
__device__ __forceinline__ void compress_phase(const Params& P, LAS unsigned char* lds, const bf16* PROJ, const float* cs, const float* sn, bf16* KC, bf16* VC) {
    for (int u = blockIdx.x; u < 256; u += gridDim.x) compress_unit(P, lds, PROJ, cs, sn, KC, VC, u >> 7, (u >> 4) & 7, (u & 15) * 16);
    __syncthreads();
}
template <int MODE = 31>
__device__ __forceinline__ void sb_phase(const Params& P, LAS unsigned char* lds, const bf16* PROJ, const bf16* KVC, bf16* Y) {
    for (int i = blockIdx.x; i < 512; i += gridDim.x) {
        const int u = (i < 256) ? i : 767 - i;
        const int tqq = 15 - (u >> 5), bh = u & 31;
        sb_unit<MODE>(P, lds, PROJ, KVC, Y, bh >> 3, bh & 7, tqq);
    }
}
}

__device__ __forceinline__ int row_gate(int n) { return (n >> 7) * 256 + (n & 127); }
__device__ __forceinline__ int row_up(int n) { return (n >> 7) * 256 + 128 + (n & 127); }
__device__ __forceinline__ int row_id(int n) { return n; }
__device__ __forceinline__ int row_win(int oc) { return oc < 2560 ? oc : (oc < 2584 ? oc - 2560 + C_GATE : oc - 24); }
template <int F8 = 0, bool CMROW = false, class RowFn>
__device__ __forceinline__ void transpose_item(const float* W, int K, int N, bf16* WT, RowFn rowfn, LAS float* scr, int item, int lane, const float* kscale = nullptr, const unsigned* cmax = nullptr) {
    const int nblk = (N + 63) / 64, kb = item / nblk, nb = item % nblk, k0 = 64 * kb, n0 = 64 * nb;
    const int nn = n0 + 4 * (lane & 15), kr = lane >> 4;
    f32x4 v[16];
#pragma unroll
    for (int i = 0; i < 16; ++i) v[i] = nn < N ? __builtin_nontemporal_load((const f32x4*)(W + (size_t)(k0 + 4 * i + kr) * N + nn)) : (f32x4){0.f, 0.f, 0.f, 0.f};
#pragma unroll
    for (int i = 0; i < 16; ++i) { if (kscale) v[i] = v[i] * kscale[k0 + 4 * i + kr];
        if (F8 == 1) v[i] = v[i] * pg8::F8_WSCALE;
        LAS float* d = scr + (4 * i + kr) * 65 + 4 * (lane & 15); d[0] = v[i][0]; d[1] = v[i][1]; d[2] = v[i][2]; d[3] = v[i][3]; }
    asm volatile("s_waitcnt lgkmcnt(0)" ::: "memory");
    const int c = lane & 7;
#pragma unroll
    for (int jj = 0; jj < 8; ++jj) { const int n = (lane >> 3) + 8 * jj; const LAS float* s = scr + (8 * c) * 65 + n;
        if constexpr (F8 == 1) { v2u o; o.x = pg8::pk4_fp8(s[0 * 65], s[1 * 65], s[2 * 65], s[3 * 65]); o.y = pg8::pk4_fp8(s[4 * 65], s[5 * 65], s[6 * 65], s[7 * 65]);
            if (n0 + n < N) *(v2u*)((unsigned char*)WT + (size_t)rowfn(n0 + n) * K + k0 + 8 * c) = o; }
        else if constexpr (F8 == 2) { const float cm = n0 + n < N ? __builtin_bit_cast(float, cmax[CMROW ? rowfn(n0 + n) : n0 + n]) : 0.f, q = cm > 0.f ? 127.0f / cm : 0.f;
            v2u o; o.x = pg8::pk4_i8(s[0 * 65], s[1 * 65], s[2 * 65], s[3 * 65], q); o.y = pg8::pk4_i8(s[4 * 65], s[5 * 65], s[6 * 65], s[7 * 65], q);
            if (n0 + n < N) *(v2u*)((unsigned char*)WT + (size_t)rowfn(n0 + n) * K + k0 + 8 * c) = o; }
        else {
        v4u o; o.x = pk2(s[0 * 65], s[1 * 65]); o.y = pk2(s[2 * 65], s[3 * 65]); o.z = pk2(s[4 * 65], s[5 * 65]); o.w = pk2(s[6 * 65], s[7 * 65]);
        if (n0 + n < N) *(v4u*)(WT + (size_t)rowfn(n0 + n) * K + k0 + 8 * c) = o; } }
    asm volatile("s_waitcnt lgkmcnt(0)" ::: "memory");
}
template <class RowFn>
__device__ __forceinline__ void colmax_item(const float* W, int N, const float* kscale, unsigned* cmax, RowFn rowfn, int kb, int strip, int lane) {
    const int n = strip * 256 + 4 * lane, k0 = 64 * kb;
    if (n >= N) return;
    float m0 = 0.f, m1 = 0.f, m2 = 0.f, m3 = 0.f;
#pragma unroll 1
    for (int i0 = 0; i0 < 64; i0 += 16) {
        f32x4 v[16];
#pragma unroll
        for (int i = 0; i < 16; ++i) v[i] = *(const f32x4*)(W + (size_t)(k0 + i0 + i) * N + n);
#pragma unroll
        for (int i = 0; i < 16; ++i) { const float ks = kscale ? kscale[k0 + i0 + i] : 1.0f;
            m0 = fmaxf(m0, fabsf(v[i][0] * ks)); m1 = fmaxf(m1, fabsf(v[i][1] * ks)); m2 = fmaxf(m2, fabsf(v[i][2] * ks)); m3 = fmaxf(m3, fabsf(v[i][3] * ks)); }
    }
    atomicMax(cmax + rowfn(n), __float_as_uint(m0)); atomicMax(cmax + rowfn(n + 1), __float_as_uint(m1)); atomicMax(cmax + rowfn(n + 2), __float_as_uint(m2)); atomicMax(cmax + rowfn(n + 3), __float_as_uint(m3));
}
__device__ __forceinline__ void colmax_phase(const Params& P) {
    int tid = threadIdx.x; asm volatile("" : "+v"(tid));
    const int lane = tid & 63, gw = blockIdx.x * NWAVES + (tid >> 6), NGW = gridDim.x * NWAVES;
    unsigned* cm = (unsigned*)(P.ws + WS_CMAX);
    constexpr int S_GU = FF / 256, I_GU = (D / 64) * S_GU;
    constexpr int S_IN = (IN_COLS + 255) / 256, I_IN = WIN_I8 ? (D / 64) * S_IN : 0;
    constexpr int I_G2 = FFN2_I8 ? 2 * I_GU : 0;
    for (int it = gw; it < 2 * I_GU + I_IN + I_G2; it += NGW) {
        if (it < 2 * I_GU) { const int mat = it / I_GU, r = it % I_GU;
            colmax_item(mat ? P.ffn1_wu : P.ffn1_wg, FF, FOLD_GAINS ? P.ffn1_norm : nullptr, cm + mat * FF, row_id, r / S_GU, r % S_GU, lane); }
        else if (it >= 2 * I_GU + I_IN) { const int q = it - 2 * I_GU - I_IN, mat = q / I_GU, r = q % I_GU;
            colmax_item(mat ? P.ffn2_wu : P.ffn2_wg, FF, FOLD_GAINS ? P.ffn2_norm : nullptr, cm + 2 * FF + NP + mat * FF, row_id, r / S_GU, r % S_GU, lane); }
        else { const int r = it - 2 * I_GU;
            colmax_item(P.w_in, IN_COLS, FOLD_GAINS ? P.mix_norm : nullptr, cm + 2 * FF, row_win, r / S_IN, r % S_IN, lane); }
    }
}
constexpr int CW_I_GU = (D / 64) * (FF / 64), CW_I_IN = (D / 64) * ((IN_COLS + 63) / 64), CW_I_OUT = (D / 64) * (D / 64), CW_I_C1 = (4096 / 64) * (256 / 64), CW_I_C2 = (256 / 64) * (128 / 64);
constexpr int CW_EARLY = 3 * CW_I_GU + CW_I_IN + CW_I_OUT + 2 * CW_I_C1 + 2 * CW_I_C2, CW_ITEMS = CW_EARLY + 3 * CW_I_GU;
__device__ __forceinline__ void convert_items(const Params& P, LAS unsigned char* lds, int lo, int hi, int gw, int NGW) {
    unsigned char* ws = P.ws;
    int tid = threadIdx.x; asm volatile("" : "+v"(tid));
    const int lane = tid & 63, wave = tid >> 6;
    LAS float* scr = (LAS float*)(lds + wave * 16640);
    constexpr int I_GU = CW_I_GU, I_DN = CW_I_GU, I_IN = CW_I_IN, I_OUT = CW_I_OUT, I_C1 = CW_I_C1, I_C2 = CW_I_C2;
    for (int it = lo + gw; it < hi; it += NGW) {
        int r = it;
        if (r < I_GU) { transpose_item<FFN1_I8 ? 2 : (FFN1_FP8 != 0)>(P.ffn1_wg, D, FF, (bf16*)(ws + WS_W1GU), row_gate, scr, r, lane, FOLD_GAINS ? P.ffn1_norm : nullptr, (const unsigned*)(ws + WS_CMAX)); continue; } r -= I_GU;
        if (r < I_GU) { transpose_item<FFN1_I8 ? 2 : (FFN1_FP8 != 0)>(P.ffn1_wu, D, FF, (bf16*)(ws + WS_W1GU), row_up, scr, r, lane, FOLD_GAINS ? P.ffn1_norm : nullptr, (const unsigned*)(ws + WS_CMAX) + FF); continue; } r -= I_GU;
        if (r < I_DN) { transpose_item<(FFN1_FP8 == 2) ? 1 : 0>(P.ffn1_wd, FF, D, (bf16*)(ws + WS_W1D), row_id, scr, r, lane); continue; } r -= I_DN;
        if (r < I_IN) { transpose_item<WIN_I8 ? 2 : 0, true>(P.w_in, D, IN_COLS, (bf16*)(ws + WS_WIN), row_win, scr, r, lane, FOLD_GAINS ? P.mix_norm : nullptr, (const unsigned*)(ws + WS_CMAX) + 2 * FF); continue; } r -= I_IN;
        if (r < I_OUT) { transpose_item(P.w_out, D, D, (bf16*)(ws + WS_WOUT), row_id, scr, r, lane); continue; } r -= I_OUT;
        if (r < I_C1) { transpose_item(P.ck_w1, 4096, 256, (bf16*)(ws + WS_WC1K), row_id, scr, r, lane); continue; } r -= I_C1;
        if (r < I_C1) { transpose_item(P.cv_w1, 4096, 256, (bf16*)(ws + WS_WC1V), row_id, scr, r, lane); continue; } r -= I_C1;
        if (r < I_C2) { transpose_item(P.ck_w2, 256, 128, (bf16*)(ws + WS_WC2K), row_id, scr, r, lane); continue; } r -= I_C2;
        if (r < I_C2) { transpose_item(P.cv_w2, 256, 128, (bf16*)(ws + WS_WC2V), row_id, scr, r, lane); continue; } r -= I_C2;
        if (r < I_GU) { transpose_item<FFN2_I8 ? 2 : ((FFN2_FP8 != 0) ? 1 : 0)>(P.ffn2_wg, D, FF, (bf16*)(ws + WS_W2GU), row_gate, scr, r, lane, FOLD_GAINS ? P.ffn2_norm : nullptr, (const unsigned*)(ws + WS_CMAX) + 2 * FF + NP); continue; } r -= I_GU;
        if (r < I_GU) { transpose_item<FFN2_I8 ? 2 : ((FFN2_FP8 != 0) ? 1 : 0)>(P.ffn2_wu, D, FF, (bf16*)(ws + WS_W2GU), row_up, scr, r, lane, FOLD_GAINS ? P.ffn2_norm : nullptr, (const unsigned*)(ws + WS_CMAX) + 3 * FF + NP); continue; } r -= I_GU;
        transpose_item<(FFN2_FP8 != 0) ? 1 : 0>(P.ffn2_wd, FF, D, (bf16*)(ws + WS_W2D), row_id, scr, r, lane);
    }
}
__device__ __forceinline__ void convert_weights(const Params& P, LAS unsigned char* lds) {
    unsigned char* ws = P.ws;
    convert_items(P, lds, 0, TAIL_CONVERT ? CW_EARLY : CW_ITEMS, blockIdx.x * NWAVES + (threadIdx.x >> 6), gridDim.x * NWAVES);
    if (blockIdx.x < 32) {
        const int which = blockIdx.x >> 4, part = (blockIdx.x & 15) * 2 + (threadIdx.x >> 8), j = threadIdx.x & 255;
        const float* pos = which ? P.cv_pos : P.ck_pos; const float* w1 = which ? P.cv_w1 : P.ck_w1;
        float a = 0.f;
#pragma unroll 32
        for (int k = 128 * part; k < 128 * part + 128; ++k) a += pos[k] * w1[(size_t)k * 256 + j];
        ((float*)(ws + WS_PBIAS))[(which * 32 + part) * 256 + j] = a;
    }
    { v4u* z = (v4u*)(ws + WS_WIN + (size_t)IN_COLS * D * (WIN_I8 ? 1 : 2)); const int n16 = (NP - IN_COLS) * D / (WIN_I8 ? 16 : 8);
      for (int i = blockIdx.x * NTHREADS + threadIdx.x; i < n16; i += gridDim.x * NTHREADS) z[i] = (v4u){0u, 0u, 0u, 0u}; }
}

__global__ void __launch_bounds__(NTHREADS, 2) fwd_kernel(Params P) {
    extern __shared__ __attribute__((aligned(16))) unsigned char lds_raw[];
    LAS unsigned char* lds = (LAS unsigned char*)lds_raw;
    const int tid = threadIdx.x;
    for (int u = tid; u < (LDS_BYTES - LDSCTL_OFF) / 4; u += NTHREADS) ((LAS unsigned*)(lds + LDSCTL_OFF))[u] = 0u;
    __syncthreads();
    unsigned char* ws = P.ws;
    XcdBarrier bar = xcd_barrier_post((unsigned*)(ws + WS_CTL) + CW_BAR, (volatile LAS unsigned*)(lds + LDSCTL_OFF + 64));
    bf16* HB = (bf16*)(ws + WS_HB); bf16* BIG = (bf16*)(ws + WS_BIG);
    float* cs = (float*)(ws + WS_COS); float* sn = (float*)(ws + WS_SIN);
    bf16* KC = (bf16*)(ws + WS_KC); bf16* VC = (bf16*)(ws + WS_VC);
    float* XR = P.out;
    bf16* X1B = (bf16*)P.out;
    bf16* X2B = (bf16*)(ws + WS_W1GU);
    unsigned char* X0F8 = ws + WS_SCR + ((size_t)32 << 20);
    unsigned char* X2F8 = ws + WS_SCR;
    float* PART = (float*)(ws + WS_PART);
    float* PART2 = (float*)(ws + WS_PART + (size_t)M * 8);
    float* PART0 = (float*)(ws + WS_PART + (size_t)M * 16);
    float* XS2 = (float*)(ws + WS_PART + (size_t)M * 32); unsigned* RMAX2 = (unsigned*)(ws + WS_RMAX) + M;
    float* XS1 = (float*)(ws + WS_PART + (size_t)M * 28);
    unsigned* RMAX1 = (unsigned*)(ws + WS_RMAX); unsigned char* X1I8 = ws + WS_SCR;
    float* XS0 = (float*)(ws + WS_PART + (size_t)M * 24);
    PG8_LAS float* RS = (PG8_LAS float*)(lds + 131072);

#define REP(n) _Pragma("unroll") for (int rep_ = 0; rep_ < (n); ++rep_)
#if FOLD_GAINS
#if FFN1_I8
    rope_tables(P.pos, cs, sn); cast_rows<true>(P.x, HB, (unsigned long long*)PART0, X0F8, XS0); colmax_phase(P);
    xcd_barrier(bar);
    convert_weights(P, lds);
#else
    REP(REP_P0) { rope_tables(P.pos, cs, sn); cast_rows(P.x, HB, (unsigned long long*)PART0, FFN1_FP8 ? X0F8 : nullptr); convert_weights(P, lds); }
#endif
#else
    REP(REP_P0) { rope_tables(P.pos, cs, sn); rmsnorm_rows(P.x, P.ffn1_norm, HB); convert_weights(P, lds); }
#endif
#if FUSE_NORMS || FOLD_GAINS
    for (int i = blockIdx.x * NTHREADS + tid; i < 2 * M; i += gridDim.x * NTHREADS) ((unsigned long long*)PART)[i] = 0ull;
#endif
    xcd_barrier(bar);
#if PROBE_P1K
    for (int pass = 0; pass < 2; ++pass) {
        pg8::Gemm g{HB, (const bf16*)(ws + WS_W1GU), M, 2 * FF, D, pass == 0 ? (PROBE_P1K >= 4 ? PROBE_P1K - 4 : PROBE_P1K - 1) : 0}; pg8::StaticOrder S; S.init(M, 2 * FF, gridDim.x, (int)blockIdx.x); S.zero = (pass == 0 && PROBE_P1K >= 4);
        if (FOLD_GAINS) pg8::row_factor_table(RS, PART0, S);
        pg8::EpiSwiglu E{BIG, FF, FOLD_GAINS ? PART0 : nullptr, RS};
        pg8::gemm_phase<pg8::EpiSwiglu, pg8::StaticOrder, true, true>(lds, g, S, E);
        if (pass == 0) xcd_barrier(bar);
    }
#else
    REP(REP_P1) {
#if FFN1_FP8
        pg8::Gemm g{(const bf16*)X0F8, (const bf16*)(ws + WS_W1GU), M, 2 * FF, D / 2}; pg8::StaticOrder S; S.init(M, 2 * FF, gridDim.x, (int)blockIdx.x);
#if FFN1_I8
        pg8::row_factor_table(RS, PART0, S, XS0);
        pg8::EpiSwigluT<true, FFN1_FP8 == 2, true> E{BIG, FF, PART0, RS, (const float*)(ws + WS_CMAX)};
        pg8::gemm_phase<pg8::EpiSwigluT<true, FFN1_FP8 == 2, true>, pg8::StaticOrder, true, true, false, true>(lds, g, S, E);
#else
        pg8::row_factor_table(RS, PART0, S);
        pg8::EpiSwigluT<true, FFN1_FP8 == 2> E{BIG, FF, PART0, RS};
        pg8::gemm_phase<pg8::EpiSwigluT<true, FFN1_FP8 == 2>, pg8::StaticOrder, true, true, true>(lds, g, S, E);
#endif
#else
        pg8::Gemm g{HB, (const bf16*)(ws + WS_W1GU), M, 2 * FF, D}; pg8::StaticOrder S; S.init(M, 2 * FF, gridDim.x, (int)blockIdx.x);
        if (FOLD_GAINS) pg8::row_factor_table(RS, PART0, S);
        pg8::EpiSwiglu E{BIG, FF, FOLD_GAINS ? PART0 : nullptr, RS};
        pg8::gemm_phase<pg8::EpiSwiglu, pg8::StaticOrder, true, true>(lds, g, S, E);
#endif
    }
#endif
    xcd_barrier(bar);
    REP(REP_P2) {
        pg8::Gemm g{BIG, (const bf16*)(ws + WS_W1D), M, D, FFN1_FP8 == 2 ? FF / 2 : FF}; pg8::StaticOrder S; S.init(M, D, gridDim.x, (int)blockIdx.x);
#if FUSE_NORMS
        pg8::EpiResid E{P.x, XR, D, 0.5f, HB, P.mix_norm, PART};
#else
        pg8::EpiResidMix<FOLD_GAINS != 0, true> E{FOLD_GAINS ? (const void*)HB : (const void*)P.x, X1B, D, FFN1_FP8 == 2 ? 0.5f / (pg8::F8_WSCALE * pg8::F8_HSCALE) : 0.5f, FOLD_GAINS ? (unsigned long long*)PART : nullptr, nullptr, WIN_I8 ? RMAX1 : nullptr};
#endif
        pg8::gemm_phase<pg8::EpiResidMix<FOLD_GAINS != 0, true>, pg8::StaticOrder, true, true, FFN1_FP8 == 2>(lds, g, S, E);
    }
    xcd_barrier(bar);
    if (blockIdx.x == gridDim.x - 1) { const float* pp = (const float*)(ws + WS_PBIAS); const int which = tid >> 8, j = tid & 255; float t[32];
#pragma unroll
        for (int part = 0; part < 32; ++part) t[part] = pp[(which * 32 + part) * 256 + j];
        float a = 0.f;
#pragma unroll
        for (int part = 0; part < 32; ++part) a += t[part];
        ((float*)(ws + WS_PBIAS + 65536))[tid] = a; }
#if !FUSE_NORMS && !FOLD_GAINS
    rmsnorm_rows_bf16(X1B, P.mix_norm, HB);
    xcd_barrier(bar);
#endif
#if WIN_I8
    quant_rows_i8(X1B, RMAX1, X1I8, XS1);
    xcd_barrier(bar);
#endif
    REP(REP_P4) {
#if WIN_I8
        pg8::Gemm g{(const bf16*)X1I8, (const bf16*)(ws + WS_WIN), M, NP, D / 2}; pg8::StaticOrder S; S.init(M, NP, gridDim.x, (int)blockIdx.x);
        pg8::row_factor_table(RS, PART, S, XS1);
        pg8::EpiStoreBf16T<true> E{BIG, NP, C_QS / 256, (C_QS + 1024) / 256, att::C1, PART, RS, (bf16*)(ws + WS_W1GU), 0, 0, (const float*)(ws + WS_CMAX) + 2 * FF};
        pg8::gemm_phase<pg8::EpiStoreBf16T<true>, pg8::StaticOrder, true, true, false, true>(lds, g, S, E);
#else
        pg8::Gemm g{FOLD_GAINS ? (const bf16*)X1B : (const bf16*)HB, (const bf16*)(ws + WS_WIN), M, NP, D}; pg8::StaticOrder S; S.init(M, NP, gridDim.x, (int)blockIdx.x);
        if (FUSE_NORMS || FOLD_GAINS) pg8::row_factor_table(RS, PART, S);
        pg8::EpiStoreBf16 E{BIG, NP, C_QS / 256, (C_QS + 1024) / 256, att::C1, (FUSE_NORMS || FOLD_GAINS) ? PART : nullptr, RS, (bf16*)(ws + WS_W1GU), SB_COMPACT ? C_KSB / 256 : 0, SB_COMPACT ? (C_VSB + 1024) / 256 : 0};
        pg8::gemm_phase<pg8::EpiStoreBf16, pg8::StaticOrder, true, true>(lds, g, S, E);
#endif
#if TAIL_CONVERT
        {
            const int G = (int)gridDim.x, rem = S.nwg % G;
            if (rem == 0) convert_items(P, lds, CW_EARLY, CW_ITEMS, (int)blockIdx.x * NWAVES + (tid >> 6), G * NWAVES);
            else if ((int)blockIdx.x >= rem) convert_items(P, lds, CW_EARLY, CW_ITEMS, ((int)blockIdx.x - rem) * NWAVES + (tid >> 6), (G - rem) * NWAVES);
        }
#endif
    }
    xcd_barrier(bar);
    postproj_naive(P, BIG, cs, sn);
    REP(REP_CMP) att::compress_phase(P, lds, BIG, cs, sn, KC, VC);
    xcd_barrier(bar);
    REP(REP_NSA) att::nsa_phase(P, lds, BIG, KC, VC, HB, (f32x4*)(ws + WS_SCR));
    REP(REP_SB) att::sb_phase(P, lds, BIG, (const bf16*)(ws + WS_W1GU), HB);
    xcd_barrier(bar);
    {
        pg8::Gemm g{HB, (const bf16*)(ws + WS_WOUT), M, D, D}; pg8::StaticOrder S; S.init(M, D, gridDim.x, (int)blockIdx.x);
#if FUSE_NORMS
        pg8::EpiResid E{XR, XR, D, 1.0f, (bf16*)(ws + WS_W1GU), P.ffn2_norm, PART2};
#else
        pg8::EpiResidMix<true, true> E{X1B, X2B, D, 1.0f, FOLD_GAINS ? (unsigned long long*)PART2 : nullptr, (FFN2_FP8 && !FFN2_I8) ? X2F8 : nullptr, FFN2_I8 ? RMAX2 : nullptr};
#endif
        pg8::gemm_phase<pg8::EpiResidMix<true, true>, pg8::StaticOrder, true, true>(lds, g, S, E);
    }
    xcd_barrier(bar);
#if !FUSE_NORMS && !FOLD_GAINS
    rmsnorm_rows_bf16(X2B, P.ffn2_norm, HB);
    xcd_barrier(bar);
#endif
#if FFN2_I8
    quant_rows_i8(X2B, RMAX2, X2F8, XS2);
    xcd_barrier(bar);
#endif
    REP(REP_P9) {
#if FFN2_I8
        pg8::Gemm g{(const bf16*)X2F8, (const bf16*)(ws + WS_W2GU), M, 2 * FF, D / 2}; pg8::StaticOrder S; S.init(M, 2 * FF, gridDim.x, (int)blockIdx.x);
        pg8::row_factor_table(RS, PART2, S, XS2);
        pg8::EpiSwigluT<true, true, true> E{BIG, FF, PART2, RS, (const float*)(ws + WS_CMAX) + 2 * FF + NP};
        pg8::gemm_phase<pg8::EpiSwigluT<true, true, true>, pg8::StaticOrder, true, true, false, true>(lds, g, S, E);
#elif FFN2_FP8
        pg8::Gemm g{(const bf16*)X2F8, (const bf16*)(ws + WS_W2GU), M, 2 * FF, D / 2}; pg8::StaticOrder S; S.init(M, 2 * FF, gridDim.x, (int)blockIdx.x);
        pg8::row_factor_table(RS, PART2, S);
        pg8::EpiSwigluT<true> E{BIG, FF, PART2, RS};
        pg8::gemm_phase<pg8::EpiSwigluT<true>, pg8::StaticOrder, true, true, true>(lds, g, S, E);
#else
        pg8::Gemm g{(FUSE_NORMS || FOLD_GAINS) ? (const bf16*)(ws + WS_W1GU) : (const bf16*)HB, (const bf16*)(ws + WS_W2GU), M, 2 * FF, D}; pg8::StaticOrder S; S.init(M, 2 * FF, gridDim.x, (int)blockIdx.x);
        if (FUSE_NORMS || FOLD_GAINS) pg8::row_factor_table(RS, PART2, S);
        pg8::EpiSwiglu E{BIG, FF, (FUSE_NORMS || FOLD_GAINS) ? PART2 : nullptr, RS};
        pg8::gemm_phase<pg8::EpiSwiglu, pg8::StaticOrder, true, true>(lds, g, S, E);
#endif
    }
    xcd_barrier(bar);
    REP(REP_P10) {
#if FFN2_FP8
        pg8::Gemm g{BIG, (const bf16*)(ws + WS_W2D), M, D, FF / 2}; pg8::StaticOrder S; S.init(M, D, gridDim.x, (int)blockIdx.x);
        pg8::EpiResidMix<true, false> E{X2B, XR, D, 0.5f / (pg8::F8_WSCALE * pg8::F8_HSCALE), nullptr};
        pg8::gemm_phase<pg8::EpiResidMix<true, false>, pg8::StaticOrder, true, true, true>(lds, g, S, E);
#else
        pg8::Gemm g{BIG, (const bf16*)(ws + WS_W2D), M, D, FF}; pg8::StaticOrder S; S.init(M, D, gridDim.x, (int)blockIdx.x);
        pg8::EpiResidMix<true, false> E{X2B, XR, D, 0.5f, nullptr};
        pg8::gemm_phase<pg8::EpiResidMix<true, false>, pg8::StaticOrder, true, true>(lds, g, S, E);
#endif
    }
#if PROBE_PP
    xcd_barrier(bar);
    postproj_naive(P, BIG, cs, sn);
#endif
#if PROBE_SB_MODE
    __syncthreads();
    att::sb_phase<PROBE_SB_MODE>(P, lds, BIG, (const bf16*)(ws + WS_SB_DUMMY_KV), (bf16*)(ws + WS_HB));
#endif
}

extern "C" void kernel_launch(void* const* d_in, const int* in_sizes, int n_in, void* d_out, int out_size, void* d_ws, size_t ws_size, hipStream_t stream) {
    static int grid = 0;
    if (grid == 0) {
        if (n_in != 25 || out_size != M * D || ws_size < WS_END) { fprintf(stderr, "kernel_launch: unexpected shapes: n_in %d out %d ws %zu\n", n_in, out_size, ws_size); grid = -1; return; }
        int dev = 0, cus = 0, per_cu = 0;
        hipGetDevice(&dev); hipDeviceGetAttribute(&cus, hipDeviceAttributeMultiprocessorCount, dev);
        if (hipFuncSetAttribute((const void*)fwd_kernel, hipFuncAttributeMaxDynamicSharedMemorySize, LDS_BYTES) != hipSuccess) { fprintf(stderr, "kernel_launch: hipFuncSetAttribute failed\n"); grid = -1; return; }
        hipOccupancyMaxActiveBlocksPerMultiprocessor(&per_cu, (const void*)fwd_kernel, NTHREADS, LDS_BYTES);
        (void)hipGetLastError();
        if (per_cu < 1) fprintf(stderr, "kernel_launch: occupancy query says %d\n", per_cu);
        grid = cus;
    }
    if (grid < 0) return;
    hipMemsetAsync((char*)d_ws + WS_CTL, 0, CTL_ZERO_BYTES, stream);
    Params p{};
    p.x = (const float*)d_in[0]; p.pos = (const int*)d_in[1];
    p.ffn1_norm = (const float*)d_in[2]; p.ffn1_wg = (const float*)d_in[3]; p.ffn1_wu = (const float*)d_in[4]; p.ffn1_wd = (const float*)d_in[5];
    p.mix_norm = (const float*)d_in[6]; p.w_in = (const float*)d_in[7]; p.q_norm = (const float*)d_in[8]; p.kc_norm = (const float*)d_in[9];
    p.ks_norm = (const float*)d_in[10]; p.kw_norm = (const float*)d_in[11]; p.ck_pos = (const float*)d_in[12]; p.ck_w1 = (const float*)d_in[13];
    p.ck_w2 = (const float*)d_in[14]; p.cv_pos = (const float*)d_in[15]; p.cv_w1 = (const float*)d_in[16]; p.cv_w2 = (const float*)d_in[17];
    p.nsa_on = (const float*)d_in[18]; p.sb_on = (const float*)d_in[19]; p.w_out = (const float*)d_in[20]; p.ffn2_norm = (const float*)d_in[21];
    p.ffn2_wg = (const float*)d_in[22]; p.ffn2_wu = (const float*)d_in[23]; p.ffn2_wd = (const float*)d_in[24];
    p.out = (float*)d_out; p.ws = (unsigned char*)d_ws;
    hipLaunchKernelGGL(fwd_kernel, dim3(grid), dim3(NTHREADS), LDS_BYTES, stream, p);
}
```

```cpp
#include <hip/hip_runtime.h>
#include <cstdio>
#include <cstdint>

#define SB_COMPACT 0
#define FOLD_GAINS 1
#define FUSE_NORMS 0
#define NSA_OPAQUE 1
#define REP_P0 1
#define REP_P1 1
#define REP_P2 1
#define REP_P4 1
#define REP_P9 1
#define REP_P10 1
#define REP_CMP 1
#define REP_NSA 1
#define REP_SB 1
#define PROBE_SB_MODE 0
#define TAIL_CONVERT 1
#define FFN2_FP8 1
#define FFN1_FP8 2
#define FFN1_I8 1
#define WIN_I8 1
#define FFN2_I8 1
#define WOUT_I8 1
#define PROBE_P1K 0
#define PROBE_PP 0

#define GAS __attribute__((address_space(1)))
#define LAS __attribute__((address_space(3)))
typedef unsigned short bf16;
typedef unsigned v4u __attribute__((ext_vector_type(4)));
typedef unsigned v2u __attribute__((ext_vector_type(2)));
typedef float f32x4 __attribute__((ext_vector_type(4)));
typedef float f32x2 __attribute__((ext_vector_type(2)));

constexpr int NBATCH = 4, SEQ = 4096, M = NBATCH * SEQ, D = 2048, FF = 5632, HD = 128;
constexpr int NCMP = 255;
constexpr int IN_COLS = 5656;
constexpr int NP = 5888;
constexpr int C_QN = 0, C_KC = 1024, C_VC = 1280, C_KS = 1536, C_VS = 1792, C_KW = 2048, C_VW = 2304, C_QS = 2560, C_KSB = 3584, C_VSB = 4608, C_GATE = 5632;
constexpr float EPS = 1e-6f;
constexpr float SCALE = 0.08838834764831845f;
constexpr float NEG_INF = -1e30f;
constexpr float QSCALE = 0.08838834764831845f * 1.4426950408889634f;

constexpr size_t MiB = 1u << 20;
constexpr size_t WS_CTL = 0, CTL_ZERO_BYTES = 1 * MiB;
constexpr size_t WS_RMAX = 256 * 1024;
constexpr size_t WS_CMAX = 512 * 1024;
constexpr size_t WS_W1GU = 2 * MiB, WS_W1D = 46 * MiB, WS_W2GU = 68 * MiB, WS_W2D = 112 * MiB, WS_WIN = 134 * MiB, WS_WOUT = 157 * MiB;
constexpr size_t WS_WC1K = 165 * MiB, WS_WC1V = 167 * MiB, WS_WC2K = 169 * MiB, WS_WC2V = 169 * MiB + 65536, WS_PBIAS = 169 * MiB + 131072;
constexpr size_t WS_COS = 170 * MiB, WS_SIN = 174 * MiB, WS_KC = 178 * MiB, WS_VC = 178 * MiB + 524288;
constexpr size_t WS_HB = 180 * MiB, WS_BIG = 244 * MiB, WS_SCR = 428 * MiB, WS_PART = 492 * MiB, WS_END = 494 * MiB;
constexpr size_t WS_SB_DUMMY_KV = WS_W2GU;
constexpr int CW_BAR = 4096;

constexpr int NWAVES = 8, NTHREADS = 512;
constexpr int LDS_BYTES = 163840;
constexpr int LDSCTL_OFF = 163840 - 1024;

__device__ __forceinline__ unsigned f2bf(float f) { unsigned u = __builtin_bit_cast(unsigned, f); return (u + 0x7fffu + ((u >> 16) & 1u)) >> 16; }
__device__ __forceinline__ unsigned pk2(float lo, float hi) { return f2bf(lo) | (f2bf(hi) << 16); }
__device__ __forceinline__ float bf2f(unsigned h) { return __builtin_bit_cast(float, h << 16); }
__device__ __forceinline__ float bflo(unsigned w) { return __builtin_bit_cast(float, w << 16); }
__device__ __forceinline__ float bfhi(unsigned w) { return __builtin_bit_cast(float, w & 0xffff0000u); }
__device__ __forceinline__ float wave_sum(float v) {
#pragma unroll
    for (int o = 1; o < 64; o <<= 1) v += __shfl_xor(v, o);
    return v;
}
__device__ __forceinline__ float wave_max(float v) {
#pragma unroll
    for (int o = 1; o < 64; o <<= 1) v = fmaxf(v, __shfl_xor(v, o));
    return v;
}
__device__ __forceinline__ float softplusf(float z) { return fmaxf(z, 0.f) + log1pf(expf(-fabsf(z))); }
__device__ __forceinline__ float sigmoidf(float z) { return 1.f / (1.f + expf(-z)); }
__device__ __forceinline__ float gelu_tanh(float x) { const float u = 0.7978845608028654f * (x + 0.044715f * x * x * x); return 0.5f * x * (1.f + tanhf(u)); }

#define XB_TMO      128
#define XB_XCNT(j)  (256  + 64 * (j))
#define XB_XSUB(j)  (1280 + 64 * (j))
#define XB_XGEN(j)  (2304 + 64 * (j))
#define XB_TOP      3328
#define XB_TOPGEN   3392
#define XCD_BAR_WORDS 3456
#define XB_SPIN_CAP (1u << 22)

__device__ __forceinline__ unsigned xb_ld(unsigned* p)              { return __hip_atomic_load(p, __ATOMIC_RELAXED, __HIP_MEMORY_SCOPE_AGENT); }
__device__ __forceinline__ unsigned xb_add(unsigned* p, unsigned v) { return __hip_atomic_fetch_add(p, v, __ATOMIC_RELAXED, __HIP_MEMORY_SCOPE_AGENT); }
__device__ __forceinline__ unsigned xb_xcc_id() { return (unsigned)__builtin_amdgcn_s_getreg((3 << 11) | 20) & 0xFu; }
#define XB_SPIN(cond, bar) do { unsigned _sp = 0; while (cond) { __builtin_amdgcn_s_sleep(1); \
    if ((++_sp & 255u) == 0u) { if (xb_ld(&(bar)[XB_TMO])) break; if (_sp > XB_SPIN_CAP) { atomicAdd(&(bar)[XB_TMO], 1u); break; } } } } while (0)

struct XcdBarrier { unsigned* bar; unsigned x; volatile LAS unsigned* st; };

__device__ __forceinline__ XcdBarrier xcd_barrier_post(unsigned* bar, volatile LAS unsigned* st) {
    XcdBarrier b; b.bar = bar; b.x = xb_xcc_id(); b.st = st;
    if (threadIdx.x == 0) (void)xb_add(&bar[XB_XCNT(b.x)], 1u);
    return b;
}
__device__ __forceinline__ void xcd_barrier_complete(unsigned* bar, unsigned x, unsigned& nloc, unsigned& nx) {
    const unsigned G = gridDim.x * gridDim.y * gridDim.z;
    unsigned sum, cnt, mine, sp = 0u;
    for (;;) {
        sum = 0u; cnt = 0u; mine = 0u;
#pragma unroll
        for (unsigned j = 0; j < 16; ++j) { const unsigned c = xb_ld(&bar[XB_XCNT(j)]); sum += c; cnt += (c > 0u) ? 1u : 0u; mine = (j == x) ? c : mine; }
        if (sum == G) break;
        __builtin_amdgcn_s_sleep(1);
        if ((++sp & 255u) == 0u) { if (xb_ld(&bar[XB_TMO])) break; if (sp > XB_SPIN_CAP) { atomicAdd(&bar[XB_TMO], 1u); break; } }
    }
    nloc = mine > 0u ? mine : 1u; nx = cnt > 0u ? cnt : 1u;
}
__device__ __forceinline__ void xcd_barrier(const XcdBarrier& b) {
    asm volatile("s_waitcnt vmcnt(0)" ::: "memory");
    __syncthreads();
    if (threadIdx.x == 0) {
        unsigned* bar = b.bar;
        __builtin_amdgcn_s_waitcnt(0);
        unsigned nloc = b.st[0], nx = b.st[1];
        if (nloc == 0u) { xcd_barrier_complete(bar, b.x, nloc, nx); b.st[0] = nloc; b.st[1] = nx; }
        const unsigned old = xb_add(&bar[XB_XSUB(b.x)], 1u);
        const unsigned gen = old / nloc;
        if (old + 1u == (gen + 1u) * nloc) {
            __builtin_amdgcn_fence(__ATOMIC_RELEASE, "agent");
            asm volatile("s_waitcnt vmcnt(0)" ::: "memory");
            const unsigned og = xb_add(&bar[XB_TOP], 1u);
            const unsigned tg = og / nx;
            if (og + 1u == (tg + 1u) * nx) xb_add(&bar[XB_TOPGEN], 1u);
            else XB_SPIN(xb_ld(&bar[XB_TOPGEN]) == tg, bar);
            __builtin_amdgcn_fence(__ATOMIC_ACQUIRE, "agent");
            xb_add(&bar[XB_XGEN(b.x)], 1u);
            asm volatile("s_waitcnt vmcnt(0)" ::: "memory");
        } else {
            XB_SPIN(xb_ld(&bar[XB_XGEN(b.x)]) == gen, bar);
            __builtin_amdgcn_fence(__ATOMIC_ACQUIRE, "agent");
            asm volatile("s_waitcnt vmcnt(0)" ::: "memory");
        }
    }
    __syncthreads();
}

namespace pg8 {
#define PG8_LAS __attribute__((address_space(3)))
typedef unsigned short bf16_t;
typedef short bf16x8 __attribute__((ext_vector_type(8)));
typedef float f32x4 __attribute__((ext_vector_type(4)));
typedef unsigned u32x4 __attribute__((ext_vector_type(4)));
constexpr int BM = 256, BK = 64, HALF = 128, HTB = HALF * BK * 2  , STAGE_BYTES = 8 * HTB, NXCD = 8, WGM = 8;

__host__ __device__ __forceinline__ int lds_byte(int r, int c) { const int st = (r >> 4) * 2 + (c >> 5), rr = r & 15, cc = c & 31, ob = rr * 64 + cc * 2; return st * 1024 + (ob ^ (((ob >> 9) & 1) << 5)); }
__host__ __device__ __forceinline__ void stage_rc(int b, int& R, int& C) { const int st = b / 1024, sb = b % 1024, swz = sb ^ (((sb >> 9) & 1) << 5); R = (st >> 1) * 16 + swz / 64; C = (st & 1) * 32 + (swz % 64) / 2; }
__host__ __device__ __forceinline__ int perm32(int rho) { const int n = rho >> 4, i = rho & 15; return 8 * (i >> 2) + 4 * n + (i & 3); }

typedef int v4i_t __attribute__((ext_vector_type(4)));
typedef int v8i_t __attribute__((ext_vector_type(8)));
__device__ __forceinline__ unsigned pk4_fp8(float a, float b, float c, float d) {
    a = __builtin_amdgcn_fmed3f(a, -448.f, 448.f); b = __builtin_amdgcn_fmed3f(b, -448.f, 448.f); c = __builtin_amdgcn_fmed3f(c, -448.f, 448.f); d = __builtin_amdgcn_fmed3f(d, -448.f, 448.f);
    int w = 0; w = __builtin_amdgcn_cvt_pk_fp8_f32(a, b, w, false); w = __builtin_amdgcn_cvt_pk_fp8_f32(c, d, w, true); return (unsigned)w;
}
__device__ __forceinline__ unsigned pk4_i8(float a, float b, float c, float d, float s) {
    const unsigned u0 = __builtin_bit_cast(unsigned, __builtin_fmaf(a, s, 12582912.0f)), u1 = __builtin_bit_cast(unsigned, __builtin_fmaf(b, s, 12582912.0f));
    const unsigned u2 = __builtin_bit_cast(unsigned, __builtin_fmaf(c, s, 12582912.0f)), u3 = __builtin_bit_cast(unsigned, __builtin_fmaf(d, s, 12582912.0f));
    return (u0 & 255u) | ((u1 & 255u) << 8) | ((u2 & 255u) << 16) | (u3 << 24);
}
constexpr float F8_WSCALE = 256.0f, F8_HSCALE = 16.0f;
struct Unit { int pm, pn, ord; };
struct Gemm { const bf16_t* A; const bf16_t* Bt; int M, N, K; int kshift = 0; };

struct StaticOrder {
    int nM, nN, nwg, G, c; int zero = 0;
    __host__ __device__ void init(int M, int N, int G_, int c_) { nM = M / BM; nN = N / BM; nwg = nM * nN; G = G_; c = c_; }
    __host__ __device__ bool next(int i, Unit& u) const {
        const long L = (long)i * G + c; if (L >= nwg) return false;
        int wgid = (int)L; { const int q = nwg / NXCD, r = nwg % NXCD, xcd = wgid % NXCD, off = wgid / NXCD; wgid = (xcd < r ? xcd * (q + 1) : r * (q + 1) + (xcd - r) * q) + off; }
        const int nig = WGM * nN, gid = wgid / nig, fm = gid * WGM, gsz = (nM - fm) < WGM ? (nM - fm) : WGM;
        u.pm = fm + ((wgid % nig) % gsz); u.pn = (wgid % nig) / gsz; u.ord = i;
        if (zero) { u.pm = 0; u.pn = 0; }
        return true;
    }
    __device__ __forceinline__ void a_ready(const Unit&) const {}
    __device__ __forceinline__ void done(const Unit&) const {}
};


__device__ __forceinline__ unsigned cvt_pk_bf16(float lo, float hi) { unsigned r; asm volatile("v_cvt_pk_bf16_f32 %0, %1, %2" : "=v"(r) : "v"(lo), "v"(hi)); return r; }
__device__ __forceinline__ float silu_mul(float g, float u) { return g * u * __builtin_amdgcn_rcpf(1.0f + __builtin_amdgcn_exp2f(-1.4426950408889634f * g)); }
__device__ __forceinline__ void row_scale_table(PG8_LAS float* rs, const float* part, const Unit& u, float inv_n, float eps) {
    asm volatile("s_waitcnt lgkmcnt(0)" ::: "memory"); __builtin_amdgcn_s_barrier(); asm volatile("" ::: "memory");
    const int t = threadIdx.x;
    if (t < 256) { const f32x4* p = (const f32x4*)(part + (size_t)(u.pm * BM + t) * 32); f32x4 a = p[0];
#pragma unroll
        for (int i = 1; i < 8; ++i) a = a + p[i];
        rs[t] = rsqrtf(((a[0] + a[1]) + (a[2] + a[3])) * inv_n + eps); }
    asm volatile("s_waitcnt lgkmcnt(0)" ::: "memory"); __builtin_amdgcn_s_barrier(); asm volatile("" ::: "memory");
}
__device__ __forceinline__ float row_factor(const float* part, int row) {
    const unsigned long long q = ((const unsigned long long*)part)[row];
    return rsqrtf((float)q * (1.0f / 16777216.0f) * (1.0f / 2048.0f) + 1e-6f);
}
template <class Sched>
__device__ __forceinline__ void row_factor_table(PG8_LAS float* rs, const float* part, const Sched& S, const float* rowmul = nullptr) {
    int t = threadIdx.x; asm volatile("" : "+v"(t));
    Unit u;
    for (int i = 0; S.next(i, u); ++i) if (t < 256) rs[i * 256 + t] = (part ? row_factor(part, u.pm * BM + t) : 1.0f) * (rowmul ? rowmul[u.pm * BM + t] : 1.0f);
    asm volatile("s_waitcnt vmcnt(0) lgkmcnt(0)" ::: "memory"); __builtin_amdgcn_s_barrier(); asm volatile("" ::: "memory");
}
template <bool F8 = false, bool O8 = F8, bool I8 = false>
struct EpiSwigluT {
    static constexpr bool PERM = true, AFTER_DRAIN = false;
    bf16_t* O; int ldo;
    const float* part; PG8_LAS float* rs;
    const float* colmax;
    static __device__ __forceinline__ unsigned silu_mul2(f32x2 g, f32x2 u) {
        const f32x2 t = g * (-1.4426950408889634f);
        f32x2 e; e.x = __builtin_amdgcn_exp2f(t.x); e.y = __builtin_amdgcn_exp2f(t.y);
        const f32x2 d = e + 1.0f;
        f32x2 rc; rc.x = __builtin_amdgcn_rcpf(d.x); rc.y = __builtin_amdgcn_rcpf(d.y);
        const f32x2 r = (g * u) * rc;
        typedef __bf16 bf16x2_t __attribute__((ext_vector_type(2)));
        return __builtin_bit_cast(unsigned, __builtin_convertvector(r, bf16x2_t));
    }
    static __device__ __forceinline__ f32x2 silu_mul2f(f32x2 g, f32x2 u) {
        const f32x2 t = g * (-1.4426950408889634f);
        f32x2 e; e.x = __builtin_amdgcn_exp2f(t.x); e.y = __builtin_amdgcn_exp2f(t.y);
        const f32x2 d = e + 1.0f;
        f32x2 rc; rc.x = __builtin_amdgcn_rcpf(d.x); rc.y = __builtin_amdgcn_rcpf(d.y);
        return (g * u) * rc;
    }
    __device__ __forceinline__ void operator()(const f32x4 (&acc)[2][2][4][2], const Unit& u, int wr, int wc, int fr, int fq) const {
        const int row0 = u.pm * BM + wr * 64 + fr, col0 = u.pn * HALF + wc * 32 + 8 * fq;
        float rf[2][4];
#pragma unroll
        for (int ai = 0; ai < 2; ++ai)
#pragma unroll
            for (int m = 0; m < 4; ++m) rf[ai][m] = part ? rs[u.ord * 256 + wr * 64 + fr + ai * HALF + m * 16] : 1.0f;
        f32x4 cg0, cg1, cu0, cu1;
        if constexpr (I8) { cg0 = *(const f32x4*)(colmax + col0); cg1 = *(const f32x4*)(colmax + col0 + 4); cu0 = *(const f32x4*)(colmax + ldo + col0); cu1 = *(const f32x4*)(colmax + ldo + col0 + 4); }
#pragma unroll
        for (int ai = 0; ai < 2; ++ai)
#pragma unroll
            for (int m = 0; m < 4; ++m) {
                if constexpr (F8) {
                    f32x4 g0, g1, u0, u1;
                    if constexpr (I8) {
                        const float rg = rf[ai][m] * (1.0f / 127.0f), ru = O8 ? rg * F8_HSCALE : rg;
                        g0 = __builtin_convertvector(__builtin_bit_cast(v4i_t, acc[ai][0][m][0]), f32x4) * (cg0 * rg); g1 = __builtin_convertvector(__builtin_bit_cast(v4i_t, acc[ai][0][m][1]), f32x4) * (cg1 * rg);
                        u0 = __builtin_convertvector(__builtin_bit_cast(v4i_t, acc[ai][1][m][0]), f32x4) * (cu0 * ru); u1 = __builtin_convertvector(__builtin_bit_cast(v4i_t, acc[ai][1][m][1]), f32x4) * (cu1 * ru);
                    } else {
                    const float rg = rf[ai][m] * (1.0f / F8_WSCALE), ru = O8 ? rg * F8_HSCALE : rg;
                    g0 = acc[ai][0][m][0] * rg; g1 = acc[ai][0][m][1] * rg; u0 = acc[ai][1][m][0] * ru; u1 = acc[ai][1][m][1] * ru;
                    }
                    const f32x2 h0 = silu_mul2f((f32x2){g0[0], g0[1]}, (f32x2){u0[0], u0[1]}), h1 = silu_mul2f((f32x2){g0[2], g0[3]}, (f32x2){u0[2], u0[3]});
                    const f32x2 h2 = silu_mul2f((f32x2){g1[0], g1[1]}, (f32x2){u1[0], u1[1]}), h3 = silu_mul2f((f32x2){g1[2], g1[3]}, (f32x2){u1[2], u1[3]});
                    if constexpr (O8) {
                    typedef unsigned u32x2 __attribute__((ext_vector_type(2))); u32x2 w; w.x = pk4_fp8(h0.x, h0.y, h1.x, h1.y); w.y = pk4_fp8(h2.x, h2.y, h3.x, h3.y);
                    *(u32x2*)((unsigned char*)O + (size_t)(row0 + ai * HALF + m * 16) * ldo + col0) = w;
                    } else {
                    typedef __bf16 bf16x2_t __attribute__((ext_vector_type(2)));
                    u32x4 w; w.x = __builtin_bit_cast(unsigned, __builtin_convertvector(h0, bf16x2_t)); w.y = __builtin_bit_cast(unsigned, __builtin_convertvector(h1, bf16x2_t));
                    w.z = __builtin_bit_cast(unsigned, __builtin_convertvector(h2, bf16x2_t)); w.w = __builtin_bit_cast(unsigned, __builtin_convertvector(h3, bf16x2_t));
                    *(u32x4*)(O + (size_t)(row0 + ai * HALF + m * 16) * ldo + col0) = w;
                    }
                } else {
                const float r = rf[ai][m];
                const f32x4 g0 = acc[ai][0][m][0] * r, g1 = acc[ai][0][m][1] * r, u0 = acc[ai][1][m][0] * r, u1 = acc[ai][1][m][1] * r;
                u32x4 w;
                w.x = silu_mul2((f32x2){g0[0], g0[1]}, (f32x2){u0[0], u0[1]}); w.y = silu_mul2((f32x2){g0[2], g0[3]}, (f32x2){u0[2], u0[3]});
                w.z = silu_mul2((f32x2){g1[0], g1[1]}, (f32x2){u1[0], u1[1]}); w.w = silu_mul2((f32x2){g1[2], g1[3]}, (f32x2){u1[2], u1[3]});
                *(u32x4*)(O + (size_t)(row0 + ai * HALF + m * 16) * ldo + col0) = w;
                }
            }
    }
};
typedef EpiSwigluT<false> EpiSwiglu;
struct EpiResid {
    static constexpr bool PERM = false, AFTER_DRAIN = false;
    const float* base; float* out; int ldc; float alpha;
    bf16_t* XG; const float* gain; float* part;
    __device__ __forceinline__ void operator()(const f32x4 (&acc)[2][2][4][2], const Unit& u, int wr, int wc, int fr, int fq) const {
        const int row0 = u.pm * BM + wr * 64 + fr, col0 = u.pn * BM + wc * 32 + 4 * fq;
        f32x4 gg[2][2];
#pragma unroll
        for (int bj = 0; bj < 2; ++bj)
#pragma unroll
            for (int n = 0; n < 2; ++n) gg[bj][n] = XG ? *(const f32x4*)(gain + col0 + bj * HALF + 16 * n) : (f32x4){0.f, 0.f, 0.f, 0.f};
#pragma unroll
        for (int ai = 0; ai < 2; ++ai) {
            f32x4 b[4][2][2];
#pragma unroll
            for (int m = 0; m < 4; ++m)
#pragma unroll
                for (int bj = 0; bj < 2; ++bj)
#pragma unroll
                    for (int n = 0; n < 2; ++n) b[m][bj][n] = *(const f32x4*)(base + (size_t)(row0 + ai * HALF + m * 16) * ldc + col0 + bj * HALF + 16 * n);
#pragma unroll
            for (int m = 0; m < 4; ++m) { const int row = row0 + ai * HALF + m * 16; const size_t ro = (size_t)row * ldc + col0; float ssq = 0.f;
#pragma unroll
                for (int bj = 0; bj < 2; ++bj)
#pragma unroll
                    for (int n = 0; n < 2; ++n) { const size_t o = ro + bj * HALF + 16 * n; const f32x4 v = b[m][bj][n] + acc[ai][bj][m][n] * alpha; *(f32x4*)(out + o) = v;
                        if (XG) { const f32x4 g4 = gg[bj][n]; ssq += (v[0] * v[0] + v[1] * v[1]) + (v[2] * v[2] + v[3] * v[3]);
                            typedef unsigned u32x2 __attribute__((ext_vector_type(2))); u32x2 w; w.x = cvt_pk_bf16(v[0] * g4[0], v[1] * g4[1]); w.y = cvt_pk_bf16(v[2] * g4[2], v[3] * g4[3]); *(u32x2*)(XG + o) = w; } }
                if (XG) { ssq += __shfl_xor(ssq, 16); ssq += __shfl_xor(ssq, 32);
                    if (fq == 0) __hip_atomic_fetch_add((unsigned long long*)part + row, (unsigned long long)(ssq * 16777216.0f), __ATOMIC_RELAXED, __HIP_MEMORY_SCOPE_AGENT); } }
        }
    }
};
template <bool BB, bool OB, bool I8 = false>
struct EpiResidMix {
    static constexpr bool PERM = false, AFTER_DRAIN = false;
    const void* base; void* out; int ldc; float alpha;
    unsigned long long* rowsq;
    unsigned char* out8;
    unsigned* rowmax;
    PG8_LAS float* rs; const float* colmax;
    __device__ __forceinline__ void operator()(const f32x4 (&acc)[2][2][4][2], const Unit& u, int wr, int wc, int fr, int fq) const {
        typedef unsigned u32x2 __attribute__((ext_vector_type(2)));
        const int row0 = u.pm * BM + wr * 64 + fr, col0 = u.pn * BM + wc * 32 + 4 * fq;
        f32x4 cm[2][2];
        if constexpr (I8) {
#pragma unroll
            for (int bj = 0; bj < 2; ++bj)
#pragma unroll
                for (int n = 0; n < 2; ++n) cm[bj][n] = *(const f32x4*)(colmax + col0 + bj * HALF + 16 * n) * (alpha * (1.0f / 127.0f));
        }
#pragma unroll
        for (int ai = 0; ai < 2; ++ai) {
            f32x4 b[4][2][2];
#pragma unroll
            for (int m = 0; m < 4; ++m)
#pragma unroll
                for (int bj = 0; bj < 2; ++bj)
#pragma unroll
                    for (int n = 0; n < 2; ++n) { const size_t o = (size_t)(row0 + ai * HALF + m * 16) * ldc + col0 + bj * HALF + 16 * n;
                        if (BB) { const u32x2 w = *(const u32x2*)((const bf16_t*)base + o);
                            b[m][bj][n] = (f32x4){__builtin_bit_cast(float, w.x << 16), __builtin_bit_cast(float, w.x & 0xffff0000u), __builtin_bit_cast(float, w.y << 16), __builtin_bit_cast(float, w.y & 0xffff0000u)}; }
                        else b[m][bj][n] = *(const f32x4*)((const float*)base + o); }
#pragma unroll
            for (int m = 0; m < 4; ++m) { float ssq = 0.f, amx = 0.f;
#pragma unroll
                for (int bj = 0; bj < 2; ++bj)
#pragma unroll
                    for (int n = 0; n < 2; ++n) { const size_t o = (size_t)(row0 + ai * HALF + m * 16) * ldc + col0 + bj * HALF + 16 * n;
                        f32x4 v;
                        if constexpr (I8) v = b[m][bj][n] + __builtin_convertvector(__builtin_bit_cast(v4i_t, acc[ai][bj][m][n]), f32x4) * (cm[bj][n] * rs[u.ord * 256 + wr * 64 + fr + ai * HALF + m * 16]);
                        else v = b[m][bj][n] + acc[ai][bj][m][n] * alpha;
                        ssq += (v[0] * v[0] + v[1] * v[1]) + (v[2] * v[2] + v[3] * v[3]);
                        if (rowmax) { amx = __builtin_fmaxf(__builtin_fmaxf(amx, __builtin_fabsf(v[0])), __builtin_fabsf(v[1])); amx = __builtin_fmaxf(__builtin_fmaxf(amx, __builtin_fabsf(v[2])), __builtin_fabsf(v[3])); }
                        if (OB) { u32x2 w; w.x = cvt_pk_bf16(v[0], v[1]); w.y = cvt_pk_bf16(v[2], v[3]); *(u32x2*)((bf16_t*)out + o) = w; }
                        else *(f32x4*)((float*)out + o) = v;
                        if (out8) *(unsigned*)(out8 + o) = pk4_fp8(v[0], v[1], v[2], v[3]); }
                if (rowsq) { ssq += __shfl_xor(ssq, 16); ssq += __shfl_xor(ssq, 32);
                    if (fq == 0) __hip_atomic_fetch_add(rowsq + (row0 + ai * HALF + m * 16), (unsigned long long)(ssq * 16777216.0f), __ATOMIC_RELAXED, __HIP_MEMORY_SCOPE_AGENT); }
                if (rowmax) { amx = __builtin_fmaxf(amx, __shfl_xor(amx, 16)); amx = __builtin_fmaxf(amx, __shfl_xor(amx, 32));
                    if (fq == 0) __hip_atomic_fetch_max(rowmax + (row0 + ai * HALF + m * 16), __builtin_bit_cast(unsigned, amx), __ATOMIC_RELAXED, __HIP_MEMORY_SCOPE_AGENT); } }
        }
    }
};
template <bool I8 = false>
struct EpiStoreBf16T {
    static constexpr bool PERM = true, AFTER_DRAIN = false;
    bf16_t* O; int ldo; int sc_lo, sc_hi; float sc;
    const float* part; PG8_LAS float* rs;
    bf16_t* KVC; int kv_lo, kv_hi;
    const float* colmax;
    __device__ __forceinline__ void operator()(const f32x4 (&acc)[2][2][4][2], const Unit& u, int wr, int wc, int fr, int fq) const {
        const int row0 = u.pm * BM + wr * 64 + fr, col0 = u.pn * BM + wc * 32 + 8 * fq;
        const float scl0 = (u.pn >= sc_lo && u.pn < sc_hi) ? sc : 1.0f;
        const bool kv = u.pn >= kv_lo && u.pn < kv_hi;
        const int which = (u.pn - kv_lo) >> 2, h0 = 2 * ((u.pn - kv_lo) & 3);
        float rf[2][4];
#pragma unroll
        for (int ai = 0; ai < 2; ++ai)
#pragma unroll
            for (int m = 0; m < 4; ++m) rf[ai][m] = part ? rs[u.ord * 256 + wr * 64 + fr + ai * HALF + m * 16] : 1.0f;
        f32x4 cm[2][2];
        if constexpr (I8) {
#pragma unroll
            for (int bj = 0; bj < 2; ++bj) { cm[bj][0] = *(const f32x4*)(colmax + col0 + bj * HALF); cm[bj][1] = *(const f32x4*)(colmax + col0 + bj * HALF + 4); } }
#pragma unroll
        for (int ai = 0; ai < 2; ++ai)
#pragma unroll
            for (int m = 0; m < 4; ++m) { const int row = row0 + ai * HALF + m * 16; bf16_t* rowp = O + (size_t)row * ldo + col0;
                const float scl = I8 ? scl0 * rf[ai][m] * (1.0f / 127.0f) : scl0 * rf[ai][m];
                bf16_t* kvp = KVC + ((size_t)((which * 4 + (row >> 12)) * 8 + h0) * 4096 + (row & 4095)) * 128 + wc * 32 + 8 * fq;
#pragma unroll
                for (int bj = 0; bj < 2; ++bj) { f32x4 v0, v1;
                    if constexpr (I8) { v0 = __builtin_convertvector(__builtin_bit_cast(v4i_t, acc[ai][bj][m][0]), f32x4) * (cm[bj][0] * scl); v1 = __builtin_convertvector(__builtin_bit_cast(v4i_t, acc[ai][bj][m][1]), f32x4) * (cm[bj][1] * scl); }
                    else { v0 = acc[ai][bj][m][0] * scl; v1 = acc[ai][bj][m][1] * scl; }
                    u32x4 w; w.x = cvt_pk_bf16(v0[0], v0[1]); w.y = cvt_pk_bf16(v0[2], v0[3]); w.z = cvt_pk_bf16(v1[0], v1[1]); w.w = cvt_pk_bf16(v1[2], v1[3]);
                    if (kv) *(u32x4*)(kvp + (size_t)bj * 4096 * 128) = w; else *(u32x4*)(rowp + bj * HALF) = w; } }
    }
};
typedef EpiStoreBf16T<false> EpiStoreBf16;
template <class Epi, class Sched, bool ALIGN_EPI = false, bool SP2 = false, bool FP8 = false, bool I8 = false>
__device__ __forceinline__ void gemm_phase(PG8_LAS unsigned char* lds, const Gemm g, const Sched& S, const Epi& E) {
    int tid_ = threadIdx.x; asm volatile("" : "+v"(tid_));
    const int tid = tid_, wid = __builtin_amdgcn_readfirstlane(tid >> 6), lane = tid & 63, wr = wid >> 2, wc = wid & 3, fr = lane & 15, fq = lane >> 4;
    const int K = g.K, nt = (K / BK) >> g.kshift;
    unsigned voffA[2], voffB[2];
#pragma unroll
    for (int i = 0; i < 2; ++i) { int R, C; stage_rc(tid * 16 + i * 8192, R, C); const int Rb = Epi::PERM ? ((R & ~31) + perm32(R & 31)) : R;
        voffA[i] = (unsigned)(R * K + C) * 2u; voffB[i] = (unsigned)(Rb * K + C) * 2u; }
    const size_t kstep = (size_t)(BK * 2);
    const size_t hstep = (size_t)HALF * K * 2;
    const size_t tstep = 2 * hstep;
    const unsigned ldsw = (unsigned)wid * 1024u;
    const int aoff = lds_byte(wr * 64 + fr, fq * 8), boff = lds_byte(wc * 32 + fr, fq * 8);
#define PG8_SA(b, h) (((b) * 2 + (h)) * HTB)
#define PG8_SB(b, h) ((4 + (b) * 2 + (h)) * HTB)
#define PG8_STAGE(bufoff, gbase, voff) do { _Pragma("unroll") for (int _i = 0; _i < 2; ++_i) \
        __builtin_amdgcn_global_load_lds((const unsigned*)((const char*)(gbase) + (voff)[_i]), (PG8_LAS unsigned*)(lds + (bufoff) + ldsw + _i * 8192), 16, 0, 0); } while (0)
#define PG8_LDA(dst, b, h) do { _Pragma("unroll") for (int m = 0; m < 4; ++m) _Pragma("unroll") for (int k = 0; k < 2; ++k) dst[m][k] = *(const PG8_LAS bf16x8*)(lds + PG8_SA(b, h) + aoff + m * 2048 + k * 1024); } while (0)
#define PG8_LDB(dst, b, h) do { _Pragma("unroll") for (int n = 0; n < 2; ++n) _Pragma("unroll") for (int k = 0; k < 2; ++k) dst[n][k] = *(const PG8_LAS bf16x8*)(lds + PG8_SB(b, h) + boff + n * 2048 + k * 1024); } while (0)
#define PG8_MMA(ai, bj, At, Bt) do { __builtin_amdgcn_s_setprio(1); _Pragma("unroll") for (int m = 0; m < 4; ++m) _Pragma("unroll") for (int n = 0; n < 2; ++n) _Pragma("unroll") for (int k = 0; k < 2; ++k) \
        acc[ai][bj][m][n] = __builtin_amdgcn_mfma_f32_16x16x32_bf16(Bt[n][k], At[m][k], acc[ai][bj][m][n], 0, 0, 0); __builtin_amdgcn_s_setprio(0); } while (0)
#define PG8_RD8(p) __builtin_shufflevector(*(const PG8_LAS v4i_t*)(p), *(const PG8_LAS v4i_t*)((p) + 1024), 0, 1, 2, 3, 4, 5, 6, 7)
#define PG8_LDA8(dst, b, h) do { _Pragma("unroll") for (int m = 0; m < 4; ++m) dst[m] = PG8_RD8(lds + PG8_SA(b, h) + aoff + m * 2048); } while (0)
#define PG8_LDB8(dst, b, h) do { _Pragma("unroll") for (int n = 0; n < 2; ++n) dst[n] = PG8_RD8(lds + PG8_SB(b, h) + boff + n * 2048); } while (0)
#define PG8_MQ(V, SW, b, a) V.SW = __builtin_amdgcn_mfma_scale_f32_16x16x128_f8f6f4(b, a, V.SW, 0, 0, 0, 0, 0, 0)
#define PG8_MMA8(ai, bj, At, Bt) do { __builtin_amdgcn_s_setprio(1); \
        PG8_MQ(accv[ai][bj][0], s0123, Bt[0], At[0]); PG8_MQ(accv[ai][bj][0], s4567, Bt[1], At[0]); PG8_MQ(accv[ai][bj][0], s89ab, Bt[0], At[1]); PG8_MQ(accv[ai][bj][0], scdef, Bt[1], At[1]); \
        PG8_MQ(accv[ai][bj][1], s0123, Bt[0], At[2]); PG8_MQ(accv[ai][bj][1], s4567, Bt[1], At[2]); PG8_MQ(accv[ai][bj][1], s89ab, Bt[0], At[3]); PG8_MQ(accv[ai][bj][1], scdef, Bt[1], At[3]); \
        __builtin_amdgcn_s_setprio(0); } while (0)
#define PG8_MMAI(ai, bj, At, Bt) do { __builtin_amdgcn_s_setprio(1); _Pragma("unroll") for (int m = 0; m < 4; ++m) _Pragma("unroll") for (int n = 0; n < 2; ++n) _Pragma("unroll") for (int k = 0; k < 2; ++k) \
        acc[ai][bj][m][n] = __builtin_bit_cast(f32x4, __builtin_amdgcn_mfma_i32_16x16x64_i8(__builtin_bit_cast(v4i_t, Bt[n][k]), __builtin_bit_cast(v4i_t, At[m][k]), __builtin_bit_cast(v4i_t, acc[ai][bj][m][n]), 0, 0, 0)); __builtin_amdgcn_s_setprio(0); } while (0)
#define PG8_MM(ai, bj, At, Bt) do { if constexpr (FP8) PG8_MMA8(ai, bj, At##8, Bt##8); else if constexpr (I8) PG8_MMAI(ai, bj, At, Bt); else PG8_MMA(ai, bj, At, Bt); } while (0)
#define PG8_LA(dst, b, h) do { if constexpr (FP8) PG8_LDA8(dst##8, b, h); else PG8_LDA(dst, b, h); } while (0)
#define PG8_LB(dst, b, h) do { if constexpr (FP8) PG8_LDB8(dst##8, b, h); else PG8_LDB(dst, b, h); } while (0)
#define PG8_WAIT_V(n) asm volatile("s_waitcnt vmcnt(" #n ")" ::: "memory")
#define PG8_WAIT_L(n) asm volatile("s_waitcnt lgkmcnt(" #n ")" ::: "memory")
#define PG8_BAR __builtin_amdgcn_s_barrier()
#define PG8_SCHED __builtin_amdgcn_sched_barrier(0)
    Unit cur, nxt; int ui = 0;
    if (!S.next(0, cur)) return;
    f32x4 acc[2][2][4][2];
    float zf = 0.f; asm volatile("" : "+v"(zf));
#pragma unroll
    for (int a = 0; a < 2; ++a)
#pragma unroll
        for (int b = 0; b < 2; ++b)
#pragma unroll
            for (int m = 0; m < 4; ++m)
#pragma unroll
                for (int n = 0; n < 2; ++n) acc[a][b][m][n] = (f32x4){zf, zf, zf, zf};
    bf16x8 At[4][2], B0[2][2], B1[2][2];
    typedef float f32x16_t __attribute__((ext_vector_type(16)));
    f32x16_t accv[2][2][2];
    if constexpr (FP8) {
#pragma unroll
        for (int a = 0; a < 2; ++a)
#pragma unroll
            for (int b = 0; b < 2; ++b)
#pragma unroll
                for (int h = 0; h < 2; ++h) accv[a][b][h] = (f32x16_t)(zf);
    }
    v8i_t At8[4], B08[2], B18[2];
    const char* cA = (const char*)g.A + (size_t)cur.pm * tstep; const char* cB = (const char*)g.Bt + (size_t)cur.pn * tstep;
    S.a_ready(cur);
    if constexpr (SP2) {
        PG8_STAGE(PG8_SB(0, 0), cB, voffB); PG8_STAGE(PG8_SB(0, 1), cB + hstep, voffB); PG8_STAGE(PG8_SA(0, 0), cA, voffA); PG8_STAGE(PG8_SA(0, 1), cA + hstep, voffA);
        if (wr == 1) PG8_BAR;
        PG8_WAIT_V(2); PG8_BAR;
        PG8_STAGE(PG8_SB(1, 0), cB + kstep, voffB); PG8_STAGE(PG8_SA(1, 0), cA + kstep, voffA); PG8_STAGE(PG8_SB(1, 1), cB + hstep + kstep, voffB);
        PG8_WAIT_V(6); PG8_BAR;
    } else {
        PG8_STAGE(PG8_SB(0, 0), cB, voffB); PG8_STAGE(PG8_SA(0, 0), cA, voffA); PG8_STAGE(PG8_SB(0, 1), cB + hstep, voffB); PG8_STAGE(PG8_SA(0, 1), cA + hstep, voffA);
        if (wr == 1) PG8_BAR;
        PG8_WAIT_V(4); PG8_BAR;
        PG8_STAGE(PG8_SB(1, 0), cB + kstep, voffB); PG8_STAGE(PG8_SA(1, 0), cA + kstep, voffA); PG8_STAGE(PG8_SB(1, 1), cB + hstep + kstep, voffB);
        PG8_WAIT_V(6); PG8_BAR;
    }
    for (;;) {
        const bool has_next = S.next(ui + 1, nxt);
        const char* nA = has_next ? (const char*)g.A + (size_t)nxt.pm * tstep : cA; const char* nB = has_next ? (const char*)g.Bt + (size_t)nxt.pn * tstep : cB;
        for (int t = 0; t < nt; t += 2) {
            const bool last = (t == nt - 2);
            const char* a1 = cA + (size_t)(t + 1) * kstep;
            const char* a2 = last ? nA : cA + (size_t)(t + 2) * kstep; const char* b2 = last ? nB : cB + (size_t)(t + 2) * kstep;
            const char* a3 = a2 + kstep; const char* b3 = b2 + kstep;
            if (last && has_next) S.a_ready(nxt);
            if constexpr (SP2) {
            PG8_LB(B0, 0, 0); PG8_LB(B1, 0, 1); PG8_SCHED; PG8_LA(At, 0, 0); PG8_STAGE(PG8_SA(1, 1), a1 + hstep, voffA);
            PG8_WAIT_V(8); PG8_WAIT_L(0); PG8_BAR; PG8_MM(0, 0, At, B0); PG8_MM(0, 1, At, B1); PG8_BAR; PG8_SCHED;
            PG8_LA(At, 0, 1); PG8_STAGE(PG8_SB(0, 0), b2, voffB); PG8_STAGE(PG8_SB(0, 1), b2 + hstep, voffB); PG8_STAGE(PG8_SA(0, 0), a2, voffA);
            PG8_WAIT_V(8); PG8_WAIT_L(0); PG8_BAR; PG8_MM(1, 0, At, B0); PG8_MM(1, 1, At, B1); PG8_BAR; PG8_SCHED;
            PG8_LB(B0, 1, 0); PG8_LB(B1, 1, 1); PG8_SCHED; PG8_LA(At, 1, 0); PG8_STAGE(PG8_SA(0, 1), a2 + hstep, voffA);
            PG8_WAIT_V(8); PG8_WAIT_L(0); PG8_BAR; PG8_MM(0, 0, At, B0); PG8_MM(0, 1, At, B1); PG8_BAR; PG8_SCHED;
            PG8_LA(At, 1, 1); PG8_STAGE(PG8_SB(1, 0), b3, voffB); PG8_STAGE(PG8_SB(1, 1), b3 + hstep, voffB); PG8_STAGE(PG8_SA(1, 0), a3, voffA);
            PG8_WAIT_V(8); PG8_WAIT_L(0); PG8_BAR; PG8_MM(1, 0, At, B0); PG8_MM(1, 1, At, B1); PG8_BAR; PG8_SCHED;
            } else {
            PG8_LB(B0, 0, 0); PG8_SCHED; PG8_LA(At, 0, 0); PG8_STAGE(PG8_SA(1, 1), a1 + hstep, voffA);
            PG8_WAIT_L(8); PG8_BAR; PG8_WAIT_L(0); PG8_MM(0, 0, At, B0); PG8_BAR; PG8_SCHED;
            PG8_LB(B1, 0, 1); PG8_STAGE(PG8_SB(0, 0), b2, voffB);
            PG8_BAR; PG8_WAIT_L(0); PG8_MM(0, 1, At, B1); PG8_BAR;
            PG8_LA(At, 0, 1); PG8_STAGE(PG8_SA(0, 0), a2, voffA);
            PG8_BAR; PG8_WAIT_L(0); PG8_MM(1, 0, At, B0); PG8_BAR; PG8_SCHED;
            PG8_STAGE(PG8_SB(0, 1), b2 + hstep, voffB);
            PG8_WAIT_V(6); PG8_BAR; PG8_MM(1, 1, At, B1); PG8_BAR;
            PG8_LB(B0, 1, 0); PG8_SCHED; PG8_LA(At, 1, 0); PG8_STAGE(PG8_SA(0, 1), a2 + hstep, voffA);
            PG8_WAIT_L(8); PG8_BAR; PG8_WAIT_L(0); PG8_MM(0, 0, At, B0); PG8_BAR; PG8_SCHED;
            PG8_LB(B1, 1, 1); PG8_STAGE(PG8_SB(1, 0), b3, voffB);
            PG8_BAR; PG8_WAIT_L(0); PG8_MM(0, 1, At, B1); PG8_BAR;
            PG8_LA(At, 1, 1); PG8_STAGE(PG8_SA(1, 0), a3, voffA);
            PG8_BAR; PG8_WAIT_L(0); PG8_MM(1, 0, At, B0); PG8_BAR; PG8_SCHED;
            PG8_STAGE(PG8_SB(1, 1), b3 + hstep, voffB);
            PG8_WAIT_V(6); PG8_BAR; PG8_MM(1, 1, At, B1); PG8_BAR;
            }
        }
        if constexpr (ALIGN_EPI) { if (wr == 0) PG8_BAR; }
        if constexpr (FP8) {
#pragma unroll
            for (int a = 0; a < 2; ++a)
#pragma unroll
                for (int b = 0; b < 2; ++b)
#pragma unroll
                    for (int h = 0; h < 2; ++h) { const f32x16_t v = accv[a][b][h]; acc[a][b][2 * h][0] = v.s0123; acc[a][b][2 * h][1] = v.s4567; acc[a][b][2 * h + 1][0] = v.s89ab; acc[a][b][2 * h + 1][1] = v.scdef; accv[a][b][h] = (f32x16_t)(zf); }
        }
        if constexpr (!Epi::AFTER_DRAIN) { E(acc, cur, wr, wc, fr, fq); S.done(cur); }
        if (!has_next) break;
#pragma unroll
        for (int a = 0; a < 2; ++a)
#pragma unroll
            for (int b = 0; b < 2; ++b)
#pragma unroll
                for (int m = 0; m < 4; ++m)
#pragma unroll
                    for (int n = 0; n < 2; ++n) acc[a][b][m][n] = (f32x4){zf, zf, zf, zf};
        cur = nxt; cA = nA; cB = nB; ++ui;
        if constexpr (ALIGN_EPI) { if (wr == 1) PG8_BAR; }
    }
    PG8_WAIT_V(0);
    if constexpr (!ALIGN_EPI) { if (wr == 0) PG8_BAR; }
    PG8_BAR;
    if constexpr (Epi::AFTER_DRAIN) { E.fused(acc, cur, wr, wc, fr, fq, lds, wid, lane); S.done(cur); }
#undef PG8_SA
#undef PG8_SB
#undef PG8_STAGE
#undef PG8_LDA
#undef PG8_LDB
#undef PG8_MMA
#undef PG8_MMA8
#undef PG8_MMAI
#undef PG8_MQ
#undef PG8_MM
#undef PG8_RD8
#undef PG8_LDA8
#undef PG8_LDB8
#undef PG8_LA
#undef PG8_LB
#undef PG8_WAIT_V
#undef PG8_WAIT_L
#undef PG8_BAR
#undef PG8_SCHED
}
}

struct Params {
    const float* x; const int* pos;
    const float *ffn1_norm, *ffn1_wg, *ffn1_wu, *ffn1_wd, *mix_norm, *w_in, *q_norm, *kc_norm, *ks_norm, *kw_norm;
    const float *ck_pos, *ck_w1, *ck_w2, *cv_pos, *cv_w1, *cv_w2, *nsa_on, *sb_on, *w_out, *ffn2_norm, *ffn2_wg, *ffn2_wu, *ffn2_wd;
    float* out; unsigned char* ws;
};


__device__ __forceinline__ void rmsnorm_rows(const float* X, const float* g, bf16* Y) {
    int tid = threadIdx.x; asm volatile("" : "+v"(tid));
    const int lane = tid & 63, gw = blockIdx.x * NWAVES + (tid >> 6), NGW = gridDim.x * NWAVES;
    f32x4 gg[8];
#pragma unroll
    for (int j = 0; j < 8; ++j) gg[j] = ((const f32x4*)g)[lane + 64 * j];
    for (int m0 = gw; m0 < M; m0 += 2 * NGW) {
        const int m1 = m0 + NGW; const bool ok1 = m1 < M;
        const f32x4* x0 = (const f32x4*)(X + (size_t)m0 * D) + lane; const f32x4* x1 = (const f32x4*)(X + (size_t)(ok1 ? m1 : m0) * D) + lane;
        f32x4 v0[8], v1[8]; float s0 = 0.f, s1 = 0.f;
#pragma unroll
        for (int j = 0; j < 8; ++j) { v0[j] = x0[64 * j]; v1[j] = x1[64 * j]; }
#pragma unroll
        for (int j = 0; j < 8; ++j) { s0 += (v0[j].x * v0[j].x + v0[j].y * v0[j].y) + (v0[j].z * v0[j].z + v0[j].w * v0[j].w); s1 += (v1[j].x * v1[j].x + v1[j].y * v1[j].y) + (v1[j].z * v1[j].z + v1[j].w * v1[j].w); }
        const float r0 = rsqrtf(wave_sum(s0) * (1.f / D) + EPS), r1 = rsqrtf(wave_sum(s1) * (1.f / D) + EPS);
        v2u* o0 = (v2u*)(Y + (size_t)m0 * D) + lane; v2u* o1 = (v2u*)(Y + (size_t)m1 * D) + lane;
#pragma unroll
        for (int j = 0; j < 8; ++j) { v2u w; w.x = pk2(v0[j].x * r0 * gg[j].x, v0[j].y * r0 * gg[j].y); w.y = pk2(v0[j].z * r0 * gg[j].z, v0[j].w * r0 * gg[j].w); o0[64 * j] = w; }
        if (ok1) {
#pragma unroll
            for (int j = 0; j < 8; ++j) { v2u w; w.x = pk2(v1[j].x * r1 * gg[j].x, v1[j].y * r1 * gg[j].y); w.y = pk2(v1[j].z * r1 * gg[j].z, v1[j].w * r1 * gg[j].w); o1[64 * j] = w; }
        }
    }
}

template <bool I8 = false>
__device__ __forceinline__ void cast_rows(const float* X, bf16* Y, unsigned long long* rowsq, unsigned char* Y8 = nullptr, float* rowscale = nullptr) {
    int tid = threadIdx.x; asm volatile("" : "+v"(tid));
    const int lane = tid & 63, gw = blockIdx.x * NWAVES + (tid >> 6), NGW = gridDim.x * NWAVES;
    for (int m0 = gw; m0 < M; m0 += 2 * NGW) {
        const int m1 = m0 + NGW; const bool ok1 = m1 < M;
        const f32x4* x0 = (const f32x4*)(X + (size_t)m0 * D) + lane; const f32x4* x1 = (const f32x4*)(X + (size_t)(ok1 ? m1 : m0) * D) + lane;
        f32x4 v0[8], v1[8]; float s0 = 0.f, s1 = 0.f;
#pragma unroll
        for (int j = 0; j < 8; ++j) { v0[j] = x0[64 * j]; v1[j] = x1[64 * j]; }
#pragma unroll
        for (int j = 0; j < 8; ++j) { s0 += (v0[j].x * v0[j].x + v0[j].y * v0[j].y) + (v0[j].z * v0[j].z + v0[j].w * v0[j].w); s1 += (v1[j].x * v1[j].x + v1[j].y * v1[j].y) + (v1[j].z * v1[j].z + v1[j].w * v1[j].w); }
        s0 = wave_sum(s0); s1 = wave_sum(s1);
        if (lane == 0) { rowsq[m0] = (unsigned long long)(s0 * 16777216.0f); if (ok1) rowsq[m1] = (unsigned long long)(s1 * 16777216.0f); }
        v2u* o0 = (v2u*)(Y + (size_t)m0 * D) + lane; v2u* o1 = (v2u*)(Y + (size_t)m1 * D) + lane;
#pragma unroll
        for (int j = 0; j < 8; ++j) { v2u w; w.x = pk2(v0[j].x, v0[j].y); w.y = pk2(v0[j].z, v0[j].w); o0[64 * j] = w; }
        float q0 = 0.f, q1 = 0.f;
        if constexpr (I8) {
            float a0 = 0.f, a1 = 0.f;
#pragma unroll
            for (int j = 0; j < 8; ++j) {
                a0 = fmaxf(a0, fabsf(v0[j][0])); a0 = fmaxf(a0, fabsf(v0[j][1])); a0 = fmaxf(a0, fabsf(v0[j][2])); a0 = fmaxf(a0, fabsf(v0[j][3]));
                a1 = fmaxf(a1, fabsf(v1[j][0])); a1 = fmaxf(a1, fabsf(v1[j][1])); a1 = fmaxf(a1, fabsf(v1[j][2])); a1 = fmaxf(a1, fabsf(v1[j][3])); }
            a0 = wave_max(a0); a1 = wave_max(a1);
            q0 = a0 > 0.f ? 127.0f / a0 : 0.f; q1 = a1 > 0.f ? 127.0f / a1 : 0.f;
            if (lane == 0) { rowscale[m0] = a0 * (1.0f / 127.0f); if (ok1) rowscale[m1] = a1 * (1.0f / 127.0f); }
        }
        if (Y8) {
#pragma unroll
            for (int j = 0; j < 8; ++j) ((unsigned*)(Y8 + (size_t)m0 * D))[lane + 64 * j] = I8 ? pg8::pk4_i8(v0[j].x, v0[j].y, v0[j].z, v0[j].w, q0) : pg8::pk4_fp8(v0[j].x, v0[j].y, v0[j].z, v0[j].w);
        }
        if (ok1) {
#pragma unroll
            for (int j = 0; j < 8; ++j) { v2u w; w.x = pk2(v1[j].x, v1[j].y); w.y = pk2(v1[j].z, v1[j].w); o1[64 * j] = w; }
            if (Y8) {
#pragma unroll
                for (int j = 0; j < 8; ++j) ((unsigned*)(Y8 + (size_t)m1 * D))[lane + 64 * j] = I8 ? pg8::pk4_i8(v1[j].x, v1[j].y, v1[j].z, v1[j].w, q1) : pg8::pk4_fp8(v1[j].x, v1[j].y, v1[j].z, v1[j].w);
            }
        }
    }
}
__device__ __forceinline__ void quant_rows_i8(const bf16* X, const unsigned* rowmax, unsigned char* Y8, float* rowscale) {
    int tid = threadIdx.x; asm volatile("" : "+v"(tid));
    const int lane = tid & 63, gw = blockIdx.x * NWAVES + (tid >> 6), NGW = gridDim.x * NWAVES;
    for (int m0 = gw; m0 < M; m0 += 2 * NGW) {
        const int m1 = m0 + NGW; const bool ok1 = m1 < M; const int mm1 = ok1 ? m1 : m0;
        const v4u* x0 = (const v4u*)(X + (size_t)m0 * D) + 4 * lane; const v4u* x1 = (const v4u*)(X + (size_t)mm1 * D) + 4 * lane;
        v4u a[4], b[4];
#pragma unroll
        for (int j = 0; j < 4; ++j) { a[j] = x0[j]; b[j] = x1[j]; }
        float am0, am1;
        if (rowmax) { am0 = __builtin_bit_cast(float, rowmax[m0]); am1 = __builtin_bit_cast(float, rowmax[mm1]); }
        else {
            float t0 = 0.f, t1 = 0.f;
#pragma unroll
            for (int j = 0; j < 4; ++j) {
                t0 = fmaxf(t0, fmaxf(fmaxf(fabsf(bflo(a[j].x)), fabsf(bfhi(a[j].x))), fmaxf(fabsf(bflo(a[j].y)), fabsf(bfhi(a[j].y))))); t0 = fmaxf(t0, fmaxf(fmaxf(fabsf(bflo(a[j].z)), fabsf(bfhi(a[j].z))), fmaxf(fabsf(bflo(a[j].w)), fabsf(bfhi(a[j].w)))));
                t1 = fmaxf(t1, fmaxf(fmaxf(fabsf(bflo(b[j].x)), fabsf(bfhi(b[j].x))), fmaxf(fabsf(bflo(b[j].y)), fabsf(bfhi(b[j].y))))); t1 = fmaxf(t1, fmaxf(fmaxf(fabsf(bflo(b[j].z)), fabsf(bfhi(b[j].z))), fmaxf(fabsf(bflo(b[j].w)), fabsf(bfhi(b[j].w))))); }
            am0 = wave_max(t0); am1 = wave_max(t1);
        }
        const float q0 = am0 > 0.f ? 127.0f / am0 : 0.f, q1 = am1 > 0.f ? 127.0f / am1 : 0.f;
        if (lane == 0) { rowscale[m0] = am0 * (1.0f / 127.0f); if (ok1) rowscale[m1] = am1 * (1.0f / 127.0f); }
        v4u o0[2], o1[2];
#pragma unroll
        for (int j = 0; j < 4; ++j) {
            const unsigned w0 = pg8::pk4_i8(__builtin_amdgcn_fmed3f(bflo(a[j].x) * q0, -127.f, 127.f), __builtin_amdgcn_fmed3f(bfhi(a[j].x) * q0, -127.f, 127.f), __builtin_amdgcn_fmed3f(bflo(a[j].y) * q0, -127.f, 127.f), __builtin_amdgcn_fmed3f(bfhi(a[j].y) * q0, -127.f, 127.f), 1.0f);
            const unsigned w1 = pg8::pk4_i8(__builtin_amdgcn_fmed3f(bflo(a[j].z) * q0, -127.f, 127.f), __builtin_amdgcn_fmed3f(bfhi(a[j].z) * q0, -127.f, 127.f), __builtin_amdgcn_fmed3f(bflo(a[j].w) * q0, -127.f, 127.f), __builtin_amdgcn_fmed3f(bfhi(a[j].w) * q0, -127.f, 127.f), 1.0f);
            const unsigned w2 = pg8::pk4_i8(__builtin_amdgcn_fmed3f(bflo(b[j].x) * q1, -127.f, 127.f), __builtin_amdgcn_fmed3f(bfhi(b[j].x) * q1, -127.f, 127.f), __builtin_amdgcn_fmed3f(bflo(b[j].y) * q1, -127.f, 127.f), __builtin_amdgcn_fmed3f(bfhi(b[j].y) * q1, -127.f, 127.f), 1.0f);
            const unsigned w3 = pg8::pk4_i8(__builtin_amdgcn_fmed3f(bflo(b[j].z) * q1, -127.f, 127.f), __builtin_amdgcn_fmed3f(bfhi(b[j].z) * q1, -127.f, 127.f), __builtin_amdgcn_fmed3f(bflo(b[j].w) * q1, -127.f, 127.f), __builtin_amdgcn_fmed3f(bfhi(b[j].w) * q1, -127.f, 127.f), 1.0f);
            if (j & 1) { o0[j >> 1].z = w0; o0[j >> 1].w = w1; o1[j >> 1].z = w2; o1[j >> 1].w = w3; } else { o0[j >> 1].x = w0; o0[j >> 1].y = w1; o1[j >> 1].x = w2; o1[j >> 1].y = w3; }
        }
        v4u* y0 = (v4u*)(Y8 + (size_t)m0 * D) + 2 * lane; y0[0] = o0[0]; y0[1] = o0[1];
        if (ok1) { v4u* y1 = (v4u*)(Y8 + (size_t)m1 * D) + 2 * lane; y1[0] = o1[0]; y1[1] = o1[1]; }
    }
}
__device__ __forceinline__ void rmsnorm_rows_bf16(const bf16* X, const float* g, bf16* Y) {
    int tid = threadIdx.x; asm volatile("" : "+v"(tid));
    const int lane = tid & 63, gw = blockIdx.x * NWAVES + (tid >> 6), NGW = gridDim.x * NWAVES;
    f32x4 ga[4], gb[4];
#pragma unroll
    for (int j = 0; j < 4; ++j) { ga[j] = *(const f32x4*)(g + 8 * (lane + 64 * j)); gb[j] = *(const f32x4*)(g + 8 * (lane + 64 * j) + 4); }
    for (int m0 = gw; m0 < M; m0 += 2 * NGW) {
        const int m1 = m0 + NGW; const bool ok1 = m1 < M;
        const v4u* x0 = (const v4u*)(X + (size_t)m0 * D) + lane; const v4u* x1 = (const v4u*)(X + (size_t)(ok1 ? m1 : m0) * D) + lane;
        v4u r0[4], r1[4];
#pragma unroll
        for (int j = 0; j < 4; ++j) { r0[j] = x0[64 * j]; r1[j] = x1[64 * j]; }
        float s0 = 0.f, s1 = 0.f;
#pragma unroll
        for (int j = 0; j < 4; ++j) {
            s0 += (bflo(r0[j].x) * bflo(r0[j].x) + bfhi(r0[j].x) * bfhi(r0[j].x)) + (bflo(r0[j].y) * bflo(r0[j].y) + bfhi(r0[j].y) * bfhi(r0[j].y)) + (bflo(r0[j].z) * bflo(r0[j].z) + bfhi(r0[j].z) * bfhi(r0[j].z)) + (bflo(r0[j].w) * bflo(r0[j].w) + bfhi(r0[j].w) * bfhi(r0[j].w));
            s1 += (bflo(r1[j].x) * bflo(r1[j].x) + bfhi(r1[j].x) * bfhi(r1[j].x)) + (bflo(r1[j].y) * bflo(r1[j].y) + bfhi(r1[j].y) * bfhi(r1[j].y)) + (bflo(r1[j].z) * bflo(r1[j].z) + bfhi(r1[j].z) * bfhi(r1[j].z)) + (bflo(r1[j].w) * bflo(r1[j].w) + bfhi(r1[j].w) * bfhi(r1[j].w));
        }
        const float q0 = rsqrtf(wave_sum(s0) * (1.f / D) + EPS), q1 = rsqrtf(wave_sum(s1) * (1.f / D) + EPS);
        v4u* o0 = (v4u*)(Y + (size_t)m0 * D) + lane; v4u* o1 = (v4u*)(Y + (size_t)m1 * D) + lane;
#pragma unroll
        for (int j = 0; j < 4; ++j) { v4u w; w.x = pk2(bflo(r0[j].x) * q0 * ga[j].x, bfhi(r0[j].x) * q0 * ga[j].y); w.y = pk2(bflo(r0[j].y) * q0 * ga[j].z, bfhi(r0[j].y) * q0 * ga[j].w);
            w.z = pk2(bflo(r0[j].z) * q0 * gb[j].x, bfhi(r0[j].z) * q0 * gb[j].y); w.w = pk2(bflo(r0[j].w) * q0 * gb[j].z, bfhi(r0[j].w) * q0 * gb[j].w); o0[64 * j] = w; }
        if (ok1) {
#pragma unroll
            for (int j = 0; j < 4; ++j) { v4u w; w.x = pk2(bflo(r1[j].x) * q1 * ga[j].x, bfhi(r1[j].x) * q1 * ga[j].y); w.y = pk2(bflo(r1[j].y) * q1 * ga[j].z, bfhi(r1[j].y) * q1 * ga[j].w);
                w.z = pk2(bflo(r1[j].z) * q1 * gb[j].x, bfhi(r1[j].z) * q1 * gb[j].y); w.w = pk2(bflo(r1[j].w) * q1 * gb[j].z, bfhi(r1[j].w) * q1 * gb[j].w); o1[64 * j] = w; }
        }
    }
}

__device__ __forceinline__ void rope_tables(const int* pos, float* cs, float* sn) {
    int tid = threadIdx.x; asm volatile("" : "+v"(tid));
    const int gt = blockIdx.x * NTHREADS + tid, NGT = gridDim.x * NTHREADS;
    for (int i = gt; i < M * 64; i += NGT) {
        const int m = i >> 6, f = i & 63;
        const float inv = powf(10000.f, -(float)(2 * f) / 128.f);
        const float ang = (float)pos[m] * inv;
        cs[i] = cosf(ang); sn[i] = sinf(ang);
    }
}

__device__ __forceinline__ void postproj_naive(const Params& P, bf16* PROJ, const float* cs, const float* sn) {
    int tid = threadIdx.x; asm volatile("" : "+v"(tid));
    const int lane = tid & 63, sub = lane & 15, gw = blockIdx.x * NWAVES + (tid >> 6), NGW = gridDim.x * NWAVES;
    constexpr int NG = M * 12 / 4;
    for (int g0 = gw; g0 < NG; g0 += 2 * NGW) {
        v2u lo[2], hi[2]; f32x4 cv[2], sv[2]; bf16* pp[2]; const float* gp[2]; float qs[2]; bool ok[2];
#pragma unroll
        for (int u = 0; u < 2; ++u) {
            const int g = g0 + u * NGW; ok[u] = g < NG;
            const int task = ok[u] ? 4 * g + (lane >> 4) : 0, m = task / 12, sl = task % 12;
            int col;
            if (sl < 8) { col = C_QN + sl * 128; gp[u] = P.q_norm; } else if (sl < 10) { col = C_KS + (sl - 8) * 128; gp[u] = P.ks_norm; } else { col = C_KW + (sl - 10) * 128; gp[u] = P.kw_norm; }
            qs[u] = sl < 8 ? QSCALE : 1.0f;
            pp[u] = PROJ + (size_t)m * NP + col + 4 * sub;
            lo[u] = *(const v2u*)pp[u]; hi[u] = *(const v2u*)(pp[u] + 64);
            cv[u] = *(const f32x4*)(cs + m * 64 + 4 * sub); sv[u] = *(const f32x4*)(sn + m * 64 + 4 * sub);
        }
#pragma unroll
        for (int u = 0; u < 2; ++u) {
            float a[4], b[4];
            a[0] = bflo(lo[u].x); a[1] = bfhi(lo[u].x); a[2] = bflo(lo[u].y); a[3] = bfhi(lo[u].y);
            b[0] = bflo(hi[u].x); b[1] = bfhi(hi[u].x); b[2] = bflo(hi[u].y); b[3] = bfhi(hi[u].y);
            float ss = (a[0] * a[0] + a[1] * a[1]) + (a[2] * a[2] + a[3] * a[3]) + (b[0] * b[0] + b[1] * b[1]) + (b[2] * b[2] + b[3] * b[3]);
            ss += __shfl_xor(ss, 1); ss += __shfl_xor(ss, 2); ss += __shfl_xor(ss, 4); ss += __shfl_xor(ss, 8);
            const float r = rsqrtf(ss * (1.f / 128.f) + EPS) * qs[u];
            const f32x4 ga = *(const f32x4*)(gp[u] + 4 * sub), gb = *(const f32x4*)(gp[u] + 64 + 4 * sub);
            float oa[4], ob[4];
#pragma unroll
            for (int e = 0; e < 4; ++e) { const float x = a[e] * r * ga[e], y = b[e] * r * gb[e]; oa[e] = x * cv[u][e] - y * sv[u][e]; ob[e] = y * cv[u][e] + x * sv[u][e]; }
            if (ok[u]) { v2u wa, wb; wa.x = pk2(oa[0], oa[1]); wa.y = pk2(oa[2], oa[3]); wb.x = pk2(ob[0], ob[1]); wb.y = pk2(ob[2], ob[3]); *(v2u*)pp[u] = wa; *(v2u*)(pp[u] + 64) = wb; }
        }
    }
}

namespace att {
typedef short bf16x8 __attribute__((ext_vector_type(8)));
typedef short s16x4 __attribute__((ext_vector_type(4)));
constexpr float C1 = 0.08838834764831845f * 1.4426950408889634f;
typedef __bf16 bf16x2_t __attribute__((ext_vector_type(2)));
__device__ __forceinline__ unsigned cvt_pk_bf16(float lo, float hi) { const bf16x2_t v = __builtin_convertvector((f32x2){lo, hi}, bf16x2_t); return __builtin_bit_cast(unsigned, v); }
__device__ __forceinline__ int offK(int key, int dc) { return key * 256 + 16 * (dc ^ ((key & 3) | (((key >> 4) & 3) << 2))); }
__device__ __forceinline__ int offV(int key, int dc) { return key * 256 + 32 * ((dc >> 1) ^ ((key & 3) | (((key >> 4) & 1) << 2))) + 16 * (dc & 1); }
struct TileRegs { v4u k[2], v[2]; };
__device__ __forceinline__ void tile_load(TileRegs& r, const bf16* kp, const bf16* vp, int ld, int tid) {
#if NSA_OPAQUE
    asm volatile("" : "+v"(tid));
#endif
#pragma unroll
    for (int i = 0; i < 2; ++i) { const int id = tid + 512 * i, key = id >> 4, dc = id & 15; r.k[i] = *(const v4u*)(kp + (size_t)key * ld + dc * 8); r.v[i] = *(const v4u*)(vp + (size_t)key * ld + dc * 8); }
}
__device__ __forceinline__ void tile_store(const TileRegs& r, LAS unsigned char* kb, LAS unsigned char* vb, int tid) {
#if NSA_OPAQUE
    asm volatile("" : "+v"(tid));
#endif
#pragma unroll
    for (int i = 0; i < 2; ++i) { const int id = tid + 512 * i, key = id >> 4, dc = id & 15; *(LAS v4u*)(kb + offK(key, dc)) = r.k[i]; *(LAS v4u*)(vb + offV(key, dc)) = r.v[i]; }
}
__device__ __forceinline__ void tile_dma(const bf16* kp, const bf16* vp, int ld, LAS unsigned char* kb, LAS unsigned char* vb, int w, int lane) {
    asm volatile("" : "+v"(lane));
#pragma unroll
    for (int i = 0; i < 2; ++i) {
        const int p = 2 * w + i, key = 4 * p + (lane >> 4), sl = lane & 15;
        const int dck = sl ^ ((key & 3) | (((key >> 4) & 3) << 2));
        const int dcv = 2 * ((sl >> 1) ^ ((key & 3) | (((key >> 4) & 1) << 2))) + (sl & 1);
        __builtin_amdgcn_global_load_lds((const unsigned*)(kp + (size_t)key * ld + dck * 8), (LAS unsigned*)(kb + 1024 * p), 16, 0, 0);
        __builtin_amdgcn_global_load_lds((const unsigned*)(vp + (size_t)key * ld + dcv * 8), (LAS unsigned*)(vb + 1024 * p), 16, 0, 0);
    }
}
__device__ __forceinline__ void dma_k4(const bf16* kp, int ld, LAS unsigned char* kb, int w, int lane) {
    asm volatile("" : "+v"(lane));
#pragma unroll
    for (int i = 0; i < 4; ++i) {
        const int p = 4 * w + i, key = 4 * p + (lane >> 4), sl = lane & 15;
        const int dck = sl ^ ((key & 3) | (((key >> 4) & 3) << 2));
        __builtin_amdgcn_global_load_lds((const unsigned*)(kp + (size_t)key * ld + dck * 8), (LAS unsigned*)(kb + 1024 * p), 16, 0, 0);
    }
}
__device__ __forceinline__ void dma_v4(const bf16* vp, int ld, LAS unsigned char* vb, int w, int lane) {
    asm volatile("" : "+v"(lane));
#pragma unroll
    for (int i = 0; i < 4; ++i) {
        const int p = 4 * w + i, key = 4 * p + (lane >> 4), sl = lane & 15;
        const int dcv = 2 * ((sl >> 1) ^ ((key & 3) | (((key >> 4) & 1) << 2))) + (sl & 1);
        __builtin_amdgcn_global_load_lds((const unsigned*)(vp + (size_t)key * ld + dcv * 8), (LAS unsigned*)(vb + 1024 * p), 16, 0, 0);
    }
}
#define ATT_WAIT_V(n) asm volatile("s_waitcnt vmcnt(" #n ")" ::: "memory")
#define ATT_BAR() do { asm volatile("s_waitcnt lgkmcnt(0)" ::: "memory"); __builtin_amdgcn_s_barrier(); asm volatile("" ::: "memory"); } while (0)
template <bool OPAQUE = true>
__device__ __forceinline__ void qk_tile(f32x4 (&s)[2][4], const bf16x8 (&qf)[2][4], const LAS unsigned char* kb, int c, int q4) {
    if (OPAQUE) asm volatile("" : "+v"(c), "+v"(q4));
    const int rowoff = (16 * (c >> 2) + (c & 3)) * 256, lowp = 16 * (q4 ^ (c & 3));
#pragma unroll
    for (int kt = 0; kt < 4; ++kt) { s[0][kt] = (f32x4){0.f, 0.f, 0.f, 0.f}; s[1][kt] = (f32x4){0.f, 0.f, 0.f, 0.f}; }
#pragma unroll
    for (int ks = 0; ks < 4; ++ks) {
        const int a = rowoff + 64 * (ks ^ (c >> 2)) + lowp;
#pragma unroll
        for (int kt = 0; kt < 4; ++kt) {
            const bf16x8 kf = *(const LAS bf16x8*)(kb + a + kt * 1024);
            s[0][kt] = __builtin_amdgcn_mfma_f32_16x16x32_bf16(kf, qf[0][ks], s[0][kt], 0, 0, 0);
            s[1][kt] = __builtin_amdgcn_mfma_f32_16x16x32_bf16(kf, qf[1][ks], s[1][kt], 0, 0, 0);
        }
    }
}
__device__ __forceinline__ void qk_tile_lq(f32x4 (&s)[2][4], const LAS unsigned char* qb, const LAS unsigned char* kb, int c, int q4, int lane) {
#if NSA_OPAQUE
    asm volatile("" : "+v"(c), "+v"(q4), "+v"(lane));
#endif
    const int rowoff = (16 * (c >> 2) + (c & 3)) * 256, lowp = 16 * (q4 ^ (c & 3));
#pragma unroll
    for (int kt = 0; kt < 4; ++kt) { s[0][kt] = (f32x4){0.f, 0.f, 0.f, 0.f}; s[1][kt] = (f32x4){0.f, 0.f, 0.f, 0.f}; }
#pragma unroll
    for (int ks = 0; ks < 4; ++ks) {
        const int a = rowoff + 64 * (ks ^ (c >> 2)) + lowp;
        const bf16x8 q0 = *(const LAS bf16x8*)(qb + (ks * 64 + lane) * 16), q1 = *(const LAS bf16x8*)(qb + ((4 + ks) * 64 + lane) * 16);
#pragma unroll
        for (int kt = 0; kt < 4; ++kt) {
            const bf16x8 kf = *(const LAS bf16x8*)(kb + a + kt * 1024);
            s[0][kt] = __builtin_amdgcn_mfma_f32_16x16x32_bf16(kf, q0, s[0][kt], 0, 0, 0);
            s[1][kt] = __builtin_amdgcn_mfma_f32_16x16x32_bf16(kf, q1, s[1][kt], 0, 0, 0);
        }
    }
}
__device__ __forceinline__ void pv_tile(f32x4 (&o)[8][2], const bf16x8 (&pf)[2][2], const LAS unsigned char* vb, int c, int q4) {
#if NSA_OPAQUE
    asm volatile("" : "+v"(c), "+v"(q4));
#endif
    const int p = c & 3;
#pragma unroll
    for (int s2 = 0; s2 < 2; ++s2) {
        const int key0 = 16 * q4 + 8 * s2 + (c >> 2);
        const int g = (key0 & 3) | (((key0 >> 4) & 1) << 2);
        const int base = key0 * 256 + 16 * (p >> 1) + 8 * (p & 1);
#pragma unroll
        for (int dt = 0; dt < 8; ++dt) {
            const LAS unsigned char* a0 = vb + base + 32 * (dt ^ g);
            const s16x4 lo = __builtin_amdgcn_ds_read_tr16_b64_v4i16((LAS s16x4*)a0);
            const s16x4 hi = __builtin_amdgcn_ds_read_tr16_b64_v4i16((LAS s16x4*)(a0 + 1024));
            const bf16x8 vf = __builtin_shufflevector(lo, hi, 0, 1, 2, 3, 4, 5, 6, 7);
            o[dt][0] = __builtin_amdgcn_mfma_f32_16x16x32_bf16(vf, pf[0][s2], o[dt][0], 0, 0, 0);
            o[dt][1] = __builtin_amdgcn_mfma_f32_16x16x32_bf16(vf, pf[1][s2], o[dt][1], 0, 0, 0);
        }
    }
}
__device__ __forceinline__ s16x4 tr_read_asm(unsigned addr) { s16x4 r; asm volatile("ds_read_b64_tr_b16 %0, %1" : "=v"(r) : "v"(addr) : "memory"); return r; }
__device__ __forceinline__ s16x4 tr_read_asm_1k(unsigned addr) { s16x4 r; asm volatile("ds_read_b64_tr_b16 %0, %1 offset:1024" : "=v"(r) : "v"(addr) : "memory"); return r; }
template <bool OPAQUE = true>
__device__ __forceinline__ void pv_tile_asm(f32x4 (&o)[8][2], const bf16x8 (&pf)[2][2], const LAS unsigned char* vb, int c, int q4) {
    if (OPAQUE) asm volatile("" : "+v"(c), "+v"(q4));
    const int p = c & 3;
#pragma unroll
    for (int s2 = 0; s2 < 2; ++s2) {
        const int key0 = 16 * q4 + 8 * s2 + (c >> 2);
        const int g = (key0 & 3) | (((key0 >> 4) & 1) << 2);
        const unsigned base = (unsigned)(size_t)vb + key0 * 256 + 16 * (p >> 1) + 8 * (p & 1);
        s16x4 lo[8], hi[8];
#pragma unroll
        for (int dt = 0; dt < 8; ++dt) { const unsigned a0 = base + 32 * (dt ^ g); lo[dt] = tr_read_asm(a0); hi[dt] = tr_read_asm_1k(a0); }
        asm volatile("s_waitcnt lgkmcnt(0)" ::: "memory");
        __builtin_amdgcn_sched_barrier(0);
#pragma unroll
        for (int dt = 0; dt < 8; ++dt) {
            const bf16x8 vf = __builtin_shufflevector(lo[dt], hi[dt], 0, 1, 2, 3, 4, 5, 6, 7);
            o[dt][0] = __builtin_amdgcn_mfma_f32_16x16x32_bf16(vf, pf[0][s2], o[dt][0], 0, 0, 0);
            o[dt][1] = __builtin_amdgcn_mfma_f32_16x16x32_bf16(vf, pf[1][s2], o[dt][1], 0, 0, 0);
        }
    }
}
struct VGroup { s16x4 lo[4], hi[4]; };
template <int G>
__device__ __forceinline__ void pv_issue(VGroup& v, const LAS unsigned char* vb, int c, int q4) {
    constexpr int s2 = G >> 1, d0 = 4 * (G & 1);
    const int p = c & 3, key0 = 16 * q4 + 8 * s2 + (c >> 2), g = (key0 & 3) | (((key0 >> 4) & 1) << 2);
    const unsigned base = (unsigned)(size_t)vb + key0 * 256 + 16 * (p >> 1) + 8 * (p & 1);
#pragma unroll
    for (int i = 0; i < 4; ++i) { const unsigned a0 = base + 32 * ((d0 + i) ^ g); v.lo[i] = tr_read_asm(a0); v.hi[i] = tr_read_asm_1k(a0); }
}
template <int G>
__device__ __forceinline__ void pv_mma(f32x4 (&o)[8][2], const VGroup& v, const bf16x8 (&pf)[2][2]) {
    constexpr int s2 = G >> 1, d0 = 4 * (G & 1);
#pragma unroll
    for (int i = 0; i < 4; ++i) {
        const bf16x8 vf = __builtin_shufflevector(v.lo[i], v.hi[i], 0, 1, 2, 3, 4, 5, 6, 7);
        o[d0 + i][0] = __builtin_amdgcn_mfma_f32_16x16x32_bf16(vf, pf[0][s2], o[d0 + i][0], 0, 0, 0);
        o[d0 + i][1] = __builtin_amdgcn_mfma_f32_16x16x32_bf16(vf, pf[1][s2], o[d0 + i][1], 0, 0, 0);
    }
}
#define PV_WAIT() do { asm volatile("s_waitcnt lgkmcnt(0)" ::: "memory"); __builtin_amdgcn_sched_barrier(0); } while (0)
__device__ __forceinline__ void pv_tile_rest(f32x4 (&o)[8][2], VGroup& va, const bf16x8 (&pf)[2][2], const LAS unsigned char* vb, int c, int q4) {
    VGroup vb2;
    PV_WAIT(); pv_issue<1>(vb2, vb, c, q4); __builtin_amdgcn_sched_barrier(0); pv_mma<0>(o, va, pf);
    PV_WAIT(); pv_issue<2>(va, vb, c, q4);  __builtin_amdgcn_sched_barrier(0); pv_mma<1>(o, vb2, pf);
    PV_WAIT(); pv_issue<3>(vb2, vb, c, q4); __builtin_amdgcn_sched_barrier(0); pv_mma<2>(o, va, pf);
    PV_WAIT(); pv_mma<3>(o, vb2, pf);
}
__device__ __forceinline__ bf16x8 pack8(float a0, float a1, float a2, float a3, float a4, float a5, float a6, float a7) {
    v4u w; w.x = cvt_pk_bf16(a0, a1); w.y = cvt_pk_bf16(a2, a3); w.z = cvt_pk_bf16(a4, a5); w.w = cvt_pk_bf16(a6, a7);
    return __builtin_bit_cast(bf16x8, w);
}


template <bool MASK>
__device__ __forceinline__ void sb_elem(const f32x4 (&s)[4], float& R, bf16x8 (&pf)[2], const int kdiff, const int c, const int q4) {
    f32x2 a2[8]; f32x2 t2 = (f32x2){1.f, 1.f};
#pragma unroll
    for (int k = 0; k < 8; ++k) {
        f32x2 e;
        e.x = __builtin_amdgcn_exp2f(s[k >> 2][k & 3]); e.y = __builtin_amdgcn_exp2f(s[2 + (k >> 2)][k & 3]);
        if (MASK) { e.x = (k < kdiff) ? e.x : 0.f; e.y = (k + 8 < kdiff) ? e.y : 0.f; }
        a2[k] = e * t2; t2 = t2 * (e + 1.0f);
    }
    const float l0 = __builtin_amdgcn_logf(t2.x), l1 = __builtin_amdgcn_logf(t2.y), run = l0 + l1;
    const float u1 = __shfl_down(run, 16), u2 = __shfl_down(run, 32), u3 = __shfl_down(run, 48);
    const float X = (q4 < 3 ? u1 : 0.f) + (q4 < 2 ? u2 : 0.f) + (q4 < 1 ? u3 : 0.f);
    const float tot = __shfl(run + X, c);
    const float base = R + X + l1;
    f32x2 sc; sc.y = __builtin_amdgcn_exp2f(-base); sc.x = __builtin_amdgcn_exp2f(-(base + l0));
    R += tot;
#pragma unroll
    for (int k = 0; k < 8; ++k) a2[k] = a2[k] * sc;
    pf[0] = pack8(a2[0].x, a2[1].x, a2[2].x, a2[3].x, a2[4].x, a2[5].x, a2[6].x, a2[7].x);
    pf[1] = pack8(a2[0].y, a2[1].y, a2[2].y, a2[3].y, a2[4].y, a2[5].y, a2[6].y, a2[7].y);
}

template <int MODE = 31>
__device__ __forceinline__ void sb_unit(const Params& P, LAS unsigned char* lds, const bf16* PROJ, const bf16* KVC, bf16* Y, int b, int h, int tqq) {
    int tid = threadIdx.x; asm volatile("" : "+v"(tid));
    const int lane = tid & 63, w = __builtin_amdgcn_readfirstlane(tid >> 6), c = lane & 15, q4 = lane >> 4;
    const int qbase = 256 * tqq + 32 * w;
    bf16x8 qf[2][4];
#pragma unroll
    for (int qt = 0; qt < 2; ++qt)
#pragma unroll
        for (int ks = 0; ks < 4; ++ks) qf[qt][ks] = *(const bf16x8*)(PROJ + (size_t)(b * SEQ + qbase + 16 * qt + c) * NP + C_QS + h * 128 + 32 * ks + 8 * q4);
#pragma unroll
    for (int qt = 0; qt < 2; ++qt)
#pragma unroll
        for (int ks = 0; ks < 4; ++ks) asm volatile("" : "+v"(qf[qt][ks]));
    f32x4 o[8][2];
#pragma unroll
    for (int dt = 0; dt < 8; ++dt) { o[dt][0] = (f32x4){0.f, 0.f, 0.f, 0.f}; o[dt][1] = (f32x4){0.f, 0.f, 0.f, 0.f}; }
    float R[2] = {0.f, 0.f};
#if SB_COMPACT
    const bf16* kg = KVC + (size_t)((b * 8 + h) * 4096) * 128; const bf16* vg = KVC + (size_t)((32 + b * 8 + h) * 4096) * 128;
    constexpr int KLD = 128;
#else
    const bf16* kg = PROJ + (size_t)(b * SEQ) * NP + C_KSB + h * 128; const bf16* vg = PROJ + (size_t)(b * SEQ) * NP + C_VSB + h * 128;
    constexpr int KLD = NP;
#endif
    const int nkt = 4 * tqq + 4;
    const bool isA = w < 4;
    if (isA && (MODE & 8)) { dma_k4(kg + (size_t)(nkt - 1) * 64 * KLD, KLD, lds, w, lane); dma_v4(vg + (size_t)(nkt - 1) * 64 * KLD, KLD, lds + 32768, w, lane); ATT_WAIT_V(0); }
    ATT_BAR();
    if (!isA) ATT_BAR();
    for (int it = 0; it < nkt; ++it) {
        const int kt64 = nkt - 1 - it, kb0 = 64 * kt64, cur = it & 1;
        const bool has = it + 1 < nkt, active = kb0 <= qbase + 30, need_mask = (kb0 + 63 >= qbase);
        const LAS unsigned char* kb = lds + cur * 16384; const LAS unsigned char* vb = lds + 32768 + cur * 16384;
        f32x4 s[2][4]; bf16x8 pf[2][2];
        if (isA && has && (MODE & 8)) dma_k4(kg + (size_t)(kt64 - 1) * 64 * KLD, KLD, lds + (cur ^ 1) * 16384, w, lane);
        if (active) {
            if (MODE & 1) qk_tile<false>(s, qf, kb, c, q4);
            else {
#pragma unroll
                for (int kt = 0; kt < 4; ++kt) { s[0][kt] = (f32x4){0.1f, -0.2f, 0.3f, R[0]}; s[1][kt] = (f32x4){-0.1f, 0.2f, -0.3f, R[1]}; asm volatile("" : "+v"(s[0][kt]), "+v"(s[1][kt])); } }
            if (MODE & 2) { if (need_mask) sb_elem<true>(s[0], R[0], pf[0], qbase + c - kb0 - 16 * q4, c, q4); else sb_elem<false>(s[0], R[0], pf[0], 64, c, q4); }
            else { pf[0][0] = __builtin_bit_cast(bf16x8, s[0][0]); pf[0][1] = __builtin_bit_cast(bf16x8, s[0][1]); R[0] += s[0][2][0] + s[0][3][1]; }
        }
        if (isA) { if (has) ATT_WAIT_V(4); else ATT_WAIT_V(0); }
        if (MODE & 16) ATT_BAR();
        if (isA && has && (MODE & 8)) dma_v4(vg + (size_t)(kt64 - 1) * 64 * KLD, KLD, lds + 32768 + (cur ^ 1) * 16384, w, lane);
        if (active) {
            VGroup vg0;
            if (MODE & 4) { pv_issue<0>(vg0, vb, c, q4); __builtin_amdgcn_sched_barrier(0); }
            if (MODE & 2) { if (need_mask) sb_elem<true>(s[1], R[1], pf[1], qbase + 16 + c - kb0 - 16 * q4, c, q4); else sb_elem<false>(s[1], R[1], pf[1], 64, c, q4); }
            else { pf[1][0] = __builtin_bit_cast(bf16x8, s[1][0]); pf[1][1] = __builtin_bit_cast(bf16x8, s[1][1]); R[1] += s[1][2][0] + s[1][3][1]; }
            if (MODE & 4) pv_tile_rest(o, vg0, pf, vb, c, q4);
            else { o[0][0] = o[0][0] + __builtin_bit_cast(f32x4, pf[0][0]) + __builtin_bit_cast(f32x4, pf[0][1]); o[0][1] = o[0][1] + __builtin_bit_cast(f32x4, pf[1][0]) + __builtin_bit_cast(f32x4, pf[1][1]); }
        }
        if (isA) { if (has) ATT_WAIT_V(4); else ATT_WAIT_V(0); }
        if (MODE & 16) ATT_BAR();
    }
    if (isA) ATT_BAR();
    f32x4 gsb[8];
#pragma unroll
    for (int dt = 0; dt < 8; ++dt) gsb[dt] = *(const f32x4*)(P.sb_on + h * 128 + 4 * q4 + 16 * dt);
#pragma unroll
    for (int qt = 0; qt < 2; ++qt) {
        float ss = 0.f;
#pragma unroll
        for (int dt = 0; dt < 8; ++dt) { const f32x4 v = o[dt][qt]; ss += (v[0] * v[0] + v[1] * v[1]) + (v[2] * v[2] + v[3] * v[3]); }
        ss += __shfl_xor(ss, 16); ss += __shfl_xor(ss, 32);
        const float r = rsqrtf(ss * (1.f / 128.f) + EPS);
        bf16* yrow = Y + (size_t)(b * SEQ + qbase + 16 * qt + c) * D + 1024 + h * 128 + 4 * q4;
#pragma unroll
        for (int dt = 0; dt < 8; ++dt) { const f32x4 v = o[dt][qt]; const f32x4 gg = gsb[dt];
            v2u wv; wv.x = cvt_pk_bf16(v[0] * r * gg[0], v[1] * r * gg[1]); wv.y = cvt_pk_bf16(v[2] * r * gg[2], v[3] * r * gg[3]);
            *(v2u*)(yrow + 16 * dt) = wv; }
    }
}

__device__ __forceinline__ void osm_step(const f32x4 (&s)[4], const bool bsel, const bool masked, const int lo, const int hi, float& m, float& l, f32x4 (&o)[8][2], const int qt, bf16x8 (&pf)[2]) {
    float v[16];
#pragma unroll
    for (int idx = 0; idx < 16; ++idx) v[idx] = s[idx >> 2][idx & 3];
    if (masked) {
#pragma unroll
        for (int idx = 0; idx < 16; ++idx) v[idx] = (idx >= lo && idx <= hi) ? v[idx] : -1e30f;
    }
    float tm = fmaxf(fmaxf(fmaxf(v[0], v[1]), fmaxf(v[2], v[3])), fmaxf(fmaxf(v[4], v[5]), fmaxf(v[6], v[7])));
    tm = fmaxf(tm, fmaxf(fmaxf(fmaxf(v[8], v[9]), fmaxf(v[10], v[11])), fmaxf(fmaxf(v[12], v[13]), fmaxf(v[14], v[15]))));
    tm = fmaxf(tm, __shfl_xor(tm, 16)); tm = fmaxf(tm, __shfl_xor(tm, 32));
    tm = bsel ? tm : -1e30f;
    const bool grow = tm > m + 8.0f;
    if (__any(grow)) {
        const float mn = grow ? tm : m, alpha = __builtin_amdgcn_exp2f(m - mn);
        l *= alpha; m = mn;
#pragma unroll
        for (int dt = 0; dt < 8; ++dt) o[dt][qt] = o[dt][qt] * alpha;
    }
    const float sub = bsel ? m : 1e30f;
    float sum = 0.f;
#pragma unroll
    for (int idx = 0; idx < 16; ++idx) { v[idx] = __builtin_amdgcn_exp2f(v[idx] - sub); sum += v[idx]; }
    l += sum;
    pf[0] = pack8(v[0], v[1], v[2], v[3], v[4], v[5], v[6], v[7]);
    pf[1] = pack8(v[8], v[9], v[10], v[11], v[12], v[13], v[14], v[15]);
}
#define ATT_TILE_PROLOGUE(KP, VP, LD) do { tile_load(tr, (KP), (VP), (LD), tid); __syncthreads(); tile_store(tr, lds, lds + 32768, tid); __syncthreads(); } while (0)
#define ATT_TILE_NEXT(HAS, KP, VP, LD) do { if (HAS) tile_load(tr, (KP), (VP), (LD), tid); } while (0)
#define ATT_TILE_END(HAS, CUR) do { if (HAS) tile_store(tr, lds + ((CUR) ^ 1) * 16384, lds + 32768 + ((CUR) ^ 1) * 16384, tid); __syncthreads(); } while (0)

__device__ __forceinline__ void nsa_unit(const Params& P, LAS unsigned char* lds, const bf16* PROJ, const bf16* KC, const bf16* VC, bf16* Y, f32x4* scr, int b, int g, int tq) {
    int tid = threadIdx.x; asm volatile("" : "+v"(tid));
    const int lane = tid & 63, w = __builtin_amdgcn_readfirstlane(tid >> 6), c = lane & 15, q4 = lane >> 4;
    const int bg = b * 2 + g, t0 = 64 * tq, hg = g * 4 + (c & 3);
    LAS float* pslc = (LAS float*)(lds + 131072);
    LAS unsigned long long* selm = (LAS unsigned long long*)(lds + 147456);
    LAS unsigned char* qb = lds + 65536 + w * 8192;
    scr += (size_t)w * 32 * 64;
    int ql[2]; ql[0] = 8 * w + (c >> 2); ql[1] = ql[0] + 4;
#pragma unroll
    for (int i = 0; i < 8; ++i) pslc[(8 * w + i) * 64 + lane] = 0.f;
    bf16x8 qf[2][4];
#pragma unroll
    for (int qt = 0; qt < 2; ++qt) {
        const bf16* prow = PROJ + (size_t)(b * SEQ + t0 + ql[qt]) * NP;
#pragma unroll
        for (int ks = 0; ks < 4; ++ks) qf[qt][ks] = *(const bf16x8*)(prow + C_QN + hg * 128 + 32 * ks + 8 * q4);
    }
#pragma unroll
    for (int qt = 0; qt < 2; ++qt)
#pragma unroll
        for (int ks = 0; ks < 4; ++ks) asm volatile("" : "+v"(qf[qt][ks]));
    float gates[2][3];
    {
        bf16 graw[2][3];
#pragma unroll
        for (int qt = 0; qt < 2; ++qt)
#pragma unroll
            for (int br = 0; br < 3; ++br) graw[qt][br] = PROJ[(size_t)(b * SEQ + t0 + ql[qt]) * NP + C_GATE + hg * 3 + br];
#pragma unroll
        for (int qt = 0; qt < 2; ++qt)
#pragma unroll
            for (int br = 0; br < 3; ++br) gates[qt][br] = 1.f / (1.f + __expf(-bf2f(graw[qt][br])));
    }
    TileRegs tr;
    f32x4 o[8][2];
    float mx[2], ls[2];
    const bf16* kcg = KC + (size_t)bg * 256 * 128; const bf16* vcg = VC + (size_t)bg * 256 * 128;
    const int nvmax = min(NCMP, 4 * tq + 3), ntc = (nvmax + 63) >> 6;
    mx[0] = mx[1] = -1e20f; ls[0] = ls[1] = 0.f;
    ATT_TILE_PROLOGUE(kcg, vcg, 128);
    for (int it = 0; it < ntc; ++it) {
        const int cur = it & 1; const bool has = it + 1 < ntc;
        ATT_TILE_NEXT(has, kcg + (size_t)(it + 1) * 64 * 128, vcg + (size_t)(it + 1) * 64 * 128, 128);
        {
            f32x4 s[2][4];
            qk_tile<false>(s, qf, lds + cur * 16384, c, q4);
#pragma unroll
            for (int qt = 0; qt < 2; ++qt) {
                const int lim = t0 + ql[qt] - 31 - 16 * (64 * it + 16 * q4);
                float tm = -1e30f, v[16];
#pragma unroll
                for (int kt = 0; kt < 4; ++kt)
#pragma unroll
                    for (int i = 0; i < 4; ++i) { v[4 * kt + i] = (16 * (4 * kt + i) <= lim) ? s[qt][kt][i] : -1e30f; tm = fmaxf(tm, v[4 * kt + i]); }
                tm = fmaxf(tm, __shfl_xor(tm, 16)); tm = fmaxf(tm, __shfl_xor(tm, 32));
                const float mn = fmaxf(mx[qt], tm); float sum = 0.f;
#pragma unroll
                for (int i = 0; i < 16; ++i) sum += __builtin_amdgcn_exp2f(v[i] - mn);
                ls[qt] = ls[qt] * __builtin_amdgcn_exp2f(mx[qt] - mn) + sum; mx[qt] = mn;
            }
        }
        ATT_TILE_END(has, cur);
    }
    float inv[2];
#pragma unroll
    for (int qt = 0; qt < 2; ++qt) { float l = ls[qt]; l += __shfl_xor(l, 16); l += __shfl_xor(l, 32); inv[qt] = l > 0.f ? 1.f / l : 0.f; }
    float g0v[2]; g0v[0] = gates[0][0]; g0v[1] = gates[1][0];
#pragma unroll
    for (int dt = 0; dt < 8; ++dt) { o[dt][0] = (f32x4){0.f, 0.f, 0.f, 0.f}; o[dt][1] = (f32x4){0.f, 0.f, 0.f, 0.f}; }
    ATT_TILE_PROLOGUE(kcg, vcg, 128);
    for (int it = 0; it < ntc; ++it) {
        const int cur = it & 1; const bool has = it + 1 < ntc;
        ATT_TILE_NEXT(has, kcg + (size_t)(it + 1) * 64 * 128, vcg + (size_t)(it + 1) * 64 * 128, 128);
        {
            f32x4 s[2][4];
            qk_tile<false>(s, qf, lds + cur * 16384, c, q4);
            bf16x8 pf[2][2];
#pragma unroll
            for (int qt = 0; qt < 2; ++qt) {
                const int lim = t0 + ql[qt] - 31 - 16 * (64 * it + 16 * q4);
                float p[16];
#pragma unroll
                for (int kt = 0; kt < 4; ++kt)
#pragma unroll
                    for (int i = 0; i < 4; ++i) p[4 * kt + i] = (16 * (4 * kt + i) <= lim) ? __builtin_amdgcn_exp2f(s[qt][kt][i] - mx[qt]) * inv[qt] : 0.f;
                const int jb = 16 * it + 4 * q4;
#pragma unroll
                for (int kt = 0; kt < 4; ++kt) {
                    float gs = (p[4 * kt] + p[4 * kt + 1]) + (p[4 * kt + 2] + p[4 * kt + 3]), e3 = p[4 * kt + 3];
                    gs += __shfl_xor(gs, 1); gs += __shfl_xor(gs, 2); e3 += __shfl_xor(e3, 1); e3 += __shfl_xor(e3, 2);
                    if ((c & 3) == 0) {
                        LAS float* row = pslc + ql[qt] * 64;
                        __hip_atomic_fetch_add(row + jb + kt, gs, __ATOMIC_RELAXED, __HIP_MEMORY_SCOPE_WORKGROUP);
                        if (jb + kt + 1 < 64) __hip_atomic_fetch_add(row + jb + kt + 1, e3, __ATOMIC_RELAXED, __HIP_MEMORY_SCOPE_WORKGROUP);
                    }
                }
                const float g0 = g0v[qt];
                pf[qt][0] = pack8(p[0] * g0, p[1] * g0, p[2] * g0, p[3] * g0, p[4] * g0, p[5] * g0, p[6] * g0, p[7] * g0);
                pf[qt][1] = pack8(p[8] * g0, p[9] * g0, p[10] * g0, p[11] * g0, p[12] * g0, p[13] * g0, p[14] * g0, p[15] * g0);
            }
            pv_tile(o, pf, lds + 32768 + cur * 16384, c, q4);
        }
        ATT_TILE_END(has, cur);
    }
#pragma unroll
    for (int dt = 0; dt < 8; ++dt) { scr[lane * 32 + 2 * dt] = o[dt][0]; scr[lane * 32 + 2 * dt + 1] = o[dt][1]; }
    asm volatile("s_waitcnt lgkmcnt(0)" ::: "memory");
    {
        unsigned long long wor = 0ull;
        const int j = lane;
        const bool causal = j <= tq, forced = (j == 0) || (j == tq) || (j == tq - 1);
        const unsigned long long cmask = __ballot(causal);
        for (int i = 0; i < 8; ++i) {
            const float pv = pslc[(8 * w + i) * 64 + j];
            const unsigned key = causal ? (forced ? 0xFFFFFFFFu : __float_as_uint(pv) + 1u) : 0u;
            unsigned T = 0u;
#pragma unroll
            for (int bit = 31; bit >= 0; --bit) { const unsigned cand = T | (1u << bit); if (__popcll(__ballot(key >= cand)) >= 16) T = cand; }
            const unsigned long long gt = __ballot(key > T); unsigned long long eq = __ballot(key == T), take = 0ull;
            for (int need = 16 - __popcll(gt); need > 0 && eq != 0ull; --need) { const unsigned long long low = eq & (~eq + 1ull); take |= low; eq ^= low; }
            const unsigned long long mask = (gt | take) & cmask;
            if (lane == 0) selm[8 * w + i] = mask;
            wor |= mask;
        }
        if (lane == 0) selm[64 + w] = wor;
    }
    __syncthreads();
    unsigned long long uni = 0ull;
#pragma unroll
    for (int i = 0; i < 8; ++i) uni |= selm[64 + i];
    uni = ((unsigned long long)__builtin_amdgcn_readfirstlane((unsigned)(uni >> 32)) << 32) | (unsigned long long)__builtin_amdgcn_readfirstlane((unsigned)uni);
    {
#pragma unroll
        for (int dt = 0; dt < 8; ++dt) { o[dt][0] = (f32x4){0.f, 0.f, 0.f, 0.f}; o[dt][1] = (f32x4){0.f, 0.f, 0.f, 0.f}; }
        mx[0] = mx[1] = -1e20f; ls[0] = ls[1] = 0.f;
        const bf16* kg = PROJ + (size_t)(b * SEQ) * NP + C_KS + g * 128; const bf16* vg = PROJ + (size_t)(b * SEQ) * NP + C_VS + g * 128;
        unsigned long long rem = uni;
        int j = __builtin_ctzll(rem); rem &= rem - 1ull;
        ATT_TILE_PROLOGUE(kg + (size_t)j * 64 * NP, vg + (size_t)j * 64 * NP, NP);
        for (int it = 0;; ++it) {
            const int cur = it & 1; const bool has = rem != 0ull;
            const int jn = has ? __builtin_ctzll(rem) : 0; rem &= rem - 1ull;
            ATT_TILE_NEXT(has, kg + (size_t)jn * 64 * NP, vg + (size_t)jn * 64 * NP, NP);
            const bool b0 = (selm[ql[0]] >> j) & 1ull, b1 = (selm[ql[1]] >> j) & 1ull;
            if (__ballot(b0 || b1) != 0ull) {
                f32x4 s[2][4];
                qk_tile<false>(s, qf, lds + cur * 16384, c, q4);
                bf16x8 pf[2][2];
                osm_step(s[0], b0, j == tq, -64, ql[0] - 16 * q4, mx[0], ls[0], o, 0, pf[0]);
                osm_step(s[1], b1, j == tq, -64, ql[1] - 16 * q4, mx[1], ls[1], o, 1, pf[1]);
                pv_tile(o, pf, lds + 32768 + cur * 16384, c, q4);
            }
            ATT_TILE_END(has, cur);
            if (!has) break;
            j = jn;
        }
#pragma unroll
        for (int qt = 0; qt < 2; ++qt) {
            float l = ls[qt]; l += __shfl_xor(l, 16); l += __shfl_xor(l, 32);
            const float cb = gates[qt][1] / l;
#pragma unroll
            for (int dt = 0; dt < 8; ++dt) scr[lane * 32 + 16 + 2 * dt + qt] = o[dt][qt] * cb;
        }
    }
    {
#pragma unroll
        for (int dt = 0; dt < 8; ++dt) { o[dt][0] = (f32x4){0.f, 0.f, 0.f, 0.f}; o[dt][1] = (f32x4){0.f, 0.f, 0.f, 0.f}; }
        mx[0] = mx[1] = -1e20f; ls[0] = ls[1] = 0.f;
        const bf16* kg = PROJ + (size_t)(b * SEQ) * NP + C_KW + g * 128; const bf16* vg = PROJ + (size_t)(b * SEQ) * NP + C_VW + g * 128;
        const int k0 = max(0, tq - 8), nw = tq - k0 + 1;
        ATT_TILE_PROLOGUE(kg + (size_t)k0 * 64 * NP, vg + (size_t)k0 * 64 * NP, NP);
        for (int it = 0; it < nw; ++it) {
            const int cur = it & 1, kt64 = k0 + it; const bool has = it + 1 < nw;
            ATT_TILE_NEXT(has, kg + (size_t)(kt64 + 1) * 64 * NP, vg + (size_t)(kt64 + 1) * 64 * NP, NP);
            {
                f32x4 s[2][4];
                qk_tile<false>(s, qf, lds + cur * 16384, c, q4);
                bf16x8 pf[2][2];
                {
                    const int d0 = ql[0] - 16 * q4, d1 = ql[1] - 16 * q4;
                    const bool first = (kt64 == tq - 8), edge = first || (kt64 == tq);
                    osm_step(s[0], true, edge, first ? d0 + 1 : -64, first ? 64 : d0, mx[0], ls[0], o, 0, pf[0]);
                    osm_step(s[1], true, edge, first ? d1 + 1 : -64, first ? 64 : d1, mx[1], ls[1], o, 1, pf[1]);
                }
                pv_tile(o, pf, lds + 32768 + cur * 16384, c, q4);
            }
            ATT_TILE_END(has, cur);
        }
    }
    f32x4 gns[8];
#pragma unroll
    for (int dt = 0; dt < 8; ++dt) gns[dt] = *(const f32x4*)(P.nsa_on + hg * 128 + 4 * q4 + 16 * dt);
#pragma unroll
    for (int qt = 0; qt < 2; ++qt) {
        float l = ls[qt]; l += __shfl_xor(l, 16); l += __shfl_xor(l, 32);
        const float cb = gates[qt][2] / l;
        float ss = 0.f;
#pragma unroll
        for (int dt = 0; dt < 8; ++dt) { const f32x4 a = (scr[lane * 32 + 2 * dt + qt] + scr[lane * 32 + 16 + 2 * dt + qt]) + o[dt][qt] * cb; o[dt][qt] = a; ss += (a[0] * a[0] + a[1] * a[1]) + (a[2] * a[2] + a[3] * a[3]); if ((dt & 3) == 3) __builtin_amdgcn_sched_barrier(0); }
        ss += __shfl_xor(ss, 16); ss += __shfl_xor(ss, 32);
        const float r = rsqrtf(ss * (1.f / 128.f) + EPS);
        bf16* yrow = Y + (size_t)(b * SEQ + t0 + ql[qt]) * D + hg * 128 + 4 * q4;
#pragma unroll
        for (int dt = 0; dt < 8; ++dt) { const f32x4 v = o[dt][qt]; const f32x4 gg = gns[dt];
            v2u wv; wv.x = cvt_pk_bf16(v[0] * r * gg[0], v[1] * r * gg[1]); wv.y = cvt_pk_bf16(v[2] * r * gg[2], v[3] * r * gg[3]);
            *(v2u*)(yrow + 16 * dt) = wv; if (dt & 1) __builtin_amdgcn_sched_barrier(0); }
    }
    __syncthreads();
}
__device__ __forceinline__ void nsa_phase(const Params& P, LAS unsigned char* lds, const bf16* PROJ, const bf16* KC, const bf16* VC, bf16* Y, f32x4* scratch) {
    for (int i = blockIdx.x; i < 512; i += gridDim.x) {
        const int u = (i < 256) ? i : 767 - i;
        const int tq = 63 - (u >> 3), bg = u & 7;
        nsa_unit(P, lds, PROJ, KC, VC, Y, scratch + (size_t)blockIdx.x * 16384, bg >> 1, bg & 1, tq);
    }
}

__device__ __forceinline__ void compress_unit(const Params& P, LAS unsigned char* lds, const bf16* PROJ, const float* cs, const float* sn, bf16* KC, bf16* VC, int which, int bg, int n0) {
    int tid = threadIdx.x; asm volatile("" : "+v"(tid));
    const int lane = tid & 63, w = __builtin_amdgcn_readfirstlane(tid >> 6), c = lane & 15, q4 = lane >> 4;
    const int b = bg >> 1, g = bg & 1, col = (which ? C_VC : C_KC) + g * 128;
    constexpr int XS = 272;
    __syncthreads();
    for (int i = tid; i < 272 * 8; i += NTHREADS) {
        const int tk = i >> 3, ch = i & 7, s = 16 * n0 + tk;
        v4u lo = (v4u){0u, 0u, 0u, 0u}, hi = (v4u){0u, 0u, 0u, 0u};
        if (s < SEQ) {
            const int m = b * SEQ + s;
            lo = *(const v4u*)(PROJ + (size_t)m * NP + col + 8 * ch); hi = *(const v4u*)(PROJ + (size_t)m * NP + col + 64 + 8 * ch);
            if (!which) {
                const f32x4 c0 = *(const f32x4*)(cs + m * 64 + 8 * ch), c1 = *(const f32x4*)(cs + m * 64 + 8 * ch + 4), s0 = *(const f32x4*)(sn + m * 64 + 8 * ch), s1 = *(const f32x4*)(sn + m * 64 + 8 * ch + 4);
                float a[8], d[8];
                a[0] = bflo(lo.x); a[1] = bfhi(lo.x); a[2] = bflo(lo.y); a[3] = bfhi(lo.y); a[4] = bflo(lo.z); a[5] = bfhi(lo.z); a[6] = bflo(lo.w); a[7] = bfhi(lo.w);
                d[0] = bflo(hi.x); d[1] = bfhi(hi.x); d[2] = bflo(hi.y); d[3] = bfhi(hi.y); d[4] = bflo(hi.z); d[5] = bfhi(hi.z); d[6] = bflo(hi.w); d[7] = bfhi(hi.w);
                float ra[8], rd[8];
#pragma unroll
                for (int e = 0; e < 8; ++e) { const float cc = e < 4 ? c0[e] : c1[e - 4], ss = e < 4 ? s0[e] : s1[e - 4]; ra[e] = a[e] * cc - d[e] * ss; rd[e] = d[e] * cc + a[e] * ss; }
                lo.x = cvt_pk_bf16(ra[0], ra[1]); lo.y = cvt_pk_bf16(ra[2], ra[3]); lo.z = cvt_pk_bf16(ra[4], ra[5]); lo.w = cvt_pk_bf16(ra[6], ra[7]);
                hi.x = cvt_pk_bf16(rd[0], rd[1]); hi.y = cvt_pk_bf16(rd[2], rd[3]); hi.z = cvt_pk_bf16(rd[4], rd[5]); hi.w = cvt_pk_bf16(rd[6], rd[7]);
            }
        }
        *(LAS v4u*)(lds + tk * XS + 16 * ch) = lo; *(LAS v4u*)(lds + tk * XS + 128 + 16 * ch) = hi;
    }
    __syncthreads();
    const bf16* w1t = (const bf16*)(P.ws + (which ? WS_WC1V : WS_WC1K)) + (size_t)(32 * w + c) * 4096 + 8 * q4;
    f32x4 h0 = (f32x4){0.f, 0.f, 0.f, 0.f}, h1 = (f32x4){0.f, 0.f, 0.f, 0.f};
    const LAS unsigned char* xb = lds + (16 * c) * XS + 16 * q4;
#pragma unroll 16
    for (int ks = 0; ks < 128; ++ks) {
        const bf16x8 xf = *(const LAS bf16x8*)(xb + (ks >> 2) * XS + (ks & 3) * 64);
        const bf16x8 a0 = *(const bf16x8*)(w1t + 32 * ks), a1 = *(const bf16x8*)(w1t + 16 * 4096 + 32 * ks);
        h0 = __builtin_amdgcn_mfma_f32_16x16x32_bf16(a0, xf, h0, 0, 0, 0);
        h1 = __builtin_amdgcn_mfma_f32_16x16x32_bf16(a1, xf, h1, 0, 0, 0);
    }
    const float* pb = (const float*)(P.ws + WS_PBIAS + 65536) + which * 256 + 32 * w + 4 * q4;
    const f32x4 pb0 = *(const f32x4*)pb, pb1 = *(const f32x4*)(pb + 16);
    const bf16x8 hf = pack8(gelu_tanh(h0[0] + pb0[0]), gelu_tanh(h0[1] + pb0[1]), gelu_tanh(h0[2] + pb0[2]), gelu_tanh(h0[3] + pb0[3]),
                            gelu_tanh(h1[0] + pb1[0]), gelu_tanh(h1[1] + pb1[1]), gelu_tanh(h1[2] + pb1[2]), gelu_tanh(h1[3] + pb1[3]));
    const bf16* w2t = (const bf16*)(P.ws + (which ? WS_WC2V : WS_WC2K)) + (size_t)c * 256 + 32 * w + 4 * q4;
    __syncthreads();
    LAS float* part = (LAS float*)lds;
#pragma unroll
    for (int dt = 0; dt < 8; ++dt) {
        const v2u wa = *(const v2u*)(w2t + (size_t)(16 * dt) * 256), wb = *(const v2u*)(w2t + (size_t)(16 * dt) * 256 + 16);
        v4u wv; wv.x = wa.x; wv.y = wa.y; wv.z = wb.x; wv.w = wb.y;
        const f32x4 oa = __builtin_amdgcn_mfma_f32_16x16x32_bf16(__builtin_bit_cast(bf16x8, wv), hf, (f32x4){0.f, 0.f, 0.f, 0.f}, 0, 0, 0);
        *(LAS f32x4*)(part + (w * 16 + c) * 128 + 16 * dt + 4 * q4) = oa;
    }
    __syncthreads();
#pragma unroll
    for (int r = 0; r < 2; ++r) {
        const int n = 2 * w + r;
        float a = 0.f, d = 0.f;
#pragma unroll
        for (int ww = 0; ww < 8; ++ww) { a += part[(ww * 16 + n) * 128 + lane]; d += part[(ww * 16 + n) * 128 + 64 + lane]; }
        if (!which) { const float rr = rsqrtf(wave_sum(a * a + d * d) * (1.f / 128.f) + EPS); a = a * rr * P.kc_norm[lane]; d = d * rr * P.kc_norm[lane + 64]; }
        bf16* op = (which ? VC : KC) + ((size_t)bg * 256 + n0 + n) * 128;
        if (n0 + n < NCMP) { op[lane] = (bf16)f2bf(a); op[lane + 64] = (bf16)f2bf(d); } else { op[lane] = 0; op[lane + 64] = 0; }
    }
}
__device__ __forceinline__ void compress_phase(const Params& P, LAS unsigned char* lds, const bf16* PROJ, const float* cs, const float* sn, bf16* KC, bf16* VC) {
    for (int u = blockIdx.x; u < 256; u += gridDim.x) compress_unit(P, lds, PROJ, cs, sn, KC, VC, u >> 7, (u >> 4) & 7, (u & 15) * 16);
    __syncthreads();
}
template <int MODE = 31>
__device__ __forceinline__ void sb_phase(const Params& P, LAS unsigned char* lds, const bf16* PROJ, const bf16* KVC, bf16* Y) {
    for (int i = blockIdx.x; i < 512; i += gridDim.x) {
        const int u = (i < 256) ? i : 767 - i;
        const int tqq = 15 - (u >> 5), bh = u & 31;
        sb_unit<MODE>(P, lds, PROJ, KVC, Y, bh >> 3, bh & 7, tqq);
    }
}
}

__device__ __forceinline__ int row_gate(int n) { return (n >> 7) * 256 + (n & 127); }
__device__ __forceinline__ int row_up(int n) { return (n >> 7) * 256 + 128 + (n & 127); }
__device__ __forceinline__ int row_id(int n) { return n; }
__device__ __forceinline__ int row_win(int oc) { return oc < 2560 ? oc : (oc < 2584 ? oc - 2560 + C_GATE : oc - 24); }
template <int F8 = 0, bool CMROW = false, class RowFn>
__device__ __forceinline__ void transpose_item(const float* W, int K, int N, bf16* WT, RowFn rowfn, LAS float* scr, int item, int lane, const float* kscale = nullptr, const unsigned* cmax = nullptr) {
    const int nblk = (N + 63) / 64, kb = item / nblk, nb = item % nblk, k0 = 64 * kb, n0 = 64 * nb;
    const int nn = n0 + 4 * (lane & 15), kr = lane >> 4;
    f32x4 v[16];
#pragma unroll
    for (int i = 0; i < 16; ++i) v[i] = nn < N ? __builtin_nontemporal_load((const f32x4*)(W + (size_t)(k0 + 4 * i + kr) * N + nn)) : (f32x4){0.f, 0.f, 0.f, 0.f};
#pragma unroll
    for (int i = 0; i < 16; ++i) { if (kscale) v[i] = v[i] * kscale[k0 + 4 * i + kr];
        if (F8 == 1) v[i] = v[i] * pg8::F8_WSCALE;
        LAS float* d = scr + (4 * i + kr) * 65 + 4 * (lane & 15); d[0] = v[i][0]; d[1] = v[i][1]; d[2] = v[i][2]; d[3] = v[i][3]; }
    asm volatile("s_waitcnt lgkmcnt(0)" ::: "memory");
    const int c = lane & 7;
#pragma unroll
    for (int jj = 0; jj < 8; ++jj) { const int n = (lane >> 3) + 8 * jj; const LAS float* s = scr + (8 * c) * 65 + n;
        if constexpr (F8 == 1) { v2u o; o.x = pg8::pk4_fp8(s[0 * 65], s[1 * 65], s[2 * 65], s[3 * 65]); o.y = pg8::pk4_fp8(s[4 * 65], s[5 * 65], s[6 * 65], s[7 * 65]);
            if (n0 + n < N) *(v2u*)((unsigned char*)WT + (size_t)rowfn(n0 + n) * K + k0 + 8 * c) = o; }
        else if constexpr (F8 == 2) { const float cm = n0 + n < N ? __builtin_bit_cast(float, cmax[CMROW ? rowfn(n0 + n) : n0 + n]) : 0.f, q = cm > 0.f ? 127.0f / cm : 0.f;
            v2u o; o.x = pg8::pk4_i8(s[0 * 65], s[1 * 65], s[2 * 65], s[3 * 65], q); o.y = pg8::pk4_i8(s[4 * 65], s[5 * 65], s[6 * 65], s[7 * 65], q);
            if (n0 + n < N) *(v2u*)((unsigned char*)WT + (size_t)rowfn(n0 + n) * K + k0 + 8 * c) = o; }
        else {
        v4u o; o.x = pk2(s[0 * 65], s[1 * 65]); o.y = pk2(s[2 * 65], s[3 * 65]); o.z = pk2(s[4 * 65], s[5 * 65]); o.w = pk2(s[6 * 65], s[7 * 65]);
        if (n0 + n < N) *(v4u*)(WT + (size_t)rowfn(n0 + n) * K + k0 + 8 * c) = o; } }
    asm volatile("s_waitcnt lgkmcnt(0)" ::: "memory");
}
template <class RowFn>
__device__ __forceinline__ void colmax_item(const float* W, int N, const float* kscale, unsigned* cmax, RowFn rowfn, int kb, int strip, int lane) {
    const int n = strip * 256 + 4 * lane, k0 = 64 * kb;
    if (n >= N) return;
    float m0 = 0.f, m1 = 0.f, m2 = 0.f, m3 = 0.f;
#pragma unroll 1
    for (int i0 = 0; i0 < 64; i0 += 16) {
        f32x4 v[16];
#pragma unroll
        for (int i = 0; i < 16; ++i) v[i] = *(const f32x4*)(W + (size_t)(k0 + i0 + i) * N + n);
#pragma unroll
        for (int i = 0; i < 16; ++i) { const float ks = kscale ? kscale[k0 + i0 + i] : 1.0f;
            m0 = fmaxf(m0, fabsf(v[i][0] * ks)); m1 = fmaxf(m1, fabsf(v[i][1] * ks)); m2 = fmaxf(m2, fabsf(v[i][2] * ks)); m3 = fmaxf(m3, fabsf(v[i][3] * ks)); }
    }
    atomicMax(cmax + rowfn(n), __float_as_uint(m0)); atomicMax(cmax + rowfn(n + 1), __float_as_uint(m1)); atomicMax(cmax + rowfn(n + 2), __float_as_uint(m2)); atomicMax(cmax + rowfn(n + 3), __float_as_uint(m3));
}
__device__ __forceinline__ void colmax_phase(const Params& P) {
    int tid = threadIdx.x; asm volatile("" : "+v"(tid));
    const int lane = tid & 63, gw = blockIdx.x * NWAVES + (tid >> 6), NGW = gridDim.x * NWAVES;
    unsigned* cm = (unsigned*)(P.ws + WS_CMAX);
    constexpr int S_GU = FF / 256, I_GU = (D / 64) * S_GU;
    constexpr int S_IN = (IN_COLS + 255) / 256, I_IN = WIN_I8 ? (D / 64) * S_IN : 0;
    constexpr int I_G2 = FFN2_I8 ? 2 * I_GU : 0, S_OUT = D / 256, I_OUT = WOUT_I8 ? (D / 64) * S_OUT : 0;
    for (int it = gw; it < 2 * I_GU + I_IN + I_G2 + I_OUT; it += NGW) {
        if (it >= 2 * I_GU + I_IN + I_G2) { const int r = it - (2 * I_GU + I_IN + I_G2);
            colmax_item(P.w_out, D, nullptr, cm + 4 * FF + NP, row_id, r / S_OUT, r % S_OUT, lane); continue; }
        if (it < 2 * I_GU) { const int mat = it / I_GU, r = it % I_GU;
            colmax_item(mat ? P.ffn1_wu : P.ffn1_wg, FF, FOLD_GAINS ? P.ffn1_norm : nullptr, cm + mat * FF, row_id, r / S_GU, r % S_GU, lane); }
        else if (it >= 2 * I_GU + I_IN) { const int q = it - 2 * I_GU - I_IN, mat = q / I_GU, r = q % I_GU;
            colmax_item(mat ? P.ffn2_wu : P.ffn2_wg, FF, FOLD_GAINS ? P.ffn2_norm : nullptr, cm + 2 * FF + NP + mat * FF, row_id, r / S_GU, r % S_GU, lane); }
        else { const int r = it - 2 * I_GU;
            colmax_item(P.w_in, IN_COLS, FOLD_GAINS ? P.mix_norm : nullptr, cm + 2 * FF, row_win, r / S_IN, r % S_IN, lane); }
    }
}
constexpr int CW_I_GU = (D / 64) * (FF / 64), CW_I_IN = (D / 64) * ((IN_COLS + 63) / 64), CW_I_OUT = (D / 64) * (D / 64), CW_I_C1 = (4096 / 64) * (256 / 64), CW_I_C2 = (256 / 64) * (128 / 64);
constexpr int CW_EARLY = 3 * CW_I_GU + CW_I_IN + CW_I_OUT + 2 * CW_I_C1 + 2 * CW_I_C2, CW_ITEMS = CW_EARLY + 3 * CW_I_GU;
__device__ __forceinline__ void convert_items(const Params& P, LAS unsigned char* lds, int lo, int hi, int gw, int NGW) {
    unsigned char* ws = P.ws;
    int tid = threadIdx.x; asm volatile("" : "+v"(tid));
    const int lane = tid & 63, wave = tid >> 6;
    LAS float* scr = (LAS float*)(lds + wave * 16640);
    constexpr int I_GU = CW_I_GU, I_DN = CW_I_GU, I_IN = CW_I_IN, I_OUT = CW_I_OUT, I_C1 = CW_I_C1, I_C2 = CW_I_C2;
    for (int it = lo + gw; it < hi; it += NGW) {
        int r = it;
        if (r < I_GU) { transpose_item<FFN1_I8 ? 2 : (FFN1_FP8 != 0)>(P.ffn1_wg, D, FF, (bf16*)(ws + WS_W1GU), row_gate, scr, r, lane, FOLD_GAINS ? P.ffn1_norm : nullptr, (const unsigned*)(ws + WS_CMAX)); continue; } r -= I_GU;
        if (r < I_GU) { transpose_item<FFN1_I8 ? 2 : (FFN1_FP8 != 0)>(P.ffn1_wu, D, FF, (bf16*)(ws + WS_W1GU), row_up, scr, r, lane, FOLD_GAINS ? P.ffn1_norm : nullptr, (const unsigned*)(ws + WS_CMAX) + FF); continue; } r -= I_GU;
        if (r < I_DN) { transpose_item<(FFN1_FP8 == 2) ? 1 : 0>(P.ffn1_wd, FF, D, (bf16*)(ws + WS_W1D), row_id, scr, r, lane); continue; } r -= I_DN;
        if (r < I_IN) { transpose_item<WIN_I8 ? 2 : 0, true>(P.w_in, D, IN_COLS, (bf16*)(ws + WS_WIN), row_win, scr, r, lane, FOLD_GAINS ? P.mix_norm : nullptr, (const unsigned*)(ws + WS_CMAX) + 2 * FF); continue; } r -= I_IN;
        if (r < I_OUT) { transpose_item<WOUT_I8 ? 2 : 0>(P.w_out, D, D, (bf16*)(ws + WS_WOUT), row_id, scr, r, lane, nullptr, (const unsigned*)(ws + WS_CMAX) + 4 * FF + NP); continue; } r -= I_OUT;
        if (r < I_C1) { transpose_item(P.ck_w1, 4096, 256, (bf16*)(ws + WS_WC1K), row_id, scr, r, lane); continue; } r -= I_C1;
        if (r < I_C1) { transpose_item(P.cv_w1, 4096, 256, (bf16*)(ws + WS_WC1V), row_id, scr, r, lane); continue; } r -= I_C1;
        if (r < I_C2) { transpose_item(P.ck_w2, 256, 128, (bf16*)(ws + WS_WC2K), row_id, scr, r, lane); continue; } r -= I_C2;
        if (r < I_C2) { transpose_item(P.cv_w2, 256, 128, (bf16*)(ws + WS_WC2V), row_id, scr, r, lane); continue; } r -= I_C2;
        if (r < I_GU) { transpose_item<FFN2_I8 ? 2 : ((FFN2_FP8 != 0) ? 1 : 0)>(P.ffn2_wg, D, FF, (bf16*)(ws + WS_W2GU), row_gate, scr, r, lane, FOLD_GAINS ? P.ffn2_norm : nullptr, (const unsigned*)(ws + WS_CMAX) + 2 * FF + NP); continue; } r -= I_GU;
        if (r < I_GU) { transpose_item<FFN2_I8 ? 2 : ((FFN2_FP8 != 0) ? 1 : 0)>(P.ffn2_wu, D, FF, (bf16*)(ws + WS_W2GU), row_up, scr, r, lane, FOLD_GAINS ? P.ffn2_norm : nullptr, (const unsigned*)(ws + WS_CMAX) + 3 * FF + NP); continue; } r -= I_GU;
        transpose_item<(FFN2_FP8 != 0) ? 1 : 0>(P.ffn2_wd, FF, D, (bf16*)(ws + WS_W2D), row_id, scr, r, lane);
    }
}
__device__ __forceinline__ void convert_weights(const Params& P, LAS unsigned char* lds) {
    unsigned char* ws = P.ws;
    convert_items(P, lds, 0, TAIL_CONVERT ? CW_EARLY : CW_ITEMS, blockIdx.x * NWAVES + (threadIdx.x >> 6), gridDim.x * NWAVES);
    if (blockIdx.x < 32) {
        const int which = blockIdx.x >> 4, part = (blockIdx.x & 15) * 2 + (threadIdx.x >> 8), j = threadIdx.x & 255;
        const float* pos = which ? P.cv_pos : P.ck_pos; const float* w1 = which ? P.cv_w1 : P.ck_w1;
        float a = 0.f;
#pragma unroll 32
        for (int k = 128 * part; k < 128 * part + 128; ++k) a += pos[k] * w1[(size_t)k * 256 + j];
        ((float*)(ws + WS_PBIAS))[(which * 32 + part) * 256 + j] = a;
    }
    { v4u* z = (v4u*)(ws + WS_WIN + (size_t)IN_COLS * D * (WIN_I8 ? 1 : 2)); const int n16 = (NP - IN_COLS) * D / (WIN_I8 ? 16 : 8);
      for (int i = blockIdx.x * NTHREADS + threadIdx.x; i < n16; i += gridDim.x * NTHREADS) z[i] = (v4u){0u, 0u, 0u, 0u}; }
}

__global__ void __launch_bounds__(NTHREADS, 2) fwd_kernel(Params P) {
    extern __shared__ __attribute__((aligned(16))) unsigned char lds_raw[];
    LAS unsigned char* lds = (LAS unsigned char*)lds_raw;
    const int tid = threadIdx.x;
    for (int u = tid; u < (LDS_BYTES - LDSCTL_OFF) / 4; u += NTHREADS) ((LAS unsigned*)(lds + LDSCTL_OFF))[u] = 0u;
    __syncthreads();
    unsigned char* ws = P.ws;
    XcdBarrier bar = xcd_barrier_post((unsigned*)(ws + WS_CTL) + CW_BAR, (volatile LAS unsigned*)(lds + LDSCTL_OFF + 64));
    bf16* HB = (bf16*)(ws + WS_HB); bf16* BIG = (bf16*)(ws + WS_BIG);
    float* cs = (float*)(ws + WS_COS); float* sn = (float*)(ws + WS_SIN);
    bf16* KC = (bf16*)(ws + WS_KC); bf16* VC = (bf16*)(ws + WS_VC);
    float* XR = P.out;
    bf16* X1B = (bf16*)P.out;
    bf16* X2B = (bf16*)(ws + WS_W1GU);
    unsigned char* X0F8 = ws + WS_SCR + ((size_t)32 << 20);
    unsigned char* X2F8 = ws + WS_SCR;
    float* PART = (float*)(ws + WS_PART);
    float* PART2 = (float*)(ws + WS_PART + (size_t)M * 8);
    float* PART0 = (float*)(ws + WS_PART + (size_t)M * 16);
    float* XS2 = (float*)(ws + WS_PART + (size_t)M * 32); unsigned* RMAX2 = (unsigned*)(ws + WS_RMAX) + M;
    float* XSY = (float*)(ws + WS_PART + (size_t)M * 36); unsigned char* YI8 = ws + WS_SCR + ((size_t)32 << 20);
    float* XS1 = (float*)(ws + WS_PART + (size_t)M * 28);
    unsigned* RMAX1 = (unsigned*)(ws + WS_RMAX); unsigned char* X1I8 = ws + WS_SCR;
    float* XS0 = (float*)(ws + WS_PART + (size_t)M * 24);
    PG8_LAS float* RS = (PG8_LAS float*)(lds + 131072);

#define REP(n) _Pragma("unroll") for (int rep_ = 0; rep_ < (n); ++rep_)
#if FOLD_GAINS
#if FFN1_I8
    rope_tables(P.pos, cs, sn); cast_rows<true>(P.x, HB, (unsigned long long*)PART0, X0F8, XS0); colmax_phase(P);
    xcd_barrier(bar);
    convert_weights(P, lds);
#else
    REP(REP_P0) { rope_tables(P.pos, cs, sn); cast_rows(P.x, HB, (unsigned long long*)PART0, FFN1_FP8 ? X0F8 : nullptr); convert_weights(P, lds); }
#endif
#else
    REP(REP_P0) { rope_tables(P.pos, cs, sn); rmsnorm_rows(P.x, P.ffn1_norm, HB); convert_weights(P, lds); }
#endif
#if FUSE_NORMS || FOLD_GAINS
    for (int i = blockIdx.x * NTHREADS + tid; i < 2 * M; i += gridDim.x * NTHREADS) ((unsigned long long*)PART)[i] = 0ull;
#endif
    xcd_barrier(bar);
#if PROBE_P1K
    for (int pass = 0; pass < 2; ++pass) {
        pg8::Gemm g{HB, (const bf16*)(ws + WS_W1GU), M, 2 * FF, D, pass == 0 ? (PROBE_P1K >= 4 ? PROBE_P1K - 4 : PROBE_P1K - 1) : 0}; pg8::StaticOrder S; S.init(M, 2 * FF, gridDim.x, (int)blockIdx.x); S.zero = (pass == 0 && PROBE_P1K >= 4);
        if (FOLD_GAINS) pg8::row_factor_table(RS, PART0, S);
        pg8::EpiSwiglu E{BIG, FF, FOLD_GAINS ? PART0 : nullptr, RS};
        pg8::gemm_phase<pg8::EpiSwiglu, pg8::StaticOrder, true, true>(lds, g, S, E);
        if (pass == 0) xcd_barrier(bar);
    }
#else
    REP(REP_P1) {
#if FFN1_FP8
        pg8::Gemm g{(const bf16*)X0F8, (const bf16*)(ws + WS_W1GU), M, 2 * FF, D / 2}; pg8::StaticOrder S; S.init(M, 2 * FF, gridDim.x, (int)blockIdx.x);
#if FFN1_I8
        pg8::row_factor_table(RS, PART0, S, XS0);
        pg8::EpiSwigluT<true, FFN1_FP8 == 2, true> E{BIG, FF, PART0, RS, (const float*)(ws + WS_CMAX)};
        pg8::gemm_phase<pg8::EpiSwigluT<true, FFN1_FP8 == 2, true>, pg8::StaticOrder, true, true, false, true>(lds, g, S, E);
#else
        pg8::row_factor_table(RS, PART0, S);
        pg8::EpiSwigluT<true, FFN1_FP8 == 2> E{BIG, FF, PART0, RS};
        pg8::gemm_phase<pg8::EpiSwigluT<true, FFN1_FP8 == 2>, pg8::StaticOrder, true, true, true>(lds, g, S, E);
#endif
#else
        pg8::Gemm g{HB, (const bf16*)(ws + WS_W1GU), M, 2 * FF, D}; pg8::StaticOrder S; S.init(M, 2 * FF, gridDim.x, (int)blockIdx.x);
        if (FOLD_GAINS) pg8::row_factor_table(RS, PART0, S);
        pg8::EpiSwiglu E{BIG, FF, FOLD_GAINS ? PART0 : nullptr, RS};
        pg8::gemm_phase<pg8::EpiSwiglu, pg8::StaticOrder, true, true>(lds, g, S, E);
#endif
    }
#endif
    xcd_barrier(bar);
    REP(REP_P2) {
        pg8::Gemm g{BIG, (const bf16*)(ws + WS_W1D), M, D, FFN1_FP8 == 2 ? FF / 2 : FF}; pg8::StaticOrder S; S.init(M, D, gridDim.x, (int)blockIdx.x);
#if FUSE_NORMS
        pg8::EpiResid E{P.x, XR, D, 0.5f, HB, P.mix_norm, PART};
#else
        pg8::EpiResidMix<FOLD_GAINS != 0, true> E{FOLD_GAINS ? (const void*)HB : (const void*)P.x, X1B, D, FFN1_FP8 == 2 ? 0.5f / (pg8::F8_WSCALE * pg8::F8_HSCALE) : 0.5f, FOLD_GAINS ? (unsigned long long*)PART : nullptr};
#endif
        pg8::gemm_phase<pg8::EpiResidMix<FOLD_GAINS != 0, true>, pg8::StaticOrder, true, true, FFN1_FP8 == 2>(lds, g, S, E);
    }
    xcd_barrier(bar);
    if (blockIdx.x == gridDim.x - 1) { const float* pp = (const float*)(ws + WS_PBIAS); const int which = tid >> 8, j = tid & 255; float t[32];
#pragma unroll
        for (int part = 0; part < 32; ++part) t[part] = pp[(which * 32 + part) * 256 + j];
        float a = 0.f;
#pragma unroll
        for (int part = 0; part < 32; ++part) a += t[part];
        ((float*)(ws + WS_PBIAS + 65536))[tid] = a; }
#if !FUSE_NORMS && !FOLD_GAINS
    rmsnorm_rows_bf16(X1B, P.mix_norm, HB);
    xcd_barrier(bar);
#endif
#if WIN_I8
    quant_rows_i8(X1B, nullptr, X1I8, XS1);
    xcd_barrier(bar);
#endif
    REP(REP_P4) {
#if WIN_I8
        pg8::Gemm g{(const bf16*)X1I8, (const bf16*)(ws + WS_WIN), M, NP, D / 2}; pg8::StaticOrder S; S.init(M, NP, gridDim.x, (int)blockIdx.x);
        pg8::row_factor_table(RS, PART, S, XS1);
        pg8::EpiStoreBf16T<true> E{BIG, NP, C_QS / 256, (C_QS + 1024) / 256, att::C1, PART, RS, (bf16*)(ws + WS_W1GU), 0, 0, (const float*)(ws + WS_CMAX) + 2 * FF};
        pg8::gemm_phase<pg8::EpiStoreBf16T<true>, pg8::StaticOrder, true, true, false, true>(lds, g, S, E);
#else
        pg8::Gemm g{FOLD_GAINS ? (const bf16*)X1B : (const bf16*)HB, (const bf16*)(ws + WS_WIN), M, NP, D}; pg8::StaticOrder S; S.init(M, NP, gridDim.x, (int)blockIdx.x);
        if (FUSE_NORMS || FOLD_GAINS) pg8::row_factor_table(RS, PART, S);
        pg8::EpiStoreBf16 E{BIG, NP, C_QS / 256, (C_QS + 1024) / 256, att::C1, (FUSE_NORMS || FOLD_GAINS) ? PART : nullptr, RS, (bf16*)(ws + WS_W1GU), SB_COMPACT ? C_KSB / 256 : 0, SB_COMPACT ? (C_VSB + 1024) / 256 : 0};
        pg8::gemm_phase<pg8::EpiStoreBf16, pg8::StaticOrder, true, true>(lds, g, S, E);
#endif
#if TAIL_CONVERT
        {
            const int G = (int)gridDim.x, rem = S.nwg % G;
            if (rem == 0) convert_items(P, lds, CW_EARLY, CW_ITEMS, (int)blockIdx.x * NWAVES + (tid >> 6), G * NWAVES);
            else if ((int)blockIdx.x >= rem) convert_items(P, lds, CW_EARLY, CW_ITEMS, ((int)blockIdx.x - rem) * NWAVES + (tid >> 6), (G - rem) * NWAVES);
        }
#endif
    }
    xcd_barrier(bar);
    postproj_naive(P, BIG, cs, sn);
    REP(REP_CMP) att::compress_phase(P, lds, BIG, cs, sn, KC, VC);
    xcd_barrier(bar);
    REP(REP_NSA) att::nsa_phase(P, lds, BIG, KC, VC, HB, (f32x4*)(ws + WS_SCR));
    REP(REP_SB) att::sb_phase(P, lds, BIG, (const bf16*)(ws + WS_W1GU), HB);
    xcd_barrier(bar);
#if WOUT_I8
    quant_rows_i8(HB, nullptr, YI8, XSY);
    xcd_barrier(bar);
    {
        pg8::Gemm g{(const bf16*)YI8, (const bf16*)(ws + WS_WOUT), M, D, D / 2}; pg8::StaticOrder S; S.init(M, D, gridDim.x, (int)blockIdx.x);
        pg8::row_factor_table(RS, nullptr, S, XSY);
        pg8::EpiResidMix<true, true, true> E{X1B, X2B, D, 1.0f, (unsigned long long*)PART2, nullptr, nullptr, RS, (const float*)(ws + WS_CMAX) + 4 * FF + NP};
        pg8::gemm_phase<pg8::EpiResidMix<true, true, true>, pg8::StaticOrder, true, true, false, true>(lds, g, S, E);
    }
#else
    {
        pg8::Gemm g{HB, (const bf16*)(ws + WS_WOUT), M, D, D}; pg8::StaticOrder S; S.init(M, D, gridDim.x, (int)blockIdx.x);
#if FUSE_NORMS
        pg8::EpiResid E{XR, XR, D, 1.0f, (bf16*)(ws + WS_W1GU), P.ffn2_norm, PART2};
#else
        pg8::EpiResidMix<true, true> E{X1B, X2B, D, 1.0f, FOLD_GAINS ? (unsigned long long*)PART2 : nullptr, (FFN2_FP8 && !FFN2_I8) ? X2F8 : nullptr, FFN2_I8 ? RMAX2 : nullptr};
#endif
        pg8::gemm_phase<pg8::EpiResidMix<true, true>, pg8::StaticOrder, true, true>(lds, g, S, E);
    }
#endif
    xcd_barrier(bar);
#if !FUSE_NORMS && !FOLD_GAINS
    rmsnorm_rows_bf16(X2B, P.ffn2_norm, HB);
    xcd_barrier(bar);
#endif
#if FFN2_I8
    quant_rows_i8(X2B, nullptr, X2F8, XS2);
    xcd_barrier(bar);
#endif
    REP(REP_P9) {
#if FFN2_I8
        pg8::Gemm g{(const bf16*)X2F8, (const bf16*)(ws + WS_W2GU), M, 2 * FF, D / 2}; pg8::StaticOrder S; S.init(M, 2 * FF, gridDim.x, (int)blockIdx.x);
        pg8::row_factor_table(RS, PART2, S, XS2);
        pg8::EpiSwigluT<true, true, true> E{BIG, FF, PART2, RS, (const float*)(ws + WS_CMAX) + 2 * FF + NP};
        pg8::gemm_phase<pg8::EpiSwigluT<true, true, true>, pg8::StaticOrder, true, true, false, true>(lds, g, S, E);
#elif FFN2_FP8
        pg8::Gemm g{(const bf16*)X2F8, (const bf16*)(ws + WS_W2GU), M, 2 * FF, D / 2}; pg8::StaticOrder S; S.init(M, 2 * FF, gridDim.x, (int)blockIdx.x);
        pg8::row_factor_table(RS, PART2, S);
        pg8::EpiSwigluT<true> E{BIG, FF, PART2, RS};
        pg8::gemm_phase<pg8::EpiSwigluT<true>, pg8::StaticOrder, true, true, true>(lds, g, S, E);
#else
        pg8::Gemm g{(FUSE_NORMS || FOLD_GAINS) ? (const bf16*)(ws + WS_W1GU) : (const bf16*)HB, (const bf16*)(ws + WS_W2GU), M, 2 * FF, D}; pg8::StaticOrder S; S.init(M, 2 * FF, gridDim.x, (int)blockIdx.x);
        if (FUSE_NORMS || FOLD_GAINS) pg8::row_factor_table(RS, PART2, S);
        pg8::EpiSwiglu E{BIG, FF, (FUSE_NORMS || FOLD_GAINS) ? PART2 : nullptr, RS};
        pg8::gemm_phase<pg8::EpiSwiglu, pg8::StaticOrder, true, true>(lds, g, S, E);
#endif
    }
    xcd_barrier(bar);
    REP(REP_P10) {
#if FFN2_FP8
        pg8::Gemm g{BIG, (const bf16*)(ws + WS_W2D), M, D, FF / 2}; pg8::StaticOrder S; S.init(M, D, gridDim.x, (int)blockIdx.x);
        pg8::EpiResidMix<true, false> E{X2B, XR, D, 0.5f / (pg8::F8_WSCALE * pg8::F8_HSCALE), nullptr};
        pg8::gemm_phase<pg8::EpiResidMix<true, false>, pg8::StaticOrder, true, true, true>(lds, g, S, E);
#else
        pg8::Gemm g{BIG, (const bf16*)(ws + WS_W2D), M, D, FF}; pg8::StaticOrder S; S.init(M, D, gridDim.x, (int)blockIdx.x);
        pg8::EpiResidMix<true, false> E{X2B, XR, D, 0.5f, nullptr};
        pg8::gemm_phase<pg8::EpiResidMix<true, false>, pg8::StaticOrder, true, true>(lds, g, S, E);
#endif
    }
#if PROBE_PP
    xcd_barrier(bar);
    postproj_naive(P, BIG, cs, sn);
#endif
#if PROBE_SB_MODE
    __syncthreads();
    att::sb_phase<PROBE_SB_MODE>(P, lds, BIG, (const bf16*)(ws + WS_SB_DUMMY_KV), (bf16*)(ws + WS_HB));
#endif
}

extern "C" void kernel_launch(void* const* d_in, const int* in_sizes, int n_in, void* d_out, int out_size, void* d_ws, size_t ws_size, hipStream_t stream) {
    static int grid = 0;
    if (grid == 0) {
        if (n_in != 25 || out_size != M * D || ws_size < WS_END) { fprintf(stderr, "kernel_launch: unexpected shapes: n_in %d out %d ws %zu\n", n_in, out_size, ws_size); grid = -1; return; }
        int dev = 0, cus = 0, per_cu = 0;
        hipGetDevice(&dev); hipDeviceGetAttribute(&cus, hipDeviceAttributeMultiprocessorCount, dev);
        if (hipFuncSetAttribute((const void*)fwd_kernel, hipFuncAttributeMaxDynamicSharedMemorySize, LDS_BYTES) != hipSuccess) { fprintf(stderr, "kernel_launch: hipFuncSetAttribute failed\n"); grid = -1; return; }
        hipOccupancyMaxActiveBlocksPerMultiprocessor(&per_cu, (const void*)fwd_kernel, NTHREADS, LDS_BYTES);
        (void)hipGetLastError();
        if (per_cu < 1) fprintf(stderr, "kernel_launch: occupancy query says %d\n", per_cu);
        grid = cus;
    }
    if (grid < 0) return;
    hipMemsetAsync((char*)d_ws + WS_CTL, 0, CTL_ZERO_BYTES, stream);
    Params p{};
    p.x = (const float*)d_in[0]; p.pos = (const int*)d_in[1];
    p.ffn1_norm = (const float*)d_in[2]; p.ffn1_wg = (const float*)d_in[3]; p.ffn1_wu = (const float*)d_in[4]; p.ffn1_wd = (const float*)d_in[5];
    p.mix_norm = (const float*)d_in[6]; p.w_in = (const float*)d_in[7]; p.q_norm = (const float*)d_in[8]; p.kc_norm = (const float*)d_in[9];
    p.ks_norm = (const float*)d_in[10]; p.kw_norm = (const float*)d_in[11]; p.ck_pos = (const float*)d_in[12]; p.ck_w1 = (const float*)d_in[13];
    p.ck_w2 = (const float*)d_in[14]; p.cv_pos = (const float*)d_in[15]; p.cv_w1 = (const float*)d_in[16]; p.cv_w2 = (const float*)d_in[17];
    p.nsa_on = (const float*)d_in[18]; p.sb_on = (const float*)d_in[19]; p.w_out = (const float*)d_in[20]; p.ffn2_norm = (const float*)d_in[21];
    p.ffn2_wg = (const float*)d_in[22]; p.ffn2_wu = (const float*)d_in[23]; p.ffn2_wd = (const float*)d_in[24];
    p.out = (float*)d_out; p.ws = (unsigned char*)d_ws;
    hipLaunchKernelGGL(fwd_kernel, dim3(grid), dim3(NTHREADS), LDS_BYTES, stream, p);
}
```
